# Optimizing an MI355X kernel written in HIP

```python
import jax, jax.numpy as jnp
from jax import lax
import numpy as np

D_MODEL = 2048
BATCH = 4
SEQ = 2048
DEPTH = 1

GRID_W = 64
CTX_LEN = 256
HEAD_DIM = 128
N_Q_HEADS = 12
N_KV_HEADS = 4
Q_PER_KV = N_Q_HEADS // N_KV_HEADS
N_FOURIER_GROUPS = 4
FOURIER_GROUP_DIM = 128
ATTN_WIDTH = N_Q_HEADS * HEAD_DIM
KV_WIDTH = N_KV_HEADS * HEAD_DIM
FOURIER_WIDTH = N_FOURIER_GROUPS * FOURIER_GROUP_DIM
IN_WIDTH = ATTN_WIDTH + 2 * KV_WIDTH + FOURIER_WIDTH
MIX_WIDTH = ATTN_WIDTH + FOURIER_WIDTH
D_FF = 4 * D_MODEL
Q_BLOCK = 128
ROPE_THETA = 10000.0
ROPE_AXIS_DIM = HEAD_DIM // 2
N_MOD = 6
EPS = 1e-6

kernel_name = "hybrid_gqa_fourier_dit_prefix_layer"


def rmsnorm(x, g):
    xf = x.astype(jnp.float32)
    y = xf * lax.rsqrt(jnp.mean(xf * xf, axis=-1, keepdims=True) + EPS)
    return (y * g.astype(jnp.float32)).astype(x.dtype)


def modulate(h, shift, scale):
    return h * (1.0 + scale) + shift


def axial_rope_tables(rows):
    t = jnp.arange(rows * GRID_W)
    row = (t // GRID_W).astype(jnp.float32)
    col = (t % GRID_W).astype(jnp.float32)
    inv = ROPE_THETA ** (-jnp.arange(0, ROPE_AXIS_DIM, 2, dtype=jnp.float32) / ROPE_AXIS_DIM)
    ang_r = row[:, None, None] * inv
    ang_c = col[:, None, None] * inv
    return (jnp.cos(ang_r), jnp.sin(ang_r), jnp.cos(ang_c), jnp.sin(ang_c))


def rotate(x, cos, sin):
    half = x.shape[-1] // 2
    x1, x2 = x[..., :half], x[..., half:]
    return jnp.concatenate([x1 * cos - x2 * sin, x2 * cos + x1 * sin], axis=-1)


def apply_axial_rope(x, tabs):
    cr, sr, cc, sc = tabs
    xf = x.astype(jnp.float32)
    y = jnp.concatenate([rotate(xf[..., :ROPE_AXIS_DIM], cr, sr),
                         rotate(xf[..., ROPE_AXIS_DIM:], cc, sc)], axis=-1)
    return y.astype(x.dtype)


def heads(t, n):
    return t.reshape(t.shape[:-1] + (n, HEAD_DIM))


def gqa_scores_out(qblk, k_f, v_f):
    s = jnp.einsum('bqkgd,bnkd->bkgqn', qblk.astype(jnp.float32), k_f) * (HEAD_DIM ** -0.5)
    p = jax.nn.softmax(s, axis=-1)
    return jnp.einsum('bkgqn,bnkd->bqkgd', p, v_f)


def latent_attention(q, k, v, kc, vc):
    B, S = q.shape[0], q.shape[1]
    nblk = S // Q_BLOCK
    k_f = jnp.concatenate([kc, k], axis=1).astype(jnp.float32)
    v_f = jnp.concatenate([vc, v], axis=1).astype(jnp.float32)
    qb = q.reshape(B, nblk, Q_BLOCK, N_KV_HEADS, Q_PER_KV, HEAD_DIM)
    qb = jnp.moveaxis(qb, 1, 0)
    out = lax.map(lambda qblk: gqa_scores_out(qblk, k_f, v_f), qb)
    out = jnp.moveaxis(out, 0, 1).reshape(B, S, ATTN_WIDTH)
    return out.astype(q.dtype)


def context_attention(qc, kc, vc):
    B, L = qc.shape[0], qc.shape[1]
    qb = qc.reshape(B, L, N_KV_HEADS, Q_PER_KV, HEAD_DIM)
    o = gqa_scores_out(qb, kc.astype(jnp.float32), vc.astype(jnp.float32))
    return o.reshape(B, L, ATTN_WIDTH).astype(qc.dtype)


def fourier_mix(u, w_f):
    B, N = u.shape[0], u.shape[1]
    ug = u.reshape(B, N, N_FOURIER_GROUPS, FOURIER_GROUP_DIM).astype(jnp.float32)
    f = jnp.fft.fft2(ug, axes=(1, 3), norm='ortho').real
    y = jnp.einsum('bngc,gcd->bngd', f, w_f.astype(jnp.float32))
    return y.reshape(B, N, FOURIER_WIDTH).astype(u.dtype)


def split_proj(p):
    q = p[..., :ATTN_WIDTH]
    k = p[..., ATTN_WIDTH:ATTN_WIDTH + KV_WIDTH]
    v = p[..., ATTN_WIDTH + KV_WIDTH:ATTN_WIDTH + 2 * KV_WIDTH]
    u = p[..., ATTN_WIDTH + 2 * KV_WIDTH:]
    return q, k, v, u


def sq_relu_mlp(h, w1, w2):
    a = jax.nn.relu(h @ w1)
    return (a * a) @ w2


def hybrid_layer(x, ctx, mod_lat, mod_ctx, g1, w_in, q_g, k_g, w_f, w_out, g2, w1, w2, tabs, update_ctx):
    sh1, sc1, gt1, sh2, sc2, gt2 = jnp.split(mod_lat, N_MOD, axis=-1)
    csh1, csc1, cgt1, csh2, csc2, cgt2 = jnp.split(mod_ctx, N_MOD, axis=-1)

    hc = modulate(rmsnorm(ctx, g1), csh1, csc1)
    if update_ctx:
        qc, kc, vc, uc = split_proj(hc @ w_in)
    else:
        kv = hc @ w_in[:, ATTN_WIDTH:ATTN_WIDTH + 2 * KV_WIDTH]
        kc, vc = kv[..., :KV_WIDTH], kv[..., KV_WIDTH:]
    kc = rmsnorm(heads(kc, N_KV_HEADS), k_g)
    vc = heads(vc, N_KV_HEADS)

    h = modulate(rmsnorm(x, g1), sh1, sc1)
    q, k, v, u = split_proj(h @ w_in)
    q = apply_axial_rope(rmsnorm(heads(q, N_Q_HEADS), q_g), tabs)
    k = apply_axial_rope(rmsnorm(heads(k, N_KV_HEADS), k_g), tabs)
    v = heads(v, N_KV_HEADS)
    attn = latent_attention(q, k, v, kc, vc)
    four = fourier_mix(u, w_f)
    x = x + gt1 * (jnp.concatenate([attn, four], axis=-1) @ w_out)

    h2 = modulate(rmsnorm(x, g2), sh2, sc2)
    x = x + gt2 * sq_relu_mlp(h2, w1, w2)

    if update_ctx:
        qc = rmsnorm(heads(qc, N_Q_HEADS), q_g)
        attn_c = context_attention(qc, kc, vc)
        four_c = fourier_mix(uc, w_f)
        ctx = ctx + cgt1 * (jnp.concatenate([attn_c, four_c], axis=-1) @ w_out)
        hc2 = modulate(rmsnorm(ctx, g2), csh2, csc2)
        ctx = ctx + cgt2 * sq_relu_mlp(hc2, w1, w2)
    return x, ctx


def setup_inputs(seed: int = 0) -> dict:
    key = jax.random.key(seed)
    ks = jax.random.split(key, 16)
    f32 = jnp.float32
    n = lambda k, shape, s: jax.random.normal(k, shape, f32) * s
    return {
        "x": n(ks[0], (BATCH, SEQ, D_MODEL), 1.0),
        "c": n(ks[1], (BATCH, D_MODEL), 1.0),
        "ctx": n(ks[2], (BATCH, CTX_LEN, D_MODEL), 1.0),
        "c_ctx": n(ks[3], (D_MODEL,), 1.0),
        "w_ada": n(ks[4], (DEPTH, D_MODEL, N_MOD * D_MODEL), D_MODEL ** -0.5),
        "b_ada": n(ks[5], (DEPTH, N_MOD * D_MODEL), 0.02),
        "norm1_g": 1.0 + n(ks[6], (DEPTH, D_MODEL), 0.02),
        "w_in": n(ks[7], (DEPTH, D_MODEL, IN_WIDTH), D_MODEL ** -0.5),
        "q_norm_g": 1.0 + n(ks[8], (DEPTH, HEAD_DIM), 0.02),
        "k_norm_g": 1.0 + n(ks[9], (DEPTH, HEAD_DIM), 0.02),
        "w_fourier": n(ks[10], (DEPTH, N_FOURIER_GROUPS, FOURIER_GROUP_DIM, FOURIER_GROUP_DIM), FOURIER_GROUP_DIM ** -0.5),
        "w_out": n(ks[11], (DEPTH, MIX_WIDTH, D_MODEL), MIX_WIDTH ** -0.5),
        "norm2_g": 1.0 + n(ks[12], (DEPTH, D_MODEL), 0.02),
        "w_mlp1": n(ks[13], (DEPTH, D_MODEL, D_FF), D_MODEL ** -0.5),
        "w_mlp2": n(ks[14], (DEPTH, D_FF, D_MODEL), D_FF ** -0.5),
        "final_norm_g": 1.0 + n(ks[15], (D_MODEL,), 0.02),
    }


def reference(x, c, ctx, c_ctx, w_ada, b_ada, norm1_g, w_in, q_norm_g, k_norm_g, w_fourier,
              w_out, norm2_g, w_mlp1, w_mlp2, final_norm_g):
    ROWS = x.shape[1] // GRID_W
    tabs = axial_rope_tables(ROWS)
    silu_c = jax.nn.silu(c)
    silu_cc = jax.nn.silu(c_ctx)
    for layer in range(DEPTH):
        mod_lat = (silu_c @ w_ada[layer] + b_ada[layer])[:, None, :]
        mod_ctx = (silu_cc @ w_ada[layer] + b_ada[layer])[None, None, :]
        x, ctx = hybrid_layer(x, ctx, mod_lat, mod_ctx, norm1_g[layer], w_in[layer],
                              q_norm_g[layer], k_norm_g[layer], w_fourier[layer], w_out[layer],
                              norm2_g[layer], w_mlp1[layer], w_mlp2[layer], tabs,
                              update_ctx=(layer < DEPTH - 1))
    return rmsnorm(x, final_norm_g)
```

```cpp
#include <hip/hip_runtime.h>
#include <hip/hip_bf16.h>
#include <hip/hip_cooperative_groups.h>
#include <cstdio>
#include <cstdint>
namespace cg = cooperative_groups;

#define LAS __attribute__((address_space(3)))
typedef unsigned short bf16_t;
typedef short bf16x8 __attribute__((ext_vector_type(8)));
typedef short s16x4 __attribute__((ext_vector_type(4)));
typedef float f32x4 __attribute__((ext_vector_type(4)));
typedef float f32x16 __attribute__((ext_vector_type(16)));
typedef unsigned u32x4 __attribute__((ext_vector_type(4)));
typedef unsigned u32x2 __attribute__((ext_vector_type(2)));

constexpr int DM = 2048, NB = 4, SEQ = 2048, CTXL = 256, HD = 128, NQH = 12, NKVH = 4;
constexpr int AW = 1536, KVW = 512, FW = 512, INW = 3072, DFF = 8192, NMOD6 = 6 * DM;
constexpr int MTOK = NB * SEQ, MCTX = NB * CTXL, SKV = SEQ + CTXL;
constexpr float EPS = 1e-6f;

constexpr size_t MiB = 1u << 20;
constexpr size_t WS_MOD = 0;
constexpr size_t WS_GT = 1 * MiB;
constexpr size_t WS_WIN = 2 * MiB;
constexpr size_t WS_WOUT = 14 * MiB;
constexpr size_t WS_W1 = 22 * MiB;
constexpr size_t WS_W2 = 54 * MiB;
constexpr size_t WS_DFT = 86 * MiB;
constexpr size_t WS_H2 = 102 * MiB;
constexpr size_t WS_H = 134 * MiB;
constexpr size_t WS_Q = 170 * MiB;
constexpr size_t WS_K = 194 * MiB;
constexpr size_t WS_V = 203 * MiB;
constexpr size_t WS_U = 212 * MiB;
constexpr size_t WS_ZT = 220 * MiB;
constexpr size_t WS_MIX = 236 * MiB;
constexpr size_t WS_A1 = 134 * MiB;
constexpr size_t WS_END = 268 * MiB;

constexpr int LDS_BYTES = 131072 + 1024;

struct Params { const float* in[16]; float* out; unsigned char* ws; };
enum { I_X = 0, I_C, I_CTX, I_CCTX, I_WADA, I_BADA, I_G1, I_WIN, I_QG, I_KG, I_WF, I_WOUT, I_G2, I_W1, I_W2, I_GF };

__device__ __forceinline__ unsigned cvt_pk_bf16(float lo, float hi) { unsigned r; asm("v_cvt_pk_bf16_f32 %0, %1, %2" : "=v"(r) : "v"(lo), "v"(hi)); return r; }
__device__ __forceinline__ float bf2f(bf16_t v) { return __uint_as_float(((unsigned)v) << 16); }
__device__ __forceinline__ bf16_t f2bf(float f) { return (bf16_t)(cvt_pk_bf16(f, 0.f) & 0xffffu); }
__device__ __forceinline__ float wave_sum(float v) {
#pragma unroll
    for (int o = 1; o < 64; o <<= 1) v += __shfl_xor(v, o);
    return v;
}
#define LDS_WAIT() asm volatile("s_waitcnt lgkmcnt(0)" ::: "memory")

constexpr int BM = 256, BK = 64, HALF = 128, HTB = HALF * BK * 2, NXCD = 8, WGM = 8;
__device__ __forceinline__ int lds_byte(int r, int c) { const int st = (r >> 4) * 2 + (c >> 5), rr = r & 15, cc = c & 31, ob = rr * 64 + cc * 2; return st * 1024 + (ob ^ (((ob >> 9) & 1) << 5)); }
__device__ __forceinline__ void stage_rc(int b, int& R, int& C) { const int st = b / 1024, sb = b % 1024, swz = sb ^ (((sb >> 9) & 1) << 5); R = (st >> 1) * 16 + swz / 64; C = (st & 1) * 32 + (swz % 64) / 2; }
__device__ __forceinline__ int perm32(int rho) { const int n = rho >> 4, i = rho & 15; return 8 * (i >> 2) + 4 * n + (i & 3); }

struct Unit { int pm, pn; const char* a; const char* b; };
enum { G_IN = 0, G_F1, G_F2, G_OUT, G_UP, G_DOWN };

__device__ __forceinline__ void remap_tile(int L, int nM, int nN, int& pm, int& pn) {
    const int nwg = nM * nN; int wgid = L;
    { const int q = nwg / NXCD, r = nwg % NXCD, xcd = wgid % NXCD, off = wgid / NXCD; wgid = (xcd < r ? xcd * (q + 1) : r * (q + 1) + (xcd - r) * q) + off; }
    const int nig = WGM * nN, gid = wgid / nig, fm = gid * WGM, gsz = (nM - fm) < WGM ? (nM - fm) : WGM;
    pm = fm + ((wgid % nig) % gsz); pn = (wgid % nig) / gsz;
}

__device__ __forceinline__ bool get_unit(const unsigned char* ws, int mode, int i, int G, int c, Unit& u) {
    const long L = (long)i * G + c;
    switch (mode) {
    case G_IN: {
        if (L >= 400) return false;
        if (L < 384) remap_tile((int)L, 32, 12, u.pm, u.pn);
        else { const int idx = (int)L - 384; u.pm = 32 + (idx >> 2); u.pn = 6 + (idx & 3); }
        u.a = (const char*)ws + WS_H + (size_t)u.pm * 256 * DM * 2; u.b = (const char*)ws + WS_WIN + (size_t)u.pn * 256 * DM * 2; return true; }
    case G_F1: {
        if (L >= 128) return false;
        const int g = (int)L >> 5; u.pm = g; u.pn = (int)L & 31;
        u.a = (const char*)ws + WS_GT + (size_t)g * 256 * 128 * 2; u.b = (const char*)ws + WS_U + ((size_t)u.pn * 256 * FW + g * 128) * 2; return true; }
    case G_F2: {
        if (L >= 64) return false;
        const int b = (int)L >> 4, pm = ((int)L >> 1) & 7, pn = (int)L & 1; u.pm = b * 8 + pm; u.pn = pn;
        u.a = (const char*)ws + WS_DFT + (size_t)pm * 256 * 4096 * 2; u.b = (const char*)ws + WS_ZT + ((size_t)(b * 512 + pn * 256) * 4096) * 2; return true; }
    case G_OUT: {
        if (L >= 256) return false;
        remap_tile((int)L, 32, 8, u.pm, u.pn);
        u.a = (const char*)ws + WS_MIX + (size_t)u.pm * 256 * DM * 2; u.b = (const char*)ws + WS_WOUT + (size_t)u.pn * 256 * DM * 2; return true; }
    case G_UP: {
        if (L >= 1024) return false;
        remap_tile((int)L, 32, 32, u.pm, u.pn);
        u.a = (const char*)ws + WS_H2 + (size_t)u.pm * 256 * DM * 2; u.b = (const char*)ws + WS_W1 + (size_t)u.pn * 256 * DM * 2; return true; }
    default: {
        if (L >= 256) return false;
        remap_tile((int)L, 32, 8, u.pm, u.pn);
        u.a = (const char*)ws + WS_A1 + (size_t)u.pm * 256 * DFF * 2; u.b = (const char*)ws + WS_W2 + (size_t)u.pn * 256 * DFF * 2; return true; }
    }
}

__device__ __forceinline__ void gemm_epilogue(const Params& P, int mode, const f32x4 (&acc)[2][2][4][2], const Unit& u, int wr, int wc, int fr, int fq) {
    unsigned char* ws = P.ws;
    if (mode == G_OUT || mode == G_DOWN) {
        const float* resid = (mode == G_OUT) ? P.in[I_X] : P.out;
        const float* gate = (const float*)(ws + WS_MOD) + (size_t)(u.pm >> 3) * NMOD6 + (mode == G_OUT ? 2 * DM : 5 * DM);
        const int col0 = u.pn * 256 + wc * 32 + 4 * fq;
        f32x4 gv[2][2];
#pragma unroll
        for (int bj = 0; bj < 2; ++bj)
#pragma unroll
            for (int n = 0; n < 2; ++n) gv[bj][n] = *(const f32x4*)(gate + col0 + bj * HALF + n * 16);
#pragma unroll
        for (int ai = 0; ai < 2; ++ai)
#pragma unroll
            for (int m = 0; m < 4; ++m) {
                const size_t off = (size_t)(u.pm * 256 + ai * HALF + wr * 64 + m * 16 + fr) * DM + col0;
#pragma unroll
                for (int bj = 0; bj < 2; ++bj)
#pragma unroll
                    for (int n = 0; n < 2; ++n) {
                        const f32x4 r = *(const f32x4*)(resid + off + bj * HALF + n * 16);
                        *(f32x4*)(P.out + off + bj * HALF + n * 16) = r + gv[bj][n] * acc[ai][bj][m][n];
                    }
            }
        return;
    }
    bf16_t* base; size_t ld, aistride;
    if (mode == G_IN) {
        const int pm = u.pm, pn = u.pn;
        if (pn < 6) { base = (bf16_t*)(ws + WS_Q) + (size_t)pm * 256 * AW + pn * 256; ld = AW; }
        else if (pn < 10) {
            const size_t krow0 = (pm < 32) ? (size_t)(pm >> 3) * SKV + CTXL + (size_t)(pm & 7) * 256 : (size_t)(pm - 32) * SKV;
            base = (bf16_t*)(ws + (pn < 8 ? WS_K : WS_V)) + krow0 * KVW + ((pn - 6) & 1) * 256; ld = KVW; }
        else { base = (bf16_t*)(ws + WS_U) + (size_t)pm * 256 * FW + (pn - 10) * 256; ld = FW; }
        aistride = 128 * ld;
    } else if (mode == G_F1) {
        const int g = u.pm, b = u.pn >> 3, s0 = (u.pn & 7) * 256;
        base = (bf16_t*)(ws + WS_ZT) + ((size_t)(b * 512 + g * 128) * 4096 + s0); ld = 4096; aistride = 2048;
    } else if (mode == G_F2) {
        base = (bf16_t*)(ws + WS_MIX) + (size_t)u.pm * 256 * DM + AW + u.pn * 256; ld = DM; aistride = 128 * ld;
    } else {
        base = (bf16_t*)(ws + WS_A1) + (size_t)u.pm * 256 * DFF + u.pn * 256; ld = DFF; aistride = 128 * ld;
    }
    const bool relu2 = (mode == G_UP);
    bf16_t* p0 = base + (size_t)(wr * 64 + fr) * ld + wc * 32 + 8 * fq;
#pragma unroll
    for (int ai = 0; ai < 2; ++ai)
#pragma unroll
        for (int m = 0; m < 4; ++m) {
            bf16_t* rowp = p0 + ai * aistride + (size_t)(m * 16) * ld;
#pragma unroll
            for (int bj = 0; bj < 2; ++bj) {
                f32x4 v0 = acc[ai][bj][m][0], v1 = acc[ai][bj][m][1];
                if (relu2) {
#pragma unroll
                    for (int e = 0; e < 4; ++e) { const float a = fmaxf(v0[e], 0.f), b = fmaxf(v1[e], 0.f); v0[e] = a * a; v1[e] = b * b; }
                }
                u32x4 w; w.x = cvt_pk_bf16(v0[0], v0[1]); w.y = cvt_pk_bf16(v0[2], v0[3]); w.z = cvt_pk_bf16(v1[0], v1[1]); w.w = cvt_pk_bf16(v1[2], v1[3]);
                *(u32x4*)(rowp + bj * HALF) = w;
            }
        }
}

__device__ __forceinline__ void gemm_phase(LAS unsigned char* lds, const Params& P, const int mode, const int G, const int c) {
    int tid_ = threadIdx.x; asm volatile("" : "+v"(tid_));
    const int tid = tid_, wid = __builtin_amdgcn_readfirstlane(tid >> 6), lane = tid & 63, wr = wid >> 2, wc = wid & 3, fr = lane & 15, fq = lane >> 4;
    int lda, ldb, K; bool perm = true;
    switch (mode) {
    case G_IN: lda = DM; ldb = DM; K = DM; break;
    case G_F1: lda = 128; ldb = FW; K = 128; break;
    case G_F2: lda = 4096; ldb = 4096; K = 4096; break;
    case G_OUT: lda = DM; ldb = DM; K = DM; perm = false; break;
    case G_UP: lda = DM; ldb = DM; K = DM; break;
    default: lda = DFF; ldb = DFF; K = DFF; perm = false; break;
    }
    const int nt = K / BK;
    unsigned voffA[2], voffB[2];
#pragma unroll
    for (int i = 0; i < 2; ++i) { int R, C; stage_rc(tid * 16 + i * 8192, R, C); const int Rb = perm ? ((R & ~31) + perm32(R & 31)) : R;
        voffA[i] = (unsigned)(R * lda + C) * 2u; voffB[i] = (unsigned)(Rb * ldb + C) * 2u; }
    const size_t kstep = (size_t)(BK * 2);
    const size_t hstepA = (size_t)HALF * lda * 2, hstepB = (size_t)HALF * ldb * 2;
    const unsigned ldsw = (unsigned)wid * 1024u;
    const int aoff = lds_byte(wr * 64 + fr, fq * 8), boff = lds_byte(wc * 32 + fr, fq * 8);
#define PG8_SA(b, h) (((b) * 2 + (h)) * HTB)
#define PG8_SB(b, h) ((4 + (b) * 2 + (h)) * HTB)
#define PG8_STAGE(bufoff, gbase, voff) do { _Pragma("unroll") for (int _i = 0; _i < 2; ++_i) \
        __builtin_amdgcn_global_load_lds((const unsigned*)((const char*)(gbase) + (voff)[_i]), (LAS unsigned*)(lds + (bufoff) + ldsw + _i * 8192), 16, 0, 0); } while (0)
#define PG8_LDA(dst, b, h) do { _Pragma("unroll") for (int m = 0; m < 4; ++m) _Pragma("unroll") for (int k = 0; k < 2; ++k) dst[m][k] = *(const LAS bf16x8*)(lds + PG8_SA(b, h) + aoff + m * 2048 + k * 1024); } while (0)
#define PG8_LDB(dst, b, h) do { _Pragma("unroll") for (int n = 0; n < 2; ++n) _Pragma("unroll") for (int k = 0; k < 2; ++k) dst[n][k] = *(const LAS bf16x8*)(lds + PG8_SB(b, h) + boff + n * 2048 + k * 1024); } while (0)
#define PG8_MMA(ai, bj, At, Bt) do { __builtin_amdgcn_s_setprio(1); _Pragma("unroll") for (int m = 0; m < 4; ++m) _Pragma("unroll") for (int n = 0; n < 2; ++n) _Pragma("unroll") for (int k = 0; k < 2; ++k) \
        acc[ai][bj][m][n] = __builtin_amdgcn_mfma_f32_16x16x32_bf16(Bt[n][k], At[m][k], acc[ai][bj][m][n], 0, 0, 0); __builtin_amdgcn_s_setprio(0); } while (0)
#define PG8_WAIT_V(n) asm volatile("s_waitcnt vmcnt(" #n ")" ::: "memory")
#define PG8_WAIT_L(n) asm volatile("s_waitcnt lgkmcnt(" #n ")" ::: "memory")
#define PG8_BAR __builtin_amdgcn_s_barrier()
#define PG8_SCHED __builtin_amdgcn_sched_barrier(0)
    Unit cur, nxt; int ui = 0;
    if (!get_unit(P.ws, mode, 0, G, c, cur)) return;
    f32x4 acc[2][2][4][2];
#pragma unroll
    for (int a = 0; a < 2; ++a)
#pragma unroll
        for (int b = 0; b < 2; ++b)
#pragma unroll
            for (int m = 0; m < 4; ++m)
#pragma unroll
                for (int n = 0; n < 2; ++n) acc[a][b][m][n] = (f32x4){0.f, 0.f, 0.f, 0.f};
    bf16x8 At[4][2], B0[2][2], B1[2][2];
    const char* cA = cur.a; const char* cB = cur.b;
    PG8_STAGE(PG8_SB(0, 0), cB, voffB); PG8_STAGE(PG8_SB(0, 1), cB + hstepB, voffB); PG8_STAGE(PG8_SA(0, 0), cA, voffA); PG8_STAGE(PG8_SA(0, 1), cA + hstepA, voffA);
    if (wr == 1) PG8_BAR;
    PG8_WAIT_V(2); PG8_BAR;
    PG8_STAGE(PG8_SB(1, 0), cB + kstep, voffB); PG8_STAGE(PG8_SA(1, 0), cA + kstep, voffA); PG8_STAGE(PG8_SB(1, 1), cB + hstepB + kstep, voffB);
    PG8_WAIT_V(6); PG8_BAR;
    for (;;) {
        const bool has_next = get_unit(P.ws, mode, ui + 1, G, c, nxt);
        const char* nA = has_next ? nxt.a : cA; const char* nB = has_next ? nxt.b : cB;
        for (int t = 0; t < nt; t += 2) {
            const bool last = (t == nt - 2);
            const char* a1 = cA + (size_t)(t + 1) * kstep;
            const char* a2 = last ? nA : cA + (size_t)(t + 2) * kstep; const char* b2 = last ? nB : cB + (size_t)(t + 2) * kstep;
            const char* a3 = a2 + kstep; const char* b3 = b2 + kstep;
            PG8_LDB(B0, 0, 0); PG8_LDB(B1, 0, 1); PG8_SCHED; PG8_LDA(At, 0, 0); PG8_STAGE(PG8_SA(1, 1), a1 + hstepA, voffA);
            PG8_WAIT_V(8); PG8_WAIT_L(0); PG8_BAR; PG8_MMA(0, 0, At, B0); PG8_MMA(0, 1, At, B1); PG8_BAR; PG8_SCHED;
            PG8_LDA(At, 0, 1); PG8_STAGE(PG8_SB(0, 0), b2, voffB); PG8_STAGE(PG8_SB(0, 1), b2 + hstepB, voffB); PG8_STAGE(PG8_SA(0, 0), a2, voffA);
            PG8_WAIT_V(8); PG8_WAIT_L(0); PG8_BAR; PG8_MMA(1, 0, At, B0); PG8_MMA(1, 1, At, B1); PG8_BAR; PG8_SCHED;
            PG8_LDB(B0, 1, 0); PG8_LDB(B1, 1, 1); PG8_SCHED; PG8_LDA(At, 1, 0); PG8_STAGE(PG8_SA(0, 1), a2 + hstepA, voffA);
            PG8_WAIT_V(8); PG8_WAIT_L(0); PG8_BAR; PG8_MMA(0, 0, At, B0); PG8_MMA(0, 1, At, B1); PG8_BAR; PG8_SCHED;
            PG8_LDA(At, 1, 1); PG8_STAGE(PG8_SB(1, 0), b3, voffB); PG8_STAGE(PG8_SB(1, 1), b3 + hstepB, voffB); PG8_STAGE(PG8_SA(1, 0), a3, voffA);
            PG8_WAIT_V(8); PG8_WAIT_L(0); PG8_BAR; PG8_MMA(1, 0, At, B0); PG8_MMA(1, 1, At, B1); PG8_BAR; PG8_SCHED;
        }
        if (wr == 0) PG8_BAR;
        gemm_epilogue(P, mode, acc, cur, wr, wc, fr, fq);
        if (!has_next) break;
#pragma unroll
        for (int a = 0; a < 2; ++a)
#pragma unroll
            for (int b = 0; b < 2; ++b)
#pragma unroll
                for (int m = 0; m < 4; ++m)
#pragma unroll
                    for (int n = 0; n < 2; ++n) acc[a][b][m][n] = (f32x4){0.f, 0.f, 0.f, 0.f};
        cur = nxt; cA = nA; cB = nB; ++ui;
        if (wr == 1) PG8_BAR;
    }
    PG8_WAIT_V(0);
    PG8_BAR;
#undef PG8_SA
#undef PG8_SB
#undef PG8_STAGE
#undef PG8_LDA
#undef PG8_LDB
#undef PG8_MMA
#undef PG8_WAIT_V
#undef PG8_WAIT_L
#undef PG8_BAR
#undef PG8_SCHED
}

namespace att {
constexpr int D = 128, NW = 8, QBLK = 32, KVBLK = 64;
constexpr float SCALE = 0.088388347648318440f;
constexpr float THR = 8.f;
constexpr int LDQ = AW, LDK = KVW, LDO = DM;
constexpr size_t SHM_V = KVBLK * D * 2, SHM_K = KVBLK * D * 2, SHM_ATTN = 2 * SHM_V + 2 * SHM_K + NW * 64 * 4;
#define KSWZ(row, colB) ((row) * 256 + ((colB) ^ (((row) & 7) << 4)))
#define SBAR() __builtin_amdgcn_sched_barrier(0)
__device__ __forceinline__ int crow(int r, int hi) { return (r & 3) + 8 * (r >> 2) + 4 * hi; }
__device__ __forceinline__ unsigned cvtpk(float lo, float hi) { unsigned r; asm volatile("v_cvt_pk_bf16_f32 %0, %1, %2" : "=v"(r) : "v"(lo), "v"(hi)); return r; }
__device__ __forceinline__ bf16x8 ld8(const bf16_t* p) { return *reinterpret_cast<const bf16x8*>(p); }

__device__ __forceinline__ void partialSM(f32x16& p0, f32x16& p1, float& m_reg, float& mn, float& alpha) {
  constexpr float C = SCALE * 1.4426950408889634f;
  float pmax = p0[0];
#pragma unroll
  for (int r = 1; r < 16; ++r) pmax = fmaxf(pmax, p0[r]);
#pragma unroll
  for (int r = 0; r < 16; ++r) pmax = fmaxf(pmax, p1[r]);
  { auto rr = __builtin_amdgcn_permlane32_swap(__float_as_uint(pmax), __float_as_uint(pmax), false, false);
    pmax = fmaxf(__uint_as_float(rr[0]), __uint_as_float(rr[1])); }
  if (__builtin_expect(__all(pmax - m_reg <= THR / SCALE), 1)) { mn = m_reg; alpha = 1.f; }
  else { mn = fmaxf(m_reg, pmax); alpha = __builtin_amdgcn_exp2f((m_reg - mn) * C); m_reg = mn; }
  float mnC = -mn * C;
#pragma unroll
  for (int r = 0; r < 16; ++r) p0[r] = fmaf(p0[r], C, mnC);
#pragma unroll
  for (int r = 0; r < 16; ++r) p1[r] = fmaf(p1[r], C, mnC);
#pragma unroll
  for (int r = 0; r < 16; ++r) p0[r] = __builtin_amdgcn_exp2f(p0[r]);
}
__device__ __forceinline__ void finishSM(f32x16& p0, f32x16& p1, float alpha, float& l_reg, bf16x8& pa0, bf16x8& pa1, bf16x8& pa2, bf16x8& pa3) {
#pragma unroll
  for (int r = 0; r < 16; ++r) p1[r] = __builtin_amdgcn_exp2f(p1[r]);
  float ps = 0;
#pragma unroll
  for (int r = 0; r < 16; ++r) ps += p0[r];
#pragma unroll
  for (int r = 0; r < 16; ++r) ps += p1[r];
  { auto rr = __builtin_amdgcn_permlane32_swap(__float_as_uint(ps), __float_as_uint(ps), false, false);
    ps = __uint_as_float(rr[0]) + __uint_as_float(rr[1]); }
  l_reg = l_reg * alpha + ps;
#define PK4(P, BASE, OUT) do { unsigned a0 = cvtpk(P[BASE + 0], P[BASE + 1]), a1 = cvtpk(P[BASE + 2], P[BASE + 3]);   \
    unsigned b0 = cvtpk(P[BASE + 4], P[BASE + 5]), b1 = cvtpk(P[BASE + 6], P[BASE + 7]);                              \
    auto r0 = __builtin_amdgcn_permlane32_swap(a0, b0, false, false); auto r1 = __builtin_amdgcn_permlane32_swap(a1, b1, false, false); \
    u32x4 w = {r0[0], r1[0], r0[1], r1[1]}; OUT = *reinterpret_cast<bf16x8*>(&w); } while (0)
  PK4(p0, 0, pa0); PK4(p0, 8, pa1); PK4(p1, 0, pa2); PK4(p1, 8, pa3);
#undef PK4
}
__device__ __forceinline__ void qkt(f32x16& p0, f32x16& p1, const bf16_t* Ks, const bf16x8* qr, int r32, int hi) {
  p0 = f32x16{}; p1 = f32x16{};
#pragma unroll
  for (int d0 = 0; d0 < 8; ++d0) { int cb = (d0 * 16 + hi * 8) * 2;
    bf16x8 b0 = *reinterpret_cast<const bf16x8*>((const char*)Ks + KSWZ(r32, cb));
    bf16x8 b1 = *reinterpret_cast<const bf16x8*>((const char*)Ks + KSWZ(32 + r32, cb));
    p0 = __builtin_amdgcn_mfma_f32_32x32x16_bf16(b0, qr[d0], p0, 0, 0, 0);
    p1 = __builtin_amdgcn_mfma_f32_32x32x16_bf16(b1, qr[d0], p1, 0, 0, 0); }
}
__device__ __forceinline__ int v_st(int k, int c) { const int kk = (k & ~0xC) | ((k & 4) << 1) | ((k & 8) >> 1); return ((kk >> 3) * 4 + (c >> 5)) * 512 + ((kk & 7) * 32 + (c & 31)) * 2; }
__device__ __forceinline__ int v_rd_base(int lane) { return ((lane & 3) << 3) | (((lane >> 2) & 3) << 6) | (((lane >> 4) & 1) << 5) | (((lane >> 5) & 1) << 8); }
constexpr int v_rd_off(int d0, int ks, int half) { return d0 * 512 + ks * 4096 + half * 2048; }
template <int OFF> __device__ __forceinline__ s16x4 tr_read(int vb) {
  s16x4 r; asm volatile("ds_read_b64_tr_b16 %0, %1 offset:%2" : "=&v"(r) : "v"(vb), "i"(OFF) : "memory"); return r;
}
template <int D0> __device__ __forceinline__ void pv_one(f32x16& od, int vb, bf16x8 pa0, bf16x8 pa1, bf16x8 pa2, bf16x8 pa3) {
  const s16x4 l0 = tr_read<v_rd_off(D0, 0, 0)>(vb), h0 = tr_read<v_rd_off(D0, 0, 1)>(vb), l1 = tr_read<v_rd_off(D0, 1, 0)>(vb), h1 = tr_read<v_rd_off(D0, 1, 1)>(vb);
  const s16x4 l2 = tr_read<v_rd_off(D0, 2, 0)>(vb), h2 = tr_read<v_rd_off(D0, 2, 1)>(vb), l3 = tr_read<v_rd_off(D0, 3, 0)>(vb), h3 = tr_read<v_rd_off(D0, 3, 1)>(vb);
  asm volatile("s_waitcnt lgkmcnt(0)" ::: "memory"); SBAR();
#define PK(L, H) (bf16x8){L[0], L[1], L[2], L[3], H[0], H[1], H[2], H[3]}
  od = __builtin_amdgcn_mfma_f32_32x32x16_bf16(pa0, PK(l0, h0), od, 0, 0, 0);
  od = __builtin_amdgcn_mfma_f32_32x32x16_bf16(pa1, PK(l1, h1), od, 0, 0, 0);
  od = __builtin_amdgcn_mfma_f32_32x32x16_bf16(pa2, PK(l2, h2), od, 0, 0, 0);
  od = __builtin_amdgcn_mfma_f32_32x32x16_bf16(pa3, PK(l3, h3), od, 0, 0, 0);
#undef PK
}
__device__ __forceinline__ void pv_d0(f32x16* o, int vb, bf16x8 pa0, bf16x8 pa1, bf16x8 pa2, bf16x8 pa3) {
  pv_one<0>(o[0], vb, pa0, pa1, pa2, pa3); pv_one<1>(o[1], vb, pa0, pa1, pa2, pa3); pv_one<2>(o[2], vb, pa0, pa1, pa2, pa3); pv_one<3>(o[3], vb, pa0, pa1, pa2, pa3);
}

__device__ __forceinline__ void attn_dense_body(const bf16_t* __restrict__ Qb, const bf16_t* __restrict__ Kh, const bf16_t* __restrict__ Vh,
                                                bf16_t* __restrict__ Ob, int seq, char* lds) {
  int tid_ = threadIdx.x; asm volatile("" : "+v"(tid_));
  const int tid = tid_, wid = tid >> 6, lane = tid & 63, r32 = lane & 31, hi = lane >> 5;
  bf16_t* V_lds = (bf16_t*)lds; bf16_t* K_lds = (bf16_t*)(lds + 2 * SHM_V);
  float* ws = (float*)(lds + 2 * SHM_V + 2 * SHM_K) + wid * 64; float* li_l = ws; float* al_l = ws + 32;
  float m_reg = -1e30f, l_reg = 0; f32x16 o[4] = {}; bf16x8 qr[8];
  const bf16_t* Qw = Qb + (long)(wid * QBLK + r32) * LDQ + hi * 8;
#pragma unroll
  for (int d0 = 0; d0 < 8; ++d0) qr[d0] = ld8(Qw + d0 * 16);
  const int sr = tid >> 4, sc = (tid & 15) * 8, vst0 = v_st(sr, sc), vst1 = v_st(32 + sr, sc);
  const int vb0 = (int)(uintptr_t)V_lds + v_rd_base(lane);
  struct { bf16x8 vs0, vs1, ks0, ks1; } sr_[2];
#define SLOAD(i, k0) do { sr_[i].vs0 = ld8(&Vh[(long)((k0) + sr) * LDK + sc]); sr_[i].vs1 = ld8(&Vh[(long)((k0) + 32 + sr) * LDK + sc]); \
    sr_[i].ks0 = ld8(&Kh[(long)((k0) + sr) * LDK + sc]); sr_[i].ks1 = ld8(&Kh[(long)((k0) + 32 + sr) * LDK + sc]); } while (0)
#define SWRITE(b, i) do { *(bf16x8*)((char*)V_lds + (b) * SHM_V + vst0) = sr_[i].vs0;          \
    *(bf16x8*)((char*)V_lds + (b) * SHM_V + vst1) = sr_[i].vs1; int kc = sc * 2;               \
    *(bf16x8*)((char*)K_lds + (b) * SHM_K + KSWZ(sr, kc)) = sr_[i].ks0;                       \
    *(bf16x8*)((char*)K_lds + (b) * SHM_K + KSWZ(32 + sr, kc)) = sr_[i].ks1; } while (0)
#define SWAIT() asm volatile("s_waitcnt vmcnt(4)" ::: "memory")
#define RESC(a) do { if (__any((a) < 1.f)) { if (hi == 0) al_l[r32] = (a); asm volatile("s_waitcnt lgkmcnt(0)" ::: "memory"); \
    _Pragma("unroll") for (int d = 0; d < 4; ++d) _Pragma("unroll") for (int r = 0; r < 16; ++r) o[d][r] *= al_l[crow(r, hi)]; } } while (0)
  f32x16 pA0, pA1, pB0, pB1; float mnA, mnB, alA, alB; bf16x8 pa0, pa1, pa2, pa3; const int NT = seq / KVBLK;
  constexpr int SE = 0, SO = 1;
  SLOAD(SE, 0); asm volatile("s_waitcnt vmcnt(0)" ::: "memory"); SWRITE(0, SE); __syncthreads();
  qkt(pA0, pA1, K_lds, qr, r32, hi); partialSM(pA0, pA1, m_reg, mnA, alA);
  SLOAD(SO, KVBLK); if (2 < NT) SLOAD(SE, 2 * KVBLK);
  SWAIT(); SWRITE(1, SO); __syncthreads();
  for (int j = 1; j + 1 < NT; j += 2) {
    SBAR(); qkt(pB0, pB1, (bf16_t*)((char*)K_lds + SHM_K), qr, r32, hi);
    finishSM(pA0, pA1, alA, l_reg, pa0, pa1, pa2, pa3); SBAR();
    SLOAD(SO, (j + 2) * KVBLK); SBAR();
    pv_d0(o, vb0, pa0, pa1, pa2, pa3); partialSM(pB0, pB1, m_reg, mnB, alB);
    __syncthreads(); SWAIT(); SWRITE(0, SE);
    RESC(alB); __syncthreads();
    SBAR(); qkt(pA0, pA1, K_lds, qr, r32, hi);
    finishSM(pB0, pB1, alB, l_reg, pa0, pa1, pa2, pa3); SBAR();
    if (j + 3 < NT) SLOAD(SE, (j + 3) * KVBLK); SBAR();
    pv_d0(o, vb0 + (int)SHM_V, pa0, pa1, pa2, pa3); partialSM(pA0, pA1, m_reg, mnA, alA);
    __syncthreads(); SWAIT(); SWRITE(1, SO);
    RESC(alA); __syncthreads();
  }
  SBAR(); qkt(pB0, pB1, (bf16_t*)((char*)K_lds + SHM_K), qr, r32, hi);
  finishSM(pA0, pA1, alA, l_reg, pa0, pa1, pa2, pa3); SBAR();
  pv_d0(o, vb0, pa0, pa1, pa2, pa3); partialSM(pB0, pB1, m_reg, mnB, alB);
  __syncthreads(); RESC(alB);
  finishSM(pB0, pB1, alB, l_reg, pa0, pa1, pa2, pa3); SBAR();
  pv_d0(o, vb0 + (int)SHM_V, pa0, pa1, pa2, pa3);
  if (hi == 0) li_l[r32] = l_reg; asm volatile("s_waitcnt lgkmcnt(0)" ::: "memory");
  float rli[16];
#pragma unroll
  for (int r = 0; r < 16; ++r) rli[r] = __builtin_amdgcn_rcpf(li_l[crow(r, hi)]);
  bf16_t* Ow = Ob + (long)(wid * QBLK) * LDO;
#pragma unroll
  for (int r = 0; r < 16; ++r) { int orow = crow(r, hi);
#pragma unroll
    for (int d0 = 0; d0 < 4; ++d0) Ow[(long)orow * LDO + d0 * 32 + r32] = f2bf(o[d0][r] * rli[r]); }
  __syncthreads();
#undef SLOAD
#undef SWRITE
#undef SWAIT
#undef RESC
}
#undef KSWZ
#undef SBAR
}

__device__ __forceinline__ void transpose_item(const float* __restrict__ W, int K, int N, bf16_t* __restrict__ WT, LAS float* scr, int item, int lane) {
    const int nblk = N / 32, kb = item / nblk, nb = item % nblk, k0 = 64 * kb, n0 = 32 * nb;
#pragma unroll 8
    for (int i = 0; i < 32; ++i) { const int kk = 2 * i + (lane >> 5); scr[kk * 33 + (lane & 31)] = W[(size_t)(k0 + kk) * N + n0 + (lane & 31)]; }
    LDS_WAIT();
    const int c = lane & 7;
#pragma unroll
    for (int j = 0; j < 4; ++j) { const int n = (lane >> 3) + 8 * j; const LAS float* s = scr + (8 * c) * 33 + n;
        u32x4 o; o.x = cvt_pk_bf16(s[0 * 33], s[1 * 33]); o.y = cvt_pk_bf16(s[2 * 33], s[3 * 33]); o.z = cvt_pk_bf16(s[4 * 33], s[5 * 33]); o.w = cvt_pk_bf16(s[6 * 33], s[7 * 33]);
        *(u32x4*)(WT + (size_t)(n0 + n) * K + k0 + 8 * c) = o; }
    LDS_WAIT();
}

__device__ __forceinline__ void phase0(const Params& P, LAS unsigned char* lds, int G) {
    int tid_ = threadIdx.x; asm volatile("" : "+v"(tid_));
    const int tid = tid_, wid = tid >> 6, lane = tid & 63;
    unsigned char* ws = P.ws;
    {
        LAS float* sl = (LAS float*)lds;
        for (int i = tid; i < 5 * DM; i += 512) { const float v = (i < 4 * DM) ? P.in[I_C][i] : P.in[I_CCTX][i - 4 * DM]; sl[i] = v / (1.f + expf(-v)); }
        __syncthreads();
        LAS float* red = (LAS float*)(lds + 40960);
        float* mod = (float*)(ws + WS_MOD);
        const float* w_ada = P.in[I_WADA];
        for (int it = blockIdx.x; it < 768; it += G) {
            const int cc = it % 48, kc = it / 48;
            const int kb = kc * 128 + wid * 16;
            const float* wp = w_ada + (size_t)kb * NMOD6 + cc * 256 + lane * 4;
            f32x4 acc[5];
#pragma unroll
            for (int r = 0; r < 5; ++r) acc[r] = (f32x4){0.f, 0.f, 0.f, 0.f};
#pragma unroll
            for (int i = 0; i < 16; ++i) {
                const f32x4 wv = *(const f32x4*)(wp + (size_t)i * NMOD6);
#pragma unroll
                for (int r = 0; r < 5; ++r) { const float s = sl[r * DM + kb + i]; acc[r] += wv * s; }
            }
#pragma unroll
            for (int r = 0; r < 5; ++r) *(LAS f32x4*)(red + (wid * 5 + r) * 256 + lane * 4) = acc[r];
            __syncthreads();
            if (tid < 320) {
                const int r = tid >> 6, q = tid & 63;
                f32x4 s = (f32x4){0.f, 0.f, 0.f, 0.f};
#pragma unroll
                for (int w = 0; w < 8; ++w) s += *(const LAS f32x4*)(red + (w * 5 + r) * 256 + q * 4);
                if (kc == 0) s += *(const f32x4*)(P.in[I_BADA] + cc * 256 + q * 4);
                float* dst = mod + (size_t)r * NMOD6 + cc * 256 + q * 4;
                unsafeAtomicAdd(dst + 0, s[0]); unsafeAtomicAdd(dst + 1, s[1]); unsafeAtomicAdd(dst + 2, s[2]); unsafeAtomicAdd(dst + 3, s[3]);
            }
            __syncthreads();
        }
    }
    {
        LAS float* scr = (LAS float*)(lds + wid * 8448);
        const int gw = blockIdx.x * 8 + wid, NGW = G * 8;
        constexpr int I_A = (DM / 64) * (INW / 32), I_B = (DM / 64) * (DM / 32), I_C1 = (DM / 64) * (DFF / 32), I_D = (DFF / 64) * (DM / 32);
        for (int it = gw; it < I_A + I_B + I_C1 + I_D; it += NGW) {
            int r = it;
            if (r < I_A) { transpose_item(P.in[I_WIN], DM, INW, (bf16_t*)(ws + WS_WIN), scr, r, lane); continue; } r -= I_A;
            if (r < I_B) { transpose_item(P.in[I_WOUT], DM, DM, (bf16_t*)(ws + WS_WOUT), scr, r, lane); continue; } r -= I_B;
            if (r < I_C1) { transpose_item(P.in[I_W1], DM, DFF, (bf16_t*)(ws + WS_W1), scr, r, lane); continue; } r -= I_C1;
            transpose_item(P.in[I_W2], DFF, DM, (bf16_t*)(ws + WS_W2), scr, r, lane);
        }
        __syncthreads();
    }
    {
        LAS float* ct = (LAS float*)lds;
        for (int j = tid; j < 2048; j += 512) ct[j] = cospif((float)j * (1.0f / 1024.0f));
        __syncthreads();
        bf16_t* dft = (bf16_t*)(ws + WS_DFT);
        for (int idx = blockIdx.x * 512 + tid; idx < 2048 * 512; idx += G * 512) {
            const int k = idx >> 9, n0 = (idx & 511) * 8, part = n0 >> 11, nn = n0 & 2047;
            float v[8];
#pragma unroll
            for (int e = 0; e < 8; ++e) { const int j = (k * (nn + e)) & 2047; v[e] = ct[part ? ((j - 512) & 2047) : j]; }
            u32x4 o; o.x = cvt_pk_bf16(v[0], v[1]); o.y = cvt_pk_bf16(v[2], v[3]); o.z = cvt_pk_bf16(v[4], v[5]); o.w = cvt_pk_bf16(v[6], v[7]);
            *(u32x4*)(dft + (size_t)k * 4096 + n0) = o;
        }
        bf16_t* gt = (bf16_t*)(ws + WS_GT);
        const float* wf = P.in[I_WF];
        for (int idx = blockIdx.x * 512 + tid; idx < 4 * 2 * 128 * 128; idx += G * 512) {
            const int d = idx & 127, cch = (idx >> 7) & 127, part = (idx >> 14) & 1, g = idx >> 15;
            float sum = 0.f;
            for (int l = 0; l < 128; ++l) {
                const int j = (cch * l) & 127;
                const float cs = part ? -ct[((j - 32) & 127) * 16] : ct[j * 16];
                sum += cs * wf[(size_t)(g * 128 + l) * 128 + d];
            }
            gt[(size_t)((g * 2 + part) * 128 + d) * 128 + cch] = f2bf(sum * (1.0f / 512.0f));
        }
    }
}

template <int MODE> __device__ __forceinline__ void rows_pass(const Params& P, int G) {
    int tid_ = threadIdx.x; asm volatile("" : "+v"(tid_));
    const int tid = tid_, wid = tid >> 6, lane = tid & 63;
    const int gw = blockIdx.x * 8 + wid, NGW = G * 8;
    const int nrows = (MODE == 0) ? (MTOK + MCTX) : MTOK;
    const float* mod = (const float*)(P.ws + WS_MOD);
    const float* gain = P.in[MODE == 0 ? I_G1 : (MODE == 1 ? I_G2 : I_GF)];
    for (int r = gw; r < nrows; r += NGW) {
        const float* src; int mr;
        if (MODE == 0) { if (r < MTOK) { src = P.in[I_X] + (size_t)r * DM; mr = r >> 11; } else { src = P.in[I_CTX] + (size_t)(r - MTOK) * DM; mr = 4; } }
        else { src = P.out + (size_t)r * DM; mr = r >> 11; }
        f32x4 v[8]; float ss = 0.f;
#pragma unroll
        for (int j = 0; j < 8; ++j) { v[j] = *(const f32x4*)(src + (lane + 64 * j) * 4); ss += (v[j].x * v[j].x + v[j].y * v[j].y) + (v[j].z * v[j].z + v[j].w * v[j].w); }
        const float rstd = rsqrtf(wave_sum(ss) * (1.0f / DM) + EPS);
#pragma unroll
        for (int j = 0; j < 8; ++j) {
            const int col = (lane + 64 * j) * 4;
            const f32x4 g = *(const f32x4*)(gain + col);
            f32x4 y = v[j] * rstd * g;
            if (MODE == 2) { *(f32x4*)(P.out + (size_t)r * DM + col) = y; }
            else {
                const float* mrow = mod + (size_t)mr * NMOD6 + (MODE == 0 ? 0 : 3 * DM);
                const f32x4 sh = *(const f32x4*)(mrow + col), sc = *(const f32x4*)(mrow + DM + col);
                y = y * (1.0f + sc) + sh;
                u32x2 o; o.x = cvt_pk_bf16(y.x, y.y); o.y = cvt_pk_bf16(y.z, y.w);
                bf16_t* dst = (bf16_t*)(P.ws + (MODE == 0 ? WS_H : WS_H2)) + (size_t)r * DM + col;
                *(u32x2*)dst = o;
            }
        }
    }
}

__device__ __forceinline__ void qk_norm_rope(const Params& P, int G) {
    int tid_ = threadIdx.x; asm volatile("" : "+v"(tid_));
    const int tid = tid_, wid = tid >> 6, lane = tid & 63, sub = lane >> 5, i = lane & 31;
    const int gw = blockIdx.x * 8 + wid, NGW = G * 8;
    const float inv = powf(10000.0f, -(float)(2 * i) / 64.0f);
    constexpr int NQ = MTOK * NQH, NK = NB * SKV * NKVH;
    for (int it = gw; it < (NQ + NK) / 2; it += NGW) {
        const int hr = it * 2 + sub;
        bf16_t* p; const float* g; int pos; bool rope;
        if (hr < NQ) { const int row = hr / NQH, h = hr - row * NQH; p = (bf16_t*)(P.ws + WS_Q) + (size_t)row * AW + h * HD; g = P.in[I_QG]; pos = row & (SEQ - 1); rope = true; }
        else { const int r2 = hr - NQ, kr = r2 >> 2, h = r2 & 3; p = (bf16_t*)(P.ws + WS_K) + (size_t)kr * KVW + h * HD; g = P.in[I_KG]; const int t = kr % SKV; rope = t >= CTXL; pos = t - CTXL; }
        float x0 = bf2f(p[i]), x1 = bf2f(p[i + 32]), x2 = bf2f(p[64 + i]), x3 = bf2f(p[96 + i]);
        float ss = (x0 * x0 + x1 * x1) + (x2 * x2 + x3 * x3);
#pragma unroll
        for (int o = 1; o < 32; o <<= 1) ss += __shfl_xor(ss, o);
        const float rstd = rsqrtf(ss * (1.0f / HD) + EPS);
        x0 *= rstd * g[i]; x1 *= rstd * g[i + 32]; x2 *= rstd * g[64 + i]; x3 *= rstd * g[96 + i];
        if (rope) {
            const float ar = (float)(pos >> 6) * inv, ac = (float)(pos & 63) * inv;
            const float cr = cosf(ar), sr = sinf(ar), cc = cosf(ac), sc = sinf(ac);
            const float y0 = x0 * cr - x1 * sr, y1 = x1 * cr + x0 * sr, y2 = x2 * cc - x3 * sc, y3 = x3 * cc + x2 * sc;
            x0 = y0; x1 = y1; x2 = y2; x3 = y3;
        }
        p[i] = f2bf(x0); p[i + 32] = f2bf(x1); p[64 + i] = f2bf(x2); p[96 + i] = f2bf(x3);
    }
}

__device__ __forceinline__ void attention_phase(const Params& P, unsigned char* lds, int G) {
    const int c = blockIdx.x;
    for (int j = 0;; ++j) {
        int au;
        if (G == 256) { if (c < 64) { if (j > 0) break; au = c; } else { au = 64 + (c - 64) + 192 * j; } }
        else au = c + G * j;
        if (au >= NB * NQH * 8) break;
        const int qb = au & 7, bh = au >> 3, h = bh % NQH, b = bh / NQH;
        const bf16_t* Qb = (const bf16_t*)(P.ws + WS_Q) + (size_t)(b * SEQ + qb * 256) * AW + h * HD;
        const bf16_t* Kh = (const bf16_t*)(P.ws + WS_K) + (size_t)b * SKV * KVW + (h / 3) * HD;
        const bf16_t* Vh = (const bf16_t*)(P.ws + WS_V) + (size_t)b * SKV * KVW + (h / 3) * HD;
        bf16_t* Ob = (bf16_t*)(P.ws + WS_MIX) + (size_t)(b * SEQ + qb * 256) * DM + h * HD;
        att::attn_dense_body(Qb, Kh, Vh, Ob, SKV, (char*)lds);
    }
}

__global__ void __launch_bounds__(512, 2) fwd_megakernel(Params P) {
    extern __shared__ __attribute__((aligned(16))) unsigned char lds[];
    cg::grid_group grid = cg::this_grid();
    const int G = gridDim.x, c = blockIdx.x;
    LAS unsigned char* l3 = (LAS unsigned char*)lds;
#pragma nounroll
    for (int ph = 0; ph < 10; ++ph) {
        int gm = -1;
        switch (ph) {
        case 0: phase0(P, l3, G); break;
        case 1: rows_pass<0>(P, G); break;
        case 2: gm = G_IN; break;
        case 3: qk_norm_rope(P, G); gm = G_F1; break;
        case 4: gm = G_F2; break;
        case 5: gm = G_OUT; break;
        case 6: rows_pass<1>(P, G); break;
        case 7: gm = G_UP; break;
        case 8: gm = G_DOWN; break;
        default: rows_pass<2>(P, G); break;
        }
#ifndef NO_GEMM
        if (gm >= 0) gemm_phase(l3, P, gm, G, c);
#endif
#ifndef NO_ATT
        if (ph == 4) attention_phase(P, lds, G);
#endif
        if (ph < 9) grid.sync();
    }
}

extern "C" void kernel_launch(void* const* d_in, const int* in_sizes, int n_in, void* d_out, int out_size, void* d_ws, size_t ws_size, hipStream_t stream) {
    static int grid_blocks = 0;
    if (grid_blocks == 0) {
        if (n_in != 16 || out_size != MTOK * DM || ws_size < WS_END) { fprintf(stderr, "kernel_launch: unexpected shapes (n_in %d out %d ws %zu)\n", n_in, out_size, ws_size); grid_blocks = -1; return; }
        int dev = 0, cus = 0, per_cu = 0;
        hipGetDevice(&dev);
        hipDeviceGetAttribute(&cus, hipDeviceAttributeMultiprocessorCount, dev);
        if (hipFuncSetAttribute((const void*)fwd_megakernel, hipFuncAttributeMaxDynamicSharedMemorySize, LDS_BYTES) != hipSuccess) { fprintf(stderr, "kernel_launch: hipFuncSetAttribute failed\n"); grid_blocks = -1; return; }
        if (hipOccupancyMaxActiveBlocksPerMultiprocessor(&per_cu, (const void*)fwd_megakernel, 512, LDS_BYTES) != hipSuccess || per_cu < 1) { fprintf(stderr, "kernel_launch: occupancy query failed (%d)\n", per_cu); per_cu = 1; }
        (void)hipGetLastError();
        grid_blocks = cus;
    }
    if (grid_blocks < 0) return;
    hipMemsetAsync((char*)d_ws + WS_MOD, 0, 5 * NMOD6 * sizeof(float), stream);
    Params p{};
    for (int i = 0; i < 16; ++i) p.in[i] = (const float*)d_in[i];
    p.out = (float*)d_out; p.ws = (unsigned char*)d_ws;
    void* args[] = {&p};
    hipError_t e = hipLaunchCooperativeKernel((const void*)fwd_megakernel, dim3(grid_blocks), dim3(512), args, LDS_BYTES, stream);
    if (e != hipSuccess) fprintf(stderr, "cooperative launch failed: %s (grid %d)\n", hipGetErrorString(e), grid_blocks);
}
#ifdef TEST_KERNELS
__global__ void __launch_bounds__(512, 2) t_att(Params P) { extern __shared__ __attribute__((aligned(16))) unsigned char lds[]; attention_phase(P, lds, gridDim.x); }
__global__ void __launch_bounds__(512, 2) t_gemm(Params P, int mode) { extern __shared__ __attribute__((aligned(16))) unsigned char lds[]; gemm_phase((LAS unsigned char*)lds, P, mode, gridDim.x, blockIdx.x); }
__global__ void __launch_bounds__(512, 2) t_gemm_up(Params P) { extern __shared__ __attribute__((aligned(16))) unsigned char lds[]; gemm_phase((LAS unsigned char*)lds, P, G_UP, gridDim.x, blockIdx.x); }
__global__ void __launch_bounds__(512, 2) t_gemm_out(Params P) { extern __shared__ __attribute__((aligned(16))) unsigned char lds[]; gemm_phase((LAS unsigned char*)lds, P, G_OUT, gridDim.x, blockIdx.x); }
#endif
```

```cpp
#include <hip/hip_runtime.h>
#include <hip/hip_bf16.h>
#include <hip/hip_cooperative_groups.h>
#include <cstdio>
#include <cstdint>
namespace cg = cooperative_groups;

#ifndef PROBE
#define PROBE 0
#endif
#define LAS __attribute__((address_space(3)))
typedef unsigned short bf16_t;
typedef short bf16x8 __attribute__((ext_vector_type(8)));
typedef short s16x4 __attribute__((ext_vector_type(4)));
typedef float f32x4 __attribute__((ext_vector_type(4)));
typedef float f32x16 __attribute__((ext_vector_type(16)));
typedef unsigned u32x4 __attribute__((ext_vector_type(4)));
typedef unsigned u32x2 __attribute__((ext_vector_type(2)));

constexpr int DM = 2048, NB = 4, SEQ = 2048, CTXL = 256, HD = 128, NQH = 12, NKVH = 4;
constexpr int AW = 1536, KVW = 512, FW = 512, INW = 3072, DFF = 8192, NMOD6 = 6 * DM;
constexpr int MTOK = NB * SEQ, MCTX = NB * CTXL, SKV = SEQ + CTXL;
constexpr float EPS = 1e-6f;

constexpr size_t MiB = 1u << 20;
constexpr size_t WS_MOD = 0;
constexpr size_t WS_BAR = 245760;
constexpr size_t WS_CTL_BYTES = 262144;
constexpr size_t WS_GT = 1 * MiB;
constexpr size_t WS_WIN = 2 * MiB;
constexpr size_t WS_WOUT = 14 * MiB;
constexpr size_t WS_W1 = 22 * MiB;
constexpr size_t WS_W2 = 54 * MiB;
constexpr size_t WS_DFT = 86 * MiB;
constexpr size_t WS_H2 = 102 * MiB;
constexpr size_t WS_H = 134 * MiB;
constexpr size_t WS_Q = 170 * MiB;
constexpr size_t WS_K = 194 * MiB;
constexpr size_t WS_V = 203 * MiB;
constexpr size_t WS_U = 212 * MiB;
constexpr size_t WS_ZT = 220 * MiB;
constexpr size_t WS_MIX = 236 * MiB;
constexpr size_t WS_A1 = 134 * MiB;
constexpr size_t WS_END = 268 * MiB;

constexpr int LDS_BYTES = 131072 + 1024;

struct Params { const float* in[16]; float* out; unsigned char* ws; };
enum { I_X = 0, I_C, I_CTX, I_CCTX, I_WADA, I_BADA, I_G1, I_WIN, I_QG, I_KG, I_WF, I_WOUT, I_G2, I_W1, I_W2, I_GF };

__device__ __forceinline__ unsigned cvt_pk_bf16(float lo, float hi) { unsigned r; asm("v_cvt_pk_bf16_f32 %0, %1, %2" : "=v"(r) : "v"(lo), "v"(hi)); return r; }
__device__ __forceinline__ float bf2f(bf16_t v) { return __uint_as_float(((unsigned)v) << 16); }
__device__ __forceinline__ bf16_t f2bf(float f) { return (bf16_t)(cvt_pk_bf16(f, 0.f) & 0xffffu); }
__device__ __forceinline__ float wave_sum(float v) {
#pragma unroll
    for (int o = 1; o < 64; o <<= 1) v += __shfl_xor(v, o);
    return v;
}
#define LDS_WAIT() asm volatile("s_waitcnt lgkmcnt(0)" ::: "memory")

constexpr int BM = 256, BK = 64, HALF = 128, HTB = HALF * BK * 2, NXCD = 8, WGM = 8;
__device__ __forceinline__ int lds_byte(int r, int c) { const int st = (r >> 4) * 2 + (c >> 5), rr = r & 15, cc = c & 31, ob = rr * 64 + cc * 2; return st * 1024 + (ob ^ (((ob >> 9) & 1) << 5)); }
__device__ __forceinline__ void stage_rc(int b, int& R, int& C) { const int st = b / 1024, sb = b % 1024, swz = sb ^ (((sb >> 9) & 1) << 5); R = (st >> 1) * 16 + swz / 64; C = (st & 1) * 32 + (swz % 64) / 2; }
__device__ __forceinline__ int perm32(int rho) { const int n = rho >> 4, i = rho & 15; return 8 * (i >> 2) + 4 * n + (i & 3); }

struct Unit { int pm, pn; const char* a; const char* b; };
enum { G_IN = 0, G_F1, G_F2, G_OUT, G_UP, G_DOWN };

__device__ __forceinline__ void remap_tile(int L, int nM, int nN, int& pm, int& pn) {
    const int nwg = nM * nN; int wgid = L;
    { const int q = nwg / NXCD, r = nwg % NXCD, xcd = wgid % NXCD, off = wgid / NXCD; wgid = (xcd < r ? xcd * (q + 1) : r * (q + 1) + (xcd - r) * q) + off; }
    const int nig = WGM * nN, gid = wgid / nig, fm = gid * WGM, gsz = (nM - fm) < WGM ? (nM - fm) : WGM;
    pm = fm + ((wgid % nig) % gsz); pn = (wgid % nig) / gsz;
}

__device__ __forceinline__ bool get_unit(const unsigned char* ws, int mode, int i, int G, int c, Unit& u) {
    const long L = (long)i * G + c;
    switch (mode) {
    case G_IN: {
        if (L >= 400) return false;
        if (L < 384) remap_tile((int)L, 32, 12, u.pm, u.pn);
        else { const int idx = (int)L - 384; u.pm = 32 + (idx >> 2); u.pn = 6 + (idx & 3); }
        u.a = (const char*)ws + WS_H + (size_t)u.pm * 256 * DM * 2; u.b = (const char*)ws + WS_WIN + (size_t)u.pn * 256 * DM * 2; return true; }
    case G_F1: {
        if (L >= 128) return false;
        const int g = (int)L >> 5; u.pm = g; u.pn = (int)L & 31;
        u.a = (const char*)ws + WS_GT + (size_t)g * 256 * 128 * 2; u.b = (const char*)ws + WS_U + ((size_t)u.pn * 256 * FW + g * 128) * 2; return true; }
    case G_F2: {
        if (L >= 64) return false;
        const int b = (int)L >> 4, pm = ((int)L >> 1) & 7, pn = (int)L & 1; u.pm = b * 8 + pm; u.pn = pn;
        u.a = (const char*)ws + WS_DFT + (size_t)pm * 256 * 4096 * 2; u.b = (const char*)ws + WS_ZT + ((size_t)(b * 512 + pn * 256) * 4096) * 2; return true; }
    case G_OUT: {
        if (L >= 256) return false;
        remap_tile((int)L, 32, 8, u.pm, u.pn);
        u.a = (const char*)ws + WS_MIX + (size_t)u.pm * 256 * DM * 2; u.b = (const char*)ws + WS_WOUT + (size_t)u.pn * 256 * DM * 2; return true; }
    case G_UP: {
        if (L >= 1024) return false;
        remap_tile((int)L, 32, 32, u.pm, u.pn);
        u.a = (const char*)ws + WS_H2 + (size_t)u.pm * 256 * DM * 2; u.b = (const char*)ws + WS_W1 + (size_t)u.pn * 256 * DM * 2; return true; }
    default: {
        if (L >= 256) return false;
        remap_tile((int)L, 32, 8, u.pm, u.pn);
        u.a = (const char*)ws + WS_A1 + (size_t)u.pm * 256 * DFF * 2; u.b = (const char*)ws + WS_W2 + (size_t)u.pn * 256 * DFF * 2; return true; }
    }
}

__device__ __forceinline__ void gemm_epilogue(const Params& P, int mode, const f32x4 (&acc)[2][2][4][2], const Unit& u, int wr, int wc, int fr, int fq) {
    unsigned char* ws = P.ws;
    if (mode == G_OUT || mode == G_DOWN) {
        const float* resid = (mode == G_OUT) ? P.in[I_X] : P.out;
        const float* gate = (const float*)(ws + WS_MOD) + (size_t)(u.pm >> 3) * NMOD6 + (mode == G_OUT ? 2 * DM : 5 * DM);
        const int col0 = u.pn * 256 + wc * 32 + 4 * fq;
        f32x4 gv[2][2];
#pragma unroll
        for (int bj = 0; bj < 2; ++bj)
#pragma unroll
            for (int n = 0; n < 2; ++n) gv[bj][n] = *(const f32x4*)(gate + col0 + bj * HALF + n * 16);
#pragma unroll
        for (int ai = 0; ai < 2; ++ai)
#pragma unroll
            for (int m = 0; m < 4; ++m) {
                const size_t off = (size_t)(u.pm * 256 + ai * HALF + wr * 64 + m * 16 + fr) * DM + col0;
#pragma unroll
                for (int bj = 0; bj < 2; ++bj)
#pragma unroll
                    for (int n = 0; n < 2; ++n) {
                        const f32x4 r = *(const f32x4*)(resid + off + bj * HALF + n * 16);
                        *(f32x4*)(P.out + off + bj * HALF + n * 16) = r + gv[bj][n] * acc[ai][bj][m][n];
                    }
            }
        return;
    }
    bf16_t* base; size_t ld, aistride;
    if (mode == G_IN) {
        const int pm = u.pm, pn = u.pn;
        if (pn < 6) { base = (bf16_t*)(ws + WS_Q) + (size_t)pm * 256 * AW + pn * 256; ld = AW; }
        else if (pn < 10) {
            const size_t krow0 = (pm < 32) ? (size_t)(pm >> 3) * SKV + CTXL + (size_t)(pm & 7) * 256 : (size_t)(pm - 32) * SKV;
            base = (bf16_t*)(ws + (pn < 8 ? WS_K : WS_V)) + krow0 * KVW + ((pn - 6) & 1) * 256; ld = KVW; }
        else { base = (bf16_t*)(ws + WS_U) + (size_t)pm * 256 * FW + (pn - 10) * 256; ld = FW; }
        aistride = 128 * ld;
    } else if (mode == G_F1) {
        const int g = u.pm, b = u.pn >> 3, s0 = (u.pn & 7) * 256;
        base = (bf16_t*)(ws + WS_ZT) + ((size_t)(b * 512 + g * 128) * 4096 + s0); ld = 4096; aistride = 2048;
    } else if (mode == G_F2) {
        base = (bf16_t*)(ws + WS_MIX) + (size_t)u.pm * 256 * DM + AW + u.pn * 256; ld = DM; aistride = 128 * ld;
    } else {
        base = (bf16_t*)(ws + WS_A1) + (size_t)u.pm * 256 * DFF + u.pn * 256; ld = DFF; aistride = 128 * ld;
    }
    const bool relu2 = (mode == G_UP);
    bf16_t* p0 = base + (size_t)(wr * 64 + fr) * ld + wc * 32 + 8 * fq;
#pragma unroll
    for (int ai = 0; ai < 2; ++ai)
#pragma unroll
        for (int m = 0; m < 4; ++m) {
            bf16_t* rowp = p0 + ai * aistride + (size_t)(m * 16) * ld;
#pragma unroll
            for (int bj = 0; bj < 2; ++bj) {
                f32x4 v0 = acc[ai][bj][m][0], v1 = acc[ai][bj][m][1];
                if (relu2) {
#pragma unroll
                    for (int e = 0; e < 4; ++e) { const float a = fmaxf(v0[e], 0.f), b = fmaxf(v1[e], 0.f); v0[e] = a * a; v1[e] = b * b; }
                }
                u32x4 w; w.x = cvt_pk_bf16(v0[0], v0[1]); w.y = cvt_pk_bf16(v0[2], v0[3]); w.z = cvt_pk_bf16(v1[0], v1[1]); w.w = cvt_pk_bf16(v1[2], v1[3]);
                *(u32x4*)(rowp + bj * HALF) = w;
            }
        }
}

__device__ __forceinline__ void gemm_phase(LAS unsigned char* lds, const Params& P, const int mode, const int G, const int c) {
    int tid_ = threadIdx.x; asm volatile("" : "+v"(tid_));
    const int tid = tid_, wid = __builtin_amdgcn_readfirstlane(tid >> 6), lane = tid & 63, wr = wid >> 2, wc = wid & 3, fr = lane & 15, fq = lane >> 4;
    int lda, ldb, K; bool perm = true;
    switch (mode) {
    case G_IN: lda = DM; ldb = DM; K = DM; break;
    case G_F1: lda = 128; ldb = FW; K = 128; break;
    case G_F2: lda = 4096; ldb = 4096; K = 4096; break;
    case G_OUT: lda = DM; ldb = DM; K = DM; perm = false; break;
    case G_UP: lda = DM; ldb = DM; K = DM; break;
    default: lda = DFF; ldb = DFF; K = DFF; perm = false; break;
    }
    const int nt = K / BK;
    unsigned voffA[2], voffB[2];
#pragma unroll
    for (int i = 0; i < 2; ++i) { int R, C; stage_rc(tid * 16 + i * 8192, R, C); const int Rb = perm ? ((R & ~31) + perm32(R & 31)) : R;
        voffA[i] = (unsigned)(R * lda + C) * 2u; voffB[i] = (unsigned)(Rb * ldb + C) * 2u; }
    const size_t kstep = (size_t)(BK * 2);
    const size_t hstepA = (size_t)HALF * lda * 2, hstepB = (size_t)HALF * ldb * 2;
    const unsigned ldsw = (unsigned)wid * 1024u;
    const int aoff = lds_byte(wr * 64 + fr, fq * 8), boff = lds_byte(wc * 32 + fr, fq * 8);
#define PG8_SA(b, h) (((b) * 2 + (h)) * HTB)
#define PG8_SB(b, h) ((4 + (b) * 2 + (h)) * HTB)
#define PG8_STAGE(bufoff, gbase, voff) do { _Pragma("unroll") for (int _i = 0; _i < 2; ++_i) \
        __builtin_amdgcn_global_load_lds((const unsigned*)((const char*)(gbase) + (voff)[_i]), (LAS unsigned*)(lds + (bufoff) + ldsw + _i * 8192), 16, 0, 0); } while (0)
#define PG8_LDA(dst, b, h) do { _Pragma("unroll") for (int m = 0; m < 4; ++m) _Pragma("unroll") for (int k = 0; k < 2; ++k) dst[m][k] = *(const LAS bf16x8*)(lds + PG8_SA(b, h) + aoff + m * 2048 + k * 1024); } while (0)
#define PG8_LDB(dst, b, h) do { _Pragma("unroll") for (int n = 0; n < 2; ++n) _Pragma("unroll") for (int k = 0; k < 2; ++k) dst[n][k] = *(const LAS bf16x8*)(lds + PG8_SB(b, h) + boff + n * 2048 + k * 1024); } while (0)
#define PG8_MMA(ai, bj, At, Bt) do { __builtin_amdgcn_s_setprio(1); _Pragma("unroll") for (int m = 0; m < 4; ++m) _Pragma("unroll") for (int n = 0; n < 2; ++n) _Pragma("unroll") for (int k = 0; k < 2; ++k) \
        acc[ai][bj][m][n] = __builtin_amdgcn_mfma_f32_16x16x32_bf16(Bt[n][k], At[m][k], acc[ai][bj][m][n], 0, 0, 0); __builtin_amdgcn_s_setprio(0); } while (0)
#define PG8_WAIT_V(n) asm volatile("s_waitcnt vmcnt(" #n ")" ::: "memory")
#define PG8_WAIT_L(n) asm volatile("s_waitcnt lgkmcnt(" #n ")" ::: "memory")
#define PG8_BAR __builtin_amdgcn_s_barrier()
#define PG8_SCHED __builtin_amdgcn_sched_barrier(0)
    Unit cur, nxt; int ui = 0;
    if (!get_unit(P.ws, mode, 0, G, c, cur)) return;
    f32x4 acc[2][2][4][2];
#pragma unroll
    for (int a = 0; a < 2; ++a)
#pragma unroll
        for (int b = 0; b < 2; ++b)
#pragma unroll
            for (int m = 0; m < 4; ++m)
#pragma unroll
                for (int n = 0; n < 2; ++n) acc[a][b][m][n] = (f32x4){0.f, 0.f, 0.f, 0.f};
    bf16x8 At[4][2], B0[2][2], B1[2][2];
    const char* cA = cur.a; const char* cB = cur.b;
    PG8_STAGE(PG8_SB(0, 0), cB, voffB); PG8_STAGE(PG8_SB(0, 1), cB + hstepB, voffB); PG8_STAGE(PG8_SA(0, 0), cA, voffA); PG8_STAGE(PG8_SA(0, 1), cA + hstepA, voffA);
    if (wr == 1) PG8_BAR;
    PG8_WAIT_V(2); PG8_BAR;
    PG8_STAGE(PG8_SB(1, 0), cB + kstep, voffB); PG8_STAGE(PG8_SA(1, 0), cA + kstep, voffA); PG8_STAGE(PG8_SB(1, 1), cB + hstepB + kstep, voffB);
    PG8_WAIT_V(6); PG8_BAR;
    for (;;) {
        const bool has_next = get_unit(P.ws, mode, ui + 1, G, c, nxt);
        const char* nA = has_next ? nxt.a : cA; const char* nB = has_next ? nxt.b : cB;
        for (int t = 0; t < nt; t += 2) {
            const bool last = (t == nt - 2);
            const char* a1 = cA + (size_t)(t + 1) * kstep;
            const char* a2 = last ? nA : cA + (size_t)(t + 2) * kstep; const char* b2 = last ? nB : cB + (size_t)(t + 2) * kstep;
            const char* a3 = a2 + kstep; const char* b3 = b2 + kstep;
            PG8_LDB(B0, 0, 0); PG8_LDB(B1, 0, 1); PG8_SCHED; PG8_LDA(At, 0, 0); PG8_STAGE(PG8_SA(1, 1), a1 + hstepA, voffA);
            PG8_WAIT_V(8); PG8_WAIT_L(0); PG8_BAR; PG8_MMA(0, 0, At, B0); PG8_MMA(0, 1, At, B1); PG8_BAR; PG8_SCHED;
            PG8_LDA(At, 0, 1); PG8_STAGE(PG8_SB(0, 0), b2, voffB); PG8_STAGE(PG8_SB(0, 1), b2 + hstepB, voffB); PG8_STAGE(PG8_SA(0, 0), a2, voffA);
            PG8_WAIT_V(8); PG8_WAIT_L(0); PG8_BAR; PG8_MMA(1, 0, At, B0); PG8_MMA(1, 1, At, B1); PG8_BAR; PG8_SCHED;
            PG8_LDB(B0, 1, 0); PG8_LDB(B1, 1, 1); PG8_SCHED; PG8_LDA(At, 1, 0); PG8_STAGE(PG8_SA(0, 1), a2 + hstepA, voffA);
            PG8_WAIT_V(8); PG8_WAIT_L(0); PG8_BAR; PG8_MMA(0, 0, At, B0); PG8_MMA(0, 1, At, B1); PG8_BAR; PG8_SCHED;
            PG8_LDA(At, 1, 1); PG8_STAGE(PG8_SB(1, 0), b3, voffB); PG8_STAGE(PG8_SB(1, 1), b3 + hstepB, voffB); PG8_STAGE(PG8_SA(1, 0), a3, voffA);
            PG8_WAIT_V(8); PG8_WAIT_L(0); PG8_BAR; PG8_MMA(1, 0, At, B0); PG8_MMA(1, 1, At, B1); PG8_BAR; PG8_SCHED;
        }
        if (wr == 0) PG8_BAR;
        gemm_epilogue(P, mode, acc, cur, wr, wc, fr, fq);
        if (!has_next) break;
#pragma unroll
        for (int a = 0; a < 2; ++a)
#pragma unroll
            for (int b = 0; b < 2; ++b)
#pragma unroll
                for (int m = 0; m < 4; ++m)
#pragma unroll
                    for (int n = 0; n < 2; ++n) acc[a][b][m][n] = (f32x4){0.f, 0.f, 0.f, 0.f};
        cur = nxt; cA = nA; cB = nB; ++ui;
        if (wr == 1) PG8_BAR;
    }
    PG8_WAIT_V(0);
    PG8_BAR;
#undef PG8_SA
#undef PG8_SB
#undef PG8_STAGE
#undef PG8_LDA
#undef PG8_LDB
#undef PG8_MMA
#undef PG8_WAIT_V
#undef PG8_WAIT_L
#undef PG8_BAR
#undef PG8_SCHED
}

namespace att {
constexpr int D = 128, NW = 8, QBLK = 32, KVBLK = 64;
constexpr float SCALE = 0.088388347648318440f;
constexpr float THR = 8.f;
constexpr int LDQ = AW, LDK = KVW, LDO = DM;
constexpr size_t SHM_V = KVBLK * D * 2, SHM_K = KVBLK * D * 2, SHM_ATTN = 2 * SHM_V + 2 * SHM_K + NW * 64 * 4;
#define KSWZ(row, colB) ((row) * 256 + ((colB) ^ (((row) & 7) << 4)))
#define SBAR() __builtin_amdgcn_sched_barrier(0)
__device__ __forceinline__ int crow(int r, int hi) { return (r & 3) + 8 * (r >> 2) + 4 * hi; }
__device__ __forceinline__ unsigned cvtpk(float lo, float hi) { unsigned r; asm volatile("v_cvt_pk_bf16_f32 %0, %1, %2" : "=v"(r) : "v"(lo), "v"(hi)); return r; }
__device__ __forceinline__ bf16x8 ld8(const bf16_t* p) { return *reinterpret_cast<const bf16x8*>(p); }

__device__ __forceinline__ void partialSM(f32x16& p0, f32x16& p1, float& m_reg, float& mn, float& alpha) {
  constexpr float C = SCALE * 1.4426950408889634f;
  float pmax = p0[0];
#pragma unroll
  for (int r = 1; r < 16; ++r) pmax = fmaxf(pmax, p0[r]);
#pragma unroll
  for (int r = 0; r < 16; ++r) pmax = fmaxf(pmax, p1[r]);
  { auto rr = __builtin_amdgcn_permlane32_swap(__float_as_uint(pmax), __float_as_uint(pmax), false, false);
    pmax = fmaxf(__uint_as_float(rr[0]), __uint_as_float(rr[1])); }
  if (__builtin_expect(__all(pmax - m_reg <= THR / SCALE), 1)) { mn = m_reg; alpha = 1.f; }
  else { mn = fmaxf(m_reg, pmax); alpha = __builtin_amdgcn_exp2f((m_reg - mn) * C); m_reg = mn; }
  float mnC = -mn * C;
#pragma unroll
  for (int r = 0; r < 16; ++r) p0[r] = fmaf(p0[r], C, mnC);
#pragma unroll
  for (int r = 0; r < 16; ++r) p1[r] = fmaf(p1[r], C, mnC);
#pragma unroll
  for (int r = 0; r < 16; ++r) p0[r] = __builtin_amdgcn_exp2f(p0[r]);
}
__device__ __forceinline__ void finishSM(f32x16& p0, f32x16& p1, float alpha, float& l_reg, bf16x8& pa0, bf16x8& pa1, bf16x8& pa2, bf16x8& pa3) {
#pragma unroll
  for (int r = 0; r < 16; ++r) p1[r] = __builtin_amdgcn_exp2f(p1[r]);
  float ps = 0;
#pragma unroll
  for (int r = 0; r < 16; ++r) ps += p0[r];
#pragma unroll
  for (int r = 0; r < 16; ++r) ps += p1[r];
  { auto rr = __builtin_amdgcn_permlane32_swap(__float_as_uint(ps), __float_as_uint(ps), false, false);
    ps = __uint_as_float(rr[0]) + __uint_as_float(rr[1]); }
  l_reg = l_reg * alpha + ps;
#define PK4(P, BASE, OUT) do { unsigned a0 = cvtpk(P[BASE + 0], P[BASE + 1]), a1 = cvtpk(P[BASE + 2], P[BASE + 3]);   \
    unsigned b0 = cvtpk(P[BASE + 4], P[BASE + 5]), b1 = cvtpk(P[BASE + 6], P[BASE + 7]);                              \
    auto r0 = __builtin_amdgcn_permlane32_swap(a0, b0, false, false); auto r1 = __builtin_amdgcn_permlane32_swap(a1, b1, false, false); \
    u32x4 w = {r0[0], r1[0], r0[1], r1[1]}; OUT = *reinterpret_cast<bf16x8*>(&w); } while (0)
  PK4(p0, 0, pa0); PK4(p0, 8, pa1); PK4(p1, 0, pa2); PK4(p1, 8, pa3);
#undef PK4
}
__device__ __forceinline__ void qkt(f32x16& p0, f32x16& p1, const bf16_t* Ks, const bf16x8* qr, int r32, int hi) {
  p0 = f32x16{}; p1 = f32x16{};
#pragma unroll
  for (int d0 = 0; d0 < 8; ++d0) { int cb = (d0 * 16 + hi * 8) * 2;
    bf16x8 b0 = *reinterpret_cast<const bf16x8*>((const char*)Ks + KSWZ(r32, cb));
    bf16x8 b1 = *reinterpret_cast<const bf16x8*>((const char*)Ks + KSWZ(32 + r32, cb));
    p0 = __builtin_amdgcn_mfma_f32_32x32x16_bf16(b0, qr[d0], p0, 0, 0, 0);
    p1 = __builtin_amdgcn_mfma_f32_32x32x16_bf16(b1, qr[d0], p1, 0, 0, 0); }
}
__device__ __forceinline__ int v_st(int k, int c) { const int kk = (k & ~0xC) | ((k & 4) << 1) | ((k & 8) >> 1); return ((kk >> 3) * 4 + (c >> 5)) * 512 + ((kk & 7) * 32 + (c & 31)) * 2; }
__device__ __forceinline__ int v_rd_base(int lane) { return ((lane & 3) << 3) | (((lane >> 2) & 3) << 6) | (((lane >> 4) & 1) << 5) | (((lane >> 5) & 1) << 8); }
constexpr int v_rd_off(int d0, int ks, int half) { return d0 * 512 + ks * 4096 + half * 2048; }
template <int OFF> __device__ __forceinline__ s16x4 tr_read(int vb) {
  s16x4 r; asm volatile("ds_read_b64_tr_b16 %0, %1 offset:%2" : "=&v"(r) : "v"(vb), "i"(OFF) : "memory"); return r;
}
template <int D0> __device__ __forceinline__ void pv_one(f32x16& od, int vb, bf16x8 pa0, bf16x8 pa1, bf16x8 pa2, bf16x8 pa3) {
  const s16x4 l0 = tr_read<v_rd_off(D0, 0, 0)>(vb), h0 = tr_read<v_rd_off(D0, 0, 1)>(vb), l1 = tr_read<v_rd_off(D0, 1, 0)>(vb), h1 = tr_read<v_rd_off(D0, 1, 1)>(vb);
  const s16x4 l2 = tr_read<v_rd_off(D0, 2, 0)>(vb), h2 = tr_read<v_rd_off(D0, 2, 1)>(vb), l3 = tr_read<v_rd_off(D0, 3, 0)>(vb), h3 = tr_read<v_rd_off(D0, 3, 1)>(vb);
  asm volatile("s_waitcnt lgkmcnt(0)" ::: "memory"); SBAR();
#define PK(L, H) (bf16x8){L[0], L[1], L[2], L[3], H[0], H[1], H[2], H[3]}
  od = __builtin_amdgcn_mfma_f32_32x32x16_bf16(pa0, PK(l0, h0), od, 0, 0, 0);
  od = __builtin_amdgcn_mfma_f32_32x32x16_bf16(pa1, PK(l1, h1), od, 0, 0, 0);
  od = __builtin_amdgcn_mfma_f32_32x32x16_bf16(pa2, PK(l2, h2), od, 0, 0, 0);
  od = __builtin_amdgcn_mfma_f32_32x32x16_bf16(pa3, PK(l3, h3), od, 0, 0, 0);
#undef PK
}
__device__ __forceinline__ void pv_d0(f32x16* o, int vb, bf16x8 pa0, bf16x8 pa1, bf16x8 pa2, bf16x8 pa3) {
  pv_one<0>(o[0], vb, pa0, pa1, pa2, pa3); pv_one<1>(o[1], vb, pa0, pa1, pa2, pa3); pv_one<2>(o[2], vb, pa0, pa1, pa2, pa3); pv_one<3>(o[3], vb, pa0, pa1, pa2, pa3);
}

__device__ __forceinline__ void attn_dense_body(const bf16_t* __restrict__ Qb, const bf16_t* __restrict__ Kh, const bf16_t* __restrict__ Vh,
                                                bf16_t* __restrict__ Ob, int seq, char* lds) {
  int tid_ = threadIdx.x; asm volatile("" : "+v"(tid_));
  const int tid = tid_, wid = tid >> 6, lane = tid & 63, r32 = lane & 31, hi = lane >> 5;
  bf16_t* V_lds = (bf16_t*)lds; bf16_t* K_lds = (bf16_t*)(lds + 2 * SHM_V);
  float* ws = (float*)(lds + 2 * SHM_V + 2 * SHM_K) + wid * 64; float* li_l = ws; float* al_l = ws + 32;
  float m_reg = -1e30f, l_reg = 0; f32x16 o[4] = {}; bf16x8 qr[8];
  const bf16_t* Qw = Qb + (long)(wid * QBLK + r32) * LDQ + hi * 8;
#pragma unroll
  for (int d0 = 0; d0 < 8; ++d0) qr[d0] = ld8(Qw + d0 * 16);
  const int sr = tid >> 4, sc = (tid & 15) * 8, vst0 = v_st(sr, sc), vst1 = v_st(32 + sr, sc);
  const int vb0 = (int)(uintptr_t)V_lds + v_rd_base(lane);
  struct { bf16x8 vs0, vs1, ks0, ks1; } sr_[2];
#define SLOAD(i, k0) do { sr_[i].vs0 = ld8(&Vh[(long)((k0) + sr) * LDK + sc]); sr_[i].vs1 = ld8(&Vh[(long)((k0) + 32 + sr) * LDK + sc]); \
    sr_[i].ks0 = ld8(&Kh[(long)((k0) + sr) * LDK + sc]); sr_[i].ks1 = ld8(&Kh[(long)((k0) + 32 + sr) * LDK + sc]); } while (0)
#define SWRITE(b, i) do { *(bf16x8*)((char*)V_lds + (b) * SHM_V + vst0) = sr_[i].vs0;          \
    *(bf16x8*)((char*)V_lds + (b) * SHM_V + vst1) = sr_[i].vs1; int kc = sc * 2;               \
    *(bf16x8*)((char*)K_lds + (b) * SHM_K + KSWZ(sr, kc)) = sr_[i].ks0;                       \
    *(bf16x8*)((char*)K_lds + (b) * SHM_K + KSWZ(32 + sr, kc)) = sr_[i].ks1; } while (0)
#define SWAIT() asm volatile("s_waitcnt vmcnt(4)" ::: "memory")
#define RESC(a) do { if (__any((a) < 1.f)) { if (hi == 0) al_l[r32] = (a); asm volatile("s_waitcnt lgkmcnt(0)" ::: "memory"); \
    _Pragma("unroll") for (int d = 0; d < 4; ++d) _Pragma("unroll") for (int r = 0; r < 16; ++r) o[d][r] *= al_l[crow(r, hi)]; } } while (0)
  f32x16 pA0, pA1, pB0, pB1; float mnA, mnB, alA, alB; bf16x8 pa0, pa1, pa2, pa3; const int NT = seq / KVBLK;
  constexpr int SE = 0, SO = 1;
  SLOAD(SE, 0); asm volatile("s_waitcnt vmcnt(0)" ::: "memory"); SWRITE(0, SE); __syncthreads();
  qkt(pA0, pA1, K_lds, qr, r32, hi); partialSM(pA0, pA1, m_reg, mnA, alA);
  SLOAD(SO, KVBLK); if (2 < NT) SLOAD(SE, 2 * KVBLK);
  SWAIT(); SWRITE(1, SO); __syncthreads();
  for (int j = 1; j + 1 < NT; j += 2) {
    SBAR(); qkt(pB0, pB1, (bf16_t*)((char*)K_lds + SHM_K), qr, r32, hi);
    finishSM(pA0, pA1, alA, l_reg, pa0, pa1, pa2, pa3); SBAR();
    SLOAD(SO, (j + 2) * KVBLK); SBAR();
    pv_d0(o, vb0, pa0, pa1, pa2, pa3); partialSM(pB0, pB1, m_reg, mnB, alB);
    __syncthreads(); SWAIT(); SWRITE(0, SE);
    RESC(alB); __syncthreads();
    SBAR(); qkt(pA0, pA1, K_lds, qr, r32, hi);
    finishSM(pB0, pB1, alB, l_reg, pa0, pa1, pa2, pa3); SBAR();
    if (j + 3 < NT) SLOAD(SE, (j + 3) * KVBLK); SBAR();
    pv_d0(o, vb0 + (int)SHM_V, pa0, pa1, pa2, pa3); partialSM(pA0, pA1, m_reg, mnA, alA);
    __syncthreads(); SWAIT(); SWRITE(1, SO);
    RESC(alA); __syncthreads();
  }
  SBAR(); qkt(pB0, pB1, (bf16_t*)((char*)K_lds + SHM_K), qr, r32, hi);
  finishSM(pA0, pA1, alA, l_reg, pa0, pa1, pa2, pa3); SBAR();
  pv_d0(o, vb0, pa0, pa1, pa2, pa3); partialSM(pB0, pB1, m_reg, mnB, alB);
  __syncthreads(); RESC(alB);
  finishSM(pB0, pB1, alB, l_reg, pa0, pa1, pa2, pa3); SBAR();
  pv_d0(o, vb0 + (int)SHM_V, pa0, pa1, pa2, pa3);
  if (hi == 0) li_l[r32] = l_reg; asm volatile("s_waitcnt lgkmcnt(0)" ::: "memory");
  float rli[16];
#pragma unroll
  for (int r = 0; r < 16; ++r) rli[r] = __builtin_amdgcn_rcpf(li_l[crow(r, hi)]);
  bf16_t* Ow = Ob + (long)(wid * QBLK) * LDO;
#pragma unroll
  for (int r = 0; r < 16; ++r) { int orow = crow(r, hi);
#pragma unroll
    for (int d0 = 0; d0 < 4; ++d0) Ow[(long)orow * LDO + d0 * 32 + r32] = f2bf(o[d0][r] * rli[r]); }
  __syncthreads();
#undef SLOAD
#undef SWRITE
#undef SWAIT
#undef RESC
}
#undef KSWZ
#undef SBAR
}

__device__ __forceinline__ void transpose_item(const float* __restrict__ W, int K, int N, bf16_t* __restrict__ WT, LAS float* scr, int item, int lane) {
    const int nblk = N / 32, kb = item / nblk, nb = item % nblk, k0 = 64 * kb, n0 = 32 * nb;
#pragma unroll 8
    for (int i = 0; i < 32; ++i) { const int kk = 2 * i + (lane >> 5); scr[kk * 33 + (lane & 31)] = W[(size_t)(k0 + kk) * N + n0 + (lane & 31)]; }
    LDS_WAIT();
    const int c = lane & 7;
#pragma unroll
    for (int j = 0; j < 4; ++j) { const int n = (lane >> 3) + 8 * j; const LAS float* s = scr + (8 * c) * 33 + n;
        u32x4 o; o.x = cvt_pk_bf16(s[0 * 33], s[1 * 33]); o.y = cvt_pk_bf16(s[2 * 33], s[3 * 33]); o.z = cvt_pk_bf16(s[4 * 33], s[5 * 33]); o.w = cvt_pk_bf16(s[6 * 33], s[7 * 33]);
        *(u32x4*)(WT + (size_t)(n0 + n) * K + k0 + 8 * c) = o; }
    LDS_WAIT();
}

__device__ __forceinline__ void phase0(const Params& P, LAS unsigned char* lds, int G, bool do_ada) {
    int tid_ = threadIdx.x; asm volatile("" : "+v"(tid_));
    const int tid = tid_, wid = tid >> 6, lane = tid & 63;
    unsigned char* ws = P.ws;
    if (do_ada) {
        LAS float* sl = (LAS float*)lds;
        for (int i = tid; i < 5 * DM; i += 512) { const float v = (i < 4 * DM) ? P.in[I_C][i] : P.in[I_CCTX][i - 4 * DM]; sl[i] = v / (1.f + expf(-v)); }
        __syncthreads();
        LAS float* red = (LAS float*)(lds + 40960);
        float* mod = (float*)(ws + WS_MOD);
        const float* w_ada = P.in[I_WADA];
        for (int it = blockIdx.x; it < 768; it += G) {
            const int cc = it % 48, kc = it / 48;
            const int kb = kc * 128 + wid * 16;
            const float* wp = w_ada + (size_t)kb * NMOD6 + cc * 256 + lane * 4;
            f32x4 acc[5];
#pragma unroll
            for (int r = 0; r < 5; ++r) acc[r] = (f32x4){0.f, 0.f, 0.f, 0.f};
#pragma unroll
            for (int i = 0; i < 16; ++i) {
                const f32x4 wv = *(const f32x4*)(wp + (size_t)i * NMOD6);
#pragma unroll
                for (int r = 0; r < 5; ++r) { const float s = sl[r * DM + kb + i]; acc[r] += wv * s; }
            }
#pragma unroll
            for (int r = 0; r < 5; ++r) *(LAS f32x4*)(red + (wid * 5 + r) * 256 + lane * 4) = acc[r];
            __syncthreads();
            if (tid < 320) {
                const int r = tid >> 6, q = tid & 63;
                f32x4 s = (f32x4){0.f, 0.f, 0.f, 0.f};
#pragma unroll
                for (int w = 0; w < 8; ++w) s += *(const LAS f32x4*)(red + (w * 5 + r) * 256 + q * 4);
                if (kc == 0) s += *(const f32x4*)(P.in[I_BADA] + cc * 256 + q * 4);
                float* dst = mod + (size_t)r * NMOD6 + cc * 256 + q * 4;
                unsafeAtomicAdd(dst + 0, s[0]); unsafeAtomicAdd(dst + 1, s[1]); unsafeAtomicAdd(dst + 2, s[2]); unsafeAtomicAdd(dst + 3, s[3]);
            }
            __syncthreads();
        }
    }
    {
        LAS float* scr = (LAS float*)(lds + wid * 8448);
        const int gw = blockIdx.x * 8 + wid, NGW = G * 8;
        constexpr int I_A = (DM / 64) * (INW / 32), I_B = (DM / 64) * (DM / 32), I_C1 = (DM / 64) * (DFF / 32), I_D = (DFF / 64) * (DM / 32);
        for (int it = gw; it < I_A + I_B + I_C1 + I_D; it += NGW) {
            int r = it;
            if (r < I_A) { transpose_item(P.in[I_WIN], DM, INW, (bf16_t*)(ws + WS_WIN), scr, r, lane); continue; } r -= I_A;
            if (r < I_B) { transpose_item(P.in[I_WOUT], DM, DM, (bf16_t*)(ws + WS_WOUT), scr, r, lane); continue; } r -= I_B;
            if (r < I_C1) { transpose_item(P.in[I_W1], DM, DFF, (bf16_t*)(ws + WS_W1), scr, r, lane); continue; } r -= I_C1;
            transpose_item(P.in[I_W2], DFF, DM, (bf16_t*)(ws + WS_W2), scr, r, lane);
        }
        __syncthreads();
    }
    {
        LAS float* ct = (LAS float*)lds;
        for (int j = tid; j < 2048; j += 512) ct[j] = cospif((float)j * (1.0f / 1024.0f));
        __syncthreads();
        bf16_t* dft = (bf16_t*)(ws + WS_DFT);
        for (int idx = blockIdx.x * 512 + tid; idx < 2048 * 512; idx += G * 512) {
            const int k = idx >> 9, n0 = (idx & 511) * 8, part = n0 >> 11, nn = n0 & 2047;
            float v[8];
#pragma unroll
            for (int e = 0; e < 8; ++e) { const int j = (k * (nn + e)) & 2047; v[e] = ct[part ? ((j - 512) & 2047) : j]; }
            u32x4 o; o.x = cvt_pk_bf16(v[0], v[1]); o.y = cvt_pk_bf16(v[2], v[3]); o.z = cvt_pk_bf16(v[4], v[5]); o.w = cvt_pk_bf16(v[6], v[7]);
            *(u32x4*)(dft + (size_t)k * 4096 + n0) = o;
        }
        bf16_t* gt = (bf16_t*)(ws + WS_GT);
        const float* wf = P.in[I_WF];
        for (int idx = blockIdx.x * 512 + tid; idx < 4 * 2 * 128 * 128; idx += G * 512) {
            const int d = idx & 127, cch = (idx >> 7) & 127, part = (idx >> 14) & 1, g = idx >> 15;
            float sum = 0.f;
            for (int l = 0; l < 128; ++l) {
                const int j = (cch * l) & 127;
                const float cs = part ? -ct[((j - 32) & 127) * 16] : ct[j * 16];
                sum += cs * wf[(size_t)(g * 128 + l) * 128 + d];
            }
            gt[(size_t)((g * 2 + part) * 128 + d) * 128 + cch] = f2bf(sum * (1.0f / 512.0f));
        }
    }
}

template <int MODE> __device__ __forceinline__ void rows_pass(const Params& P, int G) {
    int tid_ = threadIdx.x; asm volatile("" : "+v"(tid_));
    const int tid = tid_, wid = tid >> 6, lane = tid & 63;
    const int gw = blockIdx.x * 8 + wid, NGW = G * 8;
    const int nrows = (MODE == 0) ? (MTOK + MCTX) : MTOK;
    const float* mod = (const float*)(P.ws + WS_MOD);
    const float* gain = P.in[MODE == 0 ? I_G1 : (MODE == 1 ? I_G2 : I_GF)];
    for (int r = gw; r < nrows; r += NGW) {
        const float* src; int mr;
        if (MODE == 0) { if (r < MTOK) { src = P.in[I_X] + (size_t)r * DM; mr = r >> 11; } else { src = P.in[I_CTX] + (size_t)(r - MTOK) * DM; mr = 4; } }
        else { src = P.out + (size_t)r * DM; mr = r >> 11; }
        f32x4 v[8]; float ss = 0.f;
#pragma unroll
        for (int j = 0; j < 8; ++j) { v[j] = *(const f32x4*)(src + (lane + 64 * j) * 4); ss += (v[j].x * v[j].x + v[j].y * v[j].y) + (v[j].z * v[j].z + v[j].w * v[j].w); }
        const float rstd = rsqrtf(wave_sum(ss) * (1.0f / DM) + EPS);
#pragma unroll
        for (int j = 0; j < 8; ++j) {
            const int col = (lane + 64 * j) * 4;
            const f32x4 g = *(const f32x4*)(gain + col);
            f32x4 y = v[j] * rstd * g;
            if (MODE == 2) { *(f32x4*)(P.out + (size_t)r * DM + col) = y; }
            else {
                const float* mrow = mod + (size_t)mr * NMOD6 + (MODE == 0 ? 0 : 3 * DM);
                const f32x4 sh = *(const f32x4*)(mrow + col), sc = *(const f32x4*)(mrow + DM + col);
                y = y * (1.0f + sc) + sh;
                u32x2 o; o.x = cvt_pk_bf16(y.x, y.y); o.y = cvt_pk_bf16(y.z, y.w);
                bf16_t* dst = (bf16_t*)(P.ws + (MODE == 0 ? WS_H : WS_H2)) + (size_t)r * DM + col;
                *(u32x2*)dst = o;
            }
        }
    }
}

__device__ __forceinline__ void qk_norm_rope(const Params& P, int G) {
    int tid_ = threadIdx.x; asm volatile("" : "+v"(tid_));
    const int tid = tid_, wid = tid >> 6, lane = tid & 63, sub = lane >> 5, i = lane & 31;
    const int gw = blockIdx.x * 8 + wid, NGW = G * 8;
    const float inv = powf(10000.0f, -(float)(2 * i) / 64.0f);
    constexpr int NQ = MTOK * NQH, NK = NB * SKV * NKVH;
    for (int it = gw; it < (NQ + NK) / 2; it += NGW) {
        const int hr = it * 2 + sub;
        bf16_t* p; const float* g; int pos; bool rope;
        if (hr < NQ) { const int row = hr / NQH, h = hr - row * NQH; p = (bf16_t*)(P.ws + WS_Q) + (size_t)row * AW + h * HD; g = P.in[I_QG]; pos = row & (SEQ - 1); rope = true; }
        else { const int r2 = hr - NQ, kr = r2 >> 2, h = r2 & 3; p = (bf16_t*)(P.ws + WS_K) + (size_t)kr * KVW + h * HD; g = P.in[I_KG]; const int t = kr % SKV; rope = t >= CTXL; pos = t - CTXL; }
        float x0 = bf2f(p[i]), x1 = bf2f(p[i + 32]), x2 = bf2f(p[64 + i]), x3 = bf2f(p[96 + i]);
        float ss = (x0 * x0 + x1 * x1) + (x2 * x2 + x3 * x3);
#pragma unroll
        for (int o = 1; o < 32; o <<= 1) ss += __shfl_xor(ss, o);
        const float rstd = rsqrtf(ss * (1.0f / HD) + EPS);
        x0 *= rstd * g[i]; x1 *= rstd * g[i + 32]; x2 *= rstd * g[64 + i]; x3 *= rstd * g[96 + i];
        if (rope) {
            const float ar = (float)(pos >> 6) * inv, ac = (float)(pos & 63) * inv;
            const float cr = cosf(ar), sr = sinf(ar), cc = cosf(ac), sc = sinf(ac);
            const float y0 = x0 * cr - x1 * sr, y1 = x1 * cr + x0 * sr, y2 = x2 * cc - x3 * sc, y3 = x3 * cc + x2 * sc;
            x0 = y0; x1 = y1; x2 = y2; x3 = y3;
        }
        p[i] = f2bf(x0); p[i + 32] = f2bf(x1); p[64 + i] = f2bf(x2); p[96 + i] = f2bf(x3);
    }
}

__device__ __forceinline__ void attention_phase(const Params& P, unsigned char* lds, int G) {
    const int c = blockIdx.x;
    for (int j = 0;; ++j) {
        int au;
        if (G == 256) { if (c < 64) { if (j > 0) break; au = c; } else { au = 64 + (c - 64) + 192 * j; } }
        else au = c + G * j;
        if (au >= NB * NQH * 8) break;
        const int qb = au & 7, bh = au >> 3, h = bh % NQH, b = bh / NQH;
        const bf16_t* Qb = (const bf16_t*)(P.ws + WS_Q) + (size_t)(b * SEQ + qb * 256) * AW + h * HD;
        const bf16_t* Kh = (const bf16_t*)(P.ws + WS_K) + (size_t)b * SKV * KVW + (h / 3) * HD;
        const bf16_t* Vh = (const bf16_t*)(P.ws + WS_V) + (size_t)b * SKV * KVW + (h / 3) * HD;
        bf16_t* Ob = (bf16_t*)(P.ws + WS_MIX) + (size_t)(b * SEQ + qb * 256) * DM + h * HD;
        att::attn_dense_body(Qb, Kh, Vh, Ob, SKV, (char*)lds);
    }
}


#define XB_TMO      128
#define XB_XCNT(j)  (256  + 64 * (j))
#define XB_XSUB(j)  (1280 + 64 * (j))
#define XB_XGEN(j)  (2304 + 64 * (j))
#define XB_TOP      3328
#define XB_TOPGEN   3392
#define XCD_BAR_WORDS 3456
#define XB_SPIN_CAP (1u << 22)
__device__ __forceinline__ unsigned xb_ld(unsigned* p)              { return __hip_atomic_load(p, __ATOMIC_RELAXED, __HIP_MEMORY_SCOPE_AGENT); }
__device__ __forceinline__ unsigned xb_add(unsigned* p, unsigned v) { return __hip_atomic_fetch_add(p, v, __ATOMIC_RELAXED, __HIP_MEMORY_SCOPE_AGENT); }
__device__ __forceinline__ unsigned xb_xcc_id() { return (unsigned)__builtin_amdgcn_s_getreg((3 << 11) | 20) & 0xFu; }
#define XB_SPIN(cond, bar) do { unsigned _sp = 0; while (cond) { __builtin_amdgcn_s_sleep(1); \
    if ((++_sp & 255u) == 0u) { if (xb_ld(&(bar)[XB_TMO])) break; if (_sp > XB_SPIN_CAP) { atomicAdd(&(bar)[XB_TMO], 1u); break; } } } } while (0)
struct XcdBarrier { unsigned* bar; unsigned x; volatile LAS unsigned* st; };
__device__ __forceinline__ XcdBarrier xcd_barrier_post(unsigned* bar, volatile LAS unsigned* st) {
    XcdBarrier b; b.bar = bar; b.x = xb_xcc_id(); b.st = st;
    if (threadIdx.x == 0) (void)xb_add(&bar[XB_XCNT(b.x)], 1u);
    return b;
}
__device__ __forceinline__ void xcd_barrier_complete(unsigned* bar, unsigned x, unsigned& nloc, unsigned& nx) {
    const unsigned G = gridDim.x * gridDim.y * gridDim.z;
    unsigned sum, cnt, mine, sp = 0u;
    for (;;) {
        sum = 0u; cnt = 0u; mine = 0u;
#pragma unroll
        for (unsigned j = 0; j < 16; ++j) { const unsigned c = xb_ld(&bar[XB_XCNT(j)]); sum += c; cnt += (c > 0u) ? 1u : 0u; mine = (j == x) ? c : mine; }
        if (sum == G) break;
        __builtin_amdgcn_s_sleep(1);
        if ((++sp & 255u) == 0u) { if (xb_ld(&bar[XB_TMO])) break; if (sp > XB_SPIN_CAP) { atomicAdd(&bar[XB_TMO], 1u); break; } }
    }
    nloc = mine > 0u ? mine : 1u; nx = cnt > 0u ? cnt : 1u;
}
__device__ __forceinline__ void xcd_barrier(const XcdBarrier& b) {
    asm volatile("s_waitcnt vmcnt(0)" ::: "memory");
    __syncthreads();
    if (threadIdx.x == 0) {
        unsigned* bar = b.bar;
        __builtin_amdgcn_s_waitcnt(0);
        unsigned nloc = b.st[0], nx = b.st[1];
        if (nloc == 0u) { xcd_barrier_complete(bar, b.x, nloc, nx); b.st[0] = nloc; b.st[1] = nx; }
        const unsigned old = xb_add(&bar[XB_XSUB(b.x)], 1u);
        const unsigned gen = old / nloc;
        if (old + 1u == (gen + 1u) * nloc) {
            __builtin_amdgcn_fence(__ATOMIC_RELEASE, "agent");
            asm volatile("s_waitcnt vmcnt(0)" ::: "memory");
            const unsigned og = xb_add(&bar[XB_TOP], 1u);
            const unsigned tg = og / nx;
            if (og + 1u == (tg + 1u) * nx) xb_add(&bar[XB_TOPGEN], 1u);
            else XB_SPIN(xb_ld(&bar[XB_TOPGEN]) == tg, bar);
            __builtin_amdgcn_fence(__ATOMIC_ACQUIRE, "agent");
            xb_add(&bar[XB_XGEN(b.x)], 1u);
            asm volatile("s_waitcnt vmcnt(0)" ::: "memory");
        } else {
            XB_SPIN(xb_ld(&bar[XB_XGEN(b.x)]) == gen, bar);
            __builtin_amdgcn_fence(__ATOMIC_ACQUIRE, "agent");
            asm volatile("s_waitcnt vmcnt(0)" ::: "memory");
        }
    }
    __syncthreads();
}

__global__ void __launch_bounds__(512, 2) fwd_megakernel(Params P) {
    extern __shared__ __attribute__((aligned(16))) unsigned char lds[];
    cg::grid_group grid = cg::this_grid();
    const int G = gridDim.x, c = blockIdx.x;
    LAS unsigned char* l3 = (LAS unsigned char*)lds;
    volatile LAS unsigned* misc = (volatile LAS unsigned*)(l3 + 131072);
    if (threadIdx.x < 64) misc[threadIdx.x] = 0u;
    __syncthreads();
    XcdBarrier xbar = xcd_barrier_post((unsigned*)(P.ws + WS_BAR), misc + 8);
#pragma nounroll
    for (int ph = 0; ph < 10; ++ph) {
        int gm = -1;
        switch (ph) {
#if PROBE == 2
        case 0: phase0(P, l3, G, true); __syncthreads(); phase0(P, l3, G, false); break;
#else
        case 0: phase0(P, l3, G, true); break;
#endif
        case 1: rows_pass<0>(P, G); break;
        case 2: gm = G_IN; break;
        case 3: qk_norm_rope(P, G); gm = G_F1; break;
        case 4: gm = G_F2; break;
        case 5: gm = G_OUT; break;
        case 6: rows_pass<1>(P, G); break;
        case 7: gm = G_UP; break;
        case 8: gm = G_DOWN; break;
        default: rows_pass<2>(P, G); break;
        }
#ifndef NO_GEMM
        if (gm >= 0) gemm_phase(l3, P, gm, G, c);
#endif
#ifndef NO_ATT
        if (ph == 4) attention_phase(P, lds, G);
#endif
#if PROBE == 3
        if (ph == 7) { __syncthreads(); gemm_phase(l3, P, gm, G, c); }
#endif
#if PROBE == 4
        if (ph == 4) { __syncthreads(); gemm_phase(l3, P, gm, G, c); attention_phase(P, lds, G); }
#endif
#if PROBE == 1
        if (ph < 9) xcd_barrier(xbar);
#endif
        if (ph == 0) grid.sync();
        else if (ph < 9) xcd_barrier(xbar);
    }
}

extern "C" void kernel_launch(void* const* d_in, const int* in_sizes, int n_in, void* d_out, int out_size, void* d_ws, size_t ws_size, hipStream_t stream) {
    static int grid_blocks = 0;
    if (grid_blocks == 0) {
        if (n_in != 16 || out_size != MTOK * DM || ws_size < WS_END) { fprintf(stderr, "kernel_launch: unexpected shapes (n_in %d out %d ws %zu)\n", n_in, out_size, ws_size); grid_blocks = -1; return; }
        int dev = 0, cus = 0, per_cu = 0;
        (void)hipGetDevice(&dev);
        (void)hipDeviceGetAttribute(&cus, hipDeviceAttributeMultiprocessorCount, dev);
        if (hipFuncSetAttribute((const void*)fwd_megakernel, hipFuncAttributeMaxDynamicSharedMemorySize, LDS_BYTES) != hipSuccess) { fprintf(stderr, "kernel_launch: hipFuncSetAttribute failed\n"); grid_blocks = -1; return; }
        if (hipOccupancyMaxActiveBlocksPerMultiprocessor(&per_cu, (const void*)fwd_megakernel, 512, LDS_BYTES) != hipSuccess || per_cu < 1) { fprintf(stderr, "kernel_launch: occupancy query failed (%d)\n", per_cu); per_cu = 1; }
        (void)hipGetLastError();
        grid_blocks = cus;
    }
    if (grid_blocks < 0) return;
    (void)hipMemsetAsync((char*)d_ws + WS_MOD, 0, WS_CTL_BYTES, stream);
    Params p{};
    for (int i = 0; i < 16; ++i) p.in[i] = (const float*)d_in[i];
    p.out = (float*)d_out; p.ws = (unsigned char*)d_ws;
    void* args[] = {&p};
    hipError_t e = hipLaunchCooperativeKernel((const void*)fwd_megakernel, dim3(grid_blocks), dim3(512), args, LDS_BYTES, stream);
    if (e != hipSuccess) fprintf(stderr, "cooperative launch failed: %s (grid %d)\n", hipGetErrorString(e), grid_blocks);
}
#ifdef TEST_KERNELS
__global__ void __launch_bounds__(512, 2) t_att(Params P) { extern __shared__ __attribute__((aligned(16))) unsigned char lds[]; attention_phase(P, lds, gridDim.x); }
__global__ void __launch_bounds__(512, 2) t_gemm(Params P, int mode) { extern __shared__ __attribute__((aligned(16))) unsigned char lds[]; gemm_phase((LAS unsigned char*)lds, P, mode, gridDim.x, blockIdx.x); }
__global__ void __launch_bounds__(512, 2) t_gemm_up(Params P) { extern __shared__ __attribute__((aligned(16))) unsigned char lds[]; gemm_phase((LAS unsigned char*)lds, P, G_UP, gridDim.x, blockIdx.x); }
__global__ void __launch_bounds__(512, 2) t_gemm_out(Params P) { extern __shared__ __attribute__((aligned(16))) unsigned char lds[]; gemm_phase((LAS unsigned char*)lds, P, G_OUT, gridDim.x, blockIdx.x); }
#endif
```

```cpp
#include <hip/hip_runtime.h>
#include <hip/hip_bf16.h>
#include <hip/hip_cooperative_groups.h>
#include <cstdio>
#include <cstdint>
namespace cg = cooperative_groups;

#ifndef PROBE
#define PROBE 0
#endif
#define W1_IN_P0 0
#define W2_IN_P0 0
#define LAS __attribute__((address_space(3)))
typedef unsigned short bf16_t;
typedef short bf16x8 __attribute__((ext_vector_type(8)));
typedef short s16x4 __attribute__((ext_vector_type(4)));
typedef float f32x4 __attribute__((ext_vector_type(4)));
typedef float f32x16 __attribute__((ext_vector_type(16)));
typedef unsigned u32x4 __attribute__((ext_vector_type(4)));
typedef unsigned u32x2 __attribute__((ext_vector_type(2)));

constexpr int DM = 2048, NB = 4, SEQ = 2048, CTXL = 256, HD = 128, NQH = 12, NKVH = 4;
constexpr int AW = 1536, KVW = 512, FW = 512, INW = 3072, DFF = 8192, NMOD6 = 6 * DM;
constexpr int MTOK = NB * SEQ, MCTX = NB * CTXL, SKV = SEQ + CTXL;
constexpr float EPS = 1e-6f;

constexpr size_t MiB = 1u << 20;
constexpr size_t WS_MOD = 0;
constexpr size_t WS_BAR = 245760;
constexpr size_t WS_QCTR = 245760 + 16384;
constexpr size_t WS_CTL_BYTES = 262144 + 4096;
constexpr size_t WS_GT = 1 * MiB;
constexpr size_t WS_WIN = 2 * MiB;
constexpr size_t WS_WOUT = 14 * MiB;
constexpr size_t WS_W1 = 22 * MiB;
constexpr size_t WS_W2 = 54 * MiB;
constexpr size_t WS_DFT = 86 * MiB;
constexpr size_t WS_H2 = 102 * MiB;
constexpr size_t WS_H = 134 * MiB;
constexpr size_t WS_Q = 170 * MiB;
constexpr size_t WS_K = 194 * MiB;
constexpr size_t WS_V = 203 * MiB;
constexpr size_t WS_U = 212 * MiB;
constexpr size_t WS_ZT = 220 * MiB;
constexpr size_t WS_MIX = 236 * MiB;
constexpr size_t WS_A1 = 134 * MiB;
constexpr size_t WS_END = 268 * MiB;

constexpr int LDS_BYTES = 131072 + 1024;

struct Params { const float* in[16]; float* out; unsigned char* ws; };
enum { I_X = 0, I_C, I_CTX, I_CCTX, I_WADA, I_BADA, I_G1, I_WIN, I_QG, I_KG, I_WF, I_WOUT, I_G2, I_W1, I_W2, I_GF };

__device__ __forceinline__ unsigned cvt_pk_bf16(float lo, float hi) { unsigned r; asm("v_cvt_pk_bf16_f32 %0, %1, %2" : "=v"(r) : "v"(lo), "v"(hi)); return r; }
__device__ __forceinline__ float bf2f(bf16_t v) { return __uint_as_float(((unsigned)v) << 16); }
__device__ __forceinline__ bf16_t f2bf(float f) { return (bf16_t)(cvt_pk_bf16(f, 0.f) & 0xffffu); }
__device__ __forceinline__ float wave_sum(float v) {
#pragma unroll
    for (int o = 1; o < 64; o <<= 1) v += __shfl_xor(v, o);
    return v;
}
#define LDS_WAIT() asm volatile("s_waitcnt lgkmcnt(0)" ::: "memory")

constexpr int BM = 256, BK = 64, HALF = 128, HTB = HALF * BK * 2, NXCD = 8, WGM = 8;
__device__ __forceinline__ int lds_byte(int r, int c) { const int st = (r >> 4) * 2 + (c >> 5), rr = r & 15, cc = c & 31, ob = rr * 64 + cc * 2; return st * 1024 + (ob ^ (((ob >> 9) & 1) << 5)); }
__device__ __forceinline__ void stage_rc(int b, int& R, int& C) { const int st = b / 1024, sb = b % 1024, swz = sb ^ (((sb >> 9) & 1) << 5); R = (st >> 1) * 16 + swz / 64; C = (st & 1) * 32 + (swz % 64) / 2; }
__device__ __forceinline__ int perm32(int rho) { const int n = rho >> 4, i = rho & 15; return 8 * (i >> 2) + 4 * n + (i & 3); }

struct Unit { int pm, pn; const char* a; const char* b; };
enum { G_IN = 0, G_F1, G_F2, G_OUT, G_UP, G_DOWN };

__device__ __forceinline__ void remap_tile(int L, int nM, int nN, int& pm, int& pn) {
    const int nwg = nM * nN; int wgid = L;
    { const int q = nwg / NXCD, r = nwg % NXCD, xcd = wgid % NXCD, off = wgid / NXCD; wgid = (xcd < r ? xcd * (q + 1) : r * (q + 1) + (xcd - r) * q) + off; }
    const int nig = WGM * nN, gid = wgid / nig, fm = gid * WGM, gsz = (nM - fm) < WGM ? (nM - fm) : WGM;
    pm = fm + ((wgid % nig) % gsz); pn = (wgid % nig) / gsz;
}

__device__ __forceinline__ bool get_unit(const unsigned char* ws, int mode, int i, int G, int c, Unit& u) {
    const long L = (long)i * G + c;
    switch (mode) {
    case G_IN: {
        if (L >= 400) return false;
        if (L < 384) remap_tile((int)L, 32, 12, u.pm, u.pn);
        else { const int idx = (int)L - 384; u.pm = 32 + (idx >> 2); u.pn = 6 + (idx & 3); }
        u.a = (const char*)ws + WS_H + (size_t)u.pm * 256 * DM * 2; u.b = (const char*)ws + WS_WIN + (size_t)u.pn * 256 * DM * 2; return true; }
    case G_F1: {
        if (L >= 128) return false;
        const int g = (int)L >> 5; u.pm = g; u.pn = (int)L & 31;
        u.a = (const char*)ws + WS_GT + (size_t)g * 256 * 128 * 2; u.b = (const char*)ws + WS_U + ((size_t)u.pn * 256 * FW + g * 128) * 2; return true; }
    case G_F2: {
        if (L >= 64) return false;
        const int b = (int)L >> 4, pm = ((int)L >> 1) & 7, pn = (int)L & 1; u.pm = b * 8 + pm; u.pn = pn;
        u.a = (const char*)ws + WS_DFT + (size_t)pm * 256 * 4096 * 2; u.b = (const char*)ws + WS_ZT + ((size_t)(b * 512 + pn * 256) * 4096) * 2; return true; }
    case G_OUT: {
        if (L >= 256) return false;
        remap_tile((int)L, 32, 8, u.pm, u.pn);
        u.a = (const char*)ws + WS_MIX + (size_t)u.pm * 256 * DM * 2; u.b = (const char*)ws + WS_WOUT + (size_t)u.pn * 256 * DM * 2; return true; }
    case G_UP: {
        if (L >= 1024) return false;
        remap_tile((int)L, 32, 32, u.pm, u.pn);
        u.a = (const char*)ws + WS_H2 + (size_t)u.pm * 256 * DM * 2; u.b = (const char*)ws + WS_W1 + (size_t)u.pn * 256 * DM * 2; return true; }
    default: {
        if (L >= 256) return false;
        remap_tile((int)L, 32, 8, u.pm, u.pn);
        u.a = (const char*)ws + WS_A1 + (size_t)u.pm * 256 * DFF * 2; u.b = (const char*)ws + WS_W2 + (size_t)u.pn * 256 * DFF * 2; return true; }
    }
}

__device__ __forceinline__ void gemm_epilogue(const Params& P, int mode, const f32x4 (&acc)[2][2][4][2], const Unit& u, int wr, int wc, int fr, int fq) {
    unsigned char* ws = P.ws;
    if (mode == G_OUT || mode == G_DOWN) {
        const float* resid = (mode == G_OUT) ? P.in[I_X] : P.out;
        const float* gate = (const float*)(ws + WS_MOD) + (size_t)(u.pm >> 3) * NMOD6 + (mode == G_OUT ? 2 * DM : 5 * DM);
        const int col0 = u.pn * 256 + wc * 32 + 4 * fq;
        f32x4 gv[2][2];
#pragma unroll
        for (int bj = 0; bj < 2; ++bj)
#pragma unroll
            for (int n = 0; n < 2; ++n) gv[bj][n] = *(const f32x4*)(gate + col0 + bj * HALF + n * 16);
#pragma unroll
        for (int ai = 0; ai < 2; ++ai)
#pragma unroll
            for (int m = 0; m < 4; ++m) {
                const size_t off = (size_t)(u.pm * 256 + ai * HALF + wr * 64 + m * 16 + fr) * DM + col0;
#pragma unroll
                for (int bj = 0; bj < 2; ++bj)
#pragma unroll
                    for (int n = 0; n < 2; ++n) {
                        const f32x4 r = *(const f32x4*)(resid + off + bj * HALF + n * 16);
                        *(f32x4*)(P.out + off + bj * HALF + n * 16) = r + gv[bj][n] * acc[ai][bj][m][n];
                    }
            }
        return;
    }
    bf16_t* base; size_t ld, aistride;
    if (mode == G_IN) {
        const int pm = u.pm, pn = u.pn;
        if (pn < 6) { base = (bf16_t*)(ws + WS_Q) + (size_t)pm * 256 * AW + pn * 256; ld = AW; }
        else if (pn < 10) {
            const size_t krow0 = (pm < 32) ? (size_t)(pm >> 3) * SKV + CTXL + (size_t)(pm & 7) * 256 : (size_t)(pm - 32) * SKV;
            base = (bf16_t*)(ws + (pn < 8 ? WS_K : WS_V)) + krow0 * KVW + ((pn - 6) & 1) * 256; ld = KVW; }
        else { base = (bf16_t*)(ws + WS_U) + (size_t)pm * 256 * FW + (pn - 10) * 256; ld = FW; }
        aistride = 128 * ld;
    } else if (mode == G_F1) {
        const int g = u.pm, b = u.pn >> 3, s0 = (u.pn & 7) * 256;
        base = (bf16_t*)(ws + WS_ZT) + ((size_t)(b * 512 + g * 128) * 4096 + s0); ld = 4096; aistride = 2048;
    } else if (mode == G_F2) {
        base = (bf16_t*)(ws + WS_MIX) + (size_t)u.pm * 256 * DM + AW + u.pn * 256; ld = DM; aistride = 128 * ld;
    } else {
        base = (bf16_t*)(ws + WS_A1) + (size_t)u.pm * 256 * DFF + u.pn * 256; ld = DFF; aistride = 128 * ld;
    }
    const bool relu2 = (mode == G_UP);
    bf16_t* p0 = base + (size_t)(wr * 64 + fr) * ld + wc * 32 + 8 * fq;
#pragma unroll
    for (int ai = 0; ai < 2; ++ai)
#pragma unroll
        for (int m = 0; m < 4; ++m) {
            bf16_t* rowp = p0 + ai * aistride + (size_t)(m * 16) * ld;
#pragma unroll
            for (int bj = 0; bj < 2; ++bj) {
                f32x4 v0 = acc[ai][bj][m][0], v1 = acc[ai][bj][m][1];
                if (relu2) {
#pragma unroll
                    for (int e = 0; e < 4; ++e) { const float a = fmaxf(v0[e], 0.f), b = fmaxf(v1[e], 0.f); v0[e] = a * a; v1[e] = b * b; }
                }
                u32x4 w; w.x = cvt_pk_bf16(v0[0], v0[1]); w.y = cvt_pk_bf16(v0[2], v0[3]); w.z = cvt_pk_bf16(v1[0], v1[1]); w.w = cvt_pk_bf16(v1[2], v1[3]);
                *(u32x4*)(rowp + bj * HALF) = w;
            }
        }
}

__device__ __forceinline__ void gemm_phase(LAS unsigned char* lds, const Params& P, const int mode, const int G, const int c) {
    int tid_ = threadIdx.x; asm volatile("" : "+v"(tid_));
    const int tid = tid_, wid = __builtin_amdgcn_readfirstlane(tid >> 6), lane = tid & 63, wr = wid >> 2, wc = wid & 3, fr = lane & 15, fq = lane >> 4;
    int lda, ldb, K; bool perm = true;
    switch (mode) {
    case G_IN: lda = DM; ldb = DM; K = DM; break;
    case G_F1: lda = 128; ldb = FW; K = 128; break;
    case G_F2: lda = 4096; ldb = 4096; K = 4096; break;
    case G_OUT: lda = DM; ldb = DM; K = DM; perm = false; break;
    case G_UP: lda = DM; ldb = DM; K = DM; break;
    default: lda = DFF; ldb = DFF; K = DFF; perm = false; break;
    }
    const int nt = K / BK;
    unsigned voffA[2], voffB[2];
#pragma unroll
    for (int i = 0; i < 2; ++i) { int R, C; stage_rc(tid * 16 + i * 8192, R, C); const int Rb = perm ? ((R & ~31) + perm32(R & 31)) : R;
        voffA[i] = (unsigned)(R * lda + C) * 2u; voffB[i] = (unsigned)(Rb * ldb + C) * 2u; }
    const size_t kstep = (size_t)(BK * 2);
    const size_t hstepA = (size_t)HALF * lda * 2, hstepB = (size_t)HALF * ldb * 2;
    const unsigned ldsw = (unsigned)wid * 1024u;
    const int aoff = lds_byte(wr * 64 + fr, fq * 8), boff = lds_byte(wc * 32 + fr, fq * 8);
#define PG8_SA(b, h) (((b) * 2 + (h)) * HTB)
#define PG8_SB(b, h) ((4 + (b) * 2 + (h)) * HTB)
#define PG8_STAGE(bufoff, gbase, voff) do { _Pragma("unroll") for (int _i = 0; _i < 2; ++_i) \
        __builtin_amdgcn_global_load_lds((const unsigned*)((const char*)(gbase) + (voff)[_i]), (LAS unsigned*)(lds + (bufoff) + ldsw + _i * 8192), 16, 0, 0); } while (0)
#define PG8_LDA(dst, b, h) do { _Pragma("unroll") for (int m = 0; m < 4; ++m) _Pragma("unroll") for (int k = 0; k < 2; ++k) dst[m][k] = *(const LAS bf16x8*)(lds + PG8_SA(b, h) + aoff + m * 2048 + k * 1024); } while (0)
#define PG8_LDB(dst, b, h) do { _Pragma("unroll") for (int n = 0; n < 2; ++n) _Pragma("unroll") for (int k = 0; k < 2; ++k) dst[n][k] = *(const LAS bf16x8*)(lds + PG8_SB(b, h) + boff + n * 2048 + k * 1024); } while (0)
#define PG8_MMA(ai, bj, At, Bt) do { __builtin_amdgcn_s_setprio(1); _Pragma("unroll") for (int m = 0; m < 4; ++m) _Pragma("unroll") for (int n = 0; n < 2; ++n) _Pragma("unroll") for (int k = 0; k < 2; ++k) \
        acc[ai][bj][m][n] = __builtin_amdgcn_mfma_f32_16x16x32_bf16(Bt[n][k], At[m][k], acc[ai][bj][m][n], 0, 0, 0); __builtin_amdgcn_s_setprio(0); } while (0)
#define PG8_WAIT_V(n) asm volatile("s_waitcnt vmcnt(" #n ")" ::: "memory")
#define PG8_WAIT_L(n) asm volatile("s_waitcnt lgkmcnt(" #n ")" ::: "memory")
#define PG8_BAR __builtin_amdgcn_s_barrier()
#define PG8_SCHED __builtin_amdgcn_sched_barrier(0)
    Unit cur, nxt; int ui = 0;
    if (!get_unit(P.ws, mode, 0, G, c, cur)) return;
    f32x4 acc[2][2][4][2];
#pragma unroll
    for (int a = 0; a < 2; ++a)
#pragma unroll
        for (int b = 0; b < 2; ++b)
#pragma unroll
            for (int m = 0; m < 4; ++m)
#pragma unroll
                for (int n = 0; n < 2; ++n) acc[a][b][m][n] = (f32x4){0.f, 0.f, 0.f, 0.f};
    bf16x8 At[4][2], B0[2][2], B1[2][2];
    const char* cA = cur.a; const char* cB = cur.b;
    PG8_STAGE(PG8_SB(0, 0), cB, voffB); PG8_STAGE(PG8_SB(0, 1), cB + hstepB, voffB); PG8_STAGE(PG8_SA(0, 0), cA, voffA); PG8_STAGE(PG8_SA(0, 1), cA + hstepA, voffA);
    if (wr == 1) PG8_BAR;
    PG8_WAIT_V(2); PG8_BAR;
    PG8_STAGE(PG8_SB(1, 0), cB + kstep, voffB); PG8_STAGE(PG8_SA(1, 0), cA + kstep, voffA); PG8_STAGE(PG8_SB(1, 1), cB + hstepB + kstep, voffB);
    PG8_WAIT_V(6); PG8_BAR;
    for (;;) {
        const bool has_next = get_unit(P.ws, mode, ui + 1, G, c, nxt);
        const char* nA = has_next ? nxt.a : cA; const char* nB = has_next ? nxt.b : cB;
        for (int t = 0; t < nt; t += 2) {
            const bool last = (t == nt - 2);
            const char* a1 = cA + (size_t)(t + 1) * kstep;
            const char* a2 = last ? nA : cA + (size_t)(t + 2) * kstep; const char* b2 = last ? nB : cB + (size_t)(t + 2) * kstep;
            const char* a3 = a2 + kstep; const char* b3 = b2 + kstep;
            PG8_LDB(B0, 0, 0); PG8_LDB(B1, 0, 1); PG8_SCHED; PG8_LDA(At, 0, 0); PG8_STAGE(PG8_SA(1, 1), a1 + hstepA, voffA);
            PG8_WAIT_V(8); PG8_WAIT_L(0); PG8_BAR; PG8_MMA(0, 0, At, B0); PG8_MMA(0, 1, At, B1); PG8_BAR; PG8_SCHED;
            PG8_LDA(At, 0, 1); PG8_STAGE(PG8_SB(0, 0), b2, voffB); PG8_STAGE(PG8_SB(0, 1), b2 + hstepB, voffB); PG8_STAGE(PG8_SA(0, 0), a2, voffA);
            PG8_WAIT_V(8); PG8_WAIT_L(0); PG8_BAR; PG8_MMA(1, 0, At, B0); PG8_MMA(1, 1, At, B1); PG8_BAR; PG8_SCHED;
            PG8_LDB(B0, 1, 0); PG8_LDB(B1, 1, 1); PG8_SCHED; PG8_LDA(At, 1, 0); PG8_STAGE(PG8_SA(0, 1), a2 + hstepA, voffA);
            PG8_WAIT_V(8); PG8_WAIT_L(0); PG8_BAR; PG8_MMA(0, 0, At, B0); PG8_MMA(0, 1, At, B1); PG8_BAR; PG8_SCHED;
            PG8_LDA(At, 1, 1); PG8_STAGE(PG8_SB(1, 0), b3, voffB); PG8_STAGE(PG8_SB(1, 1), b3 + hstepB, voffB); PG8_STAGE(PG8_SA(1, 0), a3, voffA);
            PG8_WAIT_V(8); PG8_WAIT_L(0); PG8_BAR; PG8_MMA(1, 0, At, B0); PG8_MMA(1, 1, At, B1); PG8_BAR; PG8_SCHED;
        }
        if (wr == 0) PG8_BAR;
        gemm_epilogue(P, mode, acc, cur, wr, wc, fr, fq);
        if (!has_next) break;
#pragma unroll
        for (int a = 0; a < 2; ++a)
#pragma unroll
            for (int b = 0; b < 2; ++b)
#pragma unroll
                for (int m = 0; m < 4; ++m)
#pragma unroll
                    for (int n = 0; n < 2; ++n) acc[a][b][m][n] = (f32x4){0.f, 0.f, 0.f, 0.f};
        cur = nxt; cA = nA; cB = nB; ++ui;
        if (wr == 1) PG8_BAR;
    }
    PG8_WAIT_V(0);
    PG8_BAR;
#undef PG8_SA
#undef PG8_SB
#undef PG8_STAGE
#undef PG8_LDA
#undef PG8_LDB
#undef PG8_MMA
#undef PG8_WAIT_V
#undef PG8_WAIT_L
#undef PG8_BAR
#undef PG8_SCHED
}

namespace att {
constexpr int D = 128, NW = 8, QBLK = 32, KVBLK = 64;
constexpr float SCALE = 0.088388347648318440f;
constexpr float THR = 8.f;
constexpr int LDQ = AW, LDK = KVW, LDO = DM;
constexpr size_t SHM_V = KVBLK * D * 2, SHM_K = KVBLK * D * 2, SHM_ATTN = 2 * SHM_V + 2 * SHM_K + NW * 64 * 4;
#define KSWZ(row, colB) ((row) * 256 + ((colB) ^ (((row) & 7) << 4)))
#define SBAR() __builtin_amdgcn_sched_barrier(0)
__device__ __forceinline__ int crow(int r, int hi) { return (r & 3) + 8 * (r >> 2) + 4 * hi; }
__device__ __forceinline__ unsigned cvtpk(float lo, float hi) { unsigned r; asm volatile("v_cvt_pk_bf16_f32 %0, %1, %2" : "=v"(r) : "v"(lo), "v"(hi)); return r; }
__device__ __forceinline__ bf16x8 ld8(const bf16_t* p) { return *reinterpret_cast<const bf16x8*>(p); }

__device__ __forceinline__ void partialSM(f32x16& p0, f32x16& p1, float& m_reg, float& mn, float& alpha) {
  constexpr float C = SCALE * 1.4426950408889634f;
  float pmax = p0[0];
#pragma unroll
  for (int r = 1; r < 16; ++r) pmax = fmaxf(pmax, p0[r]);
#pragma unroll
  for (int r = 0; r < 16; ++r) pmax = fmaxf(pmax, p1[r]);
  { auto rr = __builtin_amdgcn_permlane32_swap(__float_as_uint(pmax), __float_as_uint(pmax), false, false);
    pmax = fmaxf(__uint_as_float(rr[0]), __uint_as_float(rr[1])); }
  if (__builtin_expect(__all(pmax - m_reg <= THR / SCALE), 1)) { mn = m_reg; alpha = 1.f; }
  else { mn = fmaxf(m_reg, pmax); alpha = __builtin_amdgcn_exp2f((m_reg - mn) * C); m_reg = mn; }
  float mnC = -mn * C;
#pragma unroll
  for (int r = 0; r < 16; ++r) p0[r] = fmaf(p0[r], C, mnC);
#pragma unroll
  for (int r = 0; r < 16; ++r) p1[r] = fmaf(p1[r], C, mnC);
#pragma unroll
  for (int r = 0; r < 16; ++r) p0[r] = __builtin_amdgcn_exp2f(p0[r]);
}
__device__ __forceinline__ void finishSM(f32x16& p0, f32x16& p1, float alpha, float& l_reg, bf16x8& pa0, bf16x8& pa1, bf16x8& pa2, bf16x8& pa3) {
#pragma unroll
  for (int r = 0; r < 16; ++r) p1[r] = __builtin_amdgcn_exp2f(p1[r]);
  float ps = 0;
#pragma unroll
  for (int r = 0; r < 16; ++r) ps += p0[r];
#pragma unroll
  for (int r = 0; r < 16; ++r) ps += p1[r];
  { auto rr = __builtin_amdgcn_permlane32_swap(__float_as_uint(ps), __float_as_uint(ps), false, false);
    ps = __uint_as_float(rr[0]) + __uint_as_float(rr[1]); }
  l_reg = l_reg * alpha + ps;
#define PK4(P, BASE, OUT) do { unsigned a0 = cvtpk(P[BASE + 0], P[BASE + 1]), a1 = cvtpk(P[BASE + 2], P[BASE + 3]);   \
    unsigned b0 = cvtpk(P[BASE + 4], P[BASE + 5]), b1 = cvtpk(P[BASE + 6], P[BASE + 7]);                              \
    auto r0 = __builtin_amdgcn_permlane32_swap(a0, b0, false, false); auto r1 = __builtin_amdgcn_permlane32_swap(a1, b1, false, false); \
    u32x4 w = {r0[0], r1[0], r0[1], r1[1]}; OUT = *reinterpret_cast<bf16x8*>(&w); } while (0)
  PK4(p0, 0, pa0); PK4(p0, 8, pa1); PK4(p1, 0, pa2); PK4(p1, 8, pa3);
#undef PK4
}
__device__ __forceinline__ void qkt(f32x16& p0, f32x16& p1, const bf16_t* Ks, const bf16x8* qr, int r32, int hi) {
  p0 = f32x16{}; p1 = f32x16{};
#pragma unroll
  for (int d0 = 0; d0 < 8; ++d0) { int cb = (d0 * 16 + hi * 8) * 2;
    bf16x8 b0 = *reinterpret_cast<const bf16x8*>((const char*)Ks + KSWZ(r32, cb));
    bf16x8 b1 = *reinterpret_cast<const bf16x8*>((const char*)Ks + KSWZ(32 + r32, cb));
    p0 = __builtin_amdgcn_mfma_f32_32x32x16_bf16(b0, qr[d0], p0, 0, 0, 0);
    p1 = __builtin_amdgcn_mfma_f32_32x32x16_bf16(b1, qr[d0], p1, 0, 0, 0); }
}
__device__ __forceinline__ int v_st(int k, int c) { const int kk = (k & ~0xC) | ((k & 4) << 1) | ((k & 8) >> 1); return ((kk >> 3) * 4 + (c >> 5)) * 512 + ((kk & 7) * 32 + (c & 31)) * 2; }
__device__ __forceinline__ int v_rd_base(int lane) { return ((lane & 3) << 3) | (((lane >> 2) & 3) << 6) | (((lane >> 4) & 1) << 5) | (((lane >> 5) & 1) << 8); }
constexpr int v_rd_off(int d0, int ks, int half) { return d0 * 512 + ks * 4096 + half * 2048; }
template <int OFF> __device__ __forceinline__ s16x4 tr_read(int vb) {
  s16x4 r; asm volatile("ds_read_b64_tr_b16 %0, %1 offset:%2" : "=&v"(r) : "v"(vb), "i"(OFF) : "memory"); return r;
}
template <int D0> __device__ __forceinline__ void pv_one(f32x16& od, int vb, bf16x8 pa0, bf16x8 pa1, bf16x8 pa2, bf16x8 pa3) {
  const s16x4 l0 = tr_read<v_rd_off(D0, 0, 0)>(vb), h0 = tr_read<v_rd_off(D0, 0, 1)>(vb), l1 = tr_read<v_rd_off(D0, 1, 0)>(vb), h1 = tr_read<v_rd_off(D0, 1, 1)>(vb);
  const s16x4 l2 = tr_read<v_rd_off(D0, 2, 0)>(vb), h2 = tr_read<v_rd_off(D0, 2, 1)>(vb), l3 = tr_read<v_rd_off(D0, 3, 0)>(vb), h3 = tr_read<v_rd_off(D0, 3, 1)>(vb);
  asm volatile("s_waitcnt lgkmcnt(0)" ::: "memory"); SBAR();
#define PK(L, H) (bf16x8){L[0], L[1], L[2], L[3], H[0], H[1], H[2], H[3]}
  od = __builtin_amdgcn_mfma_f32_32x32x16_bf16(pa0, PK(l0, h0), od, 0, 0, 0);
  od = __builtin_amdgcn_mfma_f32_32x32x16_bf16(pa1, PK(l1, h1), od, 0, 0, 0);
  od = __builtin_amdgcn_mfma_f32_32x32x16_bf16(pa2, PK(l2, h2), od, 0, 0, 0);
  od = __builtin_amdgcn_mfma_f32_32x32x16_bf16(pa3, PK(l3, h3), od, 0, 0, 0);
#undef PK
}
__device__ __forceinline__ void pv_d0(f32x16* o, int vb, bf16x8 pa0, bf16x8 pa1, bf16x8 pa2, bf16x8 pa3) {
  pv_one<0>(o[0], vb, pa0, pa1, pa2, pa3); pv_one<1>(o[1], vb, pa0, pa1, pa2, pa3); pv_one<2>(o[2], vb, pa0, pa1, pa2, pa3); pv_one<3>(o[3], vb, pa0, pa1, pa2, pa3);
}

__device__ __forceinline__ void attn_dense_body(const bf16_t* __restrict__ Qb, const bf16_t* __restrict__ Kh, const bf16_t* __restrict__ Vh,
                                                bf16_t* __restrict__ Ob, int seq, char* lds) {
  int tid_ = threadIdx.x; asm volatile("" : "+v"(tid_));
  const int tid = tid_, wid = tid >> 6, lane = tid & 63, r32 = lane & 31, hi = lane >> 5;
  bf16_t* V_lds = (bf16_t*)lds; bf16_t* K_lds = (bf16_t*)(lds + 2 * SHM_V);
  float* ws = (float*)(lds + 2 * SHM_V + 2 * SHM_K) + wid * 64; float* li_l = ws; float* al_l = ws + 32;
  float m_reg = -1e30f, l_reg = 0; f32x16 o[4] = {}; bf16x8 qr[8];
  const bf16_t* Qw = Qb + (long)(wid * QBLK + r32) * LDQ + hi * 8;
#pragma unroll
  for (int d0 = 0; d0 < 8; ++d0) qr[d0] = ld8(Qw + d0 * 16);
  const int sr = tid >> 4, sc = (tid & 15) * 8, vst0 = v_st(sr, sc), vst1 = v_st(32 + sr, sc);
  const int vb0 = (int)(uintptr_t)V_lds + v_rd_base(lane);
  struct { bf16x8 vs0, vs1, ks0, ks1; } sr_[2];
#define SLOAD(i, k0) do { sr_[i].vs0 = ld8(&Vh[(long)((k0) + sr) * LDK + sc]); sr_[i].vs1 = ld8(&Vh[(long)((k0) + 32 + sr) * LDK + sc]); \
    sr_[i].ks0 = ld8(&Kh[(long)((k0) + sr) * LDK + sc]); sr_[i].ks1 = ld8(&Kh[(long)((k0) + 32 + sr) * LDK + sc]); } while (0)
#define SWRITE(b, i) do { *(bf16x8*)((char*)V_lds + (b) * SHM_V + vst0) = sr_[i].vs0;          \
    *(bf16x8*)((char*)V_lds + (b) * SHM_V + vst1) = sr_[i].vs1; int kc = sc * 2;               \
    *(bf16x8*)((char*)K_lds + (b) * SHM_K + KSWZ(sr, kc)) = sr_[i].ks0;                       \
    *(bf16x8*)((char*)K_lds + (b) * SHM_K + KSWZ(32 + sr, kc)) = sr_[i].ks1; } while (0)
#define SWAIT() asm volatile("s_waitcnt vmcnt(4)" ::: "memory")
#define RESC(a) do { if (__any((a) < 1.f)) { if (hi == 0) al_l[r32] = (a); asm volatile("s_waitcnt lgkmcnt(0)" ::: "memory"); \
    _Pragma("unroll") for (int d = 0; d < 4; ++d) _Pragma("unroll") for (int r = 0; r < 16; ++r) o[d][r] *= al_l[crow(r, hi)]; } } while (0)
  f32x16 pA0, pA1, pB0, pB1; float mnA, mnB, alA, alB; bf16x8 pa0, pa1, pa2, pa3; const int NT = seq / KVBLK;
  constexpr int SE = 0, SO = 1;
  SLOAD(SE, 0); asm volatile("s_waitcnt vmcnt(0)" ::: "memory"); SWRITE(0, SE); __syncthreads();
  qkt(pA0, pA1, K_lds, qr, r32, hi); partialSM(pA0, pA1, m_reg, mnA, alA);
  SLOAD(SO, KVBLK); if (2 < NT) SLOAD(SE, 2 * KVBLK);
  SWAIT(); SWRITE(1, SO); __syncthreads();
  for (int j = 1; j + 1 < NT; j += 2) {
    SBAR(); qkt(pB0, pB1, (bf16_t*)((char*)K_lds + SHM_K), qr, r32, hi);
    finishSM(pA0, pA1, alA, l_reg, pa0, pa1, pa2, pa3); SBAR();
    SLOAD(SO, (j + 2) * KVBLK); SBAR();
    pv_d0(o, vb0, pa0, pa1, pa2, pa3); partialSM(pB0, pB1, m_reg, mnB, alB);
    __syncthreads(); SWAIT(); SWRITE(0, SE);
    RESC(alB); __syncthreads();
    SBAR(); qkt(pA0, pA1, K_lds, qr, r32, hi);
    finishSM(pB0, pB1, alB, l_reg, pa0, pa1, pa2, pa3); SBAR();
    if (j + 3 < NT) SLOAD(SE, (j + 3) * KVBLK); SBAR();
    pv_d0(o, vb0 + (int)SHM_V, pa0, pa1, pa2, pa3); partialSM(pA0, pA1, m_reg, mnA, alA);
    __syncthreads(); SWAIT(); SWRITE(1, SO);
    RESC(alA); __syncthreads();
  }
  SBAR(); qkt(pB0, pB1, (bf16_t*)((char*)K_lds + SHM_K), qr, r32, hi);
  finishSM(pA0, pA1, alA, l_reg, pa0, pa1, pa2, pa3); SBAR();
  pv_d0(o, vb0, pa0, pa1, pa2, pa3); partialSM(pB0, pB1, m_reg, mnB, alB);
  __syncthreads(); RESC(alB);
  finishSM(pB0, pB1, alB, l_reg, pa0, pa1, pa2, pa3); SBAR();
  pv_d0(o, vb0 + (int)SHM_V, pa0, pa1, pa2, pa3);
  if (hi == 0) li_l[r32] = l_reg; asm volatile("s_waitcnt lgkmcnt(0)" ::: "memory");
  float rli[16];
#pragma unroll
  for (int r = 0; r < 16; ++r) rli[r] = __builtin_amdgcn_rcpf(li_l[crow(r, hi)]);
  bf16_t* Ow = Ob + (long)(wid * QBLK) * LDO;
#pragma unroll
  for (int r = 0; r < 16; ++r) { int orow = crow(r, hi);
#pragma unroll
    for (int d0 = 0; d0 < 4; ++d0) Ow[(long)orow * LDO + d0 * 32 + r32] = f2bf(o[d0][r] * rli[r]); }
  __syncthreads();
#undef SLOAD
#undef SWRITE
#undef SWAIT
#undef RESC
}
#undef KSWZ
#undef SBAR
}

__device__ __forceinline__ void transpose_item(const float* __restrict__ W, int K, int N, bf16_t* __restrict__ WT, LAS float* scr, int item, int lane) {
    const int nblk = N / 32, kb = item / nblk, nb = item % nblk, k0 = 64 * kb, n0 = 32 * nb;
    const int kr = lane >> 3, n4 = (lane & 7) * 4;
    f32x4 v[8];
#pragma unroll
    for (int i = 0; i < 8; ++i) v[i] = *(const f32x4*)(W + (size_t)(k0 + 8 * i + kr) * N + n0 + n4);
#pragma unroll
    for (int i = 0; i < 8; ++i) { LAS float* d = scr + (8 * i + kr) * 33 + n4; d[0] = v[i].x; d[1] = v[i].y; d[2] = v[i].z; d[3] = v[i].w; }
    LDS_WAIT();
    const int c = lane & 7;
#pragma unroll
    for (int j = 0; j < 4; ++j) { const int n = (lane >> 3) + 8 * j; const LAS float* s = scr + (8 * c) * 33 + n;
        u32x4 o; o.x = cvt_pk_bf16(s[0 * 33], s[1 * 33]); o.y = cvt_pk_bf16(s[2 * 33], s[3 * 33]); o.z = cvt_pk_bf16(s[4 * 33], s[5 * 33]); o.w = cvt_pk_bf16(s[6 * 33], s[7 * 33]);
        *(u32x4*)(WT + (size_t)(n0 + n) * K + k0 + 8 * c) = o; }
    LDS_WAIT();
}
__device__ __forceinline__ void transpose_share(const float* __restrict__ W, int K, int N, bf16_t* __restrict__ WT, int w, int nw, LAS unsigned char* lds) {
    int tid_ = threadIdx.x; asm volatile("" : "+v"(tid_));
    const int wid = tid_ >> 6, lane = tid_ & 63;
    LAS float* scr = (LAS float*)(lds + wid * 8448);
    const int nitems = (K / 64) * (N / 32), nblk = N / 32;
    const int kr = lane >> 3, n4 = (lane & 7) * 4, c = lane & 7;
    int it = w * 8 + wid;
    if (it >= nitems) return;
    f32x4 v[8];
    { const int kb = it / nblk, nb = it % nblk;
#pragma unroll
      for (int i = 0; i < 8; ++i) v[i] = *(const f32x4*)(W + (size_t)(64 * kb + 8 * i + kr) * N + 32 * nb + n4); }
    for (;;) {
        const int kb = it / nblk, nb = it % nblk, k0 = 64 * kb, n0 = 32 * nb;
#pragma unroll
        for (int i = 0; i < 8; ++i) { LAS float* d = scr + (8 * i + kr) * 33 + n4; d[0] = v[i].x; d[1] = v[i].y; d[2] = v[i].z; d[3] = v[i].w; }
        const int nx = it + nw; const bool more = nx < nitems;
        if (more) { const int kb2 = nx / nblk, nb2 = nx % nblk;
#pragma unroll
            for (int i = 0; i < 8; ++i) v[i] = *(const f32x4*)(W + (size_t)(64 * kb2 + 8 * i + kr) * N + 32 * nb2 + n4); }
        LDS_WAIT();
#pragma unroll
        for (int j = 0; j < 4; ++j) { const int n = (lane >> 3) + 8 * j; const LAS float* s = scr + (8 * c) * 33 + n;
            u32x4 o; o.x = cvt_pk_bf16(s[0 * 33], s[1 * 33]); o.y = cvt_pk_bf16(s[2 * 33], s[3 * 33]); o.z = cvt_pk_bf16(s[4 * 33], s[5 * 33]); o.w = cvt_pk_bf16(s[6 * 33], s[7 * 33]);
            *(u32x4*)(WT + (size_t)(n0 + n) * K + k0 + 8 * c) = o; }
        LDS_WAIT();
        if (!more) break;
        it = nx;
    }
}

__device__ __forceinline__ void phase0(const Params& P, LAS unsigned char* lds, int G, bool do_ada) {
    int tid_ = threadIdx.x; asm volatile("" : "+v"(tid_));
    const int tid = tid_, wid = tid >> 6, lane = tid & 63;
    unsigned char* ws = P.ws;
    if (do_ada) {
        LAS float* sl = (LAS float*)lds;
        for (int i = tid; i < 5 * DM; i += 512) { const float v = (i < 4 * DM) ? P.in[I_C][i] : P.in[I_CCTX][i - 4 * DM]; sl[i] = v / (1.f + expf(-v)); }
        __syncthreads();
        LAS float* red = (LAS float*)(lds + 40960);
        float* mod = (float*)(ws + WS_MOD);
        const float* w_ada = P.in[I_WADA];
        for (int it = blockIdx.x; it < 768; it += G) {
            const int cc = it % 48, kc = it / 48;
            const int kb = kc * 128 + wid * 16;
            const float* wp = w_ada + (size_t)kb * NMOD6 + cc * 256 + lane * 4;
            f32x4 acc[5];
#pragma unroll
            for (int r = 0; r < 5; ++r) acc[r] = (f32x4){0.f, 0.f, 0.f, 0.f};
#pragma unroll
            for (int i = 0; i < 16; ++i) {
                const f32x4 wv = *(const f32x4*)(wp + (size_t)i * NMOD6);
#pragma unroll
                for (int r = 0; r < 5; ++r) { const float s = sl[r * DM + kb + i]; acc[r] += wv * s; }
            }
#pragma unroll
            for (int r = 0; r < 5; ++r) *(LAS f32x4*)(red + (wid * 5 + r) * 256 + lane * 4) = acc[r];
            __syncthreads();
            if (tid < 320) {
                const int r = tid >> 6, q = tid & 63;
                f32x4 s = (f32x4){0.f, 0.f, 0.f, 0.f};
#pragma unroll
                for (int w = 0; w < 8; ++w) s += *(const LAS f32x4*)(red + (w * 5 + r) * 256 + q * 4);
                if (kc == 0) s += *(const f32x4*)(P.in[I_BADA] + cc * 256 + q * 4);
                float* dst = mod + (size_t)r * NMOD6 + cc * 256 + q * 4;
                unsafeAtomicAdd(dst + 0, s[0]); unsafeAtomicAdd(dst + 1, s[1]); unsafeAtomicAdd(dst + 2, s[2]); unsafeAtomicAdd(dst + 3, s[3]);
            }
            __syncthreads();
        }
    }
    {
        LAS float* scr = (LAS float*)(lds + wid * 8448);
        const int gw = blockIdx.x * 8 + wid, NGW = G * 8;
        constexpr int I_A = (DM / 64) * (INW / 32), I_B = (DM / 64) * (DM / 32), I_C1 = (DM / 64) * (DFF / 32), I_D = (DFF / 64) * (DM / 32);
        for (int it = gw; it < I_A + I_B + (W1_IN_P0 ? I_C1 : 0) + (W2_IN_P0 ? I_D : 0); it += NGW) {
            int r = it;
            if (r < I_A) { transpose_item(P.in[I_WIN], DM, INW, (bf16_t*)(ws + WS_WIN), scr, r, lane); continue; } r -= I_A;
            if (r < I_B) { transpose_item(P.in[I_WOUT], DM, DM, (bf16_t*)(ws + WS_WOUT), scr, r, lane); continue; } r -= I_B;
            if (W1_IN_P0) { if (r < I_C1) { transpose_item(P.in[I_W1], DM, DFF, (bf16_t*)(ws + WS_W1), scr, r, lane); continue; } r -= I_C1; }
            transpose_item(P.in[I_W2], DFF, DM, (bf16_t*)(ws + WS_W2), scr, r, lane);
        }
        __syncthreads();
    }
    {
        LAS float* ct = (LAS float*)lds;
        for (int j = tid; j < 2048; j += 512) ct[j] = cospif((float)j * (1.0f / 1024.0f));
        __syncthreads();
        bf16_t* dft = (bf16_t*)(ws + WS_DFT);
        for (int idx = blockIdx.x * 512 + tid; idx < 2048 * 512; idx += G * 512) {
            const int k = idx >> 9, n0 = (idx & 511) * 8, part = n0 >> 11, nn = n0 & 2047;
            float v[8];
#pragma unroll
            for (int e = 0; e < 8; ++e) { const int j = (k * (nn + e)) & 2047; v[e] = ct[part ? ((j - 512) & 2047) : j]; }
            u32x4 o; o.x = cvt_pk_bf16(v[0], v[1]); o.y = cvt_pk_bf16(v[2], v[3]); o.z = cvt_pk_bf16(v[4], v[5]); o.w = cvt_pk_bf16(v[6], v[7]);
            *(u32x4*)(dft + (size_t)k * 4096 + n0) = o;
        }
        bf16_t* gt = (bf16_t*)(ws + WS_GT);
        const float* wf = P.in[I_WF];
        for (int idx = blockIdx.x * 512 + tid; idx < 4 * 2 * 128 * 128; idx += G * 512) {
            const int d = idx & 127, cch = (idx >> 7) & 127, part = (idx >> 14) & 1, g = idx >> 15;
            float sum = 0.f;
#pragma unroll 16
            for (int l = 0; l < 128; ++l) {
                const int j = (cch * l) & 127;
                const float cs = part ? -ct[((j - 32) & 127) * 16] : ct[j * 16];
                sum += cs * wf[(size_t)(g * 128 + l) * 128 + d];
            }
            gt[(size_t)((g * 2 + part) * 128 + d) * 128 + cch] = f2bf(sum * (1.0f / 512.0f));
        }
    }
}

template <int MODE> __device__ __forceinline__ void rows_pass(const Params& P, int G) {
    int tid_ = threadIdx.x; asm volatile("" : "+v"(tid_));
    const int tid = tid_, wid = tid >> 6, lane = tid & 63;
    const int gw = blockIdx.x * 8 + wid, NGW = G * 8;
    const int nrows = (MODE == 0) ? (MTOK + MCTX) : MTOK;
    const float* mod = (const float*)(P.ws + WS_MOD);
    const float* gain = P.in[MODE == 0 ? I_G1 : (MODE == 1 ? I_G2 : I_GF)];
    for (int r = gw; r < nrows; r += NGW) {
        const float* src; int mr;
        if (MODE == 0) { if (r < MTOK) { src = P.in[I_X] + (size_t)r * DM; mr = r >> 11; } else { src = P.in[I_CTX] + (size_t)(r - MTOK) * DM; mr = 4; } }
        else { src = P.out + (size_t)r * DM; mr = r >> 11; }
        f32x4 v[8]; float ss = 0.f;
#pragma unroll
        for (int j = 0; j < 8; ++j) { v[j] = *(const f32x4*)(src + (lane + 64 * j) * 4); ss += (v[j].x * v[j].x + v[j].y * v[j].y) + (v[j].z * v[j].z + v[j].w * v[j].w); }
        const float rstd = rsqrtf(wave_sum(ss) * (1.0f / DM) + EPS);
#pragma unroll
        for (int j = 0; j < 8; ++j) {
            const int col = (lane + 64 * j) * 4;
            const f32x4 g = *(const f32x4*)(gain + col);
            f32x4 y = v[j] * rstd * g;
            if (MODE == 2) { *(f32x4*)(P.out + (size_t)r * DM + col) = y; }
            else {
                const float* mrow = mod + (size_t)mr * NMOD6 + (MODE == 0 ? 0 : 3 * DM);
                const f32x4 sh = *(const f32x4*)(mrow + col), sc = *(const f32x4*)(mrow + DM + col);
                y = y * (1.0f + sc) + sh;
                u32x2 o; o.x = cvt_pk_bf16(y.x, y.y); o.y = cvt_pk_bf16(y.z, y.w);
                bf16_t* dst = (bf16_t*)(P.ws + (MODE == 0 ? WS_H : WS_H2)) + (size_t)r * DM + col;
                *(u32x2*)dst = o;
            }
        }
    }
}

__device__ __forceinline__ void qk_norm_rope(const Params& P, int G) {
    int tid_ = threadIdx.x; asm volatile("" : "+v"(tid_));
    const int tid = tid_, wid = tid >> 6, lane = tid & 63, sub = lane >> 5, i = lane & 31;
    const int gw = blockIdx.x * 8 + wid, NGW = G * 8;
    const float inv = powf(10000.0f, -(float)(2 * i) / 64.0f);
    constexpr int NQ = MTOK * NQH, NK = NB * SKV * NKVH;
    for (int it = gw; it < (NQ + NK) / 2; it += NGW) {
        const int hr = it * 2 + sub;
        bf16_t* p; const float* g; int pos; bool rope;
        if (hr < NQ) { const int row = hr / NQH, h = hr - row * NQH; p = (bf16_t*)(P.ws + WS_Q) + (size_t)row * AW + h * HD; g = P.in[I_QG]; pos = row & (SEQ - 1); rope = true; }
        else { const int r2 = hr - NQ, kr = r2 >> 2, h = r2 & 3; p = (bf16_t*)(P.ws + WS_K) + (size_t)kr * KVW + h * HD; g = P.in[I_KG]; const int t = kr % SKV; rope = t >= CTXL; pos = t - CTXL; }
        float x0 = bf2f(p[i]), x1 = bf2f(p[i + 32]), x2 = bf2f(p[64 + i]), x3 = bf2f(p[96 + i]);
        float ss = (x0 * x0 + x1 * x1) + (x2 * x2 + x3 * x3);
#pragma unroll
        for (int o = 1; o < 32; o <<= 1) ss += __shfl_xor(ss, o);
        const float rstd = rsqrtf(ss * (1.0f / HD) + EPS);
        x0 *= rstd * g[i]; x1 *= rstd * g[i + 32]; x2 *= rstd * g[64 + i]; x3 *= rstd * g[96 + i];
        if (rope) {
            const float ar = (float)(pos >> 6) * inv, ac = (float)(pos & 63) * inv;
            const float cr = cosf(ar), sr = sinf(ar), cc = cosf(ac), sc = sinf(ac);
            const float y0 = x0 * cr - x1 * sr, y1 = x1 * cr + x0 * sr, y2 = x2 * cc - x3 * sc, y3 = x3 * cc + x2 * sc;
            x0 = y0; x1 = y1; x2 = y2; x3 = y3;
        }
        p[i] = f2bf(x0); p[i + 32] = f2bf(x1); p[64 + i] = f2bf(x2); p[96 + i] = f2bf(x3);
    }
}

__device__ __forceinline__ void attention_phase(const Params& P, unsigned char* lds, int G) {
    const int c = blockIdx.x;
    for (int j = 0;; ++j) {
        int au;
        if (G == 256) { if (c < 64 || j > 1) break; au = (c - 64) + 192 * j; }
        else au = c + G * j;
        if (au >= NB * NQH * 8) break;
        const int qb = au & 7, bh = au >> 3, h = bh % NQH, b = bh / NQH;
        const bf16_t* Qb = (const bf16_t*)(P.ws + WS_Q) + (size_t)(b * SEQ + qb * 256) * AW + h * HD;
        const bf16_t* Kh = (const bf16_t*)(P.ws + WS_K) + (size_t)b * SKV * KVW + (h / 3) * HD;
        const bf16_t* Vh = (const bf16_t*)(P.ws + WS_V) + (size_t)b * SKV * KVW + (h / 3) * HD;
        bf16_t* Ob = (bf16_t*)(P.ws + WS_MIX) + (size_t)(b * SEQ + qb * 256) * DM + h * HD;
        att::attn_dense_body(Qb, Kh, Vh, Ob, SKV, (char*)lds);
    }
}


#define XB_TMO      128
#define XB_XCNT(j)  (256  + 64 * (j))
#define XB_XSUB(j)  (1280 + 64 * (j))
#define XB_XGEN(j)  (2304 + 64 * (j))
#define XB_TOP      3328
#define XB_TOPGEN   3392
#define XCD_BAR_WORDS 3456
#define XB_SPIN_CAP (1u << 22)
__device__ __forceinline__ unsigned xb_ld(unsigned* p)              { return __hip_atomic_load(p, __ATOMIC_RELAXED, __HIP_MEMORY_SCOPE_AGENT); }
__device__ __forceinline__ unsigned xb_add(unsigned* p, unsigned v) { return __hip_atomic_fetch_add(p, v, __ATOMIC_RELAXED, __HIP_MEMORY_SCOPE_AGENT); }
__device__ __forceinline__ unsigned xb_xcc_id() { return (unsigned)__builtin_amdgcn_s_getreg((3 << 11) | 20) & 0xFu; }
#define XB_SPIN(cond, bar) do { unsigned _sp = 0; while (cond) { __builtin_amdgcn_s_sleep(1); \
    if ((++_sp & 255u) == 0u) { if (xb_ld(&(bar)[XB_TMO])) break; if (_sp > XB_SPIN_CAP) { atomicAdd(&(bar)[XB_TMO], 1u); break; } } } } while (0)
struct XcdBarrier { unsigned* bar; unsigned x; volatile LAS unsigned* st; };
__device__ __forceinline__ XcdBarrier xcd_barrier_post(unsigned* bar, volatile LAS unsigned* st) {
    XcdBarrier b; b.bar = bar; b.x = xb_xcc_id(); b.st = st;
    if (threadIdx.x == 0) (void)xb_add(&bar[XB_XCNT(b.x)], 1u);
    return b;
}
__device__ __forceinline__ void xcd_barrier_complete(unsigned* bar, unsigned x, unsigned& nloc, unsigned& nx) {
    const unsigned G = gridDim.x * gridDim.y * gridDim.z;
    unsigned sum, cnt, mine, sp = 0u;
    for (;;) {
        sum = 0u; cnt = 0u; mine = 0u;
#pragma unroll
        for (unsigned j = 0; j < 16; ++j) { const unsigned c = xb_ld(&bar[XB_XCNT(j)]); sum += c; cnt += (c > 0u) ? 1u : 0u; mine = (j == x) ? c : mine; }
        if (sum == G) break;
        __builtin_amdgcn_s_sleep(1);
        if ((++sp & 255u) == 0u) { if (xb_ld(&bar[XB_TMO])) break; if (sp > XB_SPIN_CAP) { atomicAdd(&bar[XB_TMO], 1u); break; } }
    }
    nloc = mine > 0u ? mine : 1u; nx = cnt > 0u ? cnt : 1u;
}
__device__ __forceinline__ void xcd_barrier(const XcdBarrier& b) {
    asm volatile("s_waitcnt vmcnt(0)" ::: "memory");
    __syncthreads();
    if (threadIdx.x == 0) {
        unsigned* bar = b.bar;
        __builtin_amdgcn_s_waitcnt(0);
        unsigned nloc = b.st[0], nx = b.st[1];
        if (nloc == 0u) { xcd_barrier_complete(bar, b.x, nloc, nx); b.st[0] = nloc; b.st[1] = nx; }
        const unsigned old = xb_add(&bar[XB_XSUB(b.x)], 1u);
        const unsigned gen = old / nloc;
        if (old + 1u == (gen + 1u) * nloc) {
            __builtin_amdgcn_fence(__ATOMIC_RELEASE, "agent");
            asm volatile("s_waitcnt vmcnt(0)" ::: "memory");
            const unsigned og = xb_add(&bar[XB_TOP], 1u);
            const unsigned tg = og / nx;
            if (og + 1u == (tg + 1u) * nx) xb_add(&bar[XB_TOPGEN], 1u);
            else XB_SPIN(xb_ld(&bar[XB_TOPGEN]) == tg, bar);
            __builtin_amdgcn_fence(__ATOMIC_ACQUIRE, "agent");
            xb_add(&bar[XB_XGEN(b.x)], 1u);
            asm volatile("s_waitcnt vmcnt(0)" ::: "memory");
        } else {
            XB_SPIN(xb_ld(&bar[XB_XGEN(b.x)]) == gen, bar);
            __builtin_amdgcn_fence(__ATOMIC_ACQUIRE, "agent");
            asm volatile("s_waitcnt vmcnt(0)" ::: "memory");
        }
    }
    __syncthreads();
}

__global__ void __launch_bounds__(512, 2) fwd_megakernel(Params P) {
    extern __shared__ __attribute__((aligned(16))) unsigned char lds[];
    cg::grid_group grid = cg::this_grid();
    const int G = gridDim.x, c = blockIdx.x;
    LAS unsigned char* l3 = (LAS unsigned char*)lds;
    volatile LAS unsigned* misc = (volatile LAS unsigned*)(l3 + 131072);
    if (threadIdx.x < 64) misc[threadIdx.x] = 0u;
    __syncthreads();
    XcdBarrier xbar = xcd_barrier_post((unsigned*)(P.ws + WS_BAR), misc + 8);
#pragma nounroll
    for (int ph = 0; ph < 10; ++ph) {
        int gm = -1;
        switch (ph) {
#if PROBE == 2
        case 0: phase0(P, l3, G, true); __syncthreads(); phase0(P, l3, G, false); break;
#else
        case 0: phase0(P, l3, G, true); break;
#endif
        case 1: rows_pass<0>(P, G); break;
        case 2: gm = G_IN; break;
        case 3: qk_norm_rope(P, G); gm = G_F1; break;
        case 4: gm = G_F2; break;
        case 5: gm = G_OUT; break;
        case 6: rows_pass<1>(P, G); break;
        case 7: gm = G_UP; break;
        case 8: gm = G_DOWN; break;
        default: rows_pass<2>(P, G); break;
        }
#ifndef NO_GEMM
        if (gm >= 0) gemm_phase(l3, P, gm, G, c);
#endif
#ifndef NO_ATT
        if (ph == 4) attention_phase(P, lds, G);
#endif
        if (!W1_IN_P0 && ph == 2) { if (G != 256) transpose_share(P.in[I_W1], DM, DFF, (bf16_t*)(P.ws + WS_W1), c, G * 8, l3);
                                    else if (c >= 144) transpose_share(P.in[I_W1], DM, DFF, (bf16_t*)(P.ws + WS_W1), c - 144, 112 * 8, l3); }
        if (!W2_IN_P0 && ph == 4) { if (G != 256) transpose_share(P.in[I_W2], DFF, DM, (bf16_t*)(P.ws + WS_W2), c, G * 8, l3);
                                    else if (c < 64) transpose_share(P.in[I_W2], DFF, DM, (bf16_t*)(P.ws + WS_W2), c, 64 * 8, l3); }
#if PROBE == 3
        if (ph == 7) { __syncthreads(); gemm_phase(l3, P, gm, G, c); }
#endif
#if PROBE == 4
        if (ph == 4) { __syncthreads(); gemm_phase(l3, P, gm, G, c); attention_phase(P, lds, G); }
#endif
#if PROBE == 1
        if (ph < 9) xcd_barrier(xbar);
#endif
        if (G == 0x7fffffff) grid.sync();
        if (ph < 9) xcd_barrier(xbar);
    }
}

extern "C" void kernel_launch(void* const* d_in, const int* in_sizes, int n_in, void* d_out, int out_size, void* d_ws, size_t ws_size, hipStream_t stream) {
    static int grid_blocks = 0;
    if (grid_blocks == 0) {
        if (n_in != 16 || out_size != MTOK * DM || ws_size < WS_END) { fprintf(stderr, "kernel_launch: unexpected shapes (n_in %d out %d ws %zu)\n", n_in, out_size, ws_size); grid_blocks = -1; return; }
        int dev = 0, cus = 0, per_cu = 0;
        (void)hipGetDevice(&dev);
        (void)hipDeviceGetAttribute(&cus, hipDeviceAttributeMultiprocessorCount, dev);
        if (hipFuncSetAttribute((const void*)fwd_megakernel, hipFuncAttributeMaxDynamicSharedMemorySize, LDS_BYTES) != hipSuccess) { fprintf(stderr, "kernel_launch: hipFuncSetAttribute failed\n"); grid_blocks = -1; return; }
        if (hipOccupancyMaxActiveBlocksPerMultiprocessor(&per_cu, (const void*)fwd_megakernel, 512, LDS_BYTES) != hipSuccess || per_cu < 1) { fprintf(stderr, "kernel_launch: occupancy query failed (%d)\n", per_cu); per_cu = 1; }
        (void)hipGetLastError();
        grid_blocks = cus;
    }
    if (grid_blocks < 0) return;
    (void)hipMemsetAsync((char*)d_ws + WS_MOD, 0, WS_CTL_BYTES, stream);
    Params p{};
    for (int i = 0; i < 16; ++i) p.in[i] = (const float*)d_in[i];
    p.out = (float*)d_out; p.ws = (unsigned char*)d_ws;
    void* args[] = {&p};
    hipError_t e = hipLaunchCooperativeKernel((const void*)fwd_megakernel, dim3(grid_blocks), dim3(512), args, LDS_BYTES, stream);
    if (e != hipSuccess) fprintf(stderr, "cooperative launch failed: %s (grid %d)\n", hipGetErrorString(e), grid_blocks);
}
#ifdef TEST_KERNELS
__global__ void __launch_bounds__(512, 2) t_att(Params P) { extern __shared__ __attribute__((aligned(16))) unsigned char lds[]; attention_phase(P, lds, gridDim.x); }
__global__ void __launch_bounds__(512, 2) t_gemm(Params P, int mode) { extern __shared__ __attribute__((aligned(16))) unsigned char lds[]; gemm_phase((LAS unsigned char*)lds, P, mode, gridDim.x, blockIdx.x); }
__global__ void __launch_bounds__(512, 2) t_gemm_up(Params P) { extern __shared__ __attribute__((aligned(16))) unsigned char lds[]; gemm_phase((LAS unsigned char*)lds, P, G_UP, gridDim.x, blockIdx.x); }
__global__ void __launch_bounds__(512, 2) t_gemm_out(Params P) { extern __shared__ __attribute__((aligned(16))) unsigned char lds[]; gemm_phase((LAS unsigned char*)lds, P, G_OUT, gridDim.x, blockIdx.x); }
#endif
```

```cpp
#include <hip/hip_runtime.h>
#include <hip/hip_bf16.h>
#include <hip/hip_cooperative_groups.h>
#include <cstdio>
#include <cstdint>
namespace cg = cooperative_groups;

#ifndef PROBE
#define PROBE 0
#endif
#define LAS __attribute__((address_space(3)))
typedef unsigned short bf16_t;
typedef short bf16x8 __attribute__((ext_vector_type(8)));
typedef short s16x4 __attribute__((ext_vector_type(4)));
typedef float f32x4 __attribute__((ext_vector_type(4)));
typedef float f32x16 __attribute__((ext_vector_type(16)));
typedef unsigned u32x4 __attribute__((ext_vector_type(4)));
typedef unsigned u32x2 __attribute__((ext_vector_type(2)));

constexpr int DM = 2048, NB = 4, SEQ = 2048, CTXL = 256, HD = 128, NQH = 12, NKVH = 4;
constexpr int AW = 1536, KVW = 512, FW = 512, INW = 3072, DFF = 8192, NMOD6 = 6 * DM;
constexpr int MTOK = NB * SEQ, MCTX = NB * CTXL, SKV = SEQ + CTXL;
constexpr float EPS = 1e-6f;

constexpr size_t MiB = 1u << 20;
constexpr size_t WS_MOD = 0;
constexpr size_t WS_BAR = 245760;
constexpr size_t WS_QCTR = 245760 + 16384;
constexpr size_t WS_XCNT = 262144 + 4096;
constexpr size_t WS_CTL_BYTES = 262144 + 4096 + 16384;
constexpr size_t WS_XSLOT = 1 * MiB + 512 * 1024;
constexpr size_t WS_ROPE = 512 * 1024;
constexpr size_t WS_GT = 1 * MiB;
constexpr size_t WS_WIN = 2 * MiB;
constexpr size_t WS_WOUT = 14 * MiB;
constexpr size_t WS_W1 = 22 * MiB;
constexpr size_t WS_W2 = 54 * MiB;
constexpr size_t WS_DFT = 86 * MiB;
constexpr size_t WS_H2 = 102 * MiB;
constexpr size_t WS_H = 134 * MiB;
constexpr size_t WS_Q = 170 * MiB;
constexpr size_t WS_K = 194 * MiB;
constexpr size_t WS_V = 203 * MiB;
constexpr size_t WS_U = 212 * MiB;
constexpr size_t WS_ZT = 220 * MiB;
constexpr size_t WS_MIX = 236 * MiB;
constexpr size_t WS_A1 = 134 * MiB;
constexpr size_t WS_END = 268 * MiB;

constexpr int LDS_MISC = 8 * 64 * 65 * 4;
constexpr int LDS_RED = LDS_MISC + 1024;
constexpr int LDS_BYTES = LDS_RED + 8192;

struct Params { const float* in[16]; float* out; unsigned char* ws; };
enum { I_X = 0, I_C, I_CTX, I_CCTX, I_WADA, I_BADA, I_G1, I_WIN, I_QG, I_KG, I_WF, I_WOUT, I_G2, I_W1, I_W2, I_GF };

__device__ __forceinline__ unsigned cvt_pk_bf16(float lo, float hi) { unsigned r; asm("v_cvt_pk_bf16_f32 %0, %1, %2" : "=v"(r) : "v"(lo), "v"(hi)); return r; }
__device__ __forceinline__ float bf2f(bf16_t v) { return __uint_as_float(((unsigned)v) << 16); }
__device__ __forceinline__ bf16_t f2bf(float f) { return (bf16_t)(cvt_pk_bf16(f, 0.f) & 0xffffu); }
template <int M> __device__ __forceinline__ float swz_xor(float v) { return __int_as_float(__builtin_amdgcn_ds_swizzle(__float_as_int(v), 0x1F | (M << 10))); }
__device__ __forceinline__ float half_sum(float v) { auto rr = __builtin_amdgcn_permlane32_swap(__float_as_uint(v), __float_as_uint(v), false, false); return __uint_as_float(rr[0]) + __uint_as_float(rr[1]); }
__device__ __forceinline__ float wave_sum(float v) {
    v += swz_xor<1>(v); v += swz_xor<2>(v); v += swz_xor<4>(v); v += swz_xor<8>(v); v += swz_xor<16>(v);
    return half_sum(v);
}
#define LDS_WAIT() asm volatile("s_waitcnt lgkmcnt(0)" ::: "memory")

constexpr int BM = 256, BK = 64, HALF = 128, HTB = HALF * BK * 2, NXCD = 8, WGM = 8;
__device__ __forceinline__ int lds_byte(int r, int c) { const int st = (r >> 4) * 2 + (c >> 5), rr = r & 15, cc = c & 31, ob = rr * 64 + cc * 2; return st * 1024 + (ob ^ (((ob >> 9) & 1) << 5)); }
__device__ __forceinline__ void stage_rc(int b, int& R, int& C) { const int st = b / 1024, sb = b % 1024, swz = sb ^ (((sb >> 9) & 1) << 5); R = (st >> 1) * 16 + swz / 64; C = (st & 1) * 32 + (swz % 64) / 2; }
__device__ __forceinline__ int perm32(int rho) { const int n = rho >> 4, i = rho & 15; return 8 * (i >> 2) + 4 * n + (i & 3); }

struct Unit { int pm, pn; const char* a; const char* b; };
enum { G_IN = 0, G_F1, G_F2, G_OUT, G_UP, G_DOWN };

__device__ __forceinline__ void remap_tile(int L, int nM, int nN, int& pm, int& pn) {
    const int nwg = nM * nN; int wgid = L;
    { const int q = nwg / NXCD, r = nwg % NXCD, xcd = wgid % NXCD, off = wgid / NXCD; wgid = (xcd < r ? xcd * (q + 1) : r * (q + 1) + (xcd - r) * q) + off; }
    const int nig = WGM * nN, gid = wgid / nig, fm = gid * WGM, gsz = (nM - fm) < WGM ? (nM - fm) : WGM;
    pm = fm + ((wgid % nig) % gsz); pn = (wgid % nig) / gsz;
}

__device__ __forceinline__ bool get_unit(const unsigned char* ws, int mode, int i, int G, int c, Unit& u) {
    const long L = (long)i * G + c;
    switch (mode) {
    case G_IN: {
        if (L >= 400) return false;
        if (L < 384) remap_tile((int)L, 32, 12, u.pm, u.pn);
        else { const int idx = (int)L - 384; u.pm = 32 + (idx >> 2); u.pn = 6 + (idx & 3); }
        u.a = (const char*)ws + WS_H + (size_t)u.pm * 256 * DM * 2; u.b = (const char*)ws + WS_WIN + (size_t)u.pn * 256 * DM * 2; return true; }
    case G_F1: {
        if (L >= 128) return false;
        const int g = (int)L >> 5; u.pm = g; u.pn = (int)L & 31;
        u.a = (const char*)ws + WS_GT + (size_t)g * 256 * 128 * 2; u.b = (const char*)ws + WS_U + ((size_t)u.pn * 256 * FW + g * 128) * 2; return true; }
    case G_F2: {
        if (L >= 64) return false;
        const int b = (int)L >> 4, pm = ((int)L >> 1) & 7, pn = (int)L & 1; u.pm = b * 8 + pm; u.pn = pn;
        u.a = (const char*)ws + WS_DFT + (size_t)pm * 256 * 4096 * 2; u.b = (const char*)ws + WS_ZT + ((size_t)(b * 512 + pn * 256) * 4096) * 2; return true; }
    case G_OUT: {
        if (L >= 256) return false;
        remap_tile((int)L, 32, 8, u.pm, u.pn);
        u.a = (const char*)ws + WS_MIX + (size_t)u.pm * 256 * DM * 2; u.b = (const char*)ws + WS_WOUT + (size_t)u.pn * 256 * DM * 2; return true; }
    case G_UP: {
        if (L >= 1024) return false;
        remap_tile((int)L, 32, 32, u.pm, u.pn);
        u.a = (const char*)ws + WS_H2 + (size_t)u.pm * 256 * DM * 2; u.b = (const char*)ws + WS_W1 + (size_t)u.pn * 256 * DM * 2; return true; }
    default: {
        if (L >= 256) return false;
        remap_tile((int)L, 32, 8, u.pm, u.pn);
        u.a = (const char*)ws + WS_A1 + (size_t)u.pm * 256 * DFF * 2; u.b = (const char*)ws + WS_W2 + (size_t)u.pn * 256 * DFF * 2; return true; }
    }
}

__device__ __forceinline__ void gemm_epilogue(const Params& P, int mode, const f32x4 (&acc)[2][2][4][2], const Unit& u, int wr, int wc, int fr, int fq) {
    unsigned char* ws = P.ws;
    if (mode == G_OUT || mode == G_DOWN) {
        const float* resid = (mode == G_OUT) ? P.in[I_X] : P.out;
        const float* gate = (const float*)(ws + WS_MOD) + (size_t)(u.pm >> 3) * NMOD6 + (mode == G_OUT ? 2 * DM : 5 * DM);
        const int col0 = u.pn * 256 + wc * 32 + 4 * fq;
        f32x4 gv[2][2];
#pragma unroll
        for (int bj = 0; bj < 2; ++bj)
#pragma unroll
            for (int n = 0; n < 2; ++n) gv[bj][n] = *(const f32x4*)(gate + col0 + bj * HALF + n * 16);
#pragma unroll
        for (int ai = 0; ai < 2; ++ai)
#pragma unroll
            for (int m = 0; m < 4; ++m) {
                const size_t off = (size_t)(u.pm * 256 + ai * HALF + wr * 64 + m * 16 + fr) * DM + col0;
#pragma unroll
                for (int bj = 0; bj < 2; ++bj)
#pragma unroll
                    for (int n = 0; n < 2; ++n) {
                        const f32x4 r = *(const f32x4*)(resid + off + bj * HALF + n * 16);
                        *(f32x4*)(P.out + off + bj * HALF + n * 16) = r + gv[bj][n] * acc[ai][bj][m][n];
                    }
            }
        return;
    }
    bf16_t* base; size_t ld, aistride, bjstride = HALF;
    if (mode == G_IN) {
        const int pm = u.pm, pn = u.pn;
        if (pn < 6) { base = (bf16_t*)(ws + WS_Q) + (size_t)pm * 256 * AW + pn * 256; ld = AW; }
        else if (pn < 10) {
            const int b = (pm < 32) ? (pm >> 3) : (pm - 32), t0 = (pm < 32) ? CTXL + (pm & 7) * 256 : 0, h0 = ((pn - 6) & 1) * 2;
            base = (bf16_t*)(ws + (pn < 8 ? WS_K : WS_V)) + ((size_t)(b * NKVH + h0) * SKV + t0) * HD; ld = HD; bjstride = (size_t)SKV * HD; }
        else { base = (bf16_t*)(ws + WS_U) + (size_t)pm * 256 * FW + (pn - 10) * 256; ld = FW; }
        aistride = 128 * ld;
    } else if (mode == G_F1) {
        const int g = u.pm, b = u.pn >> 3, s0 = (u.pn & 7) * 256;
        base = (bf16_t*)(ws + WS_ZT) + ((size_t)(b * 512 + g * 128) * 4096 + s0); ld = 4096; aistride = 2048;
    } else if (mode == G_F2) {
        base = (bf16_t*)(ws + WS_MIX) + (size_t)u.pm * 256 * DM + AW + u.pn * 256; ld = DM; aistride = 128 * ld;
    } else {
        base = (bf16_t*)(ws + WS_A1) + (size_t)u.pm * 256 * DFF + u.pn * 256; ld = DFF; aistride = 128 * ld;
    }
    const bool relu2 = (mode == G_UP);
    bf16_t* p0 = base + (size_t)(wr * 64 + fr) * ld + wc * 32 + 8 * fq;
#pragma unroll
    for (int ai = 0; ai < 2; ++ai)
#pragma unroll
        for (int m = 0; m < 4; ++m) {
            bf16_t* rowp = p0 + ai * aistride + (size_t)(m * 16) * ld;
#pragma unroll
            for (int bj = 0; bj < 2; ++bj) {
                f32x4 v0 = acc[ai][bj][m][0], v1 = acc[ai][bj][m][1];
                if (relu2) {
#pragma unroll
                    for (int e = 0; e < 4; ++e) { const float a = fmaxf(v0[e], 0.f), b = fmaxf(v1[e], 0.f); v0[e] = a * a; v1[e] = b * b; }
                }
                u32x4 w; w.x = cvt_pk_bf16(v0[0], v0[1]); w.y = cvt_pk_bf16(v0[2], v0[3]); w.z = cvt_pk_bf16(v1[0], v1[1]); w.w = cvt_pk_bf16(v1[2], v1[3]);
                *(u32x4*)(rowp + bj * bjstride) = w;
            }
        }
}

__device__ __forceinline__ int qk_perm(int R) { const int wc = R >> 5, n = (R >> 4) & 1, p = 16 * wc + (R & 15); return (p < 32 ? p : p + 32) + 32 * n; }
__device__ __forceinline__ void gemm_epilogue_qk(const Params& P, const f32x4 (&acc)[2][2][4][2], const Unit& u, int wr, int wc, int fr, int fq, LAS unsigned char* lds) {
    asm volatile("" : "+v"(fr), "+v"(fq), "+s"(wr), "+s"(wc));
    unsigned char* ws = P.ws;
    LAS float* red = (LAS float*)(lds + LDS_RED);
    const int pm = u.pm, pn = u.pn;
#pragma unroll
    for (int ai = 0; ai < 2; ++ai)
#pragma unroll
        for (int m = 0; m < 4; ++m)
#pragma unroll
            for (int bj = 0; bj < 2; ++bj) {
                const f32x4 a = acc[ai][bj][m][0], b = acc[ai][bj][m][1];
                float ss = ((a.x * a.x + a.y * a.y) + (a.z * a.z + a.w * a.w)) + ((b.x * b.x + b.y * b.y) + (b.z * b.z + b.w * b.w));
                ss += swz_xor<16>(ss); ss = half_sum(ss);
                if (fq == 0) red[(bj * 4 + wc) * 256 + ai * HALF + wr * 64 + m * 16 + fr] = ss;
            }
    asm volatile("s_waitcnt lgkmcnt(0)" ::: "memory"); __builtin_amdgcn_s_barrier(); asm volatile("" ::: "memory");
    const bool isq = pn < 6, rope = pm < 32;
    const int p0 = 16 * wc + 4 * fq, d0 = (p0 < 32) ? p0 : p0 + 32;
    const float* g = P.in[isq ? I_QG : I_KG];
    const f32x4 g0 = *(const f32x4*)(g + d0), g1 = *(const f32x4*)(g + d0 + 32);
    bf16_t* base; size_t ld, bjstride;
    if (isq) { base = (bf16_t*)(ws + WS_Q) + (size_t)pm * 256 * AW + pn * 256; ld = AW; bjstride = HD; }
    else { const int b = rope ? (pm >> 3) : (pm - 32), t0 = rope ? CTXL + (pm & 7) * 256 : 0, h0 = (pn - 6) * 2;
           base = (bf16_t*)(ws + WS_K) + ((size_t)(b * NKVH + h0) * SKV + t0) * HD; ld = HD; bjstride = (size_t)SKV * HD; }
    const float* tab = (const float*)(ws + WS_ROPE);
    const int i0 = 16 * (wc & 1) + 4 * fq;
#pragma unroll
    for (int ai = 0; ai < 2; ++ai)
#pragma unroll
        for (int m = 0; m < 4; ++m) {
            const int rl = ai * HALF + wr * 64 + m * 16 + fr;
            f32x4 cs0 = (f32x4){1.f, 0.f, 1.f, 0.f}, cs1 = cs0;
            if (rope) { const int pos = (pm * 256 + rl) & (SEQ - 1), av = (wc < 2) ? (pos >> 6) : (pos & 63);
                        const f32x4* t = (const f32x4*)(tab + (size_t)(av * 32 + i0) * 2); cs0 = t[0]; cs1 = t[1]; }
#pragma unroll
            for (int bj = 0; bj < 2; ++bj) {
                const float tot = (red[(bj * 4 + 0) * 256 + rl] + red[(bj * 4 + 1) * 256 + rl]) + (red[(bj * 4 + 2) * 256 + rl] + red[(bj * 4 + 3) * 256 + rl]);
                const float rstd = rsqrtf(tot * (1.0f / HD) + EPS);
                const f32x4 x1 = acc[ai][bj][m][0] * rstd * g0, x2 = acc[ai][bj][m][1] * rstd * g1;
                const float a0 = x1.x * cs0.x - x2.x * cs0.y, b0 = x2.x * cs0.x + x1.x * cs0.y;
                const float a1 = x1.y * cs0.z - x2.y * cs0.w, b1 = x2.y * cs0.z + x1.y * cs0.w;
                const float a2 = x1.z * cs1.x - x2.z * cs1.y, b2 = x2.z * cs1.x + x1.z * cs1.y;
                const float a3 = x1.w * cs1.z - x2.w * cs1.w, b3 = x2.w * cs1.z + x1.w * cs1.w;
                bf16_t* rowp = base + (size_t)rl * ld + bj * bjstride + d0;
                u32x2 o1, o2; o1.x = cvt_pk_bf16(a0, a1); o1.y = cvt_pk_bf16(a2, a3); o2.x = cvt_pk_bf16(b0, b1); o2.y = cvt_pk_bf16(b2, b3);
                *(u32x2*)rowp = o1; *(u32x2*)(rowp + 32) = o2;
            }
        }
}

__device__ __forceinline__ void gemm_epilogue_fused(const Params& P, int mode, f32x4 (&acc)[2][2][4][2], const Unit& u, int wr, int wc, int fr, int fq, LAS unsigned char* lds, int tid) {
    unsigned char* ws = P.ws;
    const int x = (mode == G_OUT) ? 0 : 1;
    const float* resid = (mode == G_OUT) ? P.in[I_X] : P.out;
    const float* modb = (const float*)(ws + WS_MOD) + (size_t)(u.pm >> 3) * NMOD6;
    const float* gate = modb + (mode == G_OUT ? 2 * DM : 5 * DM);
    const int col0 = u.pn * 256 + wc * 32 + 4 * fq;
    LAS float* Pq = (LAS float*)lds;
    LAS float* S = (LAS float*)(lds + 4096);
    {
        f32x4 gv[2][2];
#pragma unroll
        for (int bj = 0; bj < 2; ++bj)
#pragma unroll
            for (int n = 0; n < 2; ++n) gv[bj][n] = *(const f32x4*)(gate + col0 + bj * HALF + n * 16);
        f32x4 rbuf[2][2][2];
        const size_t off0 = (size_t)(u.pm * 256 + wr * 64 + fr) * DM + col0;
#pragma unroll
        for (int bj = 0; bj < 2; ++bj)
#pragma unroll
            for (int n = 0; n < 2; ++n) rbuf[0][bj][n] = *(const f32x4*)(resid + off0 + bj * HALF + n * 16);
#pragma unroll
        for (int g = 0; g < 8; ++g) {
            const int ai = g >> 2, m = g & 3;
            const int rl = ai * HALF + wr * 64 + m * 16 + fr;
            const size_t off = (size_t)(u.pm * 256 + rl) * DM + col0;
            if (g < 7) { const int ai2 = (g + 1) >> 2, m2 = (g + 1) & 3; const size_t offn = (size_t)(u.pm * 256 + ai2 * HALF + wr * 64 + m2 * 16 + fr) * DM + col0;
#pragma unroll
                for (int bj = 0; bj < 2; ++bj)
#pragma unroll
                    for (int n = 0; n < 2; ++n) rbuf[(g + 1) & 1][bj][n] = *(const f32x4*)(resid + offn + bj * HALF + n * 16); }
            float ss = 0.f;
#pragma unroll
            for (int bj = 0; bj < 2; ++bj)
#pragma unroll
                for (int n = 0; n < 2; ++n) {
                    const f32x4 v = rbuf[g & 1][bj][n] + gv[bj][n] * acc[ai][bj][m][n];
                    acc[ai][bj][m][n] = v;
                    if (mode == G_OUT) *(f32x4*)(P.out + off + bj * HALF + n * 16) = v;
                    ss += (v.x * v.x + v.y * v.y) + (v.z * v.z + v.w * v.w);
                }
            ss += swz_xor<16>(ss); ss = half_sum(ss);
            if (fq == 0) Pq[rl * 4 + wc] = ss;
            asm volatile("" ::: "memory");
        }
    }
    asm volatile("s_waitcnt lgkmcnt(0)" ::: "memory"); __builtin_amdgcn_s_barrier(); asm volatile("" ::: "memory");
    float* slots = (float*)(ws + WS_XSLOT) + (size_t)x * MTOK * 8;
    unsigned* cnt = (unsigned*)(ws + WS_XCNT) + x * 32 * 64 + 64 * u.pm;
    if (tid < 256) {
        const f32x4 q = *(const LAS f32x4*)(Pq + tid * 4);
        const float tot = (q.x + q.y) + (q.z + q.w);
        __hip_atomic_store(slots + (size_t)(u.pm * 256 + tid) * 8 + u.pn, tot, __ATOMIC_RELAXED, __HIP_MEMORY_SCOPE_AGENT);
        asm volatile("s_waitcnt vmcnt(0)" ::: "memory");
        if ((tid & 63) == 0) __hip_atomic_fetch_add(cnt, 1u, __ATOMIC_RELAXED, __HIP_MEMORY_SCOPE_AGENT);
    }
    if (tid < 64) {
        unsigned sp = 0;
        while ((unsigned)__builtin_amdgcn_readfirstlane(__hip_atomic_load(cnt, __ATOMIC_RELAXED, __HIP_MEMORY_SCOPE_AGENT)) < 32u) { __builtin_amdgcn_s_sleep(2); if (++sp > (1u << 22)) break; }
        __builtin_amdgcn_fence(__ATOMIC_ACQUIRE, "agent");
    }
    asm volatile("s_waitcnt vmcnt(0) lgkmcnt(0)" ::: "memory"); __builtin_amdgcn_s_barrier(); asm volatile("" ::: "memory");
    if (tid < 256) {
        const float* sl = slots + (size_t)(u.pm * 256 + tid) * 8; float tot = 0.f;
#pragma unroll
        for (int t = 0; t < 8; ++t) tot += __hip_atomic_load(sl + t, __ATOMIC_RELAXED, __HIP_MEMORY_SCOPE_AGENT);
        S[tid] = rsqrtf(tot * (1.0f / DM) + EPS);
    }
    asm volatile("s_waitcnt lgkmcnt(0)" ::: "memory"); __builtin_amdgcn_s_barrier(); asm volatile("" ::: "memory");
    if (mode == G_OUT) {
        f32x4 gg[2][2], sc[2][2], sh[2][2];
#pragma unroll
        for (int bj = 0; bj < 2; ++bj)
#pragma unroll
            for (int n = 0; n < 2; ++n) { const int cc = col0 + bj * HALF + n * 16; gg[bj][n] = *(const f32x4*)(P.in[I_G2] + cc); sh[bj][n] = *(const f32x4*)(modb + 3 * DM + cc); sc[bj][n] = *(const f32x4*)(modb + 4 * DM + cc) + 1.0f; }
        bf16_t* h2 = (bf16_t*)(ws + WS_H2);
#pragma unroll
        for (int ai = 0; ai < 2; ++ai)
#pragma unroll
            for (int m = 0; m < 4; ++m) {
                const int rl = ai * HALF + wr * 64 + m * 16 + fr; const float rs = S[rl];
                const size_t off = (size_t)(u.pm * 256 + rl) * DM + col0;
#pragma unroll
                for (int bj = 0; bj < 2; ++bj)
#pragma unroll
                    for (int n = 0; n < 2; ++n) {
                        const f32x4 y = (acc[ai][bj][m][n] * rs * gg[bj][n]) * sc[bj][n] + sh[bj][n];
                        u32x2 o; o.x = cvt_pk_bf16(y.x, y.y); o.y = cvt_pk_bf16(y.z, y.w);
                        *(u32x2*)(h2 + off + bj * HALF + n * 16) = o;
                    }
            }
    } else {
        f32x4 gg[2][2];
#pragma unroll
        for (int bj = 0; bj < 2; ++bj)
#pragma unroll
            for (int n = 0; n < 2; ++n) gg[bj][n] = *(const f32x4*)(P.in[I_GF] + col0 + bj * HALF + n * 16);
#pragma unroll
        for (int ai = 0; ai < 2; ++ai)
#pragma unroll
            for (int m = 0; m < 4; ++m) {
                const int rl = ai * HALF + wr * 64 + m * 16 + fr; const float rs = S[rl];
                const size_t off = (size_t)(u.pm * 256 + rl) * DM + col0;
#pragma unroll
                for (int bj = 0; bj < 2; ++bj)
#pragma unroll
                    for (int n = 0; n < 2; ++n) *(f32x4*)(P.out + off + bj * HALF + n * 16) = acc[ai][bj][m][n] * rs * gg[bj][n];
            }
    }
    asm volatile("s_waitcnt lgkmcnt(0)" ::: "memory"); __builtin_amdgcn_s_barrier();
}

__device__ __forceinline__ void gemm_phase(LAS unsigned char* lds, const Params& P, const int mode, const int G, const int c) {
    int tid_ = threadIdx.x; asm volatile("" : "+v"(tid_));
    const int tid = tid_, wid = __builtin_amdgcn_readfirstlane(tid >> 6), lane = tid & 63, wr = wid >> 2, wc = wid & 3, fr = lane & 15, fq = lane >> 4;
    int lda, ldb, K; bool perm = true;
    switch (mode) {
    case G_IN: lda = DM; ldb = DM; K = DM; break;
    case G_F1: lda = 128; ldb = FW; K = 128; break;
    case G_F2: lda = 4096; ldb = 4096; K = 4096; break;
    case G_OUT: lda = DM; ldb = DM; K = DM; perm = false; break;
    case G_UP: lda = DM; ldb = DM; K = DM; break;
    default: lda = DFF; ldb = DFF; K = DFF; perm = false; break;
    }
    const int nt = K / BK;
    const bool fusedEpi = (mode == G_OUT || mode == G_DOWN) && G == 256;
    unsigned voffA[2];
#pragma unroll
    for (int i = 0; i < 2; ++i) { int R, C; stage_rc(tid * 16 + i * 8192, R, C); voffA[i] = (unsigned)(R * lda + C) * 2u; }
#define PG8_BOFF(i, qk) ([&]() { int R, C; stage_rc(tid * 16 + (i) * 8192, R, C); const int Rb = (qk) ? qk_perm(R) : (perm ? ((R & ~31) + perm32(R & 31)) : R); return (unsigned)(Rb * ldb + C) * 2u; }())
    const size_t kstep = (size_t)(BK * 2);
    const size_t hstepA = (size_t)HALF * lda * 2, hstepB = (size_t)HALF * ldb * 2;
    const unsigned ldsw = (unsigned)wid * 1024u;
    const int aoff = lds_byte(wr * 64 + fr, fq * 8), boff = lds_byte(wc * 32 + fr, fq * 8);
#define PG8_SA(b, h) (((b) * 2 + (h)) * HTB)
#define PG8_SB(b, h) ((4 + (b) * 2 + (h)) * HTB)
#define PG8_STAGE(bufoff, gbase, voff) do { _Pragma("unroll") for (int _i = 0; _i < 2; ++_i) \
        __builtin_amdgcn_global_load_lds((const unsigned*)((const char*)(gbase) + (voff)[_i]), (LAS unsigned*)(lds + (bufoff) + ldsw + _i * 8192), 16, 0, 0); } while (0)
#define PG8_LDA(dst, b, h) do { _Pragma("unroll") for (int m = 0; m < 4; ++m) _Pragma("unroll") for (int k = 0; k < 2; ++k) dst[m][k] = *(const LAS bf16x8*)(lds + PG8_SA(b, h) + aoff + m * 2048 + k * 1024); } while (0)
#define PG8_LDB(dst, b, h) do { _Pragma("unroll") for (int n = 0; n < 2; ++n) _Pragma("unroll") for (int k = 0; k < 2; ++k) dst[n][k] = *(const LAS bf16x8*)(lds + PG8_SB(b, h) + boff + n * 2048 + k * 1024); } while (0)
#define PG8_MMA(ai, bj, At, Bt) do { __builtin_amdgcn_s_setprio(1); _Pragma("unroll") for (int m = 0; m < 4; ++m) _Pragma("unroll") for (int n = 0; n < 2; ++n) _Pragma("unroll") for (int k = 0; k < 2; ++k) \
        acc[ai][bj][m][n] = __builtin_amdgcn_mfma_f32_16x16x32_bf16(Bt[n][k], At[m][k], acc[ai][bj][m][n], 0, 0, 0); __builtin_amdgcn_s_setprio(0); } while (0)
#define PG8_WAIT_V(n) asm volatile("s_waitcnt vmcnt(" #n ")" ::: "memory")
#define PG8_WAIT_L(n) asm volatile("s_waitcnt lgkmcnt(" #n ")" ::: "memory")
#define PG8_BAR __builtin_amdgcn_s_barrier()
#define PG8_SCHED __builtin_amdgcn_sched_barrier(0)
    Unit cur, nxt; int ui = 0;
    if (!get_unit(P.ws, mode, 0, G, c, cur)) return;
    f32x4 acc[2][2][4][2];
#pragma unroll
    for (int a = 0; a < 2; ++a)
#pragma unroll
        for (int b = 0; b < 2; ++b)
#pragma unroll
            for (int m = 0; m < 4; ++m)
#pragma unroll
                for (int n = 0; n < 2; ++n) acc[a][b][m][n] = (f32x4){0.f, 0.f, 0.f, 0.f};
    bf16x8 At[4][2], B0[2][2], B1[2][2];
    const char* cA = cur.a; const char* cB = cur.b;
    bool cqk = (mode == G_IN) && cur.pn < 8;
    unsigned voffB[2] = {PG8_BOFF(0, cqk), PG8_BOFF(1, cqk)};
    PG8_STAGE(PG8_SB(0, 0), cB, voffB); PG8_STAGE(PG8_SB(0, 1), cB + hstepB, voffB); PG8_STAGE(PG8_SA(0, 0), cA, voffA); PG8_STAGE(PG8_SA(0, 1), cA + hstepA, voffA);
    if (wr == 1) PG8_BAR;
    PG8_WAIT_V(2); PG8_BAR;
    PG8_STAGE(PG8_SB(1, 0), cB + kstep, voffB); PG8_STAGE(PG8_SA(1, 0), cA + kstep, voffA); PG8_STAGE(PG8_SB(1, 1), cB + hstepB + kstep, voffB);
    PG8_WAIT_V(6); PG8_BAR;
    for (;;) {
        const bool has_next = get_unit(P.ws, mode, ui + 1, G, c, nxt);
        const char* nA = has_next ? nxt.a : cA; const char* nB = has_next ? nxt.b : cB;
        const bool nqk = has_next ? ((mode == G_IN) && nxt.pn < 8) : cqk;
        for (int t = 0; t < nt; t += 2) {
            const bool last = (t == nt - 2);
            unsigned vb2[2] = {voffB[0], voffB[1]};
            if (last && nqk != cqk) { vb2[0] = PG8_BOFF(0, nqk); vb2[1] = PG8_BOFF(1, nqk); }
            const char* a1 = cA + (size_t)(t + 1) * kstep;
            const char* a2 = last ? nA : cA + (size_t)(t + 2) * kstep; const char* b2 = last ? nB : cB + (size_t)(t + 2) * kstep;
            const char* a3 = a2 + kstep; const char* b3 = b2 + kstep;
            PG8_LDB(B0, 0, 0); PG8_LDB(B1, 0, 1); PG8_SCHED; PG8_LDA(At, 0, 0); PG8_STAGE(PG8_SA(1, 1), a1 + hstepA, voffA);
            PG8_WAIT_V(8); PG8_WAIT_L(0); PG8_BAR; PG8_MMA(0, 0, At, B0); PG8_MMA(0, 1, At, B1); PG8_BAR; PG8_SCHED;
            PG8_LDA(At, 0, 1); PG8_STAGE(PG8_SB(0, 0), b2, vb2); PG8_STAGE(PG8_SB(0, 1), b2 + hstepB, vb2); PG8_STAGE(PG8_SA(0, 0), a2, voffA);
            PG8_WAIT_V(8); PG8_WAIT_L(0); PG8_BAR; PG8_MMA(1, 0, At, B0); PG8_MMA(1, 1, At, B1); PG8_BAR; PG8_SCHED;
            PG8_LDB(B0, 1, 0); PG8_LDB(B1, 1, 1); PG8_SCHED; PG8_LDA(At, 1, 0); PG8_STAGE(PG8_SA(0, 1), a2 + hstepA, voffA);
            PG8_WAIT_V(8); PG8_WAIT_L(0); PG8_BAR; PG8_MMA(0, 0, At, B0); PG8_MMA(0, 1, At, B1); PG8_BAR; PG8_SCHED;
            PG8_LDA(At, 1, 1); PG8_STAGE(PG8_SB(1, 0), b3, vb2); PG8_STAGE(PG8_SB(1, 1), b3 + hstepB, vb2); PG8_STAGE(PG8_SA(1, 0), a3, voffA);
            PG8_WAIT_V(8); PG8_WAIT_L(0); PG8_BAR; PG8_MMA(1, 0, At, B0); PG8_MMA(1, 1, At, B1); PG8_BAR; PG8_SCHED;
        }
        if (wr == 0) PG8_BAR;
        if (cqk) gemm_epilogue_qk(P, acc, cur, wr, wc, fr, fq, lds);
        else if (!fusedEpi) gemm_epilogue(P, mode, acc, cur, wr, wc, fr, fq);
        if (!has_next) break;
#pragma unroll
        for (int a = 0; a < 2; ++a)
#pragma unroll
            for (int b = 0; b < 2; ++b)
#pragma unroll
                for (int m = 0; m < 4; ++m)
#pragma unroll
                    for (int n = 0; n < 2; ++n) acc[a][b][m][n] = (f32x4){0.f, 0.f, 0.f, 0.f};
        cur = nxt; cA = nA; cB = nB; ++ui; if (nqk != cqk) { cqk = nqk; voffB[0] = PG8_BOFF(0, cqk); voffB[1] = PG8_BOFF(1, cqk); }
        if (wr == 1) PG8_BAR;
    }
    PG8_WAIT_V(0);
    PG8_BAR;
    if (fusedEpi) gemm_epilogue_fused(P, mode, acc, cur, wr, wc, fr, fq, lds, tid);
#undef PG8_BOFF
#undef PG8_SA
#undef PG8_SB
#undef PG8_STAGE
#undef PG8_LDA
#undef PG8_LDB
#undef PG8_MMA
#undef PG8_WAIT_V
#undef PG8_WAIT_L
#undef PG8_BAR
#undef PG8_SCHED
}

namespace att {
constexpr int D = 128, NW = 8, QBLK = 32, KVBLK = 64;
constexpr float SCALE = 0.088388347648318440f;
constexpr float THR = 8.f;
constexpr int LDQ = AW, LDK = HD, LDO = DM;
constexpr size_t SHM_V = KVBLK * D * 2, SHM_K = KVBLK * D * 2, SHM_ATTN = 2 * SHM_V + 2 * SHM_K + NW * 64 * 4;
#define KSWZ(row, colB) ((row) * 256 + ((colB) ^ (((row) & 7) << 4)))
#define SBAR() __builtin_amdgcn_sched_barrier(0)
__device__ __forceinline__ int crow(int r, int hi) { return (r & 3) + 8 * (r >> 2) + 4 * hi; }
__device__ __forceinline__ unsigned cvtpk(float lo, float hi) { unsigned r; asm volatile("v_cvt_pk_bf16_f32 %0, %1, %2" : "=v"(r) : "v"(lo), "v"(hi)); return r; }
__device__ __forceinline__ bf16x8 ld8(const bf16_t* p) { return *reinterpret_cast<const bf16x8*>(p); }

__device__ __forceinline__ void partialSM(f32x16& p0, f32x16& p1, float& m_reg, float& mn, float& alpha) {
  constexpr float C = SCALE * 1.4426950408889634f;
  float pmax = p0[0];
#pragma unroll
  for (int r = 1; r < 16; ++r) pmax = fmaxf(pmax, p0[r]);
#pragma unroll
  for (int r = 0; r < 16; ++r) pmax = fmaxf(pmax, p1[r]);
  { auto rr = __builtin_amdgcn_permlane32_swap(__float_as_uint(pmax), __float_as_uint(pmax), false, false);
    pmax = fmaxf(__uint_as_float(rr[0]), __uint_as_float(rr[1])); }
  if (__builtin_expect(__all(pmax - m_reg <= THR / SCALE), 1)) { mn = m_reg; alpha = 1.f; }
  else { mn = fmaxf(m_reg, pmax); alpha = __builtin_amdgcn_exp2f((m_reg - mn) * C); m_reg = mn; }
  float mnC = -mn * C;
#pragma unroll
  for (int r = 0; r < 16; ++r) p0[r] = fmaf(p0[r], C, mnC);
#pragma unroll
  for (int r = 0; r < 16; ++r) p1[r] = fmaf(p1[r], C, mnC);
#pragma unroll
  for (int r = 0; r < 16; ++r) p0[r] = __builtin_amdgcn_exp2f(p0[r]);
}
__device__ __forceinline__ void finishSM(f32x16& p0, f32x16& p1, float alpha, float& l_reg, bf16x8& pa0, bf16x8& pa1, bf16x8& pa2, bf16x8& pa3) {
#pragma unroll
  for (int r = 0; r < 16; ++r) p1[r] = __builtin_amdgcn_exp2f(p1[r]);
  float ps = 0;
#pragma unroll
  for (int r = 0; r < 16; ++r) ps += p0[r];
#pragma unroll
  for (int r = 0; r < 16; ++r) ps += p1[r];
  { auto rr = __builtin_amdgcn_permlane32_swap(__float_as_uint(ps), __float_as_uint(ps), false, false);
    ps = __uint_as_float(rr[0]) + __uint_as_float(rr[1]); }
  l_reg = l_reg * alpha + ps;
#define PK4(P, BASE, OUT) do { unsigned a0 = cvtpk(P[BASE + 0], P[BASE + 1]), a1 = cvtpk(P[BASE + 2], P[BASE + 3]);   \
    unsigned b0 = cvtpk(P[BASE + 4], P[BASE + 5]), b1 = cvtpk(P[BASE + 6], P[BASE + 7]);                              \
    auto r0 = __builtin_amdgcn_permlane32_swap(a0, b0, false, false); auto r1 = __builtin_amdgcn_permlane32_swap(a1, b1, false, false); \
    u32x4 w = {r0[0], r1[0], r0[1], r1[1]}; OUT = *reinterpret_cast<bf16x8*>(&w); } while (0)
  PK4(p0, 0, pa0); PK4(p0, 8, pa1); PK4(p1, 0, pa2); PK4(p1, 8, pa3);
#undef PK4
}
__device__ __forceinline__ void qkt(f32x16& p0, f32x16& p1, const bf16_t* Ks, const bf16x8* qr, int r32, int hi) {
  p0 = f32x16{}; p1 = f32x16{};
#pragma unroll
  for (int d0 = 0; d0 < 8; ++d0) { int cb = (d0 * 16 + hi * 8) * 2;
    bf16x8 b0 = *reinterpret_cast<const bf16x8*>((const char*)Ks + KSWZ(r32, cb));
    bf16x8 b1 = *reinterpret_cast<const bf16x8*>((const char*)Ks + KSWZ(32 + r32, cb));
    p0 = __builtin_amdgcn_mfma_f32_32x32x16_bf16(b0, qr[d0], p0, 0, 0, 0);
    p1 = __builtin_amdgcn_mfma_f32_32x32x16_bf16(b1, qr[d0], p1, 0, 0, 0); }
}
__device__ __forceinline__ int v_st(int k, int c) { const int kk = (k & ~0xC) | ((k & 4) << 1) | ((k & 8) >> 1); return ((kk >> 3) * 4 + (c >> 5)) * 512 + ((kk & 7) * 32 + (c & 31)) * 2; }
__device__ __forceinline__ int v_rd_base(int lane) { return ((lane & 3) << 3) | (((lane >> 2) & 3) << 6) | (((lane >> 4) & 1) << 5) | (((lane >> 5) & 1) << 8); }
constexpr int v_rd_off(int d0, int ks, int half) { return d0 * 512 + ks * 4096 + half * 2048; }
template <int OFF> __device__ __forceinline__ s16x4 tr_read(int vb) {
  s16x4 r; asm volatile("ds_read_b64_tr_b16 %0, %1 offset:%2" : "=&v"(r) : "v"(vb), "i"(OFF) : "memory"); return r;
}
template <int D0> __device__ __forceinline__ void pv_one(f32x16& od, int vb, bf16x8 pa0, bf16x8 pa1, bf16x8 pa2, bf16x8 pa3) {
  const s16x4 l0 = tr_read<v_rd_off(D0, 0, 0)>(vb), h0 = tr_read<v_rd_off(D0, 0, 1)>(vb), l1 = tr_read<v_rd_off(D0, 1, 0)>(vb), h1 = tr_read<v_rd_off(D0, 1, 1)>(vb);
  const s16x4 l2 = tr_read<v_rd_off(D0, 2, 0)>(vb), h2 = tr_read<v_rd_off(D0, 2, 1)>(vb), l3 = tr_read<v_rd_off(D0, 3, 0)>(vb), h3 = tr_read<v_rd_off(D0, 3, 1)>(vb);
  asm volatile("s_waitcnt lgkmcnt(0)" ::: "memory"); SBAR();
#define PK(L, H) (bf16x8){L[0], L[1], L[2], L[3], H[0], H[1], H[2], H[3]}
  od = __builtin_amdgcn_mfma_f32_32x32x16_bf16(pa0, PK(l0, h0), od, 0, 0, 0);
  od = __builtin_amdgcn_mfma_f32_32x32x16_bf16(pa1, PK(l1, h1), od, 0, 0, 0);
  od = __builtin_amdgcn_mfma_f32_32x32x16_bf16(pa2, PK(l2, h2), od, 0, 0, 0);
  od = __builtin_amdgcn_mfma_f32_32x32x16_bf16(pa3, PK(l3, h3), od, 0, 0, 0);
#undef PK
}
__device__ __forceinline__ void pv_d0(f32x16* o, int vb, bf16x8 pa0, bf16x8 pa1, bf16x8 pa2, bf16x8 pa3) {
  pv_one<0>(o[0], vb, pa0, pa1, pa2, pa3); pv_one<1>(o[1], vb, pa0, pa1, pa2, pa3); pv_one<2>(o[2], vb, pa0, pa1, pa2, pa3); pv_one<3>(o[3], vb, pa0, pa1, pa2, pa3);
}

__device__ __forceinline__ void attn_dense_body(const bf16_t* __restrict__ Qb, const bf16_t* __restrict__ Kh, const bf16_t* __restrict__ Vh,
                                                bf16_t* __restrict__ Ob, int seq, char* lds) {
  int tid_ = threadIdx.x; asm volatile("" : "+v"(tid_));
  const int tid = tid_, wid = tid >> 6, lane = tid & 63, r32 = lane & 31, hi = lane >> 5;
  bf16_t* V_lds = (bf16_t*)lds; bf16_t* K_lds = (bf16_t*)(lds + 2 * SHM_V);
  float* ws = (float*)(lds + 2 * SHM_V + 2 * SHM_K) + wid * 64; float* li_l = ws; float* al_l = ws + 32;
  float m_reg = -1e30f, l_reg = 0; f32x16 o[4] = {}; bf16x8 qr[8];
  const bf16_t* Qw = Qb + (long)(wid * QBLK + r32) * LDQ + hi * 8;
#pragma unroll
  for (int d0 = 0; d0 < 8; ++d0) qr[d0] = ld8(Qw + d0 * 16);
  const int sr = tid >> 4, sc = (tid & 15) * 8, vst0 = v_st(sr, sc), vst1 = v_st(32 + sr, sc);
  const int vb0 = (int)(uintptr_t)V_lds + v_rd_base(lane);
  struct { bf16x8 vs0, vs1, ks0, ks1; } sr_[2];
#define SLOAD(i, k0) do { sr_[i].vs0 = ld8(&Vh[(long)((k0) + sr) * LDK + sc]); sr_[i].vs1 = ld8(&Vh[(long)((k0) + 32 + sr) * LDK + sc]); \
    sr_[i].ks0 = ld8(&Kh[(long)((k0) + sr) * LDK + sc]); sr_[i].ks1 = ld8(&Kh[(long)((k0) + 32 + sr) * LDK + sc]); } while (0)
#define SWRITE(b, i) do { *(bf16x8*)((char*)V_lds + (b) * SHM_V + vst0) = sr_[i].vs0;          \
    *(bf16x8*)((char*)V_lds + (b) * SHM_V + vst1) = sr_[i].vs1; int kc = sc * 2;               \
    *(bf16x8*)((char*)K_lds + (b) * SHM_K + KSWZ(sr, kc)) = sr_[i].ks0;                       \
    *(bf16x8*)((char*)K_lds + (b) * SHM_K + KSWZ(32 + sr, kc)) = sr_[i].ks1; } while (0)
#define SWAIT() asm volatile("s_waitcnt vmcnt(4)" ::: "memory")
#define RESC(a) do { if (__any((a) < 1.f)) { if (hi == 0) al_l[r32] = (a); asm volatile("s_waitcnt lgkmcnt(0)" ::: "memory"); \
    _Pragma("unroll") for (int d = 0; d < 4; ++d) _Pragma("unroll") for (int r = 0; r < 16; ++r) o[d][r] *= al_l[crow(r, hi)]; } } while (0)
  f32x16 pA0, pA1, pB0, pB1; float mnA, mnB, alA, alB; bf16x8 pa0, pa1, pa2, pa3; const int NT = seq / KVBLK;
  constexpr int SE = 0, SO = 1;
  SLOAD(SE, 0); asm volatile("s_waitcnt vmcnt(0)" ::: "memory"); SWRITE(0, SE); __syncthreads();
  qkt(pA0, pA1, K_lds, qr, r32, hi); partialSM(pA0, pA1, m_reg, mnA, alA);
  SLOAD(SO, KVBLK); if (2 < NT) SLOAD(SE, 2 * KVBLK);
  SWAIT(); SWRITE(1, SO); __syncthreads();
  for (int j = 1; j + 1 < NT; j += 2) {
    SBAR(); qkt(pB0, pB1, (bf16_t*)((char*)K_lds + SHM_K), qr, r32, hi);
    finishSM(pA0, pA1, alA, l_reg, pa0, pa1, pa2, pa3); SBAR();
    SLOAD(SO, (j + 2) * KVBLK); SBAR();
    pv_d0(o, vb0, pa0, pa1, pa2, pa3); partialSM(pB0, pB1, m_reg, mnB, alB);
    __syncthreads(); SWAIT(); SWRITE(0, SE);
    RESC(alB); __syncthreads();
    SBAR(); qkt(pA0, pA1, K_lds, qr, r32, hi);
    finishSM(pB0, pB1, alB, l_reg, pa0, pa1, pa2, pa3); SBAR();
    if (j + 3 < NT) SLOAD(SE, (j + 3) * KVBLK); SBAR();
    pv_d0(o, vb0 + (int)SHM_V, pa0, pa1, pa2, pa3); partialSM(pA0, pA1, m_reg, mnA, alA);
    __syncthreads(); SWAIT(); SWRITE(1, SO);
    RESC(alA); __syncthreads();
  }
  SBAR(); qkt(pB0, pB1, (bf16_t*)((char*)K_lds + SHM_K), qr, r32, hi);
  finishSM(pA0, pA1, alA, l_reg, pa0, pa1, pa2, pa3); SBAR();
  pv_d0(o, vb0, pa0, pa1, pa2, pa3); partialSM(pB0, pB1, m_reg, mnB, alB);
  __syncthreads(); RESC(alB);
  finishSM(pB0, pB1, alB, l_reg, pa0, pa1, pa2, pa3); SBAR();
  pv_d0(o, vb0 + (int)SHM_V, pa0, pa1, pa2, pa3);
  if (hi == 0) li_l[r32] = l_reg; asm volatile("s_waitcnt lgkmcnt(0)" ::: "memory");
  float rli[16];
#pragma unroll
  for (int r = 0; r < 16; ++r) rli[r] = __builtin_amdgcn_rcpf(li_l[crow(r, hi)]);
  bf16_t* Ow = Ob + (long)(wid * QBLK) * LDO;
#pragma unroll
  for (int r = 0; r < 16; ++r) { int orow = crow(r, hi);
#pragma unroll
    for (int d0 = 0; d0 < 4; ++d0) Ow[(long)orow * LDO + d0 * 32 + r32] = f2bf(o[d0][r] * rli[r]); }
  __syncthreads();
#undef SLOAD
#undef SWRITE
#undef SWAIT
#undef RESC
}
#undef KSWZ
#undef SBAR
}

constexpr int TR_LDS_WAVE = 64 * 65 * 4;
__device__ __forceinline__ void transpose_share(const float* __restrict__ W, int K, int N, bf16_t* __restrict__ WT, int w, int nw, LAS unsigned char* lds, int first = 0, int last = 1 << 30) {
    int tid_ = threadIdx.x; asm volatile("" : "+v"(tid_));
    const int wid = tid_ >> 6, lane = tid_ & 63;
    LAS float* scr = (LAS float*)(lds + wid * TR_LDS_WAVE);
    const int nblk = N / 64; int nitems = (K / 64) * nblk; if (last < nitems) nitems = last;
    const int kr = lane >> 4, n4 = (lane & 15) * 4, c = lane & 7;
    int it = first + w * 8 + wid;
    if (it >= nitems) return;
    f32x4 v[16];
    { const int kb = it / nblk, nb = it - kb * nblk;
#pragma unroll
      for (int i = 0; i < 16; ++i) v[i] = *(const f32x4*)(W + (size_t)(64 * kb + 4 * i + kr) * N + 64 * nb + n4); }
    for (;;) {
        const int kb = it / nblk, nb = it - kb * nblk, k0 = 64 * kb, n0 = 64 * nb;
#pragma unroll
        for (int i = 0; i < 16; ++i) { LAS float* d = scr + (4 * i + kr) * 65 + n4; d[0] = v[i].x; d[1] = v[i].y; d[2] = v[i].z; d[3] = v[i].w; }
        const int nx = it + nw; const bool more = nx < nitems;
        if (more) { const int kb2 = nx / nblk, nb2 = nx - kb2 * nblk;
#pragma unroll
            for (int i = 0; i < 16; ++i) v[i] = *(const f32x4*)(W + (size_t)(64 * kb2 + 4 * i + kr) * N + 64 * nb2 + n4); }
        LDS_WAIT();
#pragma unroll
        for (int j = 0; j < 8; ++j) { const int n = (lane >> 3) + 8 * j; const LAS float* sp = scr + (8 * c) * 65 + n;
            u32x4 o; o.x = cvt_pk_bf16(sp[0 * 65], sp[1 * 65]); o.y = cvt_pk_bf16(sp[2 * 65], sp[3 * 65]); o.z = cvt_pk_bf16(sp[4 * 65], sp[5 * 65]); o.w = cvt_pk_bf16(sp[6 * 65], sp[7 * 65]);
            *(u32x4*)(WT + (size_t)(n0 + n) * K + k0 + 8 * c) = o; }
        LDS_WAIT();
        if (!more) break;
        it = nx;
    }
}

__device__ __forceinline__ void ada_phase(const Params& P, LAS unsigned char* lds, int G) {
    int tid_ = threadIdx.x; asm volatile("" : "+v"(tid_));
    const int tid = tid_, wid = tid >> 6, lane = tid & 63;
    unsigned char* ws = P.ws;
    LAS float* sl = (LAS float*)lds;
    for (int i = tid; i < 5 * DM; i += 512) { const float v = (i < 4 * DM) ? P.in[I_C][i] : P.in[I_CCTX][i - 4 * DM]; sl[i] = v / (1.f + expf(-v)); }
    __syncthreads();
    LAS float* red = (LAS float*)(lds + 40960);
    float* mod = (float*)(ws + WS_MOD);
    const float* w_ada = P.in[I_WADA];
    int it = blockIdx.x;
    f32x4 wv[16];
    if (it < 768) { const float* wp = w_ada + (size_t)((it / 48) * 128 + wid * 16) * NMOD6 + (it % 48) * 256 + lane * 4;
#pragma unroll
        for (int i = 0; i < 16; ++i) wv[i] = *(const f32x4*)(wp + (size_t)i * NMOD6); }
    while (it < 768) {
        const int cc = it % 48, kc = it / 48;
        const int kb = kc * 128 + wid * 16;
        f32x4 acc[5];
#pragma unroll
        for (int r = 0; r < 5; ++r) acc[r] = (f32x4){0.f, 0.f, 0.f, 0.f};
#pragma unroll
        for (int i = 0; i < 16; ++i) {
#pragma unroll
            for (int r = 0; r < 5; ++r) { const float s = sl[r * DM + kb + i]; acc[r] += wv[i] * s; }
        }
        const int nx = it + G;
        if (nx < 768) { const float* wp = w_ada + (size_t)((nx / 48) * 128 + wid * 16) * NMOD6 + (nx % 48) * 256 + lane * 4;
#pragma unroll
            for (int i = 0; i < 16; ++i) wv[i] = *(const f32x4*)(wp + (size_t)i * NMOD6); }
#pragma unroll
        for (int r = 0; r < 5; ++r) *(LAS f32x4*)(red + (wid * 5 + r) * 256 + lane * 4) = acc[r];
        asm volatile("s_waitcnt lgkmcnt(0)" ::: "memory"); __builtin_amdgcn_s_barrier(); asm volatile("" ::: "memory");
        if (tid < 320) {
            const int r = tid >> 6, q = tid & 63;
            f32x4 s = (f32x4){0.f, 0.f, 0.f, 0.f};
#pragma unroll
            for (int w = 0; w < 8; ++w) s += *(const LAS f32x4*)(red + (w * 5 + r) * 256 + q * 4);
            if (kc == 0) s += *(const f32x4*)(P.in[I_BADA] + cc * 256 + q * 4);
            float* dst = mod + (size_t)r * NMOD6 + cc * 256 + q * 4;
            unsafeAtomicAdd(dst + 0, s[0]); unsafeAtomicAdd(dst + 1, s[1]); unsafeAtomicAdd(dst + 2, s[2]); unsafeAtomicAdd(dst + 3, s[3]);
        }
        asm volatile("s_waitcnt lgkmcnt(0)" ::: "memory"); __builtin_amdgcn_s_barrier(); asm volatile("" ::: "memory");
        it = nx;
    }
    asm volatile("s_waitcnt vmcnt(0)" ::: "memory");
    __syncthreads();
    if (tid == 0) { __builtin_amdgcn_fence(__ATOMIC_RELEASE, "agent"); asm volatile("s_waitcnt vmcnt(0)" ::: "memory");
                    __hip_atomic_fetch_add((unsigned*)(ws + WS_QCTR), 1u, __ATOMIC_RELAXED, __HIP_MEMORY_SCOPE_AGENT); }
}

__device__ __forceinline__ void gen_tables(const Params& P, LAS unsigned char* lds, int blk, int nblk) {
    int tid_ = threadIdx.x; asm volatile("" : "+v"(tid_));
    const int tid = tid_;
    unsigned char* ws = P.ws;
    LAS float* ct = (LAS float*)lds;
    for (int j = tid; j < 2048; j += 512) ct[j] = cospif((float)j * (1.0f / 1024.0f));
    __syncthreads();
    bf16_t* dft = (bf16_t*)(ws + WS_DFT);
    for (int idx = blk * 512 + tid; idx < 2048 * 512; idx += nblk * 512) {
        const int k = idx >> 9, n0 = (idx & 511) * 8, part = n0 >> 11, nn = n0 & 2047;
        float v[8];
#pragma unroll
        for (int e = 0; e < 8; ++e) { const int j = (k * (nn + e)) & 2047; v[e] = ct[part ? ((j - 512) & 2047) : j]; }
        u32x4 o; o.x = cvt_pk_bf16(v[0], v[1]); o.y = cvt_pk_bf16(v[2], v[3]); o.z = cvt_pk_bf16(v[4], v[5]); o.w = cvt_pk_bf16(v[6], v[7]);
        *(u32x4*)(dft + (size_t)k * 4096 + n0) = o;
    }
    for (int idx = blk * 512 + tid; idx < 64 * 32; idx += nblk * 512) {
        const int pv = idx >> 5, i = idx & 31;
        const float ang = (float)pv * powf(10000.0f, -(float)(2 * i) / 64.0f);
        float* t = (float*)(ws + WS_ROPE) + (size_t)(pv * 32 + i) * 2;
        t[0] = cosf(ang); t[1] = sinf(ang);
    }
    bf16_t* gt = (bf16_t*)(ws + WS_GT);
    LAS float* wfs = (LAS float*)(lds + 8192);
    const int NS = nblk >= 4 ? nblk / 4 : 1;
    for (int t = blk; t < 4 * NS; t += nblk) {
        const int g = t / NS, sidx = t - g * NS;
        const float* wf = P.in[I_WF] + (size_t)g * 128 * 128;
#pragma unroll
        for (int j = 0; j < 8; ++j) *(LAS f32x4*)(wfs + (tid + 512 * j) * 4) = *(const f32x4*)(wf + (tid + 512 * j) * 4);
        __syncthreads();
        for (int idx = sidx * 512 + tid; idx < 2 * 128 * 128; idx += NS * 512) {
            const int d = idx & 127, cch = (idx >> 7) & 127, part = idx >> 14;
            float sum = 0.f;
#pragma unroll 16
            for (int l = 0; l < 128; ++l) {
                const int j = (cch * l) & 127;
                const float cs = part ? -ct[((j - 32) & 127) * 16] : ct[j * 16];
                sum += cs * wfs[l * 128 + d];
            }
            gt[(size_t)((g * 2 + part) * 128 + d) * 128 + cch] = f2bf(sum * (1.0f / 512.0f));
        }
        __syncthreads();
    }
}

template <int MODE> __device__ __forceinline__ const float* rows_src(const Params& P, int r) {
    if (MODE == 0) return (r < MTOK) ? P.in[I_X] + (size_t)r * DM : P.in[I_CTX] + (size_t)(r - MTOK) * DM;
    return P.out + (size_t)r * DM;
}
template <int MODE> __device__ __forceinline__ void rows_pass(const Params& P, int G) {
    int tid_ = threadIdx.x; asm volatile("" : "+v"(tid_));
    const int tid = tid_, wid = tid >> 6, lane = tid & 63;
    const int gw = blockIdx.x * 8 + wid, NGW = G * 8;
    const int nrows = (MODE == 0) ? (MTOK + MCTX) : MTOK;
    if (MODE == 0) {
        if (tid == 0) { unsigned sp = 0; while (__hip_atomic_load((unsigned*)(P.ws + WS_QCTR), __ATOMIC_RELAXED, __HIP_MEMORY_SCOPE_AGENT) < (unsigned)G) { __builtin_amdgcn_s_sleep(2); if (++sp > (1u << 22)) break; } }
        __syncthreads();
        __builtin_amdgcn_fence(__ATOMIC_ACQUIRE, "agent");
    }
    const float* mod = (const float*)(P.ws + WS_MOD);
    const float* gain = P.in[MODE == 0 ? I_G1 : (MODE == 1 ? I_G2 : I_GF)];
    int r = gw;
    if (r >= nrows) return;
    f32x4 v[8], nv[8];
    { const float* src = rows_src<MODE>(P, r);
#pragma unroll
      for (int j = 0; j < 8; ++j) v[j] = *(const f32x4*)(src + (lane + 64 * j) * 4); }
    for (;;) {
        const int rn = r + NGW; const bool more = rn < nrows;
        if (more) { const float* src = rows_src<MODE>(P, rn);
#pragma unroll
            for (int j = 0; j < 8; ++j) nv[j] = *(const f32x4*)(src + (lane + 64 * j) * 4); }
        const int mr = (MODE == 0 && r >= MTOK) ? 4 : (r >> 11);
        float ss = 0.f;
#pragma unroll
        for (int j = 0; j < 8; ++j) ss += (v[j].x * v[j].x + v[j].y * v[j].y) + (v[j].z * v[j].z + v[j].w * v[j].w);
        const float rstd = rsqrtf(wave_sum(ss) * (1.0f / DM) + EPS);
#pragma unroll
        for (int j = 0; j < 8; ++j) {
            const int col = (lane + 64 * j) * 4;
            const f32x4 g = *(const f32x4*)(gain + col);
            f32x4 y = v[j] * rstd * g;
            if (MODE == 2) { *(f32x4*)(P.out + (size_t)r * DM + col) = y; }
            else {
                const float* mrow = mod + (size_t)mr * NMOD6 + (MODE == 0 ? 0 : 3 * DM);
                const f32x4 sh = *(const f32x4*)(mrow + col), sc = *(const f32x4*)(mrow + DM + col);
                y = y * (1.0f + sc) + sh;
                u32x2 o; o.x = cvt_pk_bf16(y.x, y.y); o.y = cvt_pk_bf16(y.z, y.w);
                bf16_t* dst = (bf16_t*)(P.ws + (MODE == 0 ? WS_H : WS_H2)) + (size_t)r * DM + col;
                *(u32x2*)dst = o;
            }
        }
        if (!more) break;
#pragma unroll
        for (int j = 0; j < 8; ++j) v[j] = nv[j];
        r = rn;
    }
}

__device__ __forceinline__ void attention_phase(const Params& P, unsigned char* lds, int G) {
    const int c = blockIdx.x;
    for (int j = 0;; ++j) {
        int b, h, qb;
        if (G == 256) {
            if (c < 64 || j > 1) break;
            const int grp = (c & 7) + 8 * j, w = (c - 64) >> 3;
            b = grp >> 2; h = (grp & 3) * 3 + (w >> 3); qb = w & 7;
        } else {
            const int au = c + G * j;
            if (au >= NB * NQH * 8) break;
            qb = au & 7; const int bh = au >> 3; h = bh % NQH; b = bh / NQH;
        }
        const bf16_t* Qb = (const bf16_t*)(P.ws + WS_Q) + (size_t)(b * SEQ + qb * 256) * AW + h * HD;
        const bf16_t* Kh = (const bf16_t*)(P.ws + WS_K) + (size_t)(b * NKVH + h / 3) * SKV * HD;
        const bf16_t* Vh = (const bf16_t*)(P.ws + WS_V) + (size_t)(b * NKVH + h / 3) * SKV * HD;
        bf16_t* Ob = (bf16_t*)(P.ws + WS_MIX) + (size_t)(b * SEQ + qb * 256) * DM + h * HD;
        att::attn_dense_body(Qb, Kh, Vh, Ob, SKV, (char*)lds);
    }
}


#define XB_TMO      128
#define XB_XCNT(j)  (256  + 64 * (j))
#define XB_XSUB(j)  (1280 + 64 * (j))
#define XB_XGEN(j)  (2304 + 64 * (j))
#define XB_TOP      3328
#define XB_TOPGEN   3392
#define XCD_BAR_WORDS 3456
#define XB_SPIN_CAP (1u << 22)
__device__ __forceinline__ unsigned xb_ld(unsigned* p)              { return __hip_atomic_load(p, __ATOMIC_RELAXED, __HIP_MEMORY_SCOPE_AGENT); }
__device__ __forceinline__ unsigned xb_add(unsigned* p, unsigned v) { return __hip_atomic_fetch_add(p, v, __ATOMIC_RELAXED, __HIP_MEMORY_SCOPE_AGENT); }
__device__ __forceinline__ unsigned xb_xcc_id() { return (unsigned)__builtin_amdgcn_s_getreg((3 << 11) | 20) & 0xFu; }
#define XB_SPIN(cond, bar) do { unsigned _sp = 0; while (cond) { __builtin_amdgcn_s_sleep(1); \
    if ((++_sp & 255u) == 0u) { if (xb_ld(&(bar)[XB_TMO])) break; if (_sp > XB_SPIN_CAP) { atomicAdd(&(bar)[XB_TMO], 1u); break; } } } } while (0)
struct XcdBarrier { unsigned* bar; unsigned x; volatile LAS unsigned* st; };
__device__ __forceinline__ XcdBarrier xcd_barrier_post(unsigned* bar, volatile LAS unsigned* st) {
    XcdBarrier b; b.bar = bar; b.x = xb_xcc_id(); b.st = st;
    if (threadIdx.x == 0) (void)xb_add(&bar[XB_XCNT(b.x)], 1u);
    return b;
}
__device__ __forceinline__ void xcd_barrier_complete(unsigned* bar, unsigned x, unsigned& nloc, unsigned& nx) {
    const unsigned G = gridDim.x * gridDim.y * gridDim.z;
    unsigned sum, cnt, mine, sp = 0u;
    for (;;) {
        sum = 0u; cnt = 0u; mine = 0u;
#pragma nounroll
        for (unsigned j = 0; j < 16; ++j) { const unsigned c = xb_ld(&bar[XB_XCNT(j)]); sum += c; cnt += (c > 0u) ? 1u : 0u; mine = (j == x) ? c : mine; }
        if (sum == G) break;
        __builtin_amdgcn_s_sleep(1);
        if ((++sp & 255u) == 0u) { if (xb_ld(&bar[XB_TMO])) break; if (sp > XB_SPIN_CAP) { atomicAdd(&bar[XB_TMO], 1u); break; } }
    }
    nloc = mine > 0u ? mine : 1u; nx = cnt > 0u ? cnt : 1u;
}
__device__ __forceinline__ void xcd_barrier(const XcdBarrier& b) {
    asm volatile("s_waitcnt vmcnt(0)" ::: "memory");
    __syncthreads();
    if (threadIdx.x == 0) {
        unsigned* bar = b.bar;
        __builtin_amdgcn_s_waitcnt(0);
        unsigned nloc = b.st[0], nx = b.st[1];
        if (nloc == 0u) { xcd_barrier_complete(bar, b.x, nloc, nx); b.st[0] = nloc; b.st[1] = nx; }
        const unsigned old = xb_add(&bar[XB_XSUB(b.x)], 1u);
        const unsigned gen = old / nloc;
        if (old + 1u == (gen + 1u) * nloc) {
            __builtin_amdgcn_fence(__ATOMIC_RELEASE, "agent");
            asm volatile("s_waitcnt vmcnt(0)" ::: "memory");
            const unsigned og = xb_add(&bar[XB_TOP], 1u);
            const unsigned tg = og / nx;
            if (og + 1u == (tg + 1u) * nx) xb_add(&bar[XB_TOPGEN], 1u);
            else XB_SPIN(xb_ld(&bar[XB_TOPGEN]) == tg, bar);
            __builtin_amdgcn_fence(__ATOMIC_ACQUIRE, "agent");
            xb_add(&bar[XB_XGEN(b.x)], 1u);
            asm volatile("s_waitcnt vmcnt(0)" ::: "memory");
        } else {
            XB_SPIN(xb_ld(&bar[XB_XGEN(b.x)]) == gen, bar);
            __builtin_amdgcn_fence(__ATOMIC_ACQUIRE, "agent");
            asm volatile("s_waitcnt vmcnt(0)" ::: "memory");
        }
    }
    __syncthreads();
}

__global__ void __launch_bounds__(512, 2) fwd_megakernel(Params P_) {
    extern __shared__ __attribute__((aligned(16))) unsigned char lds[];
    cg::grid_group grid = cg::this_grid();
    const int G_ = gridDim.x, c_ = blockIdx.x;
    LAS unsigned char* l3 = (LAS unsigned char*)lds;
    volatile LAS unsigned* misc = (volatile LAS unsigned*)(l3 + LDS_MISC);
    if (threadIdx.x < 64) misc[threadIdx.x] = 0u;
    __syncthreads();
    XcdBarrier xbar = xcd_barrier_post((unsigned*)(P_.ws + WS_BAR), misc + 8);
#if PROBE >= 100
    unsigned long long pt0 = 0, pt1 = 0;
#endif
#pragma nounroll
    for (int ph = 0; ph < 10; ++ph) {
        Params P = P_; int G = G_, c = c_;
        asm volatile("" : "+s"(G), "+s"(c), "+s"(P.ws), "+s"(P.out));
        int gm = -1;
#if PROBE >= 100
        if (ph == PROBE - 100) pt0 = __builtin_amdgcn_s_memrealtime();
        if (ph == PROBE - 99) pt1 = __builtin_amdgcn_s_memrealtime();
#endif
        switch (ph) {
        case 0: ada_phase(P, l3, G); transpose_share(P.in[I_WIN], DM, INW, (bf16_t*)(P.ws + WS_WIN), c, G * 8, l3); transpose_share(P.in[I_WOUT], DM, DM, (bf16_t*)(P.ws + WS_WOUT), c, G * 8, l3); __syncthreads(); gen_tables(P, l3, c, G); __syncthreads();
                break;
        case 1: rows_pass<0>(P, G); break;
        case 2: gm = G_IN; break;
        case 3: gm = G_F1; break;
        case 4: gm = G_F2; break;
        case 5: gm = G_OUT; break;
        case 6: if (G != 256) rows_pass<1>(P, G); break;
        case 7: gm = G_UP; break;
        case 8: gm = G_DOWN; break;
        default: if (G != 256) rows_pass<2>(P, G); break;
        }
#ifndef NO_GEMM
        if (gm >= 0) gemm_phase(l3, P, gm, G, c);
#endif
#ifndef NO_ATT
        if (ph == 4) attention_phase(P, lds, G);
#endif
        if (ph == 2) { if (G != 256) transpose_share(P.in[I_W1], DM, DFF, (bf16_t*)(P.ws + WS_W1), c, G * 8, l3);
                       else if (c >= 144) transpose_share(P.in[I_W1], DM, DFF, (bf16_t*)(P.ws + WS_W1), c - 144, 112 * 8, l3); }
        if (ph == 4) { if (G != 256) transpose_share(P.in[I_W2], DFF, DM, (bf16_t*)(P.ws + WS_W2), c, G * 8, l3);
                       else if (c < 64) transpose_share(P.in[I_W2], DFF, DM, (bf16_t*)(P.ws + WS_W2), c, 64 * 8, l3); }
#if PROBE == 3
        if (ph == 7) { __syncthreads(); gemm_phase(l3, P, gm, G, c); }
#endif
#if PROBE == 4
        if (ph == 4) { __syncthreads(); gemm_phase(l3, P, gm, G, c); attention_phase(P, lds, G); }
#endif
        if (G == 0x7fffffff) grid.sync();
        if (ph > 0 && ph < 9 && !(G == 256 && (ph == 6 || ph == 8))) xcd_barrier(xbar);
    }
#if PROBE >= 100
    if (PROBE - 99 == 10) pt1 = __builtin_amdgcn_s_memrealtime();
    if (blockIdx.x == 0 && threadIdx.x < 64) {
        const unsigned long long te = __builtin_amdgcn_s_memrealtime(), want = 16ull * (pt1 - pt0);
        while (__builtin_amdgcn_s_memrealtime() - te < want) __builtin_amdgcn_s_sleep(8);
    }
#endif
}

extern "C" void kernel_launch(void* const* d_in, const int* in_sizes, int n_in, void* d_out, int out_size, void* d_ws, size_t ws_size, hipStream_t stream) {
    static int grid_blocks = 0;
    if (grid_blocks == 0) {
        if (n_in != 16 || out_size != MTOK * DM || ws_size < WS_END) { fprintf(stderr, "kernel_launch: unexpected shapes (n_in %d out %d ws %zu)\n", n_in, out_size, ws_size); grid_blocks = -1; return; }
        int dev = 0, cus = 0, per_cu = 0;
        (void)hipGetDevice(&dev);
        (void)hipDeviceGetAttribute(&cus, hipDeviceAttributeMultiprocessorCount, dev);
        if (hipFuncSetAttribute((const void*)fwd_megakernel, hipFuncAttributeMaxDynamicSharedMemorySize, LDS_BYTES) != hipSuccess) { fprintf(stderr, "kernel_launch: hipFuncSetAttribute failed\n"); grid_blocks = -1; return; }
        if (hipOccupancyMaxActiveBlocksPerMultiprocessor(&per_cu, (const void*)fwd_megakernel, 512, LDS_BYTES) != hipSuccess || per_cu < 1) { fprintf(stderr, "kernel_launch: occupancy query failed (%d)\n", per_cu); per_cu = 1; }
        (void)hipGetLastError();
        grid_blocks = cus;
    }
    if (grid_blocks < 0) return;
    (void)hipMemsetAsync((char*)d_ws + WS_MOD, 0, WS_CTL_BYTES, stream);
    Params p{};
    for (int i = 0; i < 16; ++i) p.in[i] = (const float*)d_in[i];
    p.out = (float*)d_out; p.ws = (unsigned char*)d_ws;
    void* args[] = {&p};
    hipError_t e = hipLaunchCooperativeKernel((const void*)fwd_megakernel, dim3(grid_blocks), dim3(512), args, LDS_BYTES, stream);
    if (e != hipSuccess) fprintf(stderr, "cooperative launch failed: %s (grid %d)\n", hipGetErrorString(e), grid_blocks);
}
#ifdef TEST_KERNELS
__global__ void __launch_bounds__(512, 2) t_att(Params P) { extern __shared__ __attribute__((aligned(16))) unsigned char lds[]; attention_phase(P, lds, gridDim.x); }
__global__ void __launch_bounds__(512, 2) t_gemm(Params P, int mode) { extern __shared__ __attribute__((aligned(16))) unsigned char lds[]; gemm_phase((LAS unsigned char*)lds, P, mode, gridDim.x, blockIdx.x); }
__global__ void __launch_bounds__(512, 2) t_gemm_up(Params P) { extern __shared__ __attribute__((aligned(16))) unsigned char lds[]; gemm_phase((LAS unsigned char*)lds, P, G_UP, gridDim.x, blockIdx.x); }
__global__ void __launch_bounds__(512, 2) t_gemm_out(Params P) { extern __shared__ __attribute__((aligned(16))) unsigned char lds[]; gemm_phase((LAS unsigned char*)lds, P, G_OUT, gridDim.x, blockIdx.x); }
#endif
```

```cpp
#include <hip/hip_runtime.h>
#include <hip/hip_bf16.h>
#include <hip/hip_cooperative_groups.h>
#include <cstdio>
#include <cstdint>
namespace cg = cooperative_groups;

#ifndef PROBE
#define PROBE 0
#endif
#define LAS __attribute__((address_space(3)))
typedef unsigned short bf16_t;
typedef short bf16x8 __attribute__((ext_vector_type(8)));
typedef short s16x4 __attribute__((ext_vector_type(4)));
typedef float f32x4 __attribute__((ext_vector_type(4)));
typedef float f32x16 __attribute__((ext_vector_type(16)));
typedef unsigned u32x4 __attribute__((ext_vector_type(4)));
typedef unsigned u32x2 __attribute__((ext_vector_type(2)));

constexpr int DM = 2048, NB = 4, SEQ = 2048, CTXL = 256, HD = 128, NQH = 12, NKVH = 4;
constexpr int AW = 1536, KVW = 512, FW = 512, INW = 3072, DFF = 8192, NMOD6 = 6 * DM;
constexpr int MTOK = NB * SEQ, MCTX = NB * CTXL, SKV = SEQ + CTXL;
constexpr float EPS = 1e-6f;

constexpr size_t MiB = 1u << 20;
constexpr size_t WS_MOD = 0;
constexpr size_t WS_BAR = 245760;
constexpr size_t WS_QCTR = 245760 + 16384;
constexpr size_t WS_XCNT = 262144 + 4096;
constexpr size_t WS_CTL_BYTES = 262144 + 4096 + 16384;
constexpr size_t WS_XSLOT = 1 * MiB + 512 * 1024;
constexpr size_t WS_ROPE = 512 * 1024;
constexpr size_t WS_GT = 1 * MiB;
constexpr size_t WS_WIN = 2 * MiB;
constexpr size_t WS_WOUT = 14 * MiB;
constexpr size_t WS_W1 = 22 * MiB;
constexpr size_t WS_W2 = 54 * MiB;
constexpr size_t WS_DFT = 86 * MiB;
constexpr size_t WS_H2 = 102 * MiB;
constexpr size_t WS_H = 134 * MiB;
constexpr size_t WS_Q = 170 * MiB;
constexpr size_t WS_K = 194 * MiB;
constexpr size_t WS_V = 203 * MiB;
constexpr size_t WS_U = 212 * MiB;
constexpr size_t WS_ZT = 220 * MiB;
constexpr size_t WS_MIX = 236 * MiB;
constexpr size_t WS_A1 = 134 * MiB;
constexpr size_t WS_END = 268 * MiB;

constexpr int LDS_MISC = 8 * 64 * 65 * 4;
constexpr int LDS_RED = LDS_MISC + 1024;
constexpr int LDS_BYTES = LDS_RED + 8192;

struct Params { const float* in[16]; float* out; unsigned char* ws; };
enum { I_X = 0, I_C, I_CTX, I_CCTX, I_WADA, I_BADA, I_G1, I_WIN, I_QG, I_KG, I_WF, I_WOUT, I_G2, I_W1, I_W2, I_GF };

__device__ __forceinline__ unsigned cvt_pk_bf16(float lo, float hi) { unsigned r; asm("v_cvt_pk_bf16_f32 %0, %1, %2" : "=v"(r) : "v"(lo), "v"(hi)); return r; }
__device__ __forceinline__ float bf2f(bf16_t v) { return __uint_as_float(((unsigned)v) << 16); }
__device__ __forceinline__ bf16_t f2bf(float f) { return (bf16_t)(cvt_pk_bf16(f, 0.f) & 0xffffu); }
template <int M> __device__ __forceinline__ float swz_xor(float v) { return __int_as_float(__builtin_amdgcn_ds_swizzle(__float_as_int(v), 0x1F | (M << 10))); }
__device__ __forceinline__ float half_sum(float v) { auto rr = __builtin_amdgcn_permlane32_swap(__float_as_uint(v), __float_as_uint(v), false, false); return __uint_as_float(rr[0]) + __uint_as_float(rr[1]); }
__device__ __forceinline__ float wave_sum(float v) {
    v += swz_xor<1>(v); v += swz_xor<2>(v); v += swz_xor<4>(v); v += swz_xor<8>(v); v += swz_xor<16>(v);
    return half_sum(v);
}
#define LDS_WAIT() asm volatile("s_waitcnt lgkmcnt(0)" ::: "memory")

constexpr int BM = 256, BK = 64, HALF = 128, HTB = HALF * BK * 2, NXCD = 8, WGM = 8;
__device__ __forceinline__ int lds_byte(int r, int c) { const int st = (r >> 4) * 2 + (c >> 5), rr = r & 15, cc = c & 31, ob = rr * 64 + cc * 2; return st * 1024 + (ob ^ (((ob >> 9) & 1) << 5)); }
__device__ __forceinline__ void stage_rc(int b, int& R, int& C) { const int st = b / 1024, sb = b % 1024, swz = sb ^ (((sb >> 9) & 1) << 5); R = (st >> 1) * 16 + swz / 64; C = (st & 1) * 32 + (swz % 64) / 2; }
__device__ __forceinline__ int perm32(int rho) { const int n = rho >> 4, i = rho & 15; return 8 * (i >> 2) + 4 * n + (i & 3); }

struct Unit { int pm, pn; const char* a; const char* b; };
enum { G_IN = 0, G_F1, G_F2, G_OUT, G_UP, G_DOWN };

__device__ __forceinline__ void remap_tile(int L, int nM, int nN, int& pm, int& pn) {
    const int nwg = nM * nN; int wgid = L;
    { const int q = nwg / NXCD, r = nwg % NXCD, xcd = wgid % NXCD, off = wgid / NXCD; wgid = (xcd < r ? xcd * (q + 1) : r * (q + 1) + (xcd - r) * q) + off; }
    const int nig = WGM * nN, gid = wgid / nig, fm = gid * WGM, gsz = (nM - fm) < WGM ? (nM - fm) : WGM;
    pm = fm + ((wgid % nig) % gsz); pn = (wgid % nig) / gsz;
}

__device__ __forceinline__ bool get_unit(const unsigned char* ws, int mode, int i, int G, int c, Unit& u) {
    const long L = (long)i * G + c;
    switch (mode) {
    case G_IN: {
        if (L >= 400) return false;
        if (L < 384) remap_tile((int)L, 32, 12, u.pm, u.pn);
        else { const int idx = (int)L - 384; u.pm = 32 + (idx >> 2); u.pn = 6 + (idx & 3); }
        u.a = (const char*)ws + WS_H + (size_t)u.pm * 256 * DM * 2; u.b = (const char*)ws + WS_WIN + (size_t)u.pn * 256 * DM * 2; return true; }
    case G_F1: {
        if (L >= 128) return false;
        const int g = (int)L >> 5; u.pm = g; u.pn = (int)L & 31;
        u.a = (const char*)ws + WS_GT + (size_t)g * 256 * 128 * 2; u.b = (const char*)ws + WS_U + ((size_t)u.pn * 256 * FW + g * 128) * 2; return true; }
    case G_F2: {
        if (L >= 64) return false;
        const int b = (int)L >> 4, pm = ((int)L >> 1) & 7, pn = (int)L & 1; u.pm = b * 8 + pm; u.pn = pn;
        u.a = (const char*)ws + WS_DFT + (size_t)pm * 256 * 4096 * 2; u.b = (const char*)ws + WS_ZT + ((size_t)(b * 512 + pn * 256) * 4096) * 2; return true; }
    case G_OUT: {
        if (L >= 256) return false;
        remap_tile((int)L, 32, 8, u.pm, u.pn);
        u.a = (const char*)ws + WS_MIX + (size_t)u.pm * 256 * DM * 2; u.b = (const char*)ws + WS_WOUT + (size_t)u.pn * 256 * DM * 2; return true; }
    case G_UP: {
        if (L >= 1024) return false;
        remap_tile((int)L, 32, 32, u.pm, u.pn);
        u.a = (const char*)ws + WS_H2 + (size_t)u.pm * 256 * DM * 2; u.b = (const char*)ws + WS_W1 + (size_t)u.pn * 256 * DM * 2; return true; }
    default: {
        if (L >= 256) return false;
        remap_tile((int)L, 32, 8, u.pm, u.pn);
        u.a = (const char*)ws + WS_A1 + (size_t)u.pm * 256 * DFF * 2; u.b = (const char*)ws + WS_W2 + (size_t)u.pn * 256 * DFF * 2; return true; }
    }
}

__device__ __forceinline__ void gemm_epilogue(const Params& P, int mode, const f32x4 (&acc)[2][2][4][2], const Unit& u, int wr, int wc, int fr, int fq) {
    unsigned char* ws = P.ws;
    if (mode == G_OUT || mode == G_DOWN) {
        const float* resid = (mode == G_OUT) ? P.in[I_X] : P.out;
        const float* gate = (const float*)(ws + WS_MOD) + (size_t)(u.pm >> 3) * NMOD6 + (mode == G_OUT ? 2 * DM : 5 * DM);
        const int col0 = u.pn * 256 + wc * 32 + 4 * fq;
        f32x4 gv[2][2];
#pragma unroll
        for (int bj = 0; bj < 2; ++bj)
#pragma unroll
            for (int n = 0; n < 2; ++n) gv[bj][n] = *(const f32x4*)(gate + col0 + bj * HALF + n * 16);
#pragma unroll
        for (int ai = 0; ai < 2; ++ai)
#pragma unroll
            for (int m = 0; m < 4; ++m) {
                const size_t off = (size_t)(u.pm * 256 + ai * HALF + wr * 64 + m * 16 + fr) * DM + col0;
#pragma unroll
                for (int bj = 0; bj < 2; ++bj)
#pragma unroll
                    for (int n = 0; n < 2; ++n) {
                        const f32x4 r = *(const f32x4*)(resid + off + bj * HALF + n * 16);
                        *(f32x4*)(P.out + off + bj * HALF + n * 16) = r + gv[bj][n] * acc[ai][bj][m][n];
                    }
            }
        return;
    }
    bf16_t* base; size_t ld, aistride, bjstride = HALF;
    if (mode == G_IN) {
        const int pm = u.pm, pn = u.pn;
        if (pn < 6) { base = (bf16_t*)(ws + WS_Q) + (size_t)pm * 256 * AW + pn * 256; ld = AW; }
        else if (pn < 10) {
            const int b = (pm < 32) ? (pm >> 3) : (pm - 32), t0 = (pm < 32) ? CTXL + (pm & 7) * 256 : 0, h0 = ((pn - 6) & 1) * 2;
            base = (bf16_t*)(ws + (pn < 8 ? WS_K : WS_V)) + ((size_t)(b * NKVH + h0) * SKV + t0) * HD; ld = HD; bjstride = (size_t)SKV * HD; }
        else { base = (bf16_t*)(ws + WS_U) + (size_t)pm * 256 * FW + (pn - 10) * 256; ld = FW; }
        aistride = 128 * ld;
    } else if (mode == G_F1) {
        const int g = u.pm, b = u.pn >> 3, s0 = (u.pn & 7) * 256;
        base = (bf16_t*)(ws + WS_ZT) + ((size_t)(b * 512 + g * 128) * 4096 + s0); ld = 4096; aistride = 2048;
    } else if (mode == G_F2) {
        base = (bf16_t*)(ws + WS_MIX) + (size_t)u.pm * 256 * DM + AW + u.pn * 256; ld = DM; aistride = 128 * ld;
    } else {
        base = (bf16_t*)(ws + WS_A1) + (size_t)u.pm * 256 * DFF + u.pn * 256; ld = DFF; aistride = 128 * ld;
    }
    const bool relu2 = (mode == G_UP);
    bf16_t* p0 = base + (size_t)(wr * 64 + fr) * ld + wc * 32 + 8 * fq;
#pragma unroll
    for (int ai = 0; ai < 2; ++ai)
#pragma unroll
        for (int m = 0; m < 4; ++m) {
            bf16_t* rowp = p0 + ai * aistride + (size_t)(m * 16) * ld;
#pragma unroll
            for (int bj = 0; bj < 2; ++bj) {
                f32x4 v0 = acc[ai][bj][m][0], v1 = acc[ai][bj][m][1];
                if (relu2) {
#pragma unroll
                    for (int e = 0; e < 4; ++e) { const float a = fmaxf(v0[e], 0.f), b = fmaxf(v1[e], 0.f); v0[e] = a * a; v1[e] = b * b; }
                }
                u32x4 w; w.x = cvt_pk_bf16(v0[0], v0[1]); w.y = cvt_pk_bf16(v0[2], v0[3]); w.z = cvt_pk_bf16(v1[0], v1[1]); w.w = cvt_pk_bf16(v1[2], v1[3]);
                *(u32x4*)(rowp + bj * bjstride) = w;
            }
        }
}

__device__ __forceinline__ int qk_perm(int R) { const int wc = R >> 5, n = (R >> 4) & 1, p = 16 * wc + (R & 15); return (p < 32 ? p : p + 32) + 32 * n; }
__device__ __forceinline__ void gemm_epilogue_qk(const Params& P, const f32x4 (&acc)[2][2][4][2], const Unit& u, int wr, int wc, int fr, int fq, LAS unsigned char* lds) {
    asm volatile("" : "+v"(fr), "+v"(fq), "+s"(wr), "+s"(wc));
    unsigned char* ws = P.ws;
    LAS float* red = (LAS float*)(lds + LDS_RED);
    const int pm = u.pm, pn = u.pn;
#pragma unroll
    for (int ai = 0; ai < 2; ++ai)
#pragma unroll
        for (int m = 0; m < 4; ++m)
#pragma unroll
            for (int bj = 0; bj < 2; ++bj) {
                const f32x4 a = acc[ai][bj][m][0], b = acc[ai][bj][m][1];
                float ss = ((a.x * a.x + a.y * a.y) + (a.z * a.z + a.w * a.w)) + ((b.x * b.x + b.y * b.y) + (b.z * b.z + b.w * b.w));
                ss += swz_xor<16>(ss); ss = half_sum(ss);
                if (fq == 0) red[(bj * 4 + wc) * 256 + ai * HALF + wr * 64 + m * 16 + fr] = ss;
            }
    asm volatile("s_waitcnt lgkmcnt(0)" ::: "memory"); __builtin_amdgcn_s_barrier(); asm volatile("" ::: "memory");
    const bool isq = pn < 6, rope = pm < 32;
    const int p0 = 16 * wc + 4 * fq, d0 = (p0 < 32) ? p0 : p0 + 32;
    const float* g = P.in[isq ? I_QG : I_KG];
    const f32x4 g0 = *(const f32x4*)(g + d0), g1 = *(const f32x4*)(g + d0 + 32);
    bf16_t* base; size_t ld, bjstride;
    if (isq) { base = (bf16_t*)(ws + WS_Q) + (size_t)pm * 256 * AW + pn * 256; ld = AW; bjstride = HD; }
    else { const int b = rope ? (pm >> 3) : (pm - 32), t0 = rope ? CTXL + (pm & 7) * 256 : 0, h0 = (pn - 6) * 2;
           base = (bf16_t*)(ws + WS_K) + ((size_t)(b * NKVH + h0) * SKV + t0) * HD; ld = HD; bjstride = (size_t)SKV * HD; }
    const float* tab = (const float*)(ws + WS_ROPE);
    const int i0 = 16 * (wc & 1) + 4 * fq;
#pragma unroll
    for (int ai = 0; ai < 2; ++ai)
#pragma unroll
        for (int m = 0; m < 4; ++m) {
            const int rl = ai * HALF + wr * 64 + m * 16 + fr;
            f32x4 cs0 = (f32x4){1.f, 0.f, 1.f, 0.f}, cs1 = cs0;
            if (rope) { const int pos = (pm * 256 + rl) & (SEQ - 1), av = (wc < 2) ? (pos >> 6) : (pos & 63);
                        const f32x4* t = (const f32x4*)(tab + (size_t)(av * 32 + i0) * 2); cs0 = t[0]; cs1 = t[1]; }
#pragma unroll
            for (int bj = 0; bj < 2; ++bj) {
                const float tot = (red[(bj * 4 + 0) * 256 + rl] + red[(bj * 4 + 1) * 256 + rl]) + (red[(bj * 4 + 2) * 256 + rl] + red[(bj * 4 + 3) * 256 + rl]);
                const float rstd = rsqrtf(tot * (1.0f / HD) + EPS);
                const f32x4 x1 = acc[ai][bj][m][0] * rstd * g0, x2 = acc[ai][bj][m][1] * rstd * g1;
                const float a0 = x1.x * cs0.x - x2.x * cs0.y, b0 = x2.x * cs0.x + x1.x * cs0.y;
                const float a1 = x1.y * cs0.z - x2.y * cs0.w, b1 = x2.y * cs0.z + x1.y * cs0.w;
                const float a2 = x1.z * cs1.x - x2.z * cs1.y, b2 = x2.z * cs1.x + x1.z * cs1.y;
                const float a3 = x1.w * cs1.z - x2.w * cs1.w, b3 = x2.w * cs1.z + x1.w * cs1.w;
                bf16_t* rowp = base + (size_t)rl * ld + bj * bjstride + d0;
                u32x2 o1, o2; o1.x = cvt_pk_bf16(a0, a1); o1.y = cvt_pk_bf16(a2, a3); o2.x = cvt_pk_bf16(b0, b1); o2.y = cvt_pk_bf16(b2, b3);
                *(u32x2*)rowp = o1; *(u32x2*)(rowp + 32) = o2;
            }
        }
}

__device__ __forceinline__ void gemm_epilogue_fused(const Params& P, int mode, f32x4 (&acc)[2][2][4][2], const Unit& u, int wr, int wc, int fr, int fq, LAS unsigned char* lds, int tid) {
    unsigned char* ws = P.ws;
    const int x = (mode == G_OUT) ? 0 : 1;
    const float* resid = (mode == G_OUT) ? P.in[I_X] : P.out;
    const float* modb = (const float*)(ws + WS_MOD) + (size_t)(u.pm >> 3) * NMOD6;
    const float* gate = modb + (mode == G_OUT ? 2 * DM : 5 * DM);
    const int col0 = u.pn * 256 + wc * 32 + 4 * fq;
    LAS float* Pq = (LAS float*)lds;
    LAS float* S = (LAS float*)(lds + 4096);
    {
        f32x4 gv[2][2];
#pragma unroll
        for (int bj = 0; bj < 2; ++bj)
#pragma unroll
            for (int n = 0; n < 2; ++n) gv[bj][n] = *(const f32x4*)(gate + col0 + bj * HALF + n * 16);
        f32x4 rbuf[2][2][2];
        const size_t off0 = (size_t)(u.pm * 256 + wr * 64 + fr) * DM + col0;
#pragma unroll
        for (int bj = 0; bj < 2; ++bj)
#pragma unroll
            for (int n = 0; n < 2; ++n) rbuf[0][bj][n] = *(const f32x4*)(resid + off0 + bj * HALF + n * 16);
#pragma unroll
        for (int g = 0; g < 8; ++g) {
            const int ai = g >> 2, m = g & 3;
            const int rl = ai * HALF + wr * 64 + m * 16 + fr;
            const size_t off = (size_t)(u.pm * 256 + rl) * DM + col0;
            if (g < 7) { const int ai2 = (g + 1) >> 2, m2 = (g + 1) & 3; const size_t offn = (size_t)(u.pm * 256 + ai2 * HALF + wr * 64 + m2 * 16 + fr) * DM + col0;
#pragma unroll
                for (int bj = 0; bj < 2; ++bj)
#pragma unroll
                    for (int n = 0; n < 2; ++n) rbuf[(g + 1) & 1][bj][n] = *(const f32x4*)(resid + offn + bj * HALF + n * 16); }
            float ss = 0.f;
#pragma unroll
            for (int bj = 0; bj < 2; ++bj)
#pragma unroll
                for (int n = 0; n < 2; ++n) {
                    const f32x4 v = rbuf[g & 1][bj][n] + gv[bj][n] * acc[ai][bj][m][n];
                    acc[ai][bj][m][n] = v;
                    if (mode == G_OUT) *(f32x4*)(P.out + off + bj * HALF + n * 16) = v;
                    ss += (v.x * v.x + v.y * v.y) + (v.z * v.z + v.w * v.w);
                }
            ss += swz_xor<16>(ss); ss = half_sum(ss);
            if (fq == 0) Pq[rl * 4 + wc] = ss;
            asm volatile("" ::: "memory");
        }
    }
    asm volatile("s_waitcnt lgkmcnt(0)" ::: "memory"); __builtin_amdgcn_s_barrier(); asm volatile("" ::: "memory");
    float* slots = (float*)(ws + WS_XSLOT) + (size_t)x * MTOK * 8;
    unsigned* cnt = (unsigned*)(ws + WS_XCNT) + x * 32 * 64 + 64 * u.pm;
    if (tid < 256) {
        const f32x4 q = *(const LAS f32x4*)(Pq + tid * 4);
        const float tot = (q.x + q.y) + (q.z + q.w);
        __hip_atomic_store(slots + (size_t)(u.pm * 256 + tid) * 8 + u.pn, tot, __ATOMIC_RELAXED, __HIP_MEMORY_SCOPE_AGENT);
        asm volatile("s_waitcnt vmcnt(0)" ::: "memory");
        if ((tid & 63) == 0) __hip_atomic_fetch_add(cnt, 1u, __ATOMIC_RELAXED, __HIP_MEMORY_SCOPE_AGENT);
    }
    if (tid < 64) {
        unsigned sp = 0;
        while ((unsigned)__builtin_amdgcn_readfirstlane(__hip_atomic_load(cnt, __ATOMIC_RELAXED, __HIP_MEMORY_SCOPE_AGENT)) < 32u) { __builtin_amdgcn_s_sleep(2); if (++sp > (1u << 22)) break; }
        __builtin_amdgcn_fence(__ATOMIC_ACQUIRE, "agent");
    }
    asm volatile("s_waitcnt vmcnt(0) lgkmcnt(0)" ::: "memory"); __builtin_amdgcn_s_barrier(); asm volatile("" ::: "memory");
    if (tid < 256) {
        const float* sl = slots + (size_t)(u.pm * 256 + tid) * 8; float tot = 0.f;
#pragma unroll
        for (int t = 0; t < 8; ++t) tot += __hip_atomic_load(sl + t, __ATOMIC_RELAXED, __HIP_MEMORY_SCOPE_AGENT);
        S[tid] = rsqrtf(tot * (1.0f / DM) + EPS);
    }
    asm volatile("s_waitcnt lgkmcnt(0)" ::: "memory"); __builtin_amdgcn_s_barrier(); asm volatile("" ::: "memory");
    if (mode == G_OUT) {
        f32x4 gg[2][2], sc[2][2], sh[2][2];
#pragma unroll
        for (int bj = 0; bj < 2; ++bj)
#pragma unroll
            for (int n = 0; n < 2; ++n) { const int cc = col0 + bj * HALF + n * 16; gg[bj][n] = *(const f32x4*)(P.in[I_G2] + cc); sh[bj][n] = *(const f32x4*)(modb + 3 * DM + cc); sc[bj][n] = *(const f32x4*)(modb + 4 * DM + cc) + 1.0f; }
        bf16_t* h2 = (bf16_t*)(ws + WS_H2);
#pragma unroll
        for (int ai = 0; ai < 2; ++ai)
#pragma unroll
            for (int m = 0; m < 4; ++m) {
                const int rl = ai * HALF + wr * 64 + m * 16 + fr; const float rs = S[rl];
                const size_t off = (size_t)(u.pm * 256 + rl) * DM + col0;
#pragma unroll
                for (int bj = 0; bj < 2; ++bj)
#pragma unroll
                    for (int n = 0; n < 2; ++n) {
                        const f32x4 y = (acc[ai][bj][m][n] * rs * gg[bj][n]) * sc[bj][n] + sh[bj][n];
                        u32x2 o; o.x = cvt_pk_bf16(y.x, y.y); o.y = cvt_pk_bf16(y.z, y.w);
                        *(u32x2*)(h2 + off + bj * HALF + n * 16) = o;
                    }
            }
    } else {
        f32x4 gg[2][2];
#pragma unroll
        for (int bj = 0; bj < 2; ++bj)
#pragma unroll
            for (int n = 0; n < 2; ++n) gg[bj][n] = *(const f32x4*)(P.in[I_GF] + col0 + bj * HALF + n * 16);
#pragma unroll
        for (int ai = 0; ai < 2; ++ai)
#pragma unroll
            for (int m = 0; m < 4; ++m) {
                const int rl = ai * HALF + wr * 64 + m * 16 + fr; const float rs = S[rl];
                const size_t off = (size_t)(u.pm * 256 + rl) * DM + col0;
#pragma unroll
                for (int bj = 0; bj < 2; ++bj)
#pragma unroll
                    for (int n = 0; n < 2; ++n) *(f32x4*)(P.out + off + bj * HALF + n * 16) = acc[ai][bj][m][n] * rs * gg[bj][n];
            }
    }
    asm volatile("s_waitcnt lgkmcnt(0)" ::: "memory"); __builtin_amdgcn_s_barrier();
}

__device__ __forceinline__ void gemm_phase(LAS unsigned char* lds, const Params& P, const int mode, const int G, const int c) {
    int tid_ = threadIdx.x; asm volatile("" : "+v"(tid_));
    const int tid = tid_, wid = __builtin_amdgcn_readfirstlane(tid >> 6), lane = tid & 63, wr = wid >> 2, wc = wid & 3, fr = lane & 15, fq = lane >> 4;
    int lda, ldb, K; bool perm = true;
    switch (mode) {
    case G_IN: lda = DM; ldb = DM; K = DM; break;
    case G_F1: lda = 128; ldb = FW; K = 128; break;
    case G_F2: lda = 4096; ldb = 4096; K = 4096; break;
    case G_OUT: lda = DM; ldb = DM; K = DM; perm = false; break;
    case G_UP: lda = DM; ldb = DM; K = DM; break;
    default: lda = DFF; ldb = DFF; K = DFF; perm = false; break;
    }
    const int nt = K / BK;
    const bool fusedEpi = (mode == G_OUT || mode == G_DOWN) && G == 256;
    unsigned voffA[2];
#pragma unroll
    for (int i = 0; i < 2; ++i) { int R, C; stage_rc(tid * 16 + i * 8192, R, C); voffA[i] = (unsigned)(R * lda + C) * 2u; }
#define PG8_BOFF(i, qk) ([&]() { int R, C; stage_rc(tid * 16 + (i) * 8192, R, C); const int Rb = (qk) ? qk_perm(R) : (perm ? ((R & ~31) + perm32(R & 31)) : R); return (unsigned)(Rb * ldb + C) * 2u; }())
    const size_t kstep = (size_t)(BK * 2);
    const size_t hstepA = (size_t)HALF * lda * 2, hstepB = (size_t)HALF * ldb * 2;
    const unsigned ldsw = (unsigned)wid * 1024u;
    const int aoff = lds_byte(wr * 64 + fr, fq * 8), boff = lds_byte(wc * 32 + fr, fq * 8);
#define PG8_SA(b, h) (((b) * 2 + (h)) * HTB)
#define PG8_SB(b, h) ((4 + (b) * 2 + (h)) * HTB)
#define PG8_STAGE(bufoff, gbase, voff) do { _Pragma("unroll") for (int _i = 0; _i < 2; ++_i) \
        __builtin_amdgcn_global_load_lds((const unsigned*)((const char*)(gbase) + (voff)[_i]), (LAS unsigned*)(lds + (bufoff) + ldsw + _i * 8192), 16, 0, 0); } while (0)
#define PG8_LDA(dst, b, h) do { _Pragma("unroll") for (int m = 0; m < 4; ++m) _Pragma("unroll") for (int k = 0; k < 2; ++k) dst[m][k] = *(const LAS bf16x8*)(lds + PG8_SA(b, h) + aoff + m * 2048 + k * 1024); } while (0)
#define PG8_LDB(dst, b, h) do { _Pragma("unroll") for (int n = 0; n < 2; ++n) _Pragma("unroll") for (int k = 0; k < 2; ++k) dst[n][k] = *(const LAS bf16x8*)(lds + PG8_SB(b, h) + boff + n * 2048 + k * 1024); } while (0)
#define PG8_MMA(ai, bj, At, Bt) do { __builtin_amdgcn_s_setprio(1); _Pragma("unroll") for (int m = 0; m < 4; ++m) _Pragma("unroll") for (int n = 0; n < 2; ++n) _Pragma("unroll") for (int k = 0; k < 2; ++k) \
        acc[ai][bj][m][n] = __builtin_amdgcn_mfma_f32_16x16x32_bf16(Bt[n][k], At[m][k], acc[ai][bj][m][n], 0, 0, 0); __builtin_amdgcn_s_setprio(0); } while (0)
#define PG8_WAIT_V(n) asm volatile("s_waitcnt vmcnt(" #n ")" ::: "memory")
#define PG8_WAIT_L(n) asm volatile("s_waitcnt lgkmcnt(" #n ")" ::: "memory")
#define PG8_BAR __builtin_amdgcn_s_barrier()
#define PG8_SCHED __builtin_amdgcn_sched_barrier(0)
    Unit cur, nxt; int ui = 0;
    if (!get_unit(P.ws, mode, 0, G, c, cur)) return;
    f32x4 acc[2][2][4][2];
#pragma unroll
    for (int a = 0; a < 2; ++a)
#pragma unroll
        for (int b = 0; b < 2; ++b)
#pragma unroll
            for (int m = 0; m < 4; ++m)
#pragma unroll
                for (int n = 0; n < 2; ++n) acc[a][b][m][n] = (f32x4){0.f, 0.f, 0.f, 0.f};
    bf16x8 At[4][2], B0[2][2], B1[2][2];
    const char* cA = cur.a; const char* cB = cur.b;
    bool cqk = (mode == G_IN) && cur.pn < 8;
    unsigned voffB[2] = {PG8_BOFF(0, cqk), PG8_BOFF(1, cqk)};
    PG8_STAGE(PG8_SB(0, 0), cB, voffB); PG8_STAGE(PG8_SB(0, 1), cB + hstepB, voffB); PG8_STAGE(PG8_SA(0, 0), cA, voffA); PG8_STAGE(PG8_SA(0, 1), cA + hstepA, voffA);
    if (wr == 1) PG8_BAR;
    PG8_WAIT_V(2); PG8_BAR;
    PG8_STAGE(PG8_SB(1, 0), cB + kstep, voffB); PG8_STAGE(PG8_SA(1, 0), cA + kstep, voffA); PG8_STAGE(PG8_SB(1, 1), cB + hstepB + kstep, voffB);
    PG8_WAIT_V(6); PG8_BAR;
    for (;;) {
        const bool has_next = get_unit(P.ws, mode, ui + 1, G, c, nxt);
        const char* nA = has_next ? nxt.a : cA; const char* nB = has_next ? nxt.b : cB;
        const bool nqk = has_next ? ((mode == G_IN) && nxt.pn < 8) : cqk;
        for (int t = 0; t < nt; t += 2) {
            const bool last = (t == nt - 2);
            unsigned vb2[2] = {voffB[0], voffB[1]};
            if (last && nqk != cqk) { vb2[0] = PG8_BOFF(0, nqk); vb2[1] = PG8_BOFF(1, nqk); }
            const char* a1 = cA + (size_t)(t + 1) * kstep;
            const char* a2 = last ? nA : cA + (size_t)(t + 2) * kstep; const char* b2 = last ? nB : cB + (size_t)(t + 2) * kstep;
            const char* a3 = a2 + kstep; const char* b3 = b2 + kstep;
            PG8_LDB(B0, 0, 0); PG8_LDB(B1, 0, 1); PG8_SCHED; PG8_LDA(At, 0, 0); PG8_STAGE(PG8_SA(1, 1), a1 + hstepA, voffA);
            PG8_WAIT_V(8); PG8_WAIT_L(0); PG8_BAR; PG8_MMA(0, 0, At, B0); PG8_MMA(0, 1, At, B1); PG8_BAR; PG8_SCHED;
            PG8_LDA(At, 0, 1); PG8_STAGE(PG8_SB(0, 0), b2, vb2); PG8_STAGE(PG8_SB(0, 1), b2 + hstepB, vb2); PG8_STAGE(PG8_SA(0, 0), a2, voffA);
            PG8_WAIT_V(8); PG8_WAIT_L(0); PG8_BAR; PG8_MMA(1, 0, At, B0); PG8_MMA(1, 1, At, B1); PG8_BAR; PG8_SCHED;
            PG8_LDB(B0, 1, 0); PG8_LDB(B1, 1, 1); PG8_SCHED; PG8_LDA(At, 1, 0); PG8_STAGE(PG8_SA(0, 1), a2 + hstepA, voffA);
            PG8_WAIT_V(8); PG8_WAIT_L(0); PG8_BAR; PG8_MMA(0, 0, At, B0); PG8_MMA(0, 1, At, B1); PG8_BAR; PG8_SCHED;
            PG8_LDA(At, 1, 1); PG8_STAGE(PG8_SB(1, 0), b3, vb2); PG8_STAGE(PG8_SB(1, 1), b3 + hstepB, vb2); PG8_STAGE(PG8_SA(1, 0), a3, voffA);
            PG8_WAIT_V(8); PG8_WAIT_L(0); PG8_BAR; PG8_MMA(1, 0, At, B0); PG8_MMA(1, 1, At, B1); PG8_BAR; PG8_SCHED;
        }
        if (wr == 0) PG8_BAR;
        if (cqk) gemm_epilogue_qk(P, acc, cur, wr, wc, fr, fq, lds);
        else if (!fusedEpi) gemm_epilogue(P, mode, acc, cur, wr, wc, fr, fq);
        if (!has_next) break;
#pragma unroll
        for (int a = 0; a < 2; ++a)
#pragma unroll
            for (int b = 0; b < 2; ++b)
#pragma unroll
                for (int m = 0; m < 4; ++m)
#pragma unroll
                    for (int n = 0; n < 2; ++n) acc[a][b][m][n] = (f32x4){0.f, 0.f, 0.f, 0.f};
        cur = nxt; cA = nA; cB = nB; ++ui; if (nqk != cqk) { cqk = nqk; voffB[0] = PG8_BOFF(0, cqk); voffB[1] = PG8_BOFF(1, cqk); }
        if (wr == 1) PG8_BAR;
    }
    PG8_WAIT_V(0);
    PG8_BAR;
    if (fusedEpi) gemm_epilogue_fused(P, mode, acc, cur, wr, wc, fr, fq, lds, tid);
#undef PG8_BOFF
#undef PG8_SA
#undef PG8_SB
#undef PG8_STAGE
#undef PG8_LDA
#undef PG8_LDB
#undef PG8_MMA
#undef PG8_WAIT_V
#undef PG8_WAIT_L
#undef PG8_BAR
#undef PG8_SCHED
}

namespace att {
constexpr int D = 128, NW = 8, QBLK = 32, KVBLK = 64;
constexpr float SCALE = 0.088388347648318440f;
constexpr float THR = 8.f;
constexpr int LDQ = AW, LDK = HD, LDO = DM;
constexpr size_t SHM_V = KVBLK * D * 2, SHM_K = KVBLK * D * 2, SHM_ATTN = 2 * SHM_V + 2 * SHM_K + NW * 64 * 4;
#define KSWZ(row, colB) ((row) * 256 + ((colB) ^ (((row) & 7) << 4)))
#define SBAR() __builtin_amdgcn_sched_barrier(0)
__device__ __forceinline__ int crow(int r, int hi) { return (r & 3) + 8 * (r >> 2) + 4 * hi; }
__device__ __forceinline__ unsigned cvtpk(float lo, float hi) { unsigned r; asm volatile("v_cvt_pk_bf16_f32 %0, %1, %2" : "=v"(r) : "v"(lo), "v"(hi)); return r; }
__device__ __forceinline__ bf16x8 ld8(const bf16_t* p) { return *reinterpret_cast<const bf16x8*>(p); }

__device__ __forceinline__ void partialSM(f32x16& p0, f32x16& p1, float& m_reg, float& mn, float& alpha) {
  constexpr float C = SCALE * 1.4426950408889634f;
  float pmax = p0[0];
#pragma unroll
  for (int r = 1; r < 16; ++r) pmax = fmaxf(pmax, p0[r]);
#pragma unroll
  for (int r = 0; r < 16; ++r) pmax = fmaxf(pmax, p1[r]);
  { auto rr = __builtin_amdgcn_permlane32_swap(__float_as_uint(pmax), __float_as_uint(pmax), false, false);
    pmax = fmaxf(__uint_as_float(rr[0]), __uint_as_float(rr[1])); }
  if (__builtin_expect(__all(pmax - m_reg <= THR / SCALE), 1)) { mn = m_reg; alpha = 1.f; }
  else { mn = fmaxf(m_reg, pmax); alpha = __builtin_amdgcn_exp2f((m_reg - mn) * C); m_reg = mn; }
  float mnC = -mn * C;
#pragma unroll
  for (int r = 0; r < 16; ++r) p0[r] = fmaf(p0[r], C, mnC);
#pragma unroll
  for (int r = 0; r < 16; ++r) p1[r] = fmaf(p1[r], C, mnC);
#pragma unroll
  for (int r = 0; r < 16; ++r) p0[r] = __builtin_amdgcn_exp2f(p0[r]);
}
__device__ __forceinline__ void finishSM(f32x16& p0, f32x16& p1, float alpha, float& l_reg, bf16x8& pa0, bf16x8& pa1, bf16x8& pa2, bf16x8& pa3) {
#pragma unroll
  for (int r = 0; r < 16; ++r) p1[r] = __builtin_amdgcn_exp2f(p1[r]);
  float ps = 0;
#pragma unroll
  for (int r = 0; r < 16; ++r) ps += p0[r];
#pragma unroll
  for (int r = 0; r < 16; ++r) ps += p1[r];
  { auto rr = __builtin_amdgcn_permlane32_swap(__float_as_uint(ps), __float_as_uint(ps), false, false);
    ps = __uint_as_float(rr[0]) + __uint_as_float(rr[1]); }
  l_reg = l_reg * alpha + ps;
#define PK4(P, BASE, OUT) do { unsigned a0 = cvtpk(P[BASE + 0], P[BASE + 1]), a1 = cvtpk(P[BASE + 2], P[BASE + 3]);   \
    unsigned b0 = cvtpk(P[BASE + 4], P[BASE + 5]), b1 = cvtpk(P[BASE + 6], P[BASE + 7]);                              \
    auto r0 = __builtin_amdgcn_permlane32_swap(a0, b0, false, false); auto r1 = __builtin_amdgcn_permlane32_swap(a1, b1, false, false); \
    u32x4 w = {r0[0], r1[0], r0[1], r1[1]}; OUT = *reinterpret_cast<bf16x8*>(&w); } while (0)
  PK4(p0, 0, pa0); PK4(p0, 8, pa1); PK4(p1, 0, pa2); PK4(p1, 8, pa3);
#undef PK4
}
__device__ __forceinline__ void qkt(f32x16& p0, f32x16& p1, const bf16_t* Ks, const bf16x8* qr, int r32, int hi) {
  p0 = f32x16{}; p1 = f32x16{};
#pragma unroll
  for (int d0 = 0; d0 < 8; ++d0) { int cb = (d0 * 16 + hi * 8) * 2;
    bf16x8 b0 = *reinterpret_cast<const bf16x8*>((const char*)Ks + KSWZ(r32, cb));
    bf16x8 b1 = *reinterpret_cast<const bf16x8*>((const char*)Ks + KSWZ(32 + r32, cb));
    p0 = __builtin_amdgcn_mfma_f32_32x32x16_bf16(b0, qr[d0], p0, 0, 0, 0);
    p1 = __builtin_amdgcn_mfma_f32_32x32x16_bf16(b1, qr[d0], p1, 0, 0, 0); }
}
__device__ __forceinline__ int v_st(int k, int c) { const int kk = (k & ~0xC) | ((k & 4) << 1) | ((k & 8) >> 1); return ((kk >> 3) * 4 + (c >> 5)) * 512 + ((kk & 7) * 32 + (c & 31)) * 2; }
__device__ __forceinline__ int v_rd_base(int lane) { return ((lane & 3) << 3) | (((lane >> 2) & 3) << 6) | (((lane >> 4) & 1) << 5) | (((lane >> 5) & 1) << 8); }
constexpr int v_rd_off(int d0, int ks, int half) { return d0 * 512 + ks * 4096 + half * 2048; }
template <int OFF> __device__ __forceinline__ s16x4 tr_read(int vb) {
  s16x4 r; asm volatile("ds_read_b64_tr_b16 %0, %1 offset:%2" : "=&v"(r) : "v"(vb), "i"(OFF) : "memory"); return r;
}
template <int D0> __device__ __forceinline__ void pv_one(f32x16& od, int vb, bf16x8 pa0, bf16x8 pa1, bf16x8 pa2, bf16x8 pa3) {
  const s16x4 l0 = tr_read<v_rd_off(D0, 0, 0)>(vb), h0 = tr_read<v_rd_off(D0, 0, 1)>(vb), l1 = tr_read<v_rd_off(D0, 1, 0)>(vb), h1 = tr_read<v_rd_off(D0, 1, 1)>(vb);
  const s16x4 l2 = tr_read<v_rd_off(D0, 2, 0)>(vb), h2 = tr_read<v_rd_off(D0, 2, 1)>(vb), l3 = tr_read<v_rd_off(D0, 3, 0)>(vb), h3 = tr_read<v_rd_off(D0, 3, 1)>(vb);
  asm volatile("s_waitcnt lgkmcnt(0)" ::: "memory"); SBAR();
#define PK(L, H) (bf16x8){L[0], L[1], L[2], L[3], H[0], H[1], H[2], H[3]}
  od = __builtin_amdgcn_mfma_f32_32x32x16_bf16(pa0, PK(l0, h0), od, 0, 0, 0);
  od = __builtin_amdgcn_mfma_f32_32x32x16_bf16(pa1, PK(l1, h1), od, 0, 0, 0);
  od = __builtin_amdgcn_mfma_f32_32x32x16_bf16(pa2, PK(l2, h2), od, 0, 0, 0);
  od = __builtin_amdgcn_mfma_f32_32x32x16_bf16(pa3, PK(l3, h3), od, 0, 0, 0);
#undef PK
}
__device__ __forceinline__ void pv_d0(f32x16* o, int vb, bf16x8 pa0, bf16x8 pa1, bf16x8 pa2, bf16x8 pa3) {
  pv_one<0>(o[0], vb, pa0, pa1, pa2, pa3); pv_one<1>(o[1], vb, pa0, pa1, pa2, pa3); pv_one<2>(o[2], vb, pa0, pa1, pa2, pa3); pv_one<3>(o[3], vb, pa0, pa1, pa2, pa3);
}

__device__ __forceinline__ void attn_dense_body(const bf16_t* __restrict__ Qb, const bf16_t* __restrict__ Kh, const bf16_t* __restrict__ Vh,
                                                bf16_t* __restrict__ Ob, int seq, char* lds) {
  int tid_ = threadIdx.x; asm volatile("" : "+v"(tid_));
  const int tid = tid_, wid = tid >> 6, lane = tid & 63, r32 = lane & 31, hi = lane >> 5;
  bf16_t* V_lds = (bf16_t*)lds; bf16_t* K_lds = (bf16_t*)(lds + 2 * SHM_V);
  float* ws = (float*)(lds + 2 * SHM_V + 2 * SHM_K) + wid * 64; float* li_l = ws; float* al_l = ws + 32;
  float m_reg = -1e30f, l_reg = 0; f32x16 o[4] = {}; bf16x8 qr[8];
  const bf16_t* Qw = Qb + (long)(wid * QBLK + r32) * LDQ + hi * 8;
#pragma unroll
  for (int d0 = 0; d0 < 8; ++d0) qr[d0] = ld8(Qw + d0 * 16);
  const int sr = tid >> 4, sc = (tid & 15) * 8, vst0 = v_st(sr, sc), vst1 = v_st(32 + sr, sc);
  const int vb0 = (int)(uintptr_t)V_lds + v_rd_base(lane);
  struct { bf16x8 vs0, vs1, ks0, ks1; } sr_[2];
#define SLOAD(i, k0) do { sr_[i].vs0 = ld8(&Vh[(long)((k0) + sr) * LDK + sc]); sr_[i].vs1 = ld8(&Vh[(long)((k0) + 32 + sr) * LDK + sc]); \
    sr_[i].ks0 = ld8(&Kh[(long)((k0) + sr) * LDK + sc]); sr_[i].ks1 = ld8(&Kh[(long)((k0) + 32 + sr) * LDK + sc]); } while (0)
#define SWRITE(b, i) do { *(bf16x8*)((char*)V_lds + (b) * SHM_V + vst0) = sr_[i].vs0;          \
    *(bf16x8*)((char*)V_lds + (b) * SHM_V + vst1) = sr_[i].vs1; int kc = sc * 2;               \
    *(bf16x8*)((char*)K_lds + (b) * SHM_K + KSWZ(sr, kc)) = sr_[i].ks0;                       \
    *(bf16x8*)((char*)K_lds + (b) * SHM_K + KSWZ(32 + sr, kc)) = sr_[i].ks1; } while (0)
#define SWAIT() asm volatile("s_waitcnt vmcnt(4)" ::: "memory")
#define RESC(a) do { if (__any((a) < 1.f)) { if (hi == 0) al_l[r32] = (a); asm volatile("s_waitcnt lgkmcnt(0)" ::: "memory"); \
    _Pragma("unroll") for (int d = 0; d < 4; ++d) _Pragma("unroll") for (int r = 0; r < 16; ++r) o[d][r] *= al_l[crow(r, hi)]; } } while (0)
  f32x16 pA0, pA1, pB0, pB1; float mnA, mnB, alA, alB; bf16x8 pa0, pa1, pa2, pa3; const int NT = seq / KVBLK;
  constexpr int SE = 0, SO = 1;
  SLOAD(SE, 0); asm volatile("s_waitcnt vmcnt(0)" ::: "memory"); SWRITE(0, SE); __syncthreads();
  qkt(pA0, pA1, K_lds, qr, r32, hi); partialSM(pA0, pA1, m_reg, mnA, alA);
  SLOAD(SO, KVBLK); if (2 < NT) SLOAD(SE, 2 * KVBLK);
  SWAIT(); SWRITE(1, SO); __syncthreads();
  for (int j = 1; j + 1 < NT; j += 2) {
    SBAR(); qkt(pB0, pB1, (bf16_t*)((char*)K_lds + SHM_K), qr, r32, hi);
    finishSM(pA0, pA1, alA, l_reg, pa0, pa1, pa2, pa3); SBAR();
    SLOAD(SO, (j + 2) * KVBLK); SBAR();
    pv_d0(o, vb0, pa0, pa1, pa2, pa3); partialSM(pB0, pB1, m_reg, mnB, alB);
    __syncthreads(); SWAIT(); SWRITE(0, SE);
    RESC(alB); __syncthreads();
    SBAR(); qkt(pA0, pA1, K_lds, qr, r32, hi);
    finishSM(pB0, pB1, alB, l_reg, pa0, pa1, pa2, pa3); SBAR();
    if (j + 3 < NT) SLOAD(SE, (j + 3) * KVBLK); SBAR();
    pv_d0(o, vb0 + (int)SHM_V, pa0, pa1, pa2, pa3); partialSM(pA0, pA1, m_reg, mnA, alA);
    __syncthreads(); SWAIT(); SWRITE(1, SO);
    RESC(alA); __syncthreads();
  }
  SBAR(); qkt(pB0, pB1, (bf16_t*)((char*)K_lds + SHM_K), qr, r32, hi);
  finishSM(pA0, pA1, alA, l_reg, pa0, pa1, pa2, pa3); SBAR();
  pv_d0(o, vb0, pa0, pa1, pa2, pa3); partialSM(pB0, pB1, m_reg, mnB, alB);
  __syncthreads(); RESC(alB);
  finishSM(pB0, pB1, alB, l_reg, pa0, pa1, pa2, pa3); SBAR();
  pv_d0(o, vb0 + (int)SHM_V, pa0, pa1, pa2, pa3);
  if (hi == 0) li_l[r32] = l_reg; asm volatile("s_waitcnt lgkmcnt(0)" ::: "memory");
  float rli[16];
#pragma unroll
  for (int r = 0; r < 16; ++r) rli[r] = __builtin_amdgcn_rcpf(li_l[crow(r, hi)]);
  bf16_t* Ow = Ob + (long)(wid * QBLK) * LDO;
#pragma unroll
  for (int r = 0; r < 16; ++r) { int orow = crow(r, hi);
#pragma unroll
    for (int d0 = 0; d0 < 4; ++d0) Ow[(long)orow * LDO + d0 * 32 + r32] = f2bf(o[d0][r] * rli[r]); }
  __syncthreads();
#undef SLOAD
#undef SWRITE
#undef SWAIT
#undef RESC
}
#undef KSWZ
#undef SBAR
}

constexpr int TR_LDS_WAVE = 64 * 65 * 4;
__device__ __forceinline__ void transpose_share(const float* __restrict__ W, int K, int N, bf16_t* __restrict__ WT, int w, int nw, LAS unsigned char* lds, int first = 0, int last = 1 << 30) {
    int tid_ = threadIdx.x; asm volatile("" : "+v"(tid_));
    const int wid = tid_ >> 6, lane = tid_ & 63;
    LAS float* scr = (LAS float*)(lds + wid * TR_LDS_WAVE);
    const int nblk = N / 64; int nitems = (K / 64) * nblk; if (last < nitems) nitems = last;
    const int kr = lane >> 4, n4 = (lane & 15) * 4, c = lane & 7;
    int it = first + w * 8 + wid;
    if (it >= nitems) return;
    f32x4 v[16];
    { const int kb = it / nblk, nb = it - kb * nblk;
#pragma unroll
      for (int i = 0; i < 16; ++i) v[i] = *(const f32x4*)(W + (size_t)(64 * kb + 4 * i + kr) * N + 64 * nb + n4); }
    for (;;) {
        const int kb = it / nblk, nb = it - kb * nblk, k0 = 64 * kb, n0 = 64 * nb;
#pragma unroll
        for (int i = 0; i < 16; ++i) { LAS float* d = scr + (4 * i + kr) * 65 + n4; d[0] = v[i].x; d[1] = v[i].y; d[2] = v[i].z; d[3] = v[i].w; }
        const int nx = it + nw; const bool more = nx < nitems;
        if (more) { const int kb2 = nx / nblk, nb2 = nx - kb2 * nblk;
#pragma unroll
            for (int i = 0; i < 16; ++i) v[i] = *(const f32x4*)(W + (size_t)(64 * kb2 + 4 * i + kr) * N + 64 * nb2 + n4); }
        LDS_WAIT();
#pragma unroll
        for (int j = 0; j < 8; ++j) { const int n = (lane >> 3) + 8 * j; const LAS float* sp = scr + (8 * c) * 65 + n;
            u32x4 o; o.x = cvt_pk_bf16(sp[0 * 65], sp[1 * 65]); o.y = cvt_pk_bf16(sp[2 * 65], sp[3 * 65]); o.z = cvt_pk_bf16(sp[4 * 65], sp[5 * 65]); o.w = cvt_pk_bf16(sp[6 * 65], sp[7 * 65]);
            *(u32x4*)(WT + (size_t)(n0 + n) * K + k0 + 8 * c) = o; }
        LDS_WAIT();
        if (!more) break;
        it = nx;
    }
}

__device__ __forceinline__ void ada_phase(const Params& P, LAS unsigned char* lds, int G) {
    int tid_ = threadIdx.x; asm volatile("" : "+v"(tid_));
    const int tid = tid_, wid = tid >> 6, lane = tid & 63;
    unsigned char* ws = P.ws;
    LAS float* sl = (LAS float*)lds;
    for (int i = tid; i < 5 * DM; i += 512) { const float v = (i < 4 * DM) ? P.in[I_C][i] : P.in[I_CCTX][i - 4 * DM]; sl[i] = v / (1.f + expf(-v)); }
    __syncthreads();
    LAS float* red = (LAS float*)(lds + 40960);
    float* mod = (float*)(ws + WS_MOD);
    const float* w_ada = P.in[I_WADA];
    int it = blockIdx.x;
    f32x4 wv[16];
    if (it < 768) { const float* wp = w_ada + (size_t)((it / 48) * 128 + wid * 16) * NMOD6 + (it % 48) * 256 + lane * 4;
#pragma unroll
        for (int i = 0; i < 16; ++i) wv[i] = *(const f32x4*)(wp + (size_t)i * NMOD6); }
    while (it < 768) {
        const int cc = it % 48, kc = it / 48;
        const int kb = kc * 128 + wid * 16;
        f32x4 acc[5];
#pragma unroll
        for (int r = 0; r < 5; ++r) acc[r] = (f32x4){0.f, 0.f, 0.f, 0.f};
#pragma unroll
        for (int i = 0; i < 16; ++i) {
#pragma unroll
            for (int r = 0; r < 5; ++r) { const float s = sl[r * DM + kb + i]; acc[r] += wv[i] * s; }
        }
        const int nx = it + G;
        if (nx < 768) { const float* wp = w_ada + (size_t)((nx / 48) * 128 + wid * 16) * NMOD6 + (nx % 48) * 256 + lane * 4;
#pragma unroll
            for (int i = 0; i < 16; ++i) wv[i] = *(const f32x4*)(wp + (size_t)i * NMOD6); }
#pragma unroll
        for (int r = 0; r < 5; ++r) *(LAS f32x4*)(red + (wid * 5 + r) * 256 + lane * 4) = acc[r];
        asm volatile("s_waitcnt lgkmcnt(0)" ::: "memory"); __builtin_amdgcn_s_barrier(); asm volatile("" ::: "memory");
        if (tid < 320) {
            const int r = tid >> 6, q = tid & 63;
            f32x4 s = (f32x4){0.f, 0.f, 0.f, 0.f};
#pragma unroll
            for (int w = 0; w < 8; ++w) s += *(const LAS f32x4*)(red + (w * 5 + r) * 256 + q * 4);
            if (kc == 0) s += *(const f32x4*)(P.in[I_BADA] + cc * 256 + q * 4);
            float* dst = mod + (size_t)r * NMOD6 + cc * 256 + q * 4;
            unsafeAtomicAdd(dst + 0, s[0]); unsafeAtomicAdd(dst + 1, s[1]); unsafeAtomicAdd(dst + 2, s[2]); unsafeAtomicAdd(dst + 3, s[3]);
        }
        asm volatile("s_waitcnt lgkmcnt(0)" ::: "memory"); __builtin_amdgcn_s_barrier(); asm volatile("" ::: "memory");
        it = nx;
    }
    asm volatile("s_waitcnt vmcnt(0)" ::: "memory");
    __syncthreads();
    if (tid == 0) { __builtin_amdgcn_fence(__ATOMIC_RELEASE, "agent"); asm volatile("s_waitcnt vmcnt(0)" ::: "memory");
                    __hip_atomic_fetch_add((unsigned*)(ws + WS_QCTR), 1u, __ATOMIC_RELAXED, __HIP_MEMORY_SCOPE_AGENT); }
}

__device__ __forceinline__ void gen_tables(const Params& P, LAS unsigned char* lds, int blk, int nblk) {
    int tid_ = threadIdx.x; asm volatile("" : "+v"(tid_));
    const int tid = tid_;
    unsigned char* ws = P.ws;
    LAS float* ct = (LAS float*)lds;
    for (int j = tid; j < 2048; j += 512) ct[j] = cospif((float)j * (1.0f / 1024.0f));
    __syncthreads();
    bf16_t* dft = (bf16_t*)(ws + WS_DFT);
    for (int idx = blk * 512 + tid; idx < 2048 * 512; idx += nblk * 512) {
        const int k = idx >> 9, n0 = (idx & 511) * 8, part = n0 >> 11, nn = n0 & 2047;
        float v[8];
#pragma unroll
        for (int e = 0; e < 8; ++e) { const int j = (k * (nn + e)) & 2047; v[e] = ct[part ? ((j - 512) & 2047) : j]; }
        u32x4 o; o.x = cvt_pk_bf16(v[0], v[1]); o.y = cvt_pk_bf16(v[2], v[3]); o.z = cvt_pk_bf16(v[4], v[5]); o.w = cvt_pk_bf16(v[6], v[7]);
        *(u32x4*)(dft + (size_t)k * 4096 + n0) = o;
    }
    for (int idx = blk * 512 + tid; idx < 64 * 32; idx += nblk * 512) {
        const int pv = idx >> 5, i = idx & 31;
        const float ang = (float)pv * powf(10000.0f, -(float)(2 * i) / 64.0f);
        float* t = (float*)(ws + WS_ROPE) + (size_t)(pv * 32 + i) * 2;
        t[0] = cosf(ang); t[1] = sinf(ang);
    }
    bf16_t* gt = (bf16_t*)(ws + WS_GT);
    LAS float* wfs = (LAS float*)(lds + 8192);
    const int NS = nblk >= 4 ? nblk / 4 : 1;
    for (int t = blk; t < 4 * NS; t += nblk) {
        const int g = t / NS, sidx = t - g * NS;
        const float* wf = P.in[I_WF] + (size_t)g * 128 * 128;
#pragma unroll
        for (int j = 0; j < 8; ++j) *(LAS f32x4*)(wfs + (tid + 512 * j) * 4) = *(const f32x4*)(wf + (tid + 512 * j) * 4);
        __syncthreads();
        for (int idx = sidx * 512 + tid; idx < 2 * 128 * 128; idx += NS * 512) {
            const int d = idx & 127, cch = (idx >> 7) & 127, part = idx >> 14;
            float sum = 0.f;
#pragma unroll 16
            for (int l = 0; l < 128; ++l) {
                const int j = (cch * l) & 127;
                const float cs = part ? -ct[((j - 32) & 127) * 16] : ct[j * 16];
                sum += cs * wfs[l * 128 + d];
            }
            gt[(size_t)((g * 2 + part) * 128 + d) * 128 + cch] = f2bf(sum * (1.0f / 512.0f));
        }
        __syncthreads();
    }
}

template <int MODE> __device__ __forceinline__ const float* rows_src(const Params& P, int r) {
    if (MODE == 0) return (r < MTOK) ? P.in[I_X] + (size_t)r * DM : P.in[I_CTX] + (size_t)(r - MTOK) * DM;
    return P.out + (size_t)r * DM;
}
template <int MODE> __device__ __forceinline__ void rows_pass(const Params& P, int G) {
    int tid_ = threadIdx.x; asm volatile("" : "+v"(tid_));
    const int tid = tid_, wid = tid >> 6, lane = tid & 63;
    const int gw = blockIdx.x * 8 + wid, NGW = G * 8;
    const int nrows = (MODE == 0) ? (MTOK + MCTX) : MTOK;
    if (MODE == 0) {
        if (tid == 0) { unsigned sp = 0; while (__hip_atomic_load((unsigned*)(P.ws + WS_QCTR), __ATOMIC_RELAXED, __HIP_MEMORY_SCOPE_AGENT) < (unsigned)G) { __builtin_amdgcn_s_sleep(2); if (++sp > (1u << 22)) break; } }
        __syncthreads();
        __builtin_amdgcn_fence(__ATOMIC_ACQUIRE, "agent");
    }
    const float* mod = (const float*)(P.ws + WS_MOD);
    const float* gain = P.in[MODE == 0 ? I_G1 : (MODE == 1 ? I_G2 : I_GF)];
    int r = gw;
    if (r >= nrows) return;
    f32x4 v[8], nv[8];
    { const float* src = rows_src<MODE>(P, r);
#pragma unroll
      for (int j = 0; j < 8; ++j) v[j] = *(const f32x4*)(src + (lane + 64 * j) * 4); }
    for (;;) {
        const int rn = r + NGW; const bool more = rn < nrows;
        if (more) { const float* src = rows_src<MODE>(P, rn);
#pragma unroll
            for (int j = 0; j < 8; ++j) nv[j] = *(const f32x4*)(src + (lane + 64 * j) * 4); }
        const int mr = (MODE == 0 && r >= MTOK) ? 4 : (r >> 11);
        float ss = 0.f;
#pragma unroll
        for (int j = 0; j < 8; ++j) ss += (v[j].x * v[j].x + v[j].y * v[j].y) + (v[j].z * v[j].z + v[j].w * v[j].w);
        const float rstd = rsqrtf(wave_sum(ss) * (1.0f / DM) + EPS);
#pragma unroll
        for (int j = 0; j < 8; ++j) {
            const int col = (lane + 64 * j) * 4;
            const f32x4 g = *(const f32x4*)(gain + col);
            f32x4 y = v[j] * rstd * g;
            if (MODE == 2) { *(f32x4*)(P.out + (size_t)r * DM + col) = y; }
            else {
                const float* mrow = mod + (size_t)mr * NMOD6 + (MODE == 0 ? 0 : 3 * DM);
                const f32x4 sh = *(const f32x4*)(mrow + col), sc = *(const f32x4*)(mrow + DM + col);
                y = y * (1.0f + sc) + sh;
                u32x2 o; o.x = cvt_pk_bf16(y.x, y.y); o.y = cvt_pk_bf16(y.z, y.w);
                bf16_t* dst = (bf16_t*)(P.ws + (MODE == 0 ? WS_H : WS_H2)) + (size_t)r * DM + col;
                *(u32x2*)dst = o;
            }
        }
        if (!more) break;
#pragma unroll
        for (int j = 0; j < 8; ++j) v[j] = nv[j];
        r = rn;
    }
}

__device__ __forceinline__ void attention_phase(const Params& P, unsigned char* lds, int G) {
    const int c = blockIdx.x;
    for (int j = 0;; ++j) {
        int b, h, qb;
        if (G == 256) {
            if (c < 64 || j > 1) break;
            const int grp = (c & 7) + 8 * j, w = (c - 64) >> 3;
            b = grp >> 2; h = (grp & 3) * 3 + (w >> 3); qb = w & 7;
        } else {
            const int au = c + G * j;
            if (au >= NB * NQH * 8) break;
            qb = au & 7; const int bh = au >> 3; h = bh % NQH; b = bh / NQH;
        }
        const bf16_t* Qb = (const bf16_t*)(P.ws + WS_Q) + (size_t)(b * SEQ + qb * 256) * AW + h * HD;
        const bf16_t* Kh = (const bf16_t*)(P.ws + WS_K) + (size_t)(b * NKVH + h / 3) * SKV * HD;
        const bf16_t* Vh = (const bf16_t*)(P.ws + WS_V) + (size_t)(b * NKVH + h / 3) * SKV * HD;
        bf16_t* Ob = (bf16_t*)(P.ws + WS_MIX) + (size_t)(b * SEQ + qb * 256) * DM + h * HD;
        att::attn_dense_body(Qb, Kh, Vh, Ob, SKV, (char*)lds);
    }
}


#define XB_TMO      128
#define XB_XCNT(j)  (256  + 64 * (j))
#define XB_XSUB(j)  (1280 + 64 * (j))
#define XB_XGEN(j)  (2304 + 64 * (j))
#define XB_TOP      3328
#define XB_TOPGEN   3392
#define XCD_BAR_WORDS 3456
#define XB_SPIN_CAP (1u << 22)
__device__ __forceinline__ unsigned xb_ld(unsigned* p)              { return __hip_atomic_load(p, __ATOMIC_RELAXED, __HIP_MEMORY_SCOPE_AGENT); }
__device__ __forceinline__ unsigned xb_add(unsigned* p, unsigned v) { return __hip_atomic_fetch_add(p, v, __ATOMIC_RELAXED, __HIP_MEMORY_SCOPE_AGENT); }
__device__ __forceinline__ unsigned xb_xcc_id() { return (unsigned)__builtin_amdgcn_s_getreg((3 << 11) | 20) & 0xFu; }
#define XB_SPIN(cond, bar) do { unsigned _sp = 0; while (cond) { __builtin_amdgcn_s_sleep(1); \
    if ((++_sp & 255u) == 0u) { if (xb_ld(&(bar)[XB_TMO])) break; if (_sp > XB_SPIN_CAP) { atomicAdd(&(bar)[XB_TMO], 1u); break; } } } } while (0)
struct XcdBarrier { unsigned* bar; unsigned x; volatile LAS unsigned* st; };
__device__ __forceinline__ XcdBarrier xcd_barrier_post(unsigned* bar, volatile LAS unsigned* st) {
    XcdBarrier b; b.bar = bar; b.x = xb_xcc_id(); b.st = st;
    if (threadIdx.x == 0) (void)xb_add(&bar[XB_XCNT(b.x)], 1u);
    return b;
}
__device__ __forceinline__ void xcd_barrier_complete(unsigned* bar, unsigned x, unsigned& nloc, unsigned& nx) {
    const unsigned G = gridDim.x * gridDim.y * gridDim.z;
    unsigned sum, cnt, mine, sp = 0u;
    for (;;) {
        sum = 0u; cnt = 0u; mine = 0u;
#pragma nounroll
        for (unsigned j = 0; j < 16; ++j) { const unsigned c = xb_ld(&bar[XB_XCNT(j)]); sum += c; cnt += (c > 0u) ? 1u : 0u; mine = (j == x) ? c : mine; }
        if (sum == G) break;
        __builtin_amdgcn_s_sleep(1);
        if ((++sp & 255u) == 0u) { if (xb_ld(&bar[XB_TMO])) break; if (sp > XB_SPIN_CAP) { atomicAdd(&bar[XB_TMO], 1u); break; } }
    }
    nloc = mine > 0u ? mine : 1u; nx = cnt > 0u ? cnt : 1u;
}
__device__ __forceinline__ void xcd_barrier(const XcdBarrier& b) {
    asm volatile("s_waitcnt vmcnt(0)" ::: "memory");
    __syncthreads();
    if (threadIdx.x == 0) {
        unsigned* bar = b.bar;
        __builtin_amdgcn_s_waitcnt(0);
        unsigned nloc = b.st[0], nx = b.st[1];
        if (nloc == 0u) { xcd_barrier_complete(bar, b.x, nloc, nx); b.st[0] = nloc; b.st[1] = nx; }
        const unsigned old = xb_add(&bar[XB_XSUB(b.x)], 1u);
        const unsigned gen = old / nloc;
        if (old + 1u == (gen + 1u) * nloc) {
            __builtin_amdgcn_fence(__ATOMIC_RELEASE, "agent");
            asm volatile("s_waitcnt vmcnt(0)" ::: "memory");
            const unsigned og = xb_add(&bar[XB_TOP], 1u);
            const unsigned tg = og / nx;
            if (og + 1u == (tg + 1u) * nx) xb_add(&bar[XB_TOPGEN], 1u);
            else XB_SPIN(xb_ld(&bar[XB_TOPGEN]) == tg, bar);
            __builtin_amdgcn_fence(__ATOMIC_ACQUIRE, "agent");
            xb_add(&bar[XB_XGEN(b.x)], 1u);
            asm volatile("s_waitcnt vmcnt(0)" ::: "memory");
        } else {
            XB_SPIN(xb_ld(&bar[XB_XGEN(b.x)]) == gen, bar);
            __builtin_amdgcn_fence(__ATOMIC_ACQUIRE, "agent");
            asm volatile("s_waitcnt vmcnt(0)" ::: "memory");
        }
    }
    __syncthreads();
}

__global__ void __launch_bounds__(512, 2) fwd_megakernel(Params P_) {
    extern __shared__ __attribute__((aligned(16))) unsigned char lds[];
    cg::grid_group grid = cg::this_grid();
    const int G_ = gridDim.x, c_ = blockIdx.x;
    LAS unsigned char* l3 = (LAS unsigned char*)lds;
    volatile LAS unsigned* misc = (volatile LAS unsigned*)(l3 + LDS_MISC);
    if (threadIdx.x < 64) misc[threadIdx.x] = 0u;
    __syncthreads();
    XcdBarrier xbar = xcd_barrier_post((unsigned*)(P_.ws + WS_BAR), misc + 8);
#if PROBE >= 100
    unsigned long long pt0 = 0, pt1 = 0;
#endif
#pragma nounroll
    for (int ph = 0; ph < 10; ++ph) {
        Params P = P_; int G = G_, c = c_;
        asm volatile("" : "+s"(G), "+s"(c), "+s"(P.ws), "+s"(P.out));
        int gm = -1;
#if PROBE >= 100
        if (ph == PROBE - 100) pt0 = __builtin_amdgcn_s_memrealtime();
        if (ph == PROBE - 99) pt1 = __builtin_amdgcn_s_memrealtime();
#endif
        switch (ph) {
        case 0: ada_phase(P, l3, G); transpose_share(P.in[I_WIN], DM, INW, (bf16_t*)(P.ws + WS_WIN), c, G * 8, l3); transpose_share(P.in[I_WOUT], DM, DM, (bf16_t*)(P.ws + WS_WOUT), c, G * 8, l3); __syncthreads(); gen_tables(P, l3, c, G); __syncthreads();
                break;
        case 1: rows_pass<0>(P, G); break;
        case 2: gm = G_IN; break;
        case 3: if (G != 256) gm = G_F1; break;
        case 4: if (G == 256 && c < 64) {
                    gemm_phase(l3, P, G_F1, 64, c);
                    asm volatile("s_waitcnt vmcnt(0)" ::: "memory"); __syncthreads();
                    if (threadIdx.x == 0) {
                        unsigned* f1c = (unsigned*)(P.ws + WS_QCTR) + 64;
                        __builtin_amdgcn_fence(__ATOMIC_RELEASE, "agent"); asm volatile("s_waitcnt vmcnt(0)" ::: "memory");
                        __hip_atomic_fetch_add(f1c, 1u, __ATOMIC_RELAXED, __HIP_MEMORY_SCOPE_AGENT);
                        unsigned sp = 0; while (__hip_atomic_load(f1c, __ATOMIC_RELAXED, __HIP_MEMORY_SCOPE_AGENT) < 64u) { __builtin_amdgcn_s_sleep(2); if (++sp > (1u << 22)) break; }
                        __builtin_amdgcn_fence(__ATOMIC_ACQUIRE, "agent"); asm volatile("s_waitcnt vmcnt(0)" ::: "memory");
                    }
                    __syncthreads();
                }
                gm = G_F2; break;
        case 5: gm = G_OUT; break;
        case 6: if (G != 256) rows_pass<1>(P, G); break;
        case 7: gm = G_UP; break;
        case 8: gm = G_DOWN; break;
        default: if (G != 256) rows_pass<2>(P, G); break;
        }
#ifndef NO_GEMM
        if (gm >= 0) gemm_phase(l3, P, gm, G, c);
#endif
#ifndef NO_ATT
        if (ph == 4) attention_phase(P, lds, G);
#endif
        if (ph == 2) { if (G != 256) transpose_share(P.in[I_W1], DM, DFF, (bf16_t*)(P.ws + WS_W1), c, G * 8, l3);
                       else if (c >= 144) transpose_share(P.in[I_W1], DM, DFF, (bf16_t*)(P.ws + WS_W1), c - 144, 112 * 8, l3); }
        if (ph == 4) { if (G != 256) transpose_share(P.in[I_W2], DFF, DM, (bf16_t*)(P.ws + WS_W2), c, G * 8, l3);
                       else if (c < 64) transpose_share(P.in[I_W2], DFF, DM, (bf16_t*)(P.ws + WS_W2), c, 64 * 8, l3); }
#if PROBE == 3
        if (ph == 7) { __syncthreads(); gemm_phase(l3, P, gm, G, c); }
#endif
#if PROBE == 4
        if (ph == 4) { __syncthreads(); gemm_phase(l3, P, gm, G, c); attention_phase(P, lds, G); }
#endif
        if (G == 0x7fffffff) grid.sync();
        if (ph > 0 && ph < 9 && !(G == 256 && (ph == 3 || ph == 6 || ph == 8))) xcd_barrier(xbar);
    }
#if PROBE >= 100
    if (PROBE - 99 == 10) pt1 = __builtin_amdgcn_s_memrealtime();
    if (blockIdx.x == 0 && threadIdx.x < 64) {
        const unsigned long long te = __builtin_amdgcn_s_memrealtime(), want = 16ull * (pt1 - pt0);
        while (__builtin_amdgcn_s_memrealtime() - te < want) __builtin_amdgcn_s_sleep(8);
    }
#endif
}

extern "C" void kernel_launch(void* const* d_in, const int* in_sizes, int n_in, void* d_out, int out_size, void* d_ws, size_t ws_size, hipStream_t stream) {
    static int grid_blocks = 0;
    if (grid_blocks == 0) {
        if (n_in != 16 || out_size != MTOK * DM || ws_size < WS_END) { fprintf(stderr, "kernel_launch: unexpected shapes (n_in %d out %d ws %zu)\n", n_in, out_size, ws_size); grid_blocks = -1; return; }
        int dev = 0, cus = 0, per_cu = 0;
        (void)hipGetDevice(&dev);
        (void)hipDeviceGetAttribute(&cus, hipDeviceAttributeMultiprocessorCount, dev);
        if (hipFuncSetAttribute((const void*)fwd_megakernel, hipFuncAttributeMaxDynamicSharedMemorySize, LDS_BYTES) != hipSuccess) { fprintf(stderr, "kernel_launch: hipFuncSetAttribute failed\n"); grid_blocks = -1; return; }
        if (hipOccupancyMaxActiveBlocksPerMultiprocessor(&per_cu, (const void*)fwd_megakernel, 512, LDS_BYTES) != hipSuccess || per_cu < 1) { fprintf(stderr, "kernel_launch: occupancy query failed (%d)\n", per_cu); per_cu = 1; }
        (void)hipGetLastError();
        grid_blocks = cus;
    }
    if (grid_blocks < 0) return;
    (void)hipMemsetAsync((char*)d_ws + WS_MOD, 0, WS_CTL_BYTES, stream);
    Params p{};
    for (int i = 0; i < 16; ++i) p.in[i] = (const float*)d_in[i];
    p.out = (float*)d_out; p.ws = (unsigned char*)d_ws;
    void* args[] = {&p};
    hipError_t e = hipLaunchCooperativeKernel((const void*)fwd_megakernel, dim3(grid_blocks), dim3(512), args, LDS_BYTES, stream);
    if (e != hipSuccess) fprintf(stderr, "cooperative launch failed: %s (grid %d)\n", hipGetErrorString(e), grid_blocks);
}
#ifdef TEST_KERNELS
__global__ void __launch_bounds__(512, 2) t_att(Params P) { extern __shared__ __attribute__((aligned(16))) unsigned char lds[]; attention_phase(P, lds, gridDim.x); }
__global__ void __launch_bounds__(512, 2) t_gemm(Params P, int mode) { extern __shared__ __attribute__((aligned(16))) unsigned char lds[]; gemm_phase((LAS unsigned char*)lds, P, mode, gridDim.x, blockIdx.x); }
__global__ void __launch_bounds__(512, 2) t_gemm_up(Params P) { extern __shared__ __attribute__((aligned(16))) unsigned char lds[]; gemm_phase((LAS unsigned char*)lds, P, G_UP, gridDim.x, blockIdx.x); }
__global__ void __launch_bounds__(512, 2) t_gemm_out(Params P) { extern __shared__ __attribute__((aligned(16))) unsigned char lds[]; gemm_phase((LAS unsigned char*)lds, P, G_OUT, gridDim.x, blockIdx.x); }
#endif
```

```cpp
#include <hip/hip_runtime.h>
#include <hip/hip_bf16.h>
#include <hip/hip_cooperative_groups.h>
#include <cstdio>
#include <cstdint>
namespace cg = cooperative_groups;

#ifndef PROBE
#define PROBE 0
#endif
#define LAS __attribute__((address_space(3)))
typedef unsigned short bf16_t;
typedef short bf16x8 __attribute__((ext_vector_type(8)));
typedef short s16x4 __attribute__((ext_vector_type(4)));
typedef float f32x4 __attribute__((ext_vector_type(4)));
typedef float f32x16 __attribute__((ext_vector_type(16)));
typedef unsigned u32x4 __attribute__((ext_vector_type(4)));
typedef unsigned u32x2 __attribute__((ext_vector_type(2)));

constexpr int DM = 2048, NB = 4, SEQ = 2048, CTXL = 256, HD = 128, NQH = 12, NKVH = 4;
constexpr int AW = 1536, KVW = 512, FW = 512, INW = 3072, DFF = 8192, NMOD6 = 6 * DM;
constexpr int MTOK = NB * SEQ, MCTX = NB * CTXL, SKV = SEQ + CTXL;
constexpr float EPS = 1e-6f;

constexpr size_t MiB = 1u << 20;
constexpr size_t WS_MOD = 0;
constexpr size_t WS_BAR = 245760;
constexpr size_t WS_QCTR = 245760 + 16384;
constexpr size_t WS_XACC = 262144 + 4096;
constexpr size_t WS_CTL_BYTES = 262144 + 4096 + 131072;
constexpr size_t WS_XSLOT = 1 * MiB + 512 * 1024;
constexpr size_t WS_ROPE = 512 * 1024;
constexpr size_t WS_GT = 1 * MiB;
constexpr size_t WS_WIN = 2 * MiB;
constexpr size_t WS_WOUT = 14 * MiB;
constexpr size_t WS_W1 = 22 * MiB;
constexpr size_t WS_W2 = 54 * MiB;
constexpr size_t WS_DFT = 86 * MiB;
constexpr size_t WS_H2 = 102 * MiB;
constexpr size_t WS_H = 134 * MiB;
constexpr size_t WS_Q = 170 * MiB;
constexpr size_t WS_K = 194 * MiB;
constexpr size_t WS_V = 203 * MiB;
constexpr size_t WS_U = 212 * MiB;
constexpr size_t WS_ZT = 220 * MiB;
constexpr size_t WS_MIX = 236 * MiB;
constexpr size_t WS_A1 = 134 * MiB;
constexpr size_t WS_END = 268 * MiB;

constexpr int LDS_MISC = 8 * 64 * 65 * 4;
constexpr int LDS_RED = LDS_MISC + 1024;
constexpr int LDS_BYTES = LDS_RED + 8192;

struct Params { const float* in[16]; float* out; unsigned char* ws; };
enum { I_X = 0, I_C, I_CTX, I_CCTX, I_WADA, I_BADA, I_G1, I_WIN, I_QG, I_KG, I_WF, I_WOUT, I_G2, I_W1, I_W2, I_GF };

__device__ __forceinline__ unsigned cvt_pk_bf16(float lo, float hi) { unsigned r; asm("v_cvt_pk_bf16_f32 %0, %1, %2" : "=v"(r) : "v"(lo), "v"(hi)); return r; }
__device__ __forceinline__ float bf2f(bf16_t v) { return __uint_as_float(((unsigned)v) << 16); }
__device__ __forceinline__ bf16_t f2bf(float f) { return (bf16_t)(cvt_pk_bf16(f, 0.f) & 0xffffu); }
template <int M> __device__ __forceinline__ float swz_xor(float v) { return __int_as_float(__builtin_amdgcn_ds_swizzle(__float_as_int(v), 0x1F | (M << 10))); }
__device__ __forceinline__ float half_sum(float v) { auto rr = __builtin_amdgcn_permlane32_swap(__float_as_uint(v), __float_as_uint(v), false, false); return __uint_as_float(rr[0]) + __uint_as_float(rr[1]); }
__device__ __forceinline__ float wave_sum(float v) {
    v += swz_xor<1>(v); v += swz_xor<2>(v); v += swz_xor<4>(v); v += swz_xor<8>(v); v += swz_xor<16>(v);
    return half_sum(v);
}
#define LDS_WAIT() asm volatile("s_waitcnt lgkmcnt(0)" ::: "memory")

constexpr int BM = 256, BK = 64, HALF = 128, HTB = HALF * BK * 2, NXCD = 8, WGM = 8;
__device__ __forceinline__ int lds_byte(int r, int c) { const int st = (r >> 4) * 2 + (c >> 5), rr = r & 15, cc = c & 31, ob = rr * 64 + cc * 2; return st * 1024 + (ob ^ (((ob >> 9) & 1) << 5)); }
__device__ __forceinline__ void stage_rc(int b, int& R, int& C) { const int st = b / 1024, sb = b % 1024, swz = sb ^ (((sb >> 9) & 1) << 5); R = (st >> 1) * 16 + swz / 64; C = (st & 1) * 32 + (swz % 64) / 2; }
__device__ __forceinline__ int perm32(int rho) { const int n = rho >> 4, i = rho & 15; return 8 * (i >> 2) + 4 * n + (i & 3); }

struct Unit { int pm, pn; const char* a; const char* b; };
enum { G_IN = 0, G_F1, G_F2, G_OUT, G_UP, G_DOWN };

__device__ __forceinline__ void remap_tile(int L, int nM, int nN, int& pm, int& pn) {
    const int nwg = nM * nN; int wgid = L;
    { const int q = nwg / NXCD, r = nwg % NXCD, xcd = wgid % NXCD, off = wgid / NXCD; wgid = (xcd < r ? xcd * (q + 1) : r * (q + 1) + (xcd - r) * q) + off; }
    const int nig = WGM * nN, gid = wgid / nig, fm = gid * WGM, gsz = (nM - fm) < WGM ? (nM - fm) : WGM;
    pm = fm + ((wgid % nig) % gsz); pn = (wgid % nig) / gsz;
}

__device__ __forceinline__ bool get_unit(const unsigned char* ws, int mode, int i, int G, int c, Unit& u) {
    const long L = (long)i * G + c;
    switch (mode) {
    case G_IN: {
        if (L >= 400) return false;
        if (L < 256) remap_tile((int)L, 32, 8, u.pm, u.pn);
        else if (L < 384) { remap_tile((int)L - 256, 32, 4, u.pm, u.pn); u.pn += 8; }
        else { const int idx = (int)L - 384; u.pm = 32 + (idx >> 2); u.pn = 6 + (idx & 3); }
        u.a = (const char*)ws + WS_H + (size_t)u.pm * 256 * DM * 2; u.b = (const char*)ws + WS_WIN + (size_t)u.pn * 256 * DM * 2; return true; }
    case G_F1: {
        if (L >= 128) return false;
        const int g = (int)L >> 5; u.pm = g; u.pn = (int)L & 31;
        u.a = (const char*)ws + WS_GT + (size_t)g * 256 * 128 * 2; u.b = (const char*)ws + WS_U + ((size_t)u.pn * 256 * FW + g * 128) * 2; return true; }
    case G_F2: {
        if (L >= 64) return false;
        const int b = (int)L >> 4, pm = ((int)L >> 1) & 7, pn = (int)L & 1; u.pm = b * 8 + pm; u.pn = pn;
        u.a = (const char*)ws + WS_DFT + (size_t)pm * 256 * 4096 * 2; u.b = (const char*)ws + WS_ZT + ((size_t)(b * 512 + pn * 256) * 4096) * 2; return true; }
    case G_OUT: {
        if (L >= 256) return false;
        remap_tile((int)L, 32, 8, u.pm, u.pn);
        u.a = (const char*)ws + WS_MIX + (size_t)u.pm * 256 * DM * 2; u.b = (const char*)ws + WS_WOUT + (size_t)u.pn * 256 * DM * 2; return true; }
    case G_UP: {
        if (L >= 1024) return false;
        remap_tile((int)L, 32, 32, u.pm, u.pn);
        u.a = (const char*)ws + WS_H2 + (size_t)u.pm * 256 * DM * 2; u.b = (const char*)ws + WS_W1 + (size_t)u.pn * 256 * DM * 2; return true; }
    default: {
        if (L >= 256) return false;
        remap_tile((int)L, 32, 8, u.pm, u.pn);
        u.a = (const char*)ws + WS_A1 + (size_t)u.pm * 256 * DFF * 2; u.b = (const char*)ws + WS_W2 + (size_t)u.pn * 256 * DFF * 2; return true; }
    }
}

__device__ __forceinline__ void gemm_epilogue(const Params& P, int mode, const f32x4 (&acc)[2][2][4][2], const Unit& u, int wr, int wc, int fr, int fq) {
    unsigned char* ws = P.ws;
    if (mode == G_OUT || mode == G_DOWN) {
        const float* resid = (mode == G_OUT) ? P.in[I_X] : P.out;
        const float* gate = (const float*)(ws + WS_MOD) + (size_t)(u.pm >> 3) * NMOD6 + (mode == G_OUT ? 2 * DM : 5 * DM);
        const int col0 = u.pn * 256 + wc * 32 + 4 * fq;
        f32x4 gv[2][2];
#pragma unroll
        for (int bj = 0; bj < 2; ++bj)
#pragma unroll
            for (int n = 0; n < 2; ++n) gv[bj][n] = *(const f32x4*)(gate + col0 + bj * HALF + n * 16);
#pragma unroll
        for (int ai = 0; ai < 2; ++ai)
#pragma unroll
            for (int m = 0; m < 4; ++m) {
                const size_t off = (size_t)(u.pm * 256 + ai * HALF + wr * 64 + m * 16 + fr) * DM + col0;
#pragma unroll
                for (int bj = 0; bj < 2; ++bj)
#pragma unroll
                    for (int n = 0; n < 2; ++n) {
                        const f32x4 r = *(const f32x4*)(resid + off + bj * HALF + n * 16);
                        *(f32x4*)(P.out + off + bj * HALF + n * 16) = r + gv[bj][n] * acc[ai][bj][m][n];
                    }
            }
        return;
    }
    bf16_t* base; size_t ld, aistride, bjstride = HALF;
    if (mode == G_IN) {
        const int pm = u.pm, pn = u.pn;
        if (pn < 6) { base = (bf16_t*)(ws + WS_Q) + (size_t)pm * 256 * AW + pn * 256; ld = AW; }
        else if (pn < 10) {
            const int b = (pm < 32) ? (pm >> 3) : (pm - 32), t0 = (pm < 32) ? CTXL + (pm & 7) * 256 : 0, h0 = ((pn - 6) & 1) * 2;
            base = (bf16_t*)(ws + (pn < 8 ? WS_K : WS_V)) + ((size_t)(b * NKVH + h0) * SKV + t0) * HD; ld = HD; bjstride = (size_t)SKV * HD; }
        else { base = (bf16_t*)(ws + WS_U) + (size_t)pm * 256 * FW + (pn - 10) * 256; ld = FW; }
        aistride = 128 * ld;
    } else if (mode == G_F1) {
        const int g = u.pm, b = u.pn >> 3, s0 = (u.pn & 7) * 256;
        base = (bf16_t*)(ws + WS_ZT) + ((size_t)(b * 512 + g * 128) * 4096 + s0); ld = 4096; aistride = 2048;
    } else if (mode == G_F2) {
        base = (bf16_t*)(ws + WS_MIX) + (size_t)u.pm * 256 * DM + AW + u.pn * 256; ld = DM; aistride = 128 * ld;
    } else {
        base = (bf16_t*)(ws + WS_A1) + (size_t)u.pm * 256 * DFF + u.pn * 256; ld = DFF; aistride = 128 * ld;
    }
    const bool relu2 = (mode == G_UP);
    bf16_t* p0 = base + (size_t)(wr * 64 + fr) * ld + wc * 32 + 8 * fq;
#pragma unroll
    for (int ai = 0; ai < 2; ++ai)
#pragma unroll
        for (int m = 0; m < 4; ++m) {
            bf16_t* rowp = p0 + ai * aistride + (size_t)(m * 16) * ld;
#pragma unroll
            for (int bj = 0; bj < 2; ++bj) {
                f32x4 v0 = acc[ai][bj][m][0], v1 = acc[ai][bj][m][1];
                if (relu2) {
#pragma unroll
                    for (int e = 0; e < 4; ++e) { const float a = fmaxf(v0[e], 0.f), b = fmaxf(v1[e], 0.f); v0[e] = a * a; v1[e] = b * b; }
                }
                u32x4 w; w.x = cvt_pk_bf16(v0[0], v0[1]); w.y = cvt_pk_bf16(v0[2], v0[3]); w.z = cvt_pk_bf16(v1[0], v1[1]); w.w = cvt_pk_bf16(v1[2], v1[3]);
                *(u32x4*)(rowp + bj * bjstride) = w;
            }
        }
}

__device__ __forceinline__ int qk_perm(int R) { const int wc = R >> 5, n = (R >> 4) & 1, p = 16 * wc + (R & 15); return (p < 32 ? p : p + 32) + 32 * n; }
__device__ __forceinline__ void gemm_epilogue_qk(const Params& P, const f32x4 (&acc)[2][2][4][2], const Unit& u, int wr, int wc, int fr, int fq, LAS unsigned char* lds) {
    asm volatile("" : "+v"(fr), "+v"(fq), "+s"(wr), "+s"(wc));
    unsigned char* ws = P.ws;
    LAS float* red = (LAS float*)(lds + LDS_RED);
    const int pm = u.pm, pn = u.pn;
#pragma unroll
    for (int ai = 0; ai < 2; ++ai)
#pragma unroll
        for (int m = 0; m < 4; ++m)
#pragma unroll
            for (int bj = 0; bj < 2; ++bj) {
                const f32x4 a = acc[ai][bj][m][0], b = acc[ai][bj][m][1];
                float ss = ((a.x * a.x + a.y * a.y) + (a.z * a.z + a.w * a.w)) + ((b.x * b.x + b.y * b.y) + (b.z * b.z + b.w * b.w));
                ss += swz_xor<16>(ss); ss = half_sum(ss);
                if (fq == 0) red[(bj * 4 + wc) * 256 + ai * HALF + wr * 64 + m * 16 + fr] = ss;
            }
    asm volatile("s_waitcnt lgkmcnt(0)" ::: "memory"); __builtin_amdgcn_s_barrier(); asm volatile("" ::: "memory");
    const bool isq = pn < 6, rope = pm < 32;
    const int p0 = 16 * wc + 4 * fq, d0 = (p0 < 32) ? p0 : p0 + 32;
    const float* g = P.in[isq ? I_QG : I_KG];
    const f32x4 g0 = *(const f32x4*)(g + d0), g1 = *(const f32x4*)(g + d0 + 32);
    bf16_t* base; size_t ld, bjstride;
    if (isq) { base = (bf16_t*)(ws + WS_Q) + (size_t)pm * 256 * AW + pn * 256; ld = AW; bjstride = HD; }
    else { const int b = rope ? (pm >> 3) : (pm - 32), t0 = rope ? CTXL + (pm & 7) * 256 : 0, h0 = (pn - 6) * 2;
           base = (bf16_t*)(ws + WS_K) + ((size_t)(b * NKVH + h0) * SKV + t0) * HD; ld = HD; bjstride = (size_t)SKV * HD; }
    const float* tab = (const float*)(ws + WS_ROPE);
    const int i0 = 16 * (wc & 1) + 4 * fq;
#pragma unroll
    for (int ai = 0; ai < 2; ++ai)
#pragma unroll
        for (int m = 0; m < 4; ++m) {
            const int rl = ai * HALF + wr * 64 + m * 16 + fr;
            f32x4 cs0 = (f32x4){1.f, 0.f, 1.f, 0.f}, cs1 = cs0;
            if (rope) { const int pos = (pm * 256 + rl) & (SEQ - 1), av = (wc < 2) ? (pos >> 6) : (pos & 63);
                        const f32x4* t = (const f32x4*)(tab + (size_t)(av * 32 + i0) * 2); cs0 = t[0]; cs1 = t[1]; }
#pragma unroll
            for (int bj = 0; bj < 2; ++bj) {
                const float tot = (red[(bj * 4 + 0) * 256 + rl] + red[(bj * 4 + 1) * 256 + rl]) + (red[(bj * 4 + 2) * 256 + rl] + red[(bj * 4 + 3) * 256 + rl]);
                const float rstd = rsqrtf(tot * (1.0f / HD) + EPS);
                const f32x4 x1 = acc[ai][bj][m][0] * rstd * g0, x2 = acc[ai][bj][m][1] * rstd * g1;
                const float a0 = x1.x * cs0.x - x2.x * cs0.y, b0 = x2.x * cs0.x + x1.x * cs0.y;
                const float a1 = x1.y * cs0.z - x2.y * cs0.w, b1 = x2.y * cs0.z + x1.y * cs0.w;
                const float a2 = x1.z * cs1.x - x2.z * cs1.y, b2 = x2.z * cs1.x + x1.z * cs1.y;
                const float a3 = x1.w * cs1.z - x2.w * cs1.w, b3 = x2.w * cs1.z + x1.w * cs1.w;
                bf16_t* rowp = base + (size_t)rl * ld + bj * bjstride + d0;
                u32x2 o1, o2; o1.x = cvt_pk_bf16(a0, a1); o1.y = cvt_pk_bf16(a2, a3); o2.x = cvt_pk_bf16(b0, b1); o2.y = cvt_pk_bf16(b2, b3);
                *(u32x2*)rowp = o1; *(u32x2*)(rowp + 32) = o2;
            }
        }
}

__device__ __forceinline__ void gemm_epilogue_fused(const Params& P, int mode, f32x4 (&acc)[2][2][4][2], const Unit& u, int wr, int wc, int fr, int fq, LAS unsigned char* lds, int tid) {
    unsigned char* ws = P.ws;
    const int x = (mode == G_OUT) ? 0 : 1;
    const float* resid = (mode == G_OUT) ? P.in[I_X] : P.out;
    const float* modb = (const float*)(ws + WS_MOD) + (size_t)(u.pm >> 3) * NMOD6;
    const float* gate = modb + (mode == G_OUT ? 2 * DM : 5 * DM);
    const int col0 = u.pn * 256 + wc * 32 + 4 * fq;
    LAS float* Pq = (LAS float*)lds;
    LAS float* S = (LAS float*)(lds + 4096);
    {
        f32x4 gv[2][2];
#pragma unroll
        for (int bj = 0; bj < 2; ++bj)
#pragma unroll
            for (int n = 0; n < 2; ++n) gv[bj][n] = *(const f32x4*)(gate + col0 + bj * HALF + n * 16);
        f32x4 rbuf[2][2][2];
        const size_t off0 = (size_t)(u.pm * 256 + wr * 64 + fr) * DM + col0;
#pragma unroll
        for (int bj = 0; bj < 2; ++bj)
#pragma unroll
            for (int n = 0; n < 2; ++n) rbuf[0][bj][n] = *(const f32x4*)(resid + off0 + bj * HALF + n * 16);
#pragma unroll
        for (int g = 0; g < 8; ++g) {
            const int ai = g >> 2, m = g & 3;
            const int rl = ai * HALF + wr * 64 + m * 16 + fr;
            const size_t off = (size_t)(u.pm * 256 + rl) * DM + col0;
            if (g < 7) { const int ai2 = (g + 1) >> 2, m2 = (g + 1) & 3; const size_t offn = (size_t)(u.pm * 256 + ai2 * HALF + wr * 64 + m2 * 16 + fr) * DM + col0;
#pragma unroll
                for (int bj = 0; bj < 2; ++bj)
#pragma unroll
                    for (int n = 0; n < 2; ++n) rbuf[(g + 1) & 1][bj][n] = *(const f32x4*)(resid + offn + bj * HALF + n * 16); }
            float ss = 0.f;
#pragma unroll
            for (int bj = 0; bj < 2; ++bj)
#pragma unroll
                for (int n = 0; n < 2; ++n) {
                    const f32x4 v = rbuf[g & 1][bj][n] + gv[bj][n] * acc[ai][bj][m][n];
                    acc[ai][bj][m][n] = v;
                    if (mode == G_OUT) *(f32x4*)(P.out + off + bj * HALF + n * 16) = v;
                    ss += (v.x * v.x + v.y * v.y) + (v.z * v.z + v.w * v.w);
                }
            ss += swz_xor<16>(ss); ss = half_sum(ss);
            if (fq == 0) Pq[rl * 4 + wc] = ss;
            asm volatile("" ::: "memory");
        }
    }
    asm volatile("s_waitcnt lgkmcnt(0)" ::: "memory"); __builtin_amdgcn_s_barrier(); asm volatile("" ::: "memory");
    if (tid < 256) {
        const f32x4 q = *(const LAS f32x4*)(Pq + tid * 4);
        const float tot = (q.x + q.y) + (q.z + q.w);
        unsigned long long* w = (unsigned long long*)(ws + WS_XACC) + (size_t)x * MTOK + (size_t)(u.pm * 256 + tid);
        __hip_atomic_fetch_add(w, (1ull << 48) + (unsigned long long)(tot * 65536.0f + 0.5f), __ATOMIC_RELAXED, __HIP_MEMORY_SCOPE_AGENT);
        unsigned long long v; unsigned sp = 0;
        for (;;) { v = __hip_atomic_load(w, __ATOMIC_RELAXED, __HIP_MEMORY_SCOPE_AGENT); if ((v >> 48) >= 8ull) break; __builtin_amdgcn_s_sleep(1); if (++sp > (1u << 22)) break; }
        S[tid] = rsqrtf((float)(v & 0xFFFFFFFFFFFFull) * (1.0f / 65536.0f) * (1.0f / DM) + EPS);
    }
    asm volatile("s_waitcnt lgkmcnt(0)" ::: "memory"); __builtin_amdgcn_s_barrier(); asm volatile("" ::: "memory");
    if (mode == G_OUT) {
        f32x4 gg[2][2], sc[2][2], sh[2][2];
#pragma unroll
        for (int bj = 0; bj < 2; ++bj)
#pragma unroll
            for (int n = 0; n < 2; ++n) { const int cc = col0 + bj * HALF + n * 16; gg[bj][n] = *(const f32x4*)(P.in[I_G2] + cc); sh[bj][n] = *(const f32x4*)(modb + 3 * DM + cc); sc[bj][n] = *(const f32x4*)(modb + 4 * DM + cc) + 1.0f; }
        bf16_t* h2 = (bf16_t*)(ws + WS_H2);
#pragma unroll
        for (int ai = 0; ai < 2; ++ai)
#pragma unroll
            for (int m = 0; m < 4; ++m) {
                const int rl = ai * HALF + wr * 64 + m * 16 + fr; const float rs = S[rl];
                const size_t off = (size_t)(u.pm * 256 + rl) * DM + col0;
#pragma unroll
                for (int bj = 0; bj < 2; ++bj)
#pragma unroll
                    for (int n = 0; n < 2; ++n) {
                        const f32x4 y = (acc[ai][bj][m][n] * rs * gg[bj][n]) * sc[bj][n] + sh[bj][n];
                        u32x2 o; o.x = cvt_pk_bf16(y.x, y.y); o.y = cvt_pk_bf16(y.z, y.w);
                        *(u32x2*)(h2 + off + bj * HALF + n * 16) = o;
                    }
            }
    } else {
        f32x4 gg[2][2];
#pragma unroll
        for (int bj = 0; bj < 2; ++bj)
#pragma unroll
            for (int n = 0; n < 2; ++n) gg[bj][n] = *(const f32x4*)(P.in[I_GF] + col0 + bj * HALF + n * 16);
#pragma unroll
        for (int ai = 0; ai < 2; ++ai)
#pragma unroll
            for (int m = 0; m < 4; ++m) {
                const int rl = ai * HALF + wr * 64 + m * 16 + fr; const float rs = S[rl];
                const size_t off = (size_t)(u.pm * 256 + rl) * DM + col0;
#pragma unroll
                for (int bj = 0; bj < 2; ++bj)
#pragma unroll
                    for (int n = 0; n < 2; ++n) *(f32x4*)(P.out + off + bj * HALF + n * 16) = acc[ai][bj][m][n] * rs * gg[bj][n];
            }
    }
    asm volatile("s_waitcnt lgkmcnt(0)" ::: "memory"); __builtin_amdgcn_s_barrier();
}

__device__ __forceinline__ void gemm_phase(LAS unsigned char* lds, const Params& P, const int mode, const int G, const int c) {
    int tid_ = threadIdx.x; asm volatile("" : "+v"(tid_));
    const int tid = tid_, wid = __builtin_amdgcn_readfirstlane(tid >> 6), lane = tid & 63, wr = wid >> 2, wc = wid & 3, fr = lane & 15, fq = lane >> 4;
    int lda, ldb, K; bool perm = true;
    switch (mode) {
    case G_IN: lda = DM; ldb = DM; K = DM; break;
    case G_F1: lda = 128; ldb = FW; K = 128; break;
    case G_F2: lda = 4096; ldb = 4096; K = 4096; break;
    case G_OUT: lda = DM; ldb = DM; K = DM; perm = false; break;
    case G_UP: lda = DM; ldb = DM; K = DM; break;
    default: lda = DFF; ldb = DFF; K = DFF; perm = false; break;
    }
    const int nt = K / BK;
    const bool fusedEpi = (mode == G_OUT || mode == G_DOWN) && G == 256;
    unsigned voffA[2];
#pragma unroll
    for (int i = 0; i < 2; ++i) { int R, C; stage_rc(tid * 16 + i * 8192, R, C); voffA[i] = (unsigned)(R * lda + C) * 2u; }
#define PG8_BOFF(i, qk) ([&]() { int R, C; stage_rc(tid * 16 + (i) * 8192, R, C); const int Rb = (qk) ? qk_perm(R) : (perm ? ((R & ~31) + perm32(R & 31)) : R); return (unsigned)(Rb * ldb + C) * 2u; }())
    const size_t kstep = (size_t)(BK * 2);
    const size_t hstepA = (size_t)HALF * lda * 2, hstepB = (size_t)HALF * ldb * 2;
    const unsigned ldsw = (unsigned)wid * 1024u;
    const int aoff = lds_byte(wr * 64 + fr, fq * 8), boff = lds_byte(wc * 32 + fr, fq * 8);
#define PG8_SA(b, h) (((b) * 2 + (h)) * HTB)
#define PG8_SB(b, h) ((4 + (b) * 2 + (h)) * HTB)
#define PG8_STAGE(bufoff, gbase, voff) do { _Pragma("unroll") for (int _i = 0; _i < 2; ++_i) \
        __builtin_amdgcn_global_load_lds((const unsigned*)((const char*)(gbase) + (voff)[_i]), (LAS unsigned*)(lds + (bufoff) + ldsw + _i * 8192), 16, 0, 0); } while (0)
#define PG8_LDA(dst, b, h) do { _Pragma("unroll") for (int m = 0; m < 4; ++m) _Pragma("unroll") for (int k = 0; k < 2; ++k) dst[m][k] = *(const LAS bf16x8*)(lds + PG8_SA(b, h) + aoff + m * 2048 + k * 1024); } while (0)
#define PG8_LDB(dst, b, h) do { _Pragma("unroll") for (int n = 0; n < 2; ++n) _Pragma("unroll") for (int k = 0; k < 2; ++k) dst[n][k] = *(const LAS bf16x8*)(lds + PG8_SB(b, h) + boff + n * 2048 + k * 1024); } while (0)
#define PG8_MMA(ai, bj, At, Bt) do { __builtin_amdgcn_s_setprio(1); _Pragma("unroll") for (int m = 0; m < 4; ++m) _Pragma("unroll") for (int n = 0; n < 2; ++n) _Pragma("unroll") for (int k = 0; k < 2; ++k) \
        acc[ai][bj][m][n] = __builtin_amdgcn_mfma_f32_16x16x32_bf16(Bt[n][k], At[m][k], acc[ai][bj][m][n], 0, 0, 0); __builtin_amdgcn_s_setprio(0); } while (0)
#define PG8_WAIT_V(n) asm volatile("s_waitcnt vmcnt(" #n ")" ::: "memory")
#define PG8_WAIT_L(n) asm volatile("s_waitcnt lgkmcnt(" #n ")" ::: "memory")
#define PG8_BAR __builtin_amdgcn_s_barrier()
#define PG8_SCHED __builtin_amdgcn_sched_barrier(0)
    Unit cur, nxt; int ui = 0;
    if (!get_unit(P.ws, mode, 0, G, c, cur)) return;
    f32x4 acc[2][2][4][2];
#pragma unroll
    for (int a = 0; a < 2; ++a)
#pragma unroll
        for (int b = 0; b < 2; ++b)
#pragma unroll
            for (int m = 0; m < 4; ++m)
#pragma unroll
                for (int n = 0; n < 2; ++n) acc[a][b][m][n] = (f32x4){0.f, 0.f, 0.f, 0.f};
    bf16x8 At[4][2], B0[2][2], B1[2][2];
    const char* cA = cur.a; const char* cB = cur.b;
    bool cqk = (mode == G_IN) && cur.pn < 8;
    unsigned voffB[2] = {PG8_BOFF(0, cqk), PG8_BOFF(1, cqk)};
    PG8_STAGE(PG8_SB(0, 0), cB, voffB); PG8_STAGE(PG8_SB(0, 1), cB + hstepB, voffB); PG8_STAGE(PG8_SA(0, 0), cA, voffA); PG8_STAGE(PG8_SA(0, 1), cA + hstepA, voffA);
    if (wr == 1) PG8_BAR;
    PG8_WAIT_V(2); PG8_BAR;
    PG8_STAGE(PG8_SB(1, 0), cB + kstep, voffB); PG8_STAGE(PG8_SA(1, 0), cA + kstep, voffA); PG8_STAGE(PG8_SB(1, 1), cB + hstepB + kstep, voffB);
    PG8_WAIT_V(6); PG8_BAR;
    for (;;) {
        const bool has_next = get_unit(P.ws, mode, ui + 1, G, c, nxt);
        const char* nA = has_next ? nxt.a : cA; const char* nB = has_next ? nxt.b : cB;
        const bool nqk = has_next ? ((mode == G_IN) && nxt.pn < 8) : cqk;
        for (int t = 0; t < nt; t += 2) {
            const bool last = (t == nt - 2);
            unsigned vb2[2] = {voffB[0], voffB[1]};
            if (last && nqk != cqk) { vb2[0] = PG8_BOFF(0, nqk); vb2[1] = PG8_BOFF(1, nqk); }
            const char* a1 = cA + (size_t)(t + 1) * kstep;
            const char* a2 = last ? nA : cA + (size_t)(t + 2) * kstep; const char* b2 = last ? nB : cB + (size_t)(t + 2) * kstep;
            const char* a3 = a2 + kstep; const char* b3 = b2 + kstep;
            PG8_LDB(B0, 0, 0); PG8_LDB(B1, 0, 1); PG8_SCHED; PG8_LDA(At, 0, 0); PG8_STAGE(PG8_SA(1, 1), a1 + hstepA, voffA);
            PG8_WAIT_V(8); PG8_WAIT_L(0); PG8_BAR; PG8_MMA(0, 0, At, B0); PG8_MMA(0, 1, At, B1); PG8_BAR; PG8_SCHED;
            PG8_LDA(At, 0, 1); PG8_STAGE(PG8_SB(0, 0), b2, vb2); PG8_STAGE(PG8_SB(0, 1), b2 + hstepB, vb2); PG8_STAGE(PG8_SA(0, 0), a2, voffA);
            PG8_WAIT_V(8); PG8_WAIT_L(0); PG8_BAR; PG8_MMA(1, 0, At, B0); PG8_MMA(1, 1, At, B1); PG8_BAR; PG8_SCHED;
            PG8_LDB(B0, 1, 0); PG8_LDB(B1, 1, 1); PG8_SCHED; PG8_LDA(At, 1, 0); PG8_STAGE(PG8_SA(0, 1), a2 + hstepA, voffA);
            PG8_WAIT_V(8); PG8_WAIT_L(0); PG8_BAR; PG8_MMA(0, 0, At, B0); PG8_MMA(0, 1, At, B1); PG8_BAR; PG8_SCHED;
            PG8_LDA(At, 1, 1); PG8_STAGE(PG8_SB(1, 0), b3, vb2); PG8_STAGE(PG8_SB(1, 1), b3 + hstepB, vb2); PG8_STAGE(PG8_SA(1, 0), a3, voffA);
            PG8_WAIT_V(8); PG8_WAIT_L(0); PG8_BAR; PG8_MMA(1, 0, At, B0); PG8_MMA(1, 1, At, B1); PG8_BAR; PG8_SCHED;
        }
        if (wr == 0) PG8_BAR;
        if (cqk) gemm_epilogue_qk(P, acc, cur, wr, wc, fr, fq, lds);
        else if (!fusedEpi) gemm_epilogue(P, mode, acc, cur, wr, wc, fr, fq);
        if (!has_next) break;
#pragma unroll
        for (int a = 0; a < 2; ++a)
#pragma unroll
            for (int b = 0; b < 2; ++b)
#pragma unroll
                for (int m = 0; m < 4; ++m)
#pragma unroll
                    for (int n = 0; n < 2; ++n) acc[a][b][m][n] = (f32x4){0.f, 0.f, 0.f, 0.f};
        cur = nxt; cA = nA; cB = nB; ++ui; if (nqk != cqk) { cqk = nqk; voffB[0] = PG8_BOFF(0, cqk); voffB[1] = PG8_BOFF(1, cqk); }
        if (wr == 1) PG8_BAR;
    }
    PG8_WAIT_V(0);
    PG8_BAR;
    if (fusedEpi) gemm_epilogue_fused(P, mode, acc, cur, wr, wc, fr, fq, lds, tid);
#undef PG8_BOFF
#undef PG8_SA
#undef PG8_SB
#undef PG8_STAGE
#undef PG8_LDA
#undef PG8_LDB
#undef PG8_MMA
#undef PG8_WAIT_V
#undef PG8_WAIT_L
#undef PG8_BAR
#undef PG8_SCHED
}

namespace att {
constexpr int D = 128, NW = 8, QBLK = 32, KVBLK = 64;
constexpr float SCALE = 0.088388347648318440f;
constexpr float THR = 8.f;
constexpr int LDQ = AW, LDK = HD, LDO = DM;
constexpr size_t SHM_V = KVBLK * D * 2, SHM_K = KVBLK * D * 2, SHM_ATTN = 2 * SHM_V + 2 * SHM_K + NW * 64 * 4;
#define KSWZ(row, colB) ((row) * 256 + ((colB) ^ (((row) & 7) << 4)))
#define SBAR() __builtin_amdgcn_sched_barrier(0)
__device__ __forceinline__ int crow(int r, int hi) { return (r & 3) + 8 * (r >> 2) + 4 * hi; }
__device__ __forceinline__ unsigned cvtpk(float lo, float hi) { unsigned r; asm volatile("v_cvt_pk_bf16_f32 %0, %1, %2" : "=v"(r) : "v"(lo), "v"(hi)); return r; }
__device__ __forceinline__ bf16x8 ld8(const bf16_t* p) { return *reinterpret_cast<const bf16x8*>(p); }

__device__ __forceinline__ void partialSM(f32x16& p0, f32x16& p1, float& m_reg, float& mn, float& alpha) {
  constexpr float C = SCALE * 1.4426950408889634f;
  float pmax = p0[0];
#pragma unroll
  for (int r = 1; r < 16; ++r) pmax = fmaxf(pmax, p0[r]);
#pragma unroll
  for (int r = 0; r < 16; ++r) pmax = fmaxf(pmax, p1[r]);
  { auto rr = __builtin_amdgcn_permlane32_swap(__float_as_uint(pmax), __float_as_uint(pmax), false, false);
    pmax = fmaxf(__uint_as_float(rr[0]), __uint_as_float(rr[1])); }
  if (__builtin_expect(__all(pmax - m_reg <= THR / SCALE), 1)) { mn = m_reg; alpha = 1.f; }
  else { mn = fmaxf(m_reg, pmax); alpha = __builtin_amdgcn_exp2f((m_reg - mn) * C); m_reg = mn; }
  float mnC = -mn * C;
#pragma unroll
  for (int r = 0; r < 16; ++r) p0[r] = fmaf(p0[r], C, mnC);
#pragma unroll
  for (int r = 0; r < 16; ++r) p1[r] = fmaf(p1[r], C, mnC);
#pragma unroll
  for (int r = 0; r < 16; ++r) p0[r] = __builtin_amdgcn_exp2f(p0[r]);
}
__device__ __forceinline__ void finishSM(f32x16& p0, f32x16& p1, float alpha, float& l_reg, bf16x8& pa0, bf16x8& pa1, bf16x8& pa2, bf16x8& pa3) {
#pragma unroll
  for (int r = 0; r < 16; ++r) p1[r] = __builtin_amdgcn_exp2f(p1[r]);
  float ps = 0;
#pragma unroll
  for (int r = 0; r < 16; ++r) ps += p0[r];
#pragma unroll
  for (int r = 0; r < 16; ++r) ps += p1[r];
  { auto rr = __builtin_amdgcn_permlane32_swap(__float_as_uint(ps), __float_as_uint(ps), false, false);
    ps = __uint_as_float(rr[0]) + __uint_as_float(rr[1]); }
  l_reg = l_reg * alpha + ps;
#define PK4(P, BASE, OUT) do { unsigned a0 = cvtpk(P[BASE + 0], P[BASE + 1]), a1 = cvtpk(P[BASE + 2], P[BASE + 3]);   \
    unsigned b0 = cvtpk(P[BASE + 4], P[BASE + 5]), b1 = cvtpk(P[BASE + 6], P[BASE + 7]);                              \
    auto r0 = __builtin_amdgcn_permlane32_swap(a0, b0, false, false); auto r1 = __builtin_amdgcn_permlane32_swap(a1, b1, false, false); \
    u32x4 w = {r0[0], r1[0], r0[1], r1[1]}; OUT = *reinterpret_cast<bf16x8*>(&w); } while (0)
  PK4(p0, 0, pa0); PK4(p0, 8, pa1); PK4(p1, 0, pa2); PK4(p1, 8, pa3);
#undef PK4
}
__device__ __forceinline__ void qkt(f32x16& p0, f32x16& p1, const bf16_t* Ks, const bf16x8* qr, int r32, int hi) {
  p0 = f32x16{}; p1 = f32x16{};
#pragma unroll
  for (int d0 = 0; d0 < 8; ++d0) { int cb = (d0 * 16 + hi * 8) * 2;
    bf16x8 b0 = *reinterpret_cast<const bf16x8*>((const char*)Ks + KSWZ(r32, cb));
    bf16x8 b1 = *reinterpret_cast<const bf16x8*>((const char*)Ks + KSWZ(32 + r32, cb));
    p0 = __builtin_amdgcn_mfma_f32_32x32x16_bf16(b0, qr[d0], p0, 0, 0, 0);
    p1 = __builtin_amdgcn_mfma_f32_32x32x16_bf16(b1, qr[d0], p1, 0, 0, 0); }
}
__device__ __forceinline__ int v_st(int k, int c) { const int kk = (k & ~0xC) | ((k & 4) << 1) | ((k & 8) >> 1); return ((kk >> 3) * 4 + (c >> 5)) * 512 + ((kk & 7) * 32 + (c & 31)) * 2; }
__device__ __forceinline__ int v_rd_base(int lane) { return ((lane & 3) << 3) | (((lane >> 2) & 3) << 6) | (((lane >> 4) & 1) << 5) | (((lane >> 5) & 1) << 8); }
constexpr int v_rd_off(int d0, int ks, int half) { return d0 * 512 + ks * 4096 + half * 2048; }
template <int OFF> __device__ __forceinline__ s16x4 tr_read(int vb) {
  s16x4 r; asm volatile("ds_read_b64_tr_b16 %0, %1 offset:%2" : "=&v"(r) : "v"(vb), "i"(OFF) : "memory"); return r;
}
template <int D0> __device__ __forceinline__ void pv_one(f32x16& od, int vb, bf16x8 pa0, bf16x8 pa1, bf16x8 pa2, bf16x8 pa3) {
  const s16x4 l0 = tr_read<v_rd_off(D0, 0, 0)>(vb), h0 = tr_read<v_rd_off(D0, 0, 1)>(vb), l1 = tr_read<v_rd_off(D0, 1, 0)>(vb), h1 = tr_read<v_rd_off(D0, 1, 1)>(vb);
  const s16x4 l2 = tr_read<v_rd_off(D0, 2, 0)>(vb), h2 = tr_read<v_rd_off(D0, 2, 1)>(vb), l3 = tr_read<v_rd_off(D0, 3, 0)>(vb), h3 = tr_read<v_rd_off(D0, 3, 1)>(vb);
  asm volatile("s_waitcnt lgkmcnt(0)" ::: "memory"); SBAR();
#define PK(L, H) (bf16x8){L[0], L[1], L[2], L[3], H[0], H[1], H[2], H[3]}
  od = __builtin_amdgcn_mfma_f32_32x32x16_bf16(pa0, PK(l0, h0), od, 0, 0, 0);
  od = __builtin_amdgcn_mfma_f32_32x32x16_bf16(pa1, PK(l1, h1), od, 0, 0, 0);
  od = __builtin_amdgcn_mfma_f32_32x32x16_bf16(pa2, PK(l2, h2), od, 0, 0, 0);
  od = __builtin_amdgcn_mfma_f32_32x32x16_bf16(pa3, PK(l3, h3), od, 0, 0, 0);
#undef PK
}
__device__ __forceinline__ void pv_d0(f32x16* o, int vb, bf16x8 pa0, bf16x8 pa1, bf16x8 pa2, bf16x8 pa3) {
  pv_one<0>(o[0], vb, pa0, pa1, pa2, pa3); pv_one<1>(o[1], vb, pa0, pa1, pa2, pa3); pv_one<2>(o[2], vb, pa0, pa1, pa2, pa3); pv_one<3>(o[3], vb, pa0, pa1, pa2, pa3);
}

__device__ __forceinline__ void attn_dense_body(const bf16_t* __restrict__ Qb, const bf16_t* __restrict__ Kh, const bf16_t* __restrict__ Vh,
                                                bf16_t* __restrict__ Ob, int seq, char* lds) {
  int tid_ = threadIdx.x; asm volatile("" : "+v"(tid_));
  const int tid = tid_, wid = tid >> 6, lane = tid & 63, r32 = lane & 31, hi = lane >> 5;
  bf16_t* V_lds = (bf16_t*)lds; bf16_t* K_lds = (bf16_t*)(lds + 2 * SHM_V);
  float* ws = (float*)(lds + 2 * SHM_V + 2 * SHM_K) + wid * 64; float* li_l = ws; float* al_l = ws + 32;
  float m_reg = -1e30f, l_reg = 0; f32x16 o[4] = {}; bf16x8 qr[8];
  const bf16_t* Qw = Qb + (long)(wid * QBLK + r32) * LDQ + hi * 8;
#pragma unroll
  for (int d0 = 0; d0 < 8; ++d0) qr[d0] = ld8(Qw + d0 * 16);
  const int sr = tid >> 4, sc = (tid & 15) * 8, vst0 = v_st(sr, sc), vst1 = v_st(32 + sr, sc);
  const int vb0 = (int)(uintptr_t)V_lds + v_rd_base(lane);
  struct { bf16x8 vs0, vs1, ks0, ks1; } sr_[2];
#define SLOAD(i, k0) do { sr_[i].vs0 = ld8(&Vh[(long)((k0) + sr) * LDK + sc]); sr_[i].vs1 = ld8(&Vh[(long)((k0) + 32 + sr) * LDK + sc]); \
    sr_[i].ks0 = ld8(&Kh[(long)((k0) + sr) * LDK + sc]); sr_[i].ks1 = ld8(&Kh[(long)((k0) + 32 + sr) * LDK + sc]); } while (0)
#define SWRITE(b, i) do { *(bf16x8*)((char*)V_lds + (b) * SHM_V + vst0) = sr_[i].vs0;          \
    *(bf16x8*)((char*)V_lds + (b) * SHM_V + vst1) = sr_[i].vs1; int kc = sc * 2;               \
    *(bf16x8*)((char*)K_lds + (b) * SHM_K + KSWZ(sr, kc)) = sr_[i].ks0;                       \
    *(bf16x8*)((char*)K_lds + (b) * SHM_K + KSWZ(32 + sr, kc)) = sr_[i].ks1; } while (0)
#define SWAIT() asm volatile("s_waitcnt vmcnt(4)" ::: "memory")
#define RESC(a) do { if (__any((a) < 1.f)) { if (hi == 0) al_l[r32] = (a); asm volatile("s_waitcnt lgkmcnt(0)" ::: "memory"); \
    _Pragma("unroll") for (int d = 0; d < 4; ++d) _Pragma("unroll") for (int r = 0; r < 16; ++r) o[d][r] *= al_l[crow(r, hi)]; } } while (0)
  f32x16 pA0, pA1, pB0, pB1; float mnA, mnB, alA, alB; bf16x8 pa0, pa1, pa2, pa3; const int NT = seq / KVBLK;
  constexpr int SE = 0, SO = 1;
  SLOAD(SE, 0); asm volatile("s_waitcnt vmcnt(0)" ::: "memory"); SWRITE(0, SE); __syncthreads();
  qkt(pA0, pA1, K_lds, qr, r32, hi); partialSM(pA0, pA1, m_reg, mnA, alA);
  SLOAD(SO, KVBLK); if (2 < NT) SLOAD(SE, 2 * KVBLK);
  SWAIT(); SWRITE(1, SO); __syncthreads();
  for (int j = 1; j + 1 < NT; j += 2) {
    SBAR(); qkt(pB0, pB1, (bf16_t*)((char*)K_lds + SHM_K), qr, r32, hi);
    finishSM(pA0, pA1, alA, l_reg, pa0, pa1, pa2, pa3); SBAR();
    SLOAD(SO, (j + 2) * KVBLK); SBAR();
    pv_d0(o, vb0, pa0, pa1, pa2, pa3); partialSM(pB0, pB1, m_reg, mnB, alB);
    __syncthreads(); SWAIT(); SWRITE(0, SE);
    RESC(alB); __syncthreads();
    SBAR(); qkt(pA0, pA1, K_lds, qr, r32, hi);
    finishSM(pB0, pB1, alB, l_reg, pa0, pa1, pa2, pa3); SBAR();
    if (j + 3 < NT) SLOAD(SE, (j + 3) * KVBLK); SBAR();
    pv_d0(o, vb0 + (int)SHM_V, pa0, pa1, pa2, pa3); partialSM(pA0, pA1, m_reg, mnA, alA);
    __syncthreads(); SWAIT(); SWRITE(1, SO);
    RESC(alA); __syncthreads();
  }
  SBAR(); qkt(pB0, pB1, (bf16_t*)((char*)K_lds + SHM_K), qr, r32, hi);
  finishSM(pA0, pA1, alA, l_reg, pa0, pa1, pa2, pa3); SBAR();
  pv_d0(o, vb0, pa0, pa1, pa2, pa3); partialSM(pB0, pB1, m_reg, mnB, alB);
  __syncthreads(); RESC(alB);
  finishSM(pB0, pB1, alB, l_reg, pa0, pa1, pa2, pa3); SBAR();
  pv_d0(o, vb0 + (int)SHM_V, pa0, pa1, pa2, pa3);
  if (hi == 0) li_l[r32] = l_reg; asm volatile("s_waitcnt lgkmcnt(0)" ::: "memory");
  float rli[16];
#pragma unroll
  for (int r = 0; r < 16; ++r) rli[r] = __builtin_amdgcn_rcpf(li_l[crow(r, hi)]);
  bf16_t* Ow = Ob + (long)(wid * QBLK) * LDO;
#pragma unroll
  for (int r = 0; r < 16; ++r) { int orow = crow(r, hi);
#pragma unroll
    for (int d0 = 0; d0 < 4; ++d0) Ow[(long)orow * LDO + d0 * 32 + r32] = f2bf(o[d0][r] * rli[r]); }
  __syncthreads();
#undef SLOAD
#undef SWRITE
#undef SWAIT
#undef RESC
}
#undef KSWZ
#undef SBAR
}

constexpr int TR_LDS_WAVE = 64 * 65 * 4;
__device__ __forceinline__ void transpose_share(const float* __restrict__ W, int K, int N, bf16_t* __restrict__ WT, int w, int nw, LAS unsigned char* lds, int first = 0, int last = 1 << 30) {
    int tid_ = threadIdx.x; asm volatile("" : "+v"(tid_));
    const int wid = tid_ >> 6, lane = tid_ & 63;
    LAS float* scr = (LAS float*)(lds + wid * TR_LDS_WAVE);
    const int nblk = N / 64; int nitems = (K / 64) * nblk; if (last < nitems) nitems = last;
    const int kr = lane >> 4, n4 = (lane & 15) * 4, c = lane & 7;
    int it = first + w * 8 + wid;
    if (it >= nitems) return;
    f32x4 v[16];
    { const int kb = it / nblk, nb = it - kb * nblk;
#pragma unroll
      for (int i = 0; i < 16; ++i) v[i] = *(const f32x4*)(W + (size_t)(64 * kb + 4 * i + kr) * N + 64 * nb + n4); }
    for (;;) {
        const int kb = it / nblk, nb = it - kb * nblk, k0 = 64 * kb, n0 = 64 * nb;
#pragma unroll
        for (int i = 0; i < 16; ++i) { LAS float* d = scr + (4 * i + kr) * 65 + n4; d[0] = v[i].x; d[1] = v[i].y; d[2] = v[i].z; d[3] = v[i].w; }
        const int nx = it + nw; const bool more = nx < nitems;
        if (more) { const int kb2 = nx / nblk, nb2 = nx - kb2 * nblk;
#pragma unroll
            for (int i = 0; i < 16; ++i) v[i] = *(const f32x4*)(W + (size_t)(64 * kb2 + 4 * i + kr) * N + 64 * nb2 + n4); }
        LDS_WAIT();
#pragma unroll
        for (int j = 0; j < 8; ++j) { const int n = (lane >> 3) + 8 * j; const LAS float* sp = scr + (8 * c) * 65 + n;
            u32x4 o; o.x = cvt_pk_bf16(sp[0 * 65], sp[1 * 65]); o.y = cvt_pk_bf16(sp[2 * 65], sp[3 * 65]); o.z = cvt_pk_bf16(sp[4 * 65], sp[5 * 65]); o.w = cvt_pk_bf16(sp[6 * 65], sp[7 * 65]);
            *(u32x4*)(WT + (size_t)(n0 + n) * K + k0 + 8 * c) = o; }
        LDS_WAIT();
        if (!more) break;
        it = nx;
    }
}

__device__ __forceinline__ void ada_phase(const Params& P, LAS unsigned char* lds, int G) {
    int tid_ = threadIdx.x; asm volatile("" : "+v"(tid_));
    const int tid = tid_, wid = tid >> 6, lane = tid & 63;
    unsigned char* ws = P.ws;
    LAS float* sl = (LAS float*)lds;
    for (int i = tid; i < 5 * DM; i += 512) { const float v = (i < 4 * DM) ? P.in[I_C][i] : P.in[I_CCTX][i - 4 * DM]; sl[i] = v / (1.f + expf(-v)); }
    __syncthreads();
    LAS float* red = (LAS float*)(lds + 40960);
    float* mod = (float*)(ws + WS_MOD);
    const float* w_ada = P.in[I_WADA];
    int it = blockIdx.x;
    f32x4 wv[16];
    if (it < 768) { const float* wp = w_ada + (size_t)((it / 48) * 128 + wid * 16) * NMOD6 + (it % 48) * 256 + lane * 4;
#pragma unroll
        for (int i = 0; i < 16; ++i) wv[i] = *(const f32x4*)(wp + (size_t)i * NMOD6); }
    while (it < 768) {
        const int cc = it % 48, kc = it / 48;
        const int kb = kc * 128 + wid * 16;
        f32x4 acc[5];
#pragma unroll
        for (int r = 0; r < 5; ++r) acc[r] = (f32x4){0.f, 0.f, 0.f, 0.f};
#pragma unroll
        for (int i = 0; i < 16; ++i) {
#pragma unroll
            for (int r = 0; r < 5; ++r) { const float s = sl[r * DM + kb + i]; acc[r] += wv[i] * s; }
        }
        const int nx = it + G;
        if (nx < 768) { const float* wp = w_ada + (size_t)((nx / 48) * 128 + wid * 16) * NMOD6 + (nx % 48) * 256 + lane * 4;
#pragma unroll
            for (int i = 0; i < 16; ++i) wv[i] = *(const f32x4*)(wp + (size_t)i * NMOD6); }
#pragma unroll
        for (int r = 0; r < 5; ++r) *(LAS f32x4*)(red + (wid * 5 + r) * 256 + lane * 4) = acc[r];
        asm volatile("s_waitcnt lgkmcnt(0)" ::: "memory"); __builtin_amdgcn_s_barrier(); asm volatile("" ::: "memory");
        if (tid < 320) {
            const int r = tid >> 6, q = tid & 63;
            f32x4 s = (f32x4){0.f, 0.f, 0.f, 0.f};
#pragma unroll
            for (int w = 0; w < 8; ++w) s += *(const LAS f32x4*)(red + (w * 5 + r) * 256 + q * 4);
            if (kc == 0) s += *(const f32x4*)(P.in[I_BADA] + cc * 256 + q * 4);
            float* dst = mod + (size_t)r * NMOD6 + cc * 256 + q * 4;
            unsafeAtomicAdd(dst + 0, s[0]); unsafeAtomicAdd(dst + 1, s[1]); unsafeAtomicAdd(dst + 2, s[2]); unsafeAtomicAdd(dst + 3, s[3]);
        }
        asm volatile("s_waitcnt lgkmcnt(0)" ::: "memory"); __builtin_amdgcn_s_barrier(); asm volatile("" ::: "memory");
        it = nx;
    }
    asm volatile("s_waitcnt vmcnt(0)" ::: "memory");
    __syncthreads();
    if (tid == 0) { __builtin_amdgcn_fence(__ATOMIC_RELEASE, "agent"); asm volatile("s_waitcnt vmcnt(0)" ::: "memory");
                    __hip_atomic_fetch_add((unsigned*)(ws + WS_QCTR), 1u, __ATOMIC_RELAXED, __HIP_MEMORY_SCOPE_AGENT); }
}

__device__ __forceinline__ void gen_tables(const Params& P, LAS unsigned char* lds, int blk, int nblk) {
    int tid_ = threadIdx.x; asm volatile("" : "+v"(tid_));
    const int tid = tid_;
    unsigned char* ws = P.ws;
    LAS float* ct = (LAS float*)lds;
    for (int j = tid; j < 2048; j += 512) ct[j] = cospif((float)j * (1.0f / 1024.0f));
    __syncthreads();
    bf16_t* dft = (bf16_t*)(ws + WS_DFT);
    for (int idx = blk * 512 + tid; idx < 2048 * 512; idx += nblk * 512) {
        const int k = idx >> 9, n0 = (idx & 511) * 8, part = n0 >> 11, nn = n0 & 2047;
        float v[8];
#pragma unroll
        for (int e = 0; e < 8; ++e) { const int j = (k * (nn + e)) & 2047; v[e] = ct[part ? ((j - 512) & 2047) : j]; }
        u32x4 o; o.x = cvt_pk_bf16(v[0], v[1]); o.y = cvt_pk_bf16(v[2], v[3]); o.z = cvt_pk_bf16(v[4], v[5]); o.w = cvt_pk_bf16(v[6], v[7]);
        *(u32x4*)(dft + (size_t)k * 4096 + n0) = o;
    }
    for (int idx = blk * 512 + tid; idx < 64 * 32; idx += nblk * 512) {
        const int pv = idx >> 5, i = idx & 31;
        const float ang = (float)pv * powf(10000.0f, -(float)(2 * i) / 64.0f);
        float* t = (float*)(ws + WS_ROPE) + (size_t)(pv * 32 + i) * 2;
        t[0] = cosf(ang); t[1] = sinf(ang);
    }
    bf16_t* gt = (bf16_t*)(ws + WS_GT);
    LAS float* wfs = (LAS float*)(lds + 8192);
    const int NS = nblk >= 4 ? nblk / 4 : 1;
    for (int t = blk; t < 4 * NS; t += nblk) {
        const int g = t / NS, sidx = t - g * NS;
        const float* wf = P.in[I_WF] + (size_t)g * 128 * 128;
#pragma unroll
        for (int j = 0; j < 8; ++j) *(LAS f32x4*)(wfs + (tid + 512 * j) * 4) = *(const f32x4*)(wf + (tid + 512 * j) * 4);
        __syncthreads();
        for (int idx = sidx * 512 + tid; idx < 2 * 128 * 128; idx += NS * 512) {
            const int d = idx & 127, cch = (idx >> 7) & 127, part = idx >> 14;
            float sum = 0.f;
#pragma unroll 16
            for (int l = 0; l < 128; ++l) {
                const int j = (cch * l) & 127;
                const float cs = part ? -ct[((j - 32) & 127) * 16] : ct[j * 16];
                sum += cs * wfs[l * 128 + d];
            }
            gt[(size_t)((g * 2 + part) * 128 + d) * 128 + cch] = f2bf(sum * (1.0f / 512.0f));
        }
        __syncthreads();
    }
}

template <int MODE> __device__ __forceinline__ const float* rows_src(const Params& P, int r) {
    if (MODE == 0) return (r < MTOK) ? P.in[I_X] + (size_t)r * DM : P.in[I_CTX] + (size_t)(r - MTOK) * DM;
    return P.out + (size_t)r * DM;
}
template <int MODE> __device__ __forceinline__ void rows_pass(const Params& P, int G) {
    int tid_ = threadIdx.x; asm volatile("" : "+v"(tid_));
    const int tid = tid_, wid = tid >> 6, lane = tid & 63;
    const int gw = blockIdx.x * 8 + wid, NGW = G * 8;
    const int nrows = (MODE == 0) ? (MTOK + MCTX) : MTOK;
    if (MODE == 0) {
        if (tid == 0) { unsigned sp = 0; while (__hip_atomic_load((unsigned*)(P.ws + WS_QCTR), __ATOMIC_RELAXED, __HIP_MEMORY_SCOPE_AGENT) < (unsigned)G) { __builtin_amdgcn_s_sleep(2); if (++sp > (1u << 22)) break; } }
        __syncthreads();
        __builtin_amdgcn_fence(__ATOMIC_ACQUIRE, "agent");
    }
    const float* mod = (const float*)(P.ws + WS_MOD);
    const float* gain = P.in[MODE == 0 ? I_G1 : (MODE == 1 ? I_G2 : I_GF)];
    int r = gw;
    if (r >= nrows) return;
    f32x4 v[8], nv[8];
    { const float* src = rows_src<MODE>(P, r);
#pragma unroll
      for (int j = 0; j < 8; ++j) v[j] = *(const f32x4*)(src + (lane + 64 * j) * 4); }
    for (;;) {
        const int rn = r + NGW; const bool more = rn < nrows;
        if (more) { const float* src = rows_src<MODE>(P, rn);
#pragma unroll
            for (int j = 0; j < 8; ++j) nv[j] = *(const f32x4*)(src + (lane + 64 * j) * 4); }
        const int mr = (MODE == 0 && r >= MTOK) ? 4 : (r >> 11);
        float ss = 0.f;
#pragma unroll
        for (int j = 0; j < 8; ++j) ss += (v[j].x * v[j].x + v[j].y * v[j].y) + (v[j].z * v[j].z + v[j].w * v[j].w);
        const float rstd = rsqrtf(wave_sum(ss) * (1.0f / DM) + EPS);
#pragma unroll
        for (int j = 0; j < 8; ++j) {
            const int col = (lane + 64 * j) * 4;
            const f32x4 g = *(const f32x4*)(gain + col);
            f32x4 y = v[j] * rstd * g;
            if (MODE == 2) { *(f32x4*)(P.out + (size_t)r * DM + col) = y; }
            else {
                const float* mrow = mod + (size_t)mr * NMOD6 + (MODE == 0 ? 0 : 3 * DM);
                const f32x4 sh = *(const f32x4*)(mrow + col), sc = *(const f32x4*)(mrow + DM + col);
                y = y * (1.0f + sc) + sh;
                u32x2 o; o.x = cvt_pk_bf16(y.x, y.y); o.y = cvt_pk_bf16(y.z, y.w);
                bf16_t* dst = (bf16_t*)(P.ws + (MODE == 0 ? WS_H : WS_H2)) + (size_t)r * DM + col;
                *(u32x2*)dst = o;
            }
        }
        if (!more) break;
#pragma unroll
        for (int j = 0; j < 8; ++j) v[j] = nv[j];
        r = rn;
    }
}

__device__ __forceinline__ void attention_phase(const Params& P, unsigned char* lds, int G) {
    const int c = blockIdx.x;
    for (int j = 0;; ++j) {
        int b, h, qb;
        if (G == 256) {
            if (c < 64 || j > 1) break;
            const int grp = (c & 7) + 8 * j, w = (c - 64) >> 3;
            b = grp >> 2; h = (grp & 3) * 3 + (w >> 3); qb = w & 7;
        } else {
            const int au = c + G * j;
            if (au >= NB * NQH * 8) break;
            qb = au & 7; const int bh = au >> 3; h = bh % NQH; b = bh / NQH;
        }
        const bf16_t* Qb = (const bf16_t*)(P.ws + WS_Q) + (size_t)(b * SEQ + qb * 256) * AW + h * HD;
        const bf16_t* Kh = (const bf16_t*)(P.ws + WS_K) + (size_t)(b * NKVH + h / 3) * SKV * HD;
        const bf16_t* Vh = (const bf16_t*)(P.ws + WS_V) + (size_t)(b * NKVH + h / 3) * SKV * HD;
        bf16_t* Ob = (bf16_t*)(P.ws + WS_MIX) + (size_t)(b * SEQ + qb * 256) * DM + h * HD;
        att::attn_dense_body(Qb, Kh, Vh, Ob, SKV, (char*)lds);
    }
}


#define XB_TMO      128
#define XB_XCNT(j)  (256  + 64 * (j))
#define XB_XSUB(j)  (1280 + 64 * (j))
#define XB_XGEN(j)  (2304 + 64 * (j))
#define XB_TOP      3328
#define XB_TOPGEN   3392
#define XCD_BAR_WORDS 3456
#define XB_SPIN_CAP (1u << 22)
__device__ __forceinline__ unsigned xb_ld(unsigned* p)              { return __hip_atomic_load(p, __ATOMIC_RELAXED, __HIP_MEMORY_SCOPE_AGENT); }
__device__ __forceinline__ unsigned xb_add(unsigned* p, unsigned v) { return __hip_atomic_fetch_add(p, v, __ATOMIC_RELAXED, __HIP_MEMORY_SCOPE_AGENT); }
__device__ __forceinline__ unsigned xb_xcc_id() { return (unsigned)__builtin_amdgcn_s_getreg((3 << 11) | 20) & 0xFu; }
#define XB_SPIN(cond, bar) do { unsigned _sp = 0; while (cond) { __builtin_amdgcn_s_sleep(1); \
    if ((++_sp & 255u) == 0u) { if (xb_ld(&(bar)[XB_TMO])) break; if (_sp > XB_SPIN_CAP) { atomicAdd(&(bar)[XB_TMO], 1u); break; } } } } while (0)
struct XcdBarrier { unsigned* bar; unsigned x; volatile LAS unsigned* st; };
__device__ __forceinline__ XcdBarrier xcd_barrier_post(unsigned* bar, volatile LAS unsigned* st) {
    XcdBarrier b; b.bar = bar; b.x = xb_xcc_id(); b.st = st;
    if (threadIdx.x == 0) (void)xb_add(&bar[XB_XCNT(b.x)], 1u);
    return b;
}
__device__ __forceinline__ void xcd_barrier_complete(unsigned* bar, unsigned x, unsigned& nloc, unsigned& nx) {
    const unsigned G = gridDim.x * gridDim.y * gridDim.z;
    unsigned sum, cnt, mine, sp = 0u;
    for (;;) {
        sum = 0u; cnt = 0u; mine = 0u;
#pragma nounroll
        for (unsigned j = 0; j < 16; ++j) { const unsigned c = xb_ld(&bar[XB_XCNT(j)]); sum += c; cnt += (c > 0u) ? 1u : 0u; mine = (j == x) ? c : mine; }
        if (sum == G) break;
        __builtin_amdgcn_s_sleep(1);
        if ((++sp & 255u) == 0u) { if (xb_ld(&bar[XB_TMO])) break; if (sp > XB_SPIN_CAP) { atomicAdd(&bar[XB_TMO], 1u); break; } }
    }
    nloc = mine > 0u ? mine : 1u; nx = cnt > 0u ? cnt : 1u;
}
__device__ __forceinline__ void xcd_barrier(const XcdBarrier& b) {
    asm volatile("s_waitcnt vmcnt(0)" ::: "memory");
    __syncthreads();
    if (threadIdx.x == 0) {
        unsigned* bar = b.bar;
        __builtin_amdgcn_s_waitcnt(0);
        unsigned nloc = b.st[0], nx = b.st[1];
        if (nloc == 0u) { xcd_barrier_complete(bar, b.x, nloc, nx); b.st[0] = nloc; b.st[1] = nx; }
        const unsigned old = xb_add(&bar[XB_XSUB(b.x)], 1u);
        const unsigned gen = old / nloc;
        if (old + 1u == (gen + 1u) * nloc) {
            __builtin_amdgcn_fence(__ATOMIC_RELEASE, "agent");
            asm volatile("s_waitcnt vmcnt(0)" ::: "memory");
            const unsigned og = xb_add(&bar[XB_TOP], 1u);
            const unsigned tg = og / nx;
            if (og + 1u == (tg + 1u) * nx) xb_add(&bar[XB_TOPGEN], 1u);
            else XB_SPIN(xb_ld(&bar[XB_TOPGEN]) == tg, bar);
            __builtin_amdgcn_fence(__ATOMIC_ACQUIRE, "agent");
            xb_add(&bar[XB_XGEN(b.x)], 1u);
            asm volatile("s_waitcnt vmcnt(0)" ::: "memory");
        } else {
            XB_SPIN(xb_ld(&bar[XB_XGEN(b.x)]) == gen, bar);
            __builtin_amdgcn_fence(__ATOMIC_ACQUIRE, "agent");
            asm volatile("s_waitcnt vmcnt(0)" ::: "memory");
        }
    }
    __syncthreads();
}

__global__ void __launch_bounds__(512, 2) fwd_megakernel(Params P_) {
    extern __shared__ __attribute__((aligned(16))) unsigned char lds[];
    cg::grid_group grid = cg::this_grid();
    const int G_ = gridDim.x, c_ = blockIdx.x;
    LAS unsigned char* l3 = (LAS unsigned char*)lds;
    volatile LAS unsigned* misc = (volatile LAS unsigned*)(l3 + LDS_MISC);
    if (threadIdx.x < 64) misc[threadIdx.x] = 0u;
    __syncthreads();
    XcdBarrier xbar = xcd_barrier_post((unsigned*)(P_.ws + WS_BAR), misc + 8);
#if PROBE >= 100
    unsigned long long pt0 = 0, pt1 = 0;
#endif
#pragma nounroll
    for (int ph = 0; ph < 10; ++ph) {
        Params P = P_; int G = G_, c = c_;
        asm volatile("" : "+s"(G), "+s"(c), "+s"(P.ws), "+s"(P.out));
        int gm = -1;
#if PROBE >= 100
        if (ph == PROBE - 100) pt0 = __builtin_amdgcn_s_memrealtime();
        if (ph == PROBE - 99) pt1 = __builtin_amdgcn_s_memrealtime();
#endif
        switch (ph) {
        case 0: ada_phase(P, l3, G); transpose_share(P.in[I_WIN], DM, INW, (bf16_t*)(P.ws + WS_WIN), c, G * 8, l3); transpose_share(P.in[I_WOUT], DM, DM, (bf16_t*)(P.ws + WS_WOUT), c, G * 8, l3); __syncthreads(); gen_tables(P, l3, c, G); __syncthreads();
                break;
        case 1: rows_pass<0>(P, G); break;
        case 2: gm = G_IN; break;
        case 3: if (G != 256) gm = G_F1; break;
        case 4: if (G == 256 && c < 64) {
                    gemm_phase(l3, P, G_F1, 64, c);
                    asm volatile("s_waitcnt vmcnt(0)" ::: "memory"); __syncthreads();
                    if (threadIdx.x == 0) {
                        unsigned* f1c = (unsigned*)(P.ws + WS_QCTR) + 64;
                        __builtin_amdgcn_fence(__ATOMIC_RELEASE, "agent"); asm volatile("s_waitcnt vmcnt(0)" ::: "memory");
                        __hip_atomic_fetch_add(f1c, 1u, __ATOMIC_RELAXED, __HIP_MEMORY_SCOPE_AGENT);
                        unsigned sp = 0; while (__hip_atomic_load(f1c, __ATOMIC_RELAXED, __HIP_MEMORY_SCOPE_AGENT) < 64u) { __builtin_amdgcn_s_sleep(2); if (++sp > (1u << 22)) break; }
                        __builtin_amdgcn_fence(__ATOMIC_ACQUIRE, "agent"); asm volatile("s_waitcnt vmcnt(0)" ::: "memory");
                    }
                    __syncthreads();
                }
                gm = G_F2; break;
        case 5: gm = G_OUT; break;
        case 6: if (G != 256) rows_pass<1>(P, G); break;
        case 7: gm = G_UP; break;
        case 8: gm = G_DOWN; break;
        default: if (G != 256) rows_pass<2>(P, G); break;
        }
#ifndef NO_GEMM
        if (gm >= 0) gemm_phase(l3, P, gm, G, c);
#endif
#ifndef NO_ATT
        if (ph == 4) attention_phase(P, lds, G);
#endif
        if (ph == 2) { if (G != 256) transpose_share(P.in[I_W1], DM, DFF, (bf16_t*)(P.ws + WS_W1), c, G * 8, l3);
                       else if (c >= 144) transpose_share(P.in[I_W1], DM, DFF, (bf16_t*)(P.ws + WS_W1), c - 144, 112 * 8, l3); }
        if (ph == 4) { if (G != 256) transpose_share(P.in[I_W2], DFF, DM, (bf16_t*)(P.ws + WS_W2), c, G * 8, l3);
                       else if (c < 64) transpose_share(P.in[I_W2], DFF, DM, (bf16_t*)(P.ws + WS_W2), c, 64 * 8, l3); }
#if PROBE == 3
        if (ph == 7) { __syncthreads(); gemm_phase(l3, P, gm, G, c); }
#endif
#if PROBE == 4
        if (ph == 4) { __syncthreads(); gemm_phase(l3, P, gm, G, c); attention_phase(P, lds, G); }
#endif
        if (G == 0x7fffffff) grid.sync();
        if (ph > 0 && ph < 9 && !(G == 256 && (ph == 3 || ph == 6 || ph == 8))) xcd_barrier(xbar);
    }
#if PROBE >= 100
    if (PROBE - 99 == 10) pt1 = __builtin_amdgcn_s_memrealtime();
    if (blockIdx.x == 0 && threadIdx.x < 64) {
        const unsigned long long te = __builtin_amdgcn_s_memrealtime(), want = 16ull * (pt1 - pt0);
        while (__builtin_amdgcn_s_memrealtime() - te < want) __builtin_amdgcn_s_sleep(8);
    }
#endif
}

extern "C" void kernel_launch(void* const* d_in, const int* in_sizes, int n_in, void* d_out, int out_size, void* d_ws, size_t ws_size, hipStream_t stream) {
    static int grid_blocks = 0;
    if (grid_blocks == 0) {
        if (n_in != 16 || out_size != MTOK * DM || ws_size < WS_END) { fprintf(stderr, "kernel_launch: unexpected shapes (n_in %d out %d ws %zu)\n", n_in, out_size, ws_size); grid_blocks = -1; return; }
        int dev = 0, cus = 0, per_cu = 0;
        (void)hipGetDevice(&dev);
        (void)hipDeviceGetAttribute(&cus, hipDeviceAttributeMultiprocessorCount, dev);
        if (hipFuncSetAttribute((const void*)fwd_megakernel, hipFuncAttributeMaxDynamicSharedMemorySize, LDS_BYTES) != hipSuccess) { fprintf(stderr, "kernel_launch: hipFuncSetAttribute failed\n"); grid_blocks = -1; return; }
        if (hipOccupancyMaxActiveBlocksPerMultiprocessor(&per_cu, (const void*)fwd_megakernel, 512, LDS_BYTES) != hipSuccess || per_cu < 1) { fprintf(stderr, "kernel_launch: occupancy query failed (%d)\n", per_cu); per_cu = 1; }
        (void)hipGetLastError();
        grid_blocks = cus;
    }
    if (grid_blocks < 0) return;
    (void)hipMemsetAsync((char*)d_ws + WS_MOD, 0, WS_CTL_BYTES, stream);
    Params p{};
    for (int i = 0; i < 16; ++i) p.in[i] = (const float*)d_in[i];
    p.out = (float*)d_out; p.ws = (unsigned char*)d_ws;
    void* args[] = {&p};
    hipError_t e = hipLaunchCooperativeKernel((const void*)fwd_megakernel, dim3(grid_blocks), dim3(512), args, LDS_BYTES, stream);
    if (e != hipSuccess) fprintf(stderr, "cooperative launch failed: %s (grid %d)\n", hipGetErrorString(e), grid_blocks);
}
#ifdef TEST_KERNELS
__global__ void __launch_bounds__(512, 2) t_att(Params P) { extern __shared__ __attribute__((aligned(16))) unsigned char lds[]; attention_phase(P, lds, gridDim.x); }
__global__ void __launch_bounds__(512, 2) t_gemm(Params P, int mode) { extern __shared__ __attribute__((aligned(16))) unsigned char lds[]; gemm_phase((LAS unsigned char*)lds, P, mode, gridDim.x, blockIdx.x); }
__global__ void __launch_bounds__(512, 2) t_gemm_up(Params P) { extern __shared__ __attribute__((aligned(16))) unsigned char lds[]; gemm_phase((LAS unsigned char*)lds, P, G_UP, gridDim.x, blockIdx.x); }
__global__ void __launch_bounds__(512, 2) t_gemm_out(Params P) { extern __shared__ __attribute__((aligned(16))) unsigned char lds[]; gemm_phase((LAS unsigned char*)lds, P, G_OUT, gridDim.x, blockIdx.x); }
#endif
```

```cpp
#include <hip/hip_runtime.h>
#include <hip/hip_bf16.h>
#include <hip/hip_cooperative_groups.h>
#include <cstdio>
#include <cstdint>
namespace cg = cooperative_groups;

#ifndef PROBE
#define PROBE 0
#endif
#define LAS __attribute__((address_space(3)))
typedef unsigned short bf16_t;
typedef short bf16x8 __attribute__((ext_vector_type(8)));
typedef short s16x4 __attribute__((ext_vector_type(4)));
typedef float f32x4 __attribute__((ext_vector_type(4)));
typedef float f32x16 __attribute__((ext_vector_type(16)));
typedef unsigned u32x4 __attribute__((ext_vector_type(4)));
typedef unsigned u32x2 __attribute__((ext_vector_type(2)));

constexpr int DM = 2048, NB = 4, SEQ = 2048, CTXL = 256, HD = 128, NQH = 12, NKVH = 4;
constexpr int AW = 1536, KVW = 512, FW = 512, INW = 3072, DFF = 8192, NMOD6 = 6 * DM;
constexpr int MTOK = NB * SEQ, MCTX = NB * CTXL, SKV = SEQ + CTXL;
constexpr float EPS = 1e-6f;

constexpr size_t MiB = 1u << 20;
constexpr size_t WS_MOD = 0;
constexpr size_t WS_BAR = 245760;
constexpr size_t WS_QCTR = 245760 + 16384;
constexpr size_t WS_XACC = 262144 + 4096;
constexpr size_t WS_CTL_BYTES = 262144 + 4096 + 131072;
constexpr size_t WS_XSLOT = 1 * MiB + 512 * 1024;
constexpr size_t WS_ROPE = 512 * 1024;
constexpr size_t WS_GT = 1 * MiB;
constexpr size_t WS_WIN = 2 * MiB;
constexpr size_t WS_WOUT = 14 * MiB;
constexpr size_t WS_W1 = 22 * MiB;
constexpr size_t WS_W2 = 54 * MiB;
constexpr size_t WS_DFT = 86 * MiB;
constexpr size_t WS_H2 = 102 * MiB;
constexpr size_t WS_H = 134 * MiB;
constexpr size_t WS_Q = 170 * MiB;
constexpr size_t WS_K = 194 * MiB;
constexpr size_t WS_V = 203 * MiB;
constexpr size_t WS_U = 212 * MiB;
constexpr size_t WS_ZT = 220 * MiB;
constexpr size_t WS_MIX = 236 * MiB;
constexpr size_t WS_A1 = 134 * MiB;
constexpr size_t WS_END = 268 * MiB;

constexpr int LDS_MISC = 8 * 64 * 65 * 4;
constexpr int LDS_RED = LDS_MISC + 1024;
constexpr int LDS_BYTES = LDS_RED + 8192;

struct Params { const float* in[16]; float* out; unsigned char* ws; };
enum { I_X = 0, I_C, I_CTX, I_CCTX, I_WADA, I_BADA, I_G1, I_WIN, I_QG, I_KG, I_WF, I_WOUT, I_G2, I_W1, I_W2, I_GF };

__device__ __forceinline__ unsigned cvt_pk_bf16(float lo, float hi) { unsigned r; asm("v_cvt_pk_bf16_f32 %0, %1, %2" : "=v"(r) : "v"(lo), "v"(hi)); return r; }
__device__ __forceinline__ float bf2f(bf16_t v) { return __uint_as_float(((unsigned)v) << 16); }
__device__ __forceinline__ bf16_t f2bf(float f) { return (bf16_t)(cvt_pk_bf16(f, 0.f) & 0xffffu); }
template <int M> __device__ __forceinline__ float swz_xor(float v) { return __int_as_float(__builtin_amdgcn_ds_swizzle(__float_as_int(v), 0x1F | (M << 10))); }
__device__ __forceinline__ float half_sum(float v) { auto rr = __builtin_amdgcn_permlane32_swap(__float_as_uint(v), __float_as_uint(v), false, false); return __uint_as_float(rr[0]) + __uint_as_float(rr[1]); }
__device__ __forceinline__ float wave_sum(float v) {
    v += swz_xor<1>(v); v += swz_xor<2>(v); v += swz_xor<4>(v); v += swz_xor<8>(v); v += swz_xor<16>(v);
    return half_sum(v);
}
#define LDS_WAIT() asm volatile("s_waitcnt lgkmcnt(0)" ::: "memory")

constexpr int BM = 256, BK = 64, HALF = 128, HTB = HALF * BK * 2, NXCD = 8, WGM = 8;
__device__ __forceinline__ int lds_byte(int r, int c) { const int st = (r >> 4) * 2 + (c >> 5), rr = r & 15, cc = c & 31, ob = rr * 64 + cc * 2; return st * 1024 + (ob ^ (((ob >> 9) & 1) << 5)); }
__device__ __forceinline__ void stage_rc(int b, int& R, int& C) { const int st = b / 1024, sb = b % 1024, swz = sb ^ (((sb >> 9) & 1) << 5); R = (st >> 1) * 16 + swz / 64; C = (st & 1) * 32 + (swz % 64) / 2; }
__device__ __forceinline__ int perm32(int rho) { const int n = rho >> 4, i = rho & 15; return 8 * (i >> 2) + 4 * n + (i & 3); }

struct Unit { int pm, pn; const char* a; const char* b; };
enum { G_IN = 0, G_F1, G_F2, G_OUT, G_UP, G_DOWN };

__device__ __forceinline__ void remap_tile(int L, int nM, int nN, int& pm, int& pn) {
    const int nwg = nM * nN; int wgid = L;
    { const int q = nwg / NXCD, r = nwg % NXCD, xcd = wgid % NXCD, off = wgid / NXCD; wgid = (xcd < r ? xcd * (q + 1) : r * (q + 1) + (xcd - r) * q) + off; }
    const int nig = WGM * nN, gid = wgid / nig, fm = gid * WGM, gsz = (nM - fm) < WGM ? (nM - fm) : WGM;
    pm = fm + ((wgid % nig) % gsz); pn = (wgid % nig) / gsz;
}

__device__ __forceinline__ bool get_unit(const unsigned char* ws, int mode, int i, int G, int c, Unit& u) {
    const long L = (long)i * G + c;
    switch (mode) {
    case G_IN: {
        if (L >= 400) return false;
        if (L < 256) remap_tile((int)L, 32, 8, u.pm, u.pn);
        else if (L < 384) { remap_tile((int)L - 256, 32, 4, u.pm, u.pn); u.pn += 8; }
        else { const int idx = (int)L - 384; u.pm = 32 + (idx >> 2); u.pn = 6 + (idx & 3); }
        u.a = (const char*)ws + WS_H + (size_t)u.pm * 256 * DM * 2; u.b = (const char*)ws + WS_WIN + (size_t)u.pn * 256 * DM * 2; return true; }
    case G_F1: {
        if (L >= 128) return false;
        const int g = (int)L >> 5; u.pm = g; u.pn = (int)L & 31;
        u.a = (const char*)ws + WS_GT + (size_t)g * 256 * 128 * 2; u.b = (const char*)ws + WS_U + ((size_t)u.pn * 256 * FW + g * 128) * 2; return true; }
    case G_F2: {
        if (L >= 64) return false;
        const int b = (int)L >> 4, pm = ((int)L >> 1) & 7, pn = (int)L & 1; u.pm = b * 8 + pm; u.pn = pn;
        u.a = (const char*)ws + WS_DFT + (size_t)pm * 256 * 4096 * 2; u.b = (const char*)ws + WS_ZT + ((size_t)(b * 512 + pn * 256) * 4096) * 2; return true; }
    case G_OUT: {
        if (L >= 256) return false;
        remap_tile((int)L, 32, 8, u.pm, u.pn);
        u.a = (const char*)ws + WS_MIX + (size_t)u.pm * 256 * DM * 2; u.b = (const char*)ws + WS_WOUT + (size_t)u.pn * 256 * DM * 2; return true; }
    case G_UP: {
        if (L >= 1024) return false;
        remap_tile((int)L, 32, 32, u.pm, u.pn);
        u.a = (const char*)ws + WS_H2 + (size_t)u.pm * 256 * DM * 2; u.b = (const char*)ws + WS_W1 + (size_t)u.pn * 256 * DM * 2; return true; }
    default: {
        if (L >= 256) return false;
        remap_tile((int)L, 32, 8, u.pm, u.pn);
        u.a = (const char*)ws + WS_A1 + (size_t)u.pm * 256 * DFF * 2; u.b = (const char*)ws + WS_W2 + (size_t)u.pn * 256 * DFF * 2; return true; }
    }
}

__device__ __forceinline__ void gemm_epilogue(const Params& P, int mode, const f32x4 (&acc)[2][2][4][2], const Unit& u, int wr, int wc, int fr, int fq) {
    unsigned char* ws = P.ws;
    if (mode == G_OUT || mode == G_DOWN) {
        const float* resid = (mode == G_OUT) ? P.in[I_X] : P.out;
        const float* gate = (const float*)(ws + WS_MOD) + (size_t)(u.pm >> 3) * NMOD6 + (mode == G_OUT ? 2 * DM : 5 * DM);
        const int col0 = u.pn * 256 + wc * 32 + 4 * fq;
        f32x4 gv[2][2];
#pragma unroll
        for (int bj = 0; bj < 2; ++bj)
#pragma unroll
            for (int n = 0; n < 2; ++n) gv[bj][n] = *(const f32x4*)(gate + col0 + bj * HALF + n * 16);
#pragma unroll
        for (int ai = 0; ai < 2; ++ai)
#pragma unroll
            for (int m = 0; m < 4; ++m) {
                const size_t off = (size_t)(u.pm * 256 + ai * HALF + wr * 64 + m * 16 + fr) * DM + col0;
#pragma unroll
                for (int bj = 0; bj < 2; ++bj)
#pragma unroll
                    for (int n = 0; n < 2; ++n) {
                        const f32x4 r = *(const f32x4*)(resid + off + bj * HALF + n * 16);
                        *(f32x4*)(P.out + off + bj * HALF + n * 16) = r + gv[bj][n] * acc[ai][bj][m][n];
                    }
            }
        return;
    }
    bf16_t* base; size_t ld, aistride, bjstride = HALF;
    if (mode == G_IN) {
        const int pm = u.pm, pn = u.pn;
        if (pn < 6) { base = (bf16_t*)(ws + WS_Q) + (size_t)pm * 256 * AW + pn * 256; ld = AW; }
        else if (pn < 10) {
            const int b = (pm < 32) ? (pm >> 3) : (pm - 32), t0 = (pm < 32) ? CTXL + (pm & 7) * 256 : 0, h0 = ((pn - 6) & 1) * 2;
            base = (bf16_t*)(ws + (pn < 8 ? WS_K : WS_V)) + ((size_t)(b * NKVH + h0) * SKV + t0) * HD; ld = HD; bjstride = (size_t)SKV * HD; }
        else { base = (bf16_t*)(ws + WS_U) + (size_t)pm * 256 * FW + (pn - 10) * 256; ld = FW; }
        aistride = 128 * ld;
    } else if (mode == G_F1) {
        const int g = u.pm, b = u.pn >> 3, s0 = (u.pn & 7) * 256;
        base = (bf16_t*)(ws + WS_ZT) + ((size_t)(b * 512 + g * 128) * 4096 + s0); ld = 4096; aistride = 2048;
    } else if (mode == G_F2) {
        base = (bf16_t*)(ws + WS_MIX) + (size_t)u.pm * 256 * DM + AW + u.pn * 256; ld = DM; aistride = 128 * ld;
    } else {
        base = (bf16_t*)(ws + WS_A1) + (size_t)u.pm * 256 * DFF + u.pn * 256; ld = DFF; aistride = 128 * ld;
    }
    const bool relu2 = (mode == G_UP);
    bf16_t* p0 = base + (size_t)(wr * 64 + fr) * ld + wc * 32 + 8 * fq;
#pragma unroll
    for (int ai = 0; ai < 2; ++ai)
#pragma unroll
        for (int m = 0; m < 4; ++m) {
            bf16_t* rowp = p0 + ai * aistride + (size_t)(m * 16) * ld;
#pragma unroll
            for (int bj = 0; bj < 2; ++bj) {
                f32x4 v0 = acc[ai][bj][m][0], v1 = acc[ai][bj][m][1];
                if (relu2) {
#pragma unroll
                    for (int e = 0; e < 4; ++e) { const float a = fmaxf(v0[e], 0.f), b = fmaxf(v1[e], 0.f); v0[e] = a * a; v1[e] = b * b; }
                }
                u32x4 w; w.x = cvt_pk_bf16(v0[0], v0[1]); w.y = cvt_pk_bf16(v0[2], v0[3]); w.z = cvt_pk_bf16(v1[0], v1[1]); w.w = cvt_pk_bf16(v1[2], v1[3]);
                *(u32x4*)(rowp + bj * bjstride) = w;
            }
        }
}

__device__ __forceinline__ int qk_perm(int R) { const int wc = R >> 5, n = (R >> 4) & 1, p = 16 * wc + (R & 15); return (p < 32 ? p : p + 32) + 32 * n; }
__device__ __forceinline__ void gemm_epilogue_qk(const Params& P, const f32x4 (&acc)[2][2][4][2], const Unit& u, int wr, int wc, int fr, int fq, LAS unsigned char* lds) {
    asm volatile("" : "+v"(fr), "+v"(fq), "+s"(wr), "+s"(wc));
    unsigned char* ws = P.ws;
    LAS float* red = (LAS float*)(lds + LDS_RED);
    const int pm = u.pm, pn = u.pn;
#pragma unroll
    for (int ai = 0; ai < 2; ++ai)
#pragma unroll
        for (int m = 0; m < 4; ++m)
#pragma unroll
            for (int bj = 0; bj < 2; ++bj) {
                const f32x4 a = acc[ai][bj][m][0], b = acc[ai][bj][m][1];
                float ss = ((a.x * a.x + a.y * a.y) + (a.z * a.z + a.w * a.w)) + ((b.x * b.x + b.y * b.y) + (b.z * b.z + b.w * b.w));
                ss += swz_xor<16>(ss); ss = half_sum(ss);
                if (fq == 0) red[(bj * 4 + wc) * 256 + ai * HALF + wr * 64 + m * 16 + fr] = ss;
            }
    asm volatile("s_waitcnt lgkmcnt(0)" ::: "memory"); __builtin_amdgcn_s_barrier(); asm volatile("" ::: "memory");
    const bool isq = pn < 6, rope = pm < 32;
    const int p0 = 16 * wc + 4 * fq, d0 = (p0 < 32) ? p0 : p0 + 32;
    const float* g = P.in[isq ? I_QG : I_KG];
    const f32x4 g0 = *(const f32x4*)(g + d0), g1 = *(const f32x4*)(g + d0 + 32);
    bf16_t* base; size_t ld, bjstride;
    if (isq) { base = (bf16_t*)(ws + WS_Q) + (size_t)pm * 256 * AW + pn * 256; ld = AW; bjstride = HD; }
    else { const int b = rope ? (pm >> 3) : (pm - 32), t0 = rope ? CTXL + (pm & 7) * 256 : 0, h0 = (pn - 6) * 2;
           base = (bf16_t*)(ws + WS_K) + ((size_t)(b * NKVH + h0) * SKV + t0) * HD; ld = HD; bjstride = (size_t)SKV * HD; }
    const float* tab = (const float*)(ws + WS_ROPE);
    const int i0 = 16 * (wc & 1) + 4 * fq;
#pragma unroll
    for (int ai = 0; ai < 2; ++ai)
#pragma unroll
        for (int m = 0; m < 4; ++m) {
            const int rl = ai * HALF + wr * 64 + m * 16 + fr;
            f32x4 cs0 = (f32x4){1.f, 0.f, 1.f, 0.f}, cs1 = cs0;
            if (rope) { const int pos = (pm * 256 + rl) & (SEQ - 1), av = (wc < 2) ? (pos >> 6) : (pos & 63);
                        const f32x4* t = (const f32x4*)(tab + (size_t)(av * 32 + i0) * 2); cs0 = t[0]; cs1 = t[1]; }
#pragma unroll
            for (int bj = 0; bj < 2; ++bj) {
                const float tot = (red[(bj * 4 + 0) * 256 + rl] + red[(bj * 4 + 1) * 256 + rl]) + (red[(bj * 4 + 2) * 256 + rl] + red[(bj * 4 + 3) * 256 + rl]);
                const float rstd = rsqrtf(tot * (1.0f / HD) + EPS);
                const f32x4 x1 = acc[ai][bj][m][0] * rstd * g0, x2 = acc[ai][bj][m][1] * rstd * g1;
                const float a0 = x1.x * cs0.x - x2.x * cs0.y, b0 = x2.x * cs0.x + x1.x * cs0.y;
                const float a1 = x1.y * cs0.z - x2.y * cs0.w, b1 = x2.y * cs0.z + x1.y * cs0.w;
                const float a2 = x1.z * cs1.x - x2.z * cs1.y, b2 = x2.z * cs1.x + x1.z * cs1.y;
                const float a3 = x1.w * cs1.z - x2.w * cs1.w, b3 = x2.w * cs1.z + x1.w * cs1.w;
                bf16_t* rowp = base + (size_t)rl * ld + bj * bjstride + d0;
                u32x2 o1, o2; o1.x = cvt_pk_bf16(a0, a1); o1.y = cvt_pk_bf16(a2, a3); o2.x = cvt_pk_bf16(b0, b1); o2.y = cvt_pk_bf16(b2, b3);
                *(u32x2*)rowp = o1; *(u32x2*)(rowp + 32) = o2;
            }
        }
}

__device__ __forceinline__ void gemm_epilogue_fused(const Params& P, int mode, f32x4 (&acc)[2][2][4][2], const Unit& u, int wr, int wc, int fr, int fq, LAS unsigned char* lds, int tid) {
    unsigned char* ws = P.ws;
    const int x = (mode == G_OUT) ? 0 : 1;
    const float* resid = (mode == G_OUT) ? P.in[I_X] : P.out;
    const float* modb = (const float*)(ws + WS_MOD) + (size_t)(u.pm >> 3) * NMOD6;
    const float* gate = modb + (mode == G_OUT ? 2 * DM : 5 * DM);
    const int col0 = u.pn * 256 + wc * 32 + 4 * fq;
    LAS float* Pq = (LAS float*)lds;
    LAS float* S = (LAS float*)(lds + 4096);
    {
        f32x4 gv[2][2];
#pragma unroll
        for (int bj = 0; bj < 2; ++bj)
#pragma unroll
            for (int n = 0; n < 2; ++n) gv[bj][n] = *(const f32x4*)(gate + col0 + bj * HALF + n * 16);
        f32x4 rbuf[2][2][2];
        const size_t off0 = (size_t)(u.pm * 256 + wr * 64 + fr) * DM + col0;
#pragma unroll
        for (int bj = 0; bj < 2; ++bj)
#pragma unroll
            for (int n = 0; n < 2; ++n) rbuf[0][bj][n] = *(const f32x4*)(resid + off0 + bj * HALF + n * 16);
#pragma unroll
        for (int g = 0; g < 8; ++g) {
            const int ai = g >> 2, m = g & 3;
            const int rl = ai * HALF + wr * 64 + m * 16 + fr;
            const size_t off = (size_t)(u.pm * 256 + rl) * DM + col0;
            if (g < 7) { const int ai2 = (g + 1) >> 2, m2 = (g + 1) & 3; const size_t offn = (size_t)(u.pm * 256 + ai2 * HALF + wr * 64 + m2 * 16 + fr) * DM + col0;
#pragma unroll
                for (int bj = 0; bj < 2; ++bj)
#pragma unroll
                    for (int n = 0; n < 2; ++n) rbuf[(g + 1) & 1][bj][n] = *(const f32x4*)(resid + offn + bj * HALF + n * 16); }
            float ss = 0.f;
#pragma unroll
            for (int bj = 0; bj < 2; ++bj)
#pragma unroll
                for (int n = 0; n < 2; ++n) {
                    const f32x4 v = rbuf[g & 1][bj][n] + gv[bj][n] * acc[ai][bj][m][n];
                    acc[ai][bj][m][n] = v;
                    if (mode == G_OUT) *(f32x4*)(P.out + off + bj * HALF + n * 16) = v;
                    ss += (v.x * v.x + v.y * v.y) + (v.z * v.z + v.w * v.w);
                }
            ss += swz_xor<16>(ss); ss = half_sum(ss);
            if (fq == 0) Pq[rl * 4 + wc] = ss;
            asm volatile("" ::: "memory");
        }
    }
    asm volatile("s_waitcnt lgkmcnt(0)" ::: "memory"); __builtin_amdgcn_s_barrier(); asm volatile("" ::: "memory");
    if (tid < 256) {
        const f32x4 q = *(const LAS f32x4*)(Pq + tid * 4);
        const float tot = (q.x + q.y) + (q.z + q.w);
        unsigned long long* w = (unsigned long long*)(ws + WS_XACC) + (size_t)x * MTOK + (size_t)(u.pm * 256 + tid);
        __hip_atomic_fetch_add(w, (1ull << 48) + (unsigned long long)(tot * 65536.0f + 0.5f), __ATOMIC_RELAXED, __HIP_MEMORY_SCOPE_AGENT);
        unsigned long long v; unsigned sp = 0;
        for (;;) { v = __hip_atomic_load(w, __ATOMIC_RELAXED, __HIP_MEMORY_SCOPE_AGENT); if ((v >> 48) >= 8ull) break; __builtin_amdgcn_s_sleep(1); if (++sp > (1u << 22)) break; }
        S[tid] = rsqrtf((float)(v & 0xFFFFFFFFFFFFull) * (1.0f / 65536.0f) * (1.0f / DM) + EPS);
    }
    asm volatile("s_waitcnt lgkmcnt(0)" ::: "memory"); __builtin_amdgcn_s_barrier(); asm volatile("" ::: "memory");
    if (mode == G_OUT) {
        f32x4 gg[2][2], sc[2][2], sh[2][2];
#pragma unroll
        for (int bj = 0; bj < 2; ++bj)
#pragma unroll
            for (int n = 0; n < 2; ++n) { const int cc = col0 + bj * HALF + n * 16; gg[bj][n] = *(const f32x4*)(P.in[I_G2] + cc); sh[bj][n] = *(const f32x4*)(modb + 3 * DM + cc); sc[bj][n] = *(const f32x4*)(modb + 4 * DM + cc) + 1.0f; }
        bf16_t* h2 = (bf16_t*)(ws + WS_H2);
#pragma unroll
        for (int ai = 0; ai < 2; ++ai)
#pragma unroll
            for (int m = 0; m < 4; ++m) {
                const int rl = ai * HALF + wr * 64 + m * 16 + fr; const float rs = S[rl];
                const size_t off = (size_t)(u.pm * 256 + rl) * DM + col0;
#pragma unroll
                for (int bj = 0; bj < 2; ++bj)
#pragma unroll
                    for (int n = 0; n < 2; ++n) {
                        const f32x4 y = (acc[ai][bj][m][n] * rs * gg[bj][n]) * sc[bj][n] + sh[bj][n];
                        u32x2 o; o.x = cvt_pk_bf16(y.x, y.y); o.y = cvt_pk_bf16(y.z, y.w);
                        *(u32x2*)(h2 + off + bj * HALF + n * 16) = o;
                    }
            }
    } else {
        f32x4 gg[2][2];
#pragma unroll
        for (int bj = 0; bj < 2; ++bj)
#pragma unroll
            for (int n = 0; n < 2; ++n) gg[bj][n] = *(const f32x4*)(P.in[I_GF] + col0 + bj * HALF + n * 16);
#pragma unroll
        for (int ai = 0; ai < 2; ++ai)
#pragma unroll
            for (int m = 0; m < 4; ++m) {
                const int rl = ai * HALF + wr * 64 + m * 16 + fr; const float rs = S[rl];
                const size_t off = (size_t)(u.pm * 256 + rl) * DM + col0;
#pragma unroll
                for (int bj = 0; bj < 2; ++bj)
#pragma unroll
                    for (int n = 0; n < 2; ++n) *(f32x4*)(P.out + off + bj * HALF + n * 16) = acc[ai][bj][m][n] * rs * gg[bj][n];
            }
    }
    asm volatile("s_waitcnt lgkmcnt(0)" ::: "memory"); __builtin_amdgcn_s_barrier();
}

__device__ __forceinline__ void gemm_phase(LAS unsigned char* lds, const Params& P, const int mode, const int G, const int c) {
    int tid_ = threadIdx.x; asm volatile("" : "+v"(tid_));
    const int tid = tid_, wid = __builtin_amdgcn_readfirstlane(tid >> 6), lane = tid & 63, wr = wid >> 2, wc = wid & 3, fr = lane & 15, fq = lane >> 4;
    int lda, ldb, K; bool perm = true;
    switch (mode) {
    case G_IN: lda = DM; ldb = DM; K = DM; break;
    case G_F1: lda = 128; ldb = FW; K = 128; break;
    case G_F2: lda = 4096; ldb = 4096; K = 4096; break;
    case G_OUT: lda = DM; ldb = DM; K = DM; perm = false; break;
    case G_UP: lda = DM; ldb = DM; K = DM; break;
    default: lda = DFF; ldb = DFF; K = DFF; perm = false; break;
    }
    const int nt = K / BK;
    const bool fusedEpi = (mode == G_OUT || mode == G_DOWN) && G == 256;
    unsigned voffA[2];
#pragma unroll
    for (int i = 0; i < 2; ++i) { int R, C; stage_rc(tid * 16 + i * 8192, R, C); voffA[i] = (unsigned)(R * lda + C) * 2u; }
#define PG8_BOFF(i, qk) ([&]() { int R, C; stage_rc(tid * 16 + (i) * 8192, R, C); const int Rb = (qk) ? qk_perm(R) : (perm ? ((R & ~31) + perm32(R & 31)) : R); return (unsigned)(Rb * ldb + C) * 2u; }())
    const size_t kstep = (size_t)(BK * 2);
    const size_t hstepA = (size_t)HALF * lda * 2, hstepB = (size_t)HALF * ldb * 2;
    const unsigned ldsw = (unsigned)wid * 1024u;
    const int aoff = lds_byte(wr * 64 + fr, fq * 8), boff = lds_byte(wc * 32 + fr, fq * 8);
#define PG8_SA(b, h) (((b) * 2 + (h)) * HTB)
#define PG8_SB(b, h) ((4 + (b) * 2 + (h)) * HTB)
#define PG8_STAGE(bufoff, gbase, voff) do { _Pragma("unroll") for (int _i = 0; _i < 2; ++_i) \
        __builtin_amdgcn_global_load_lds((const unsigned*)((const char*)(gbase) + (voff)[_i]), (LAS unsigned*)(lds + (bufoff) + ldsw + _i * 8192), 16, 0, 0); } while (0)
#define PG8_LDA(dst, b, h) do { _Pragma("unroll") for (int m = 0; m < 4; ++m) _Pragma("unroll") for (int k = 0; k < 2; ++k) dst[m][k] = *(const LAS bf16x8*)(lds + PG8_SA(b, h) + aoff + m * 2048 + k * 1024); } while (0)
#define PG8_LDB(dst, b, h) do { _Pragma("unroll") for (int n = 0; n < 2; ++n) _Pragma("unroll") for (int k = 0; k < 2; ++k) dst[n][k] = *(const LAS bf16x8*)(lds + PG8_SB(b, h) + boff + n * 2048 + k * 1024); } while (0)
#define PG8_MMA(ai, bj, At, Bt) do { __builtin_amdgcn_s_setprio(1); _Pragma("unroll") for (int m = 0; m < 4; ++m) _Pragma("unroll") for (int n = 0; n < 2; ++n) _Pragma("unroll") for (int k = 0; k < 2; ++k) \
        acc[ai][bj][m][n] = __builtin_amdgcn_mfma_f32_16x16x32_bf16(Bt[n][k], At[m][k], acc[ai][bj][m][n], 0, 0, 0); __builtin_amdgcn_s_setprio(0); } while (0)
#define PG8_WAIT_V(n) asm volatile("s_waitcnt vmcnt(" #n ")" ::: "memory")
#define PG8_WAIT_L(n) asm volatile("s_waitcnt lgkmcnt(" #n ")" ::: "memory")
#define PG8_BAR __builtin_amdgcn_s_barrier()
#define PG8_SCHED __builtin_amdgcn_sched_barrier(0)
    Unit cur, nxt; int ui = 0;
    if (!get_unit(P.ws, mode, 0, G, c, cur)) return;
    f32x4 acc[2][2][4][2];
#pragma unroll
    for (int a = 0; a < 2; ++a)
#pragma unroll
        for (int b = 0; b < 2; ++b)
#pragma unroll
            for (int m = 0; m < 4; ++m)
#pragma unroll
                for (int n = 0; n < 2; ++n) acc[a][b][m][n] = (f32x4){0.f, 0.f, 0.f, 0.f};
    bf16x8 At[4][2], B0[2][2], B1[2][2];
    const char* cA = cur.a; const char* cB = cur.b;
    bool cqk = (mode == G_IN) && cur.pn < 8;
    unsigned voffB[2] = {PG8_BOFF(0, cqk), PG8_BOFF(1, cqk)};
    PG8_STAGE(PG8_SB(0, 0), cB, voffB); PG8_STAGE(PG8_SB(0, 1), cB + hstepB, voffB); PG8_STAGE(PG8_SA(0, 0), cA, voffA); PG8_STAGE(PG8_SA(0, 1), cA + hstepA, voffA);
    if (wr == 1) PG8_BAR;
    PG8_WAIT_V(2); PG8_BAR;
    PG8_STAGE(PG8_SB(1, 0), cB + kstep, voffB); PG8_STAGE(PG8_SA(1, 0), cA + kstep, voffA); PG8_STAGE(PG8_SB(1, 1), cB + hstepB + kstep, voffB);
    PG8_WAIT_V(6); PG8_BAR;
    for (;;) {
        const bool has_next = get_unit(P.ws, mode, ui + 1, G, c, nxt);
        const char* nA = has_next ? nxt.a : cA; const char* nB = has_next ? nxt.b : cB;
        const bool nqk = has_next ? ((mode == G_IN) && nxt.pn < 8) : cqk;
        for (int t = 0; t < nt; t += 2) {
            const bool last = (t == nt - 2);
            unsigned vb2[2] = {voffB[0], voffB[1]};
            if (last && nqk != cqk) { vb2[0] = PG8_BOFF(0, nqk); vb2[1] = PG8_BOFF(1, nqk); }
            const char* a1 = cA + (size_t)(t + 1) * kstep;
            const char* a2 = last ? nA : cA + (size_t)(t + 2) * kstep; const char* b2 = last ? nB : cB + (size_t)(t + 2) * kstep;
            const char* a3 = a2 + kstep; const char* b3 = b2 + kstep;
            PG8_LDB(B0, 0, 0); PG8_LDB(B1, 0, 1); PG8_SCHED; PG8_LDA(At, 0, 0); PG8_STAGE(PG8_SA(1, 1), a1 + hstepA, voffA);
            PG8_WAIT_V(8); PG8_WAIT_L(0); PG8_BAR; PG8_MMA(0, 0, At, B0); PG8_MMA(0, 1, At, B1); PG8_BAR; PG8_SCHED;
            PG8_LDA(At, 0, 1); PG8_STAGE(PG8_SB(0, 0), b2, vb2); PG8_STAGE(PG8_SB(0, 1), b2 + hstepB, vb2); PG8_STAGE(PG8_SA(0, 0), a2, voffA);
            PG8_WAIT_V(8); PG8_WAIT_L(0); PG8_BAR; PG8_MMA(1, 0, At, B0); PG8_MMA(1, 1, At, B1); PG8_BAR; PG8_SCHED;
            PG8_LDB(B0, 1, 0); PG8_LDB(B1, 1, 1); PG8_SCHED; PG8_LDA(At, 1, 0); PG8_STAGE(PG8_SA(0, 1), a2 + hstepA, voffA);
            PG8_WAIT_V(8); PG8_WAIT_L(0); PG8_BAR; PG8_MMA(0, 0, At, B0); PG8_MMA(0, 1, At, B1); PG8_BAR; PG8_SCHED;
            PG8_LDA(At, 1, 1); PG8_STAGE(PG8_SB(1, 0), b3, vb2); PG8_STAGE(PG8_SB(1, 1), b3 + hstepB, vb2); PG8_STAGE(PG8_SA(1, 0), a3, voffA);
            PG8_WAIT_V(8); PG8_WAIT_L(0); PG8_BAR; PG8_MMA(1, 0, At, B0); PG8_MMA(1, 1, At, B1); PG8_BAR; PG8_SCHED;
        }
        if (wr == 0) PG8_BAR;
        if (cqk) gemm_epilogue_qk(P, acc, cur, wr, wc, fr, fq, lds);
        else if (!fusedEpi) gemm_epilogue(P, mode, acc, cur, wr, wc, fr, fq);
        if (!has_next) break;
#pragma unroll
        for (int a = 0; a < 2; ++a)
#pragma unroll
            for (int b = 0; b < 2; ++b)
#pragma unroll
                for (int m = 0; m < 4; ++m)
#pragma unroll
                    for (int n = 0; n < 2; ++n) acc[a][b][m][n] = (f32x4){0.f, 0.f, 0.f, 0.f};
        cur = nxt; cA = nA; cB = nB; ++ui; if (nqk != cqk) { cqk = nqk; voffB[0] = PG8_BOFF(0, cqk); voffB[1] = PG8_BOFF(1, cqk); }
        if (wr == 1) PG8_BAR;
    }
    PG8_WAIT_V(0);
    PG8_BAR;
    if (fusedEpi) gemm_epilogue_fused(P, mode, acc, cur, wr, wc, fr, fq, lds, tid);
#undef PG8_BOFF
#undef PG8_SA
#undef PG8_SB
#undef PG8_STAGE
#undef PG8_LDA
#undef PG8_LDB
#undef PG8_MMA
#undef PG8_WAIT_V
#undef PG8_WAIT_L
#undef PG8_BAR
#undef PG8_SCHED
}

namespace att {
constexpr int D = 128, NW = 8, QBLK = 32, KVBLK = 64;
constexpr float SCALE = 0.088388347648318440f;
constexpr float THR = 8.f;
constexpr int LDQ = AW, LDK = HD, LDO = DM;
constexpr size_t SHM_V = KVBLK * D * 2, SHM_K = KVBLK * D * 2, SHM_ATTN = 2 * SHM_V + 2 * SHM_K + NW * 64 * 4;
#define KSWZ(row, colB) ((row) * 256 + ((colB) ^ (((row) & 7) << 4)))
#define SBAR() __builtin_amdgcn_sched_barrier(0)
__device__ __forceinline__ int crow(int r, int hi) { return (r & 3) + 8 * (r >> 2) + 4 * hi; }
__device__ __forceinline__ unsigned cvtpk(float lo, float hi) { unsigned r; asm volatile("v_cvt_pk_bf16_f32 %0, %1, %2" : "=v"(r) : "v"(lo), "v"(hi)); return r; }
__device__ __forceinline__ bf16x8 ld8(const bf16_t* p) { return *reinterpret_cast<const bf16x8*>(p); }

__device__ __forceinline__ void partialSM(f32x16& p0, f32x16& p1, float& m_reg, float& mn, float& alpha) {
  constexpr float C = SCALE * 1.4426950408889634f;
  float pmax = p0[0];
#pragma unroll
  for (int r = 1; r < 16; ++r) pmax = fmaxf(pmax, p0[r]);
#pragma unroll
  for (int r = 0; r < 16; ++r) pmax = fmaxf(pmax, p1[r]);
  { auto rr = __builtin_amdgcn_permlane32_swap(__float_as_uint(pmax), __float_as_uint(pmax), false, false);
    pmax = fmaxf(__uint_as_float(rr[0]), __uint_as_float(rr[1])); }
  if (__builtin_expect(__all(pmax - m_reg <= THR / SCALE), 1)) { mn = m_reg; alpha = 1.f; }
  else { mn = fmaxf(m_reg, pmax); alpha = __builtin_amdgcn_exp2f((m_reg - mn) * C); m_reg = mn; }
  float mnC = -mn * C;
#pragma unroll
  for (int r = 0; r < 16; ++r) p0[r] = fmaf(p0[r], C, mnC);
#pragma unroll
  for (int r = 0; r < 16; ++r) p1[r] = fmaf(p1[r], C, mnC);
#pragma unroll
  for (int r = 0; r < 16; ++r) p0[r] = __builtin_amdgcn_exp2f(p0[r]);
}
__device__ __forceinline__ void finishSM(f32x16& p0, f32x16& p1, float alpha, float& l_reg, bf16x8& pa0, bf16x8& pa1, bf16x8& pa2, bf16x8& pa3) {
#pragma unroll
  for (int r = 0; r < 16; ++r) p1[r] = __builtin_amdgcn_exp2f(p1[r]);
  float ps = 0;
#pragma unroll
  for (int r = 0; r < 16; ++r) ps += p0[r];
#pragma unroll
  for (int r = 0; r < 16; ++r) ps += p1[r];
  { auto rr = __builtin_amdgcn_permlane32_swap(__float_as_uint(ps), __float_as_uint(ps), false, false);
    ps = __uint_as_float(rr[0]) + __uint_as_float(rr[1]); }
  l_reg = l_reg * alpha + ps;
#define PK4(P, BASE, OUT) do { unsigned a0 = cvtpk(P[BASE + 0], P[BASE + 1]), a1 = cvtpk(P[BASE + 2], P[BASE + 3]);   \
    unsigned b0 = cvtpk(P[BASE + 4], P[BASE + 5]), b1 = cvtpk(P[BASE + 6], P[BASE + 7]);                              \
    auto r0 = __builtin_amdgcn_permlane32_swap(a0, b0, false, false); auto r1 = __builtin_amdgcn_permlane32_swap(a1, b1, false, false); \
    u32x4 w = {r0[0], r1[0], r0[1], r1[1]}; OUT = *reinterpret_cast<bf16x8*>(&w); } while (0)
  PK4(p0, 0, pa0); PK4(p0, 8, pa1); PK4(p1, 0, pa2); PK4(p1, 8, pa3);
#undef PK4
}
__device__ __forceinline__ void qkt(f32x16& p0, f32x16& p1, const bf16_t* Ks, const bf16x8* qr, int r32, int hi) {
  p0 = f32x16{}; p1 = f32x16{};
#pragma unroll
  for (int d0 = 0; d0 < 8; ++d0) { int cb = (d0 * 16 + hi * 8) * 2;
    bf16x8 b0 = *reinterpret_cast<const bf16x8*>((const char*)Ks + KSWZ(r32, cb));
    bf16x8 b1 = *reinterpret_cast<const bf16x8*>((const char*)Ks + KSWZ(32 + r32, cb));
    p0 = __builtin_amdgcn_mfma_f32_32x32x16_bf16(b0, qr[d0], p0, 0, 0, 0);
    p1 = __builtin_amdgcn_mfma_f32_32x32x16_bf16(b1, qr[d0], p1, 0, 0, 0); }
}
__device__ __forceinline__ int v_st(int k, int c) { const int kk = (k & ~0xC) | ((k & 4) << 1) | ((k & 8) >> 1); return ((kk >> 3) * 4 + (c >> 5)) * 512 + ((kk & 7) * 32 + (c & 31)) * 2; }
__device__ __forceinline__ int v_rd_base(int lane) { return ((lane & 3) << 3) | (((lane >> 2) & 3) << 6) | (((lane >> 4) & 1) << 5) | (((lane >> 5) & 1) << 8); }
constexpr int v_rd_off(int d0, int ks, int half) { return d0 * 512 + ks * 4096 + half * 2048; }
template <int OFF> __device__ __forceinline__ s16x4 tr_read(int vb) {
  s16x4 r; asm volatile("ds_read_b64_tr_b16 %0, %1 offset:%2" : "=&v"(r) : "v"(vb), "i"(OFF) : "memory"); return r;
}
template <int D0> __device__ __forceinline__ void pv_one(f32x16& od, int vb, bf16x8 pa0, bf16x8 pa1, bf16x8 pa2, bf16x8 pa3) {
  const s16x4 l0 = tr_read<v_rd_off(D0, 0, 0)>(vb), h0 = tr_read<v_rd_off(D0, 0, 1)>(vb), l1 = tr_read<v_rd_off(D0, 1, 0)>(vb), h1 = tr_read<v_rd_off(D0, 1, 1)>(vb);
  const s16x4 l2 = tr_read<v_rd_off(D0, 2, 0)>(vb), h2 = tr_read<v_rd_off(D0, 2, 1)>(vb), l3 = tr_read<v_rd_off(D0, 3, 0)>(vb), h3 = tr_read<v_rd_off(D0, 3, 1)>(vb);
  asm volatile("s_waitcnt lgkmcnt(0)" ::: "memory"); SBAR();
#define PK(L, H) (bf16x8){L[0], L[1], L[2], L[3], H[0], H[1], H[2], H[3]}
  od = __builtin_amdgcn_mfma_f32_32x32x16_bf16(pa0, PK(l0, h0), od, 0, 0, 0);
  od = __builtin_amdgcn_mfma_f32_32x32x16_bf16(pa1, PK(l1, h1), od, 0, 0, 0);
  od = __builtin_amdgcn_mfma_f32_32x32x16_bf16(pa2, PK(l2, h2), od, 0, 0, 0);
  od = __builtin_amdgcn_mfma_f32_32x32x16_bf16(pa3, PK(l3, h3), od, 0, 0, 0);
#undef PK
}
__device__ __forceinline__ void pv_d0(f32x16* o, int vb, bf16x8 pa0, bf16x8 pa1, bf16x8 pa2, bf16x8 pa3) {
  pv_one<0>(o[0], vb, pa0, pa1, pa2, pa3); pv_one<1>(o[1], vb, pa0, pa1, pa2, pa3); pv_one<2>(o[2], vb, pa0, pa1, pa2, pa3); pv_one<3>(o[3], vb, pa0, pa1, pa2, pa3);
}

__device__ __forceinline__ void attn_dense_body(const bf16_t* __restrict__ Qb, const bf16_t* __restrict__ Kh, const bf16_t* __restrict__ Vh,
                                                bf16_t* __restrict__ Ob, int seq, char* lds) {
  int tid_ = threadIdx.x; asm volatile("" : "+v"(tid_));
  const int tid = tid_, wid = tid >> 6, lane = tid & 63, r32 = lane & 31, hi = lane >> 5;
  bf16_t* V_lds = (bf16_t*)lds; bf16_t* K_lds = (bf16_t*)(lds + 2 * SHM_V);
  float* ws = (float*)(lds + 2 * SHM_V + 2 * SHM_K) + wid * 64; float* li_l = ws; float* al_l = ws + 32;
  float m_reg = -1e30f, l_reg = 0; f32x16 o[4] = {}; bf16x8 qr[8];
  const bf16_t* Qw = Qb + (long)(wid * QBLK + r32) * LDQ + hi * 8;
#pragma unroll
  for (int d0 = 0; d0 < 8; ++d0) qr[d0] = ld8(Qw + d0 * 16);
  const int sr = tid >> 4, sc = (tid & 15) * 8, vst0 = v_st(sr, sc), vst1 = v_st(32 + sr, sc);
  const int vb0 = (int)(uintptr_t)V_lds + v_rd_base(lane);
  struct { bf16x8 vs0, vs1, ks0, ks1; } sr_[2];
#define SLOAD(i, k0) do { sr_[i].vs0 = ld8(&Vh[(long)((k0) + sr) * LDK + sc]); sr_[i].vs1 = ld8(&Vh[(long)((k0) + 32 + sr) * LDK + sc]); \
    sr_[i].ks0 = ld8(&Kh[(long)((k0) + sr) * LDK + sc]); sr_[i].ks1 = ld8(&Kh[(long)((k0) + 32 + sr) * LDK + sc]); } while (0)
#define SWRITE(b, i) do { *(bf16x8*)((char*)V_lds + (b) * SHM_V + vst0) = sr_[i].vs0;          \
    *(bf16x8*)((char*)V_lds + (b) * SHM_V + vst1) = sr_[i].vs1; int kc = sc * 2;               \
    *(bf16x8*)((char*)K_lds + (b) * SHM_K + KSWZ(sr, kc)) = sr_[i].ks0;                       \
    *(bf16x8*)((char*)K_lds + (b) * SHM_K + KSWZ(32 + sr, kc)) = sr_[i].ks1; } while (0)
#define SWAIT() asm volatile("s_waitcnt vmcnt(4)" ::: "memory")
#define RESC(a) do { if (__any((a) < 1.f)) { if (hi == 0) al_l[r32] = (a); asm volatile("s_waitcnt lgkmcnt(0)" ::: "memory"); \
    _Pragma("unroll") for (int d = 0; d < 4; ++d) _Pragma("unroll") for (int r = 0; r < 16; ++r) o[d][r] *= al_l[crow(r, hi)]; } } while (0)
  f32x16 pA0, pA1, pB0, pB1; float mnA, mnB, alA, alB; bf16x8 pa0, pa1, pa2, pa3; const int NT = seq / KVBLK;
  constexpr int SE = 0, SO = 1;
  SLOAD(SE, 0); asm volatile("s_waitcnt vmcnt(0)" ::: "memory"); SWRITE(0, SE); __syncthreads();
  qkt(pA0, pA1, K_lds, qr, r32, hi); partialSM(pA0, pA1, m_reg, mnA, alA);
  SLOAD(SO, KVBLK); if (2 < NT) SLOAD(SE, 2 * KVBLK);
  SWAIT(); SWRITE(1, SO); __syncthreads();
  for (int j = 1; j + 1 < NT; j += 2) {
    SBAR(); qkt(pB0, pB1, (bf16_t*)((char*)K_lds + SHM_K), qr, r32, hi);
    finishSM(pA0, pA1, alA, l_reg, pa0, pa1, pa2, pa3); SBAR();
    SLOAD(SO, (j + 2) * KVBLK); SBAR();
    pv_d0(o, vb0, pa0, pa1, pa2, pa3); partialSM(pB0, pB1, m_reg, mnB, alB);
    __syncthreads(); SWAIT(); SWRITE(0, SE);
    RESC(alB); __syncthreads();
    SBAR(); qkt(pA0, pA1, K_lds, qr, r32, hi);
    finishSM(pB0, pB1, alB, l_reg, pa0, pa1, pa2, pa3); SBAR();
    if (j + 3 < NT) SLOAD(SE, (j + 3) * KVBLK); SBAR();
    pv_d0(o, vb0 + (int)SHM_V, pa0, pa1, pa2, pa3); partialSM(pA0, pA1, m_reg, mnA, alA);
    __syncthreads(); SWAIT(); SWRITE(1, SO);
    RESC(alA); __syncthreads();
  }
  SBAR(); qkt(pB0, pB1, (bf16_t*)((char*)K_lds + SHM_K), qr, r32, hi);
  finishSM(pA0, pA1, alA, l_reg, pa0, pa1, pa2, pa3); SBAR();
  pv_d0(o, vb0, pa0, pa1, pa2, pa3); partialSM(pB0, pB1, m_reg, mnB, alB);
  __syncthreads(); RESC(alB);
  finishSM(pB0, pB1, alB, l_reg, pa0, pa1, pa2, pa3); SBAR();
  pv_d0(o, vb0 + (int)SHM_V, pa0, pa1, pa2, pa3);
  if (hi == 0) li_l[r32] = l_reg; asm volatile("s_waitcnt lgkmcnt(0)" ::: "memory");
  float rli[16];
#pragma unroll
  for (int r = 0; r < 16; ++r) rli[r] = __builtin_amdgcn_rcpf(li_l[crow(r, hi)]);
  bf16_t* Ow = Ob + (long)(wid * QBLK) * LDO;
#pragma unroll
  for (int r = 0; r < 16; ++r) { int orow = crow(r, hi);
#pragma unroll
    for (int d0 = 0; d0 < 4; ++d0) Ow[(long)orow * LDO + d0 * 32 + r32] = f2bf(o[d0][r] * rli[r]); }
  __syncthreads();
#undef SLOAD
#undef SWRITE
#undef SWAIT
#undef RESC
}
#undef KSWZ
#undef SBAR
}

constexpr int TR_LDS_WAVE = 64 * 65 * 4;
__device__ __forceinline__ void transpose_share(const float* __restrict__ W, int K, int N, bf16_t* __restrict__ WT, int w, int nw, LAS unsigned char* lds, int first = 0, int last = 1 << 30) {
    int tid_ = threadIdx.x; asm volatile("" : "+v"(tid_));
    const int wid = tid_ >> 6, lane = tid_ & 63;
    LAS float* scr = (LAS float*)(lds + wid * TR_LDS_WAVE);
    const int nblk = N / 64; int nitems = (K / 64) * nblk; if (last < nitems) nitems = last;
    const int kr = lane >> 4, n4 = (lane & 15) * 4, c = lane & 7;
    int it = first + w * 8 + wid;
    if (it >= nitems) return;
    f32x4 v[16];
    { const int kb = it / nblk, nb = it - kb * nblk;
#pragma unroll
      for (int i = 0; i < 16; ++i) v[i] = *(const f32x4*)(W + (size_t)(64 * kb + 4 * i + kr) * N + 64 * nb + n4); }
    for (;;) {
        const int kb = it / nblk, nb = it - kb * nblk, k0 = 64 * kb, n0 = 64 * nb;
#pragma unroll
        for (int i = 0; i < 16; ++i) { LAS float* d = scr + (4 * i + kr) * 65 + n4; d[0] = v[i].x; d[1] = v[i].y; d[2] = v[i].z; d[3] = v[i].w; }
        const int nx = it + nw; const bool more = nx < nitems;
        if (more) { const int kb2 = nx / nblk, nb2 = nx - kb2 * nblk;
#pragma unroll
            for (int i = 0; i < 16; ++i) v[i] = *(const f32x4*)(W + (size_t)(64 * kb2 + 4 * i + kr) * N + 64 * nb2 + n4); }
        LDS_WAIT();
#pragma unroll
        for (int j = 0; j < 8; ++j) { const int n = (lane >> 3) + 8 * j; const LAS float* sp = scr + (8 * c) * 65 + n;
            u32x4 o; o.x = cvt_pk_bf16(sp[0 * 65], sp[1 * 65]); o.y = cvt_pk_bf16(sp[2 * 65], sp[3 * 65]); o.z = cvt_pk_bf16(sp[4 * 65], sp[5 * 65]); o.w = cvt_pk_bf16(sp[6 * 65], sp[7 * 65]);
            *(u32x4*)(WT + (size_t)(n0 + n) * K + k0 + 8 * c) = o; }
        LDS_WAIT();
        if (!more) break;
        it = nx;
    }
}

__device__ __forceinline__ void dft_slice(unsigned char* ws, int first, int cnt) {
    bf16_t* dft = (bf16_t*)(ws + WS_DFT);
    for (int q = 0; q < cnt; ++q) {
        const int idx = first + q * 512;
        if (idx >= 2048 * 512) break;
        const int k = idx >> 9, n0 = (idx & 511) * 8, part = n0 >> 11, nn = n0 & 2047;
        float v[8];
#pragma unroll
        for (int e = 0; e < 8; ++e) { const float rev = (float)((k * (nn + e)) & 2047) * (1.0f / 2048.0f); v[e] = part ? __builtin_amdgcn_sinf(rev) : __builtin_amdgcn_cosf(rev); }
        u32x4 o; o.x = cvt_pk_bf16(v[0], v[1]); o.y = cvt_pk_bf16(v[2], v[3]); o.z = cvt_pk_bf16(v[4], v[5]); o.w = cvt_pk_bf16(v[6], v[7]);
        *(u32x4*)(dft + (size_t)k * 4096 + n0) = o;
    }
}

__device__ __forceinline__ void ada_phase(const Params& P, LAS unsigned char* lds, int G) {
    int tid_ = threadIdx.x; asm volatile("" : "+v"(tid_));
    const int tid = tid_, wid = tid >> 6, lane = tid & 63;
    unsigned char* ws = P.ws;
    LAS float* sl = (LAS float*)lds;
    for (int i = tid; i < 5 * DM; i += 512) { const float v = (i < 4 * DM) ? P.in[I_C][i] : P.in[I_CCTX][i - 4 * DM]; sl[i] = v / (1.f + expf(-v)); }
    __syncthreads();
    LAS float* red = (LAS float*)(lds + 40960);
    float* mod = (float*)(ws + WS_MOD);
    const float* w_ada = P.in[I_WADA];
    const int dper = (2048 * 512 / 512 + G - 1) / G, dbase = blockIdx.x * dper * 512; int jd = 0;
    int it = blockIdx.x;
    f32x4 wv[16];
    if (it < 768) { const float* wp = w_ada + (size_t)((it / 48) * 128 + wid * 16) * NMOD6 + (it % 48) * 256 + lane * 4;
#pragma unroll
        for (int i = 0; i < 16; ++i) wv[i] = *(const f32x4*)(wp + (size_t)i * NMOD6); }
    while (it < 768) {
        const int cc = it % 48, kc = it / 48;
        const int kb = kc * 128 + wid * 16;
        f32x4 acc[5];
#pragma unroll
        for (int r = 0; r < 5; ++r) acc[r] = (f32x4){0.f, 0.f, 0.f, 0.f};
#pragma unroll
        for (int i = 0; i < 16; ++i) {
#pragma unroll
            for (int r = 0; r < 5; ++r) { const float s = sl[r * DM + kb + i]; acc[r] += wv[i] * s; }
        }
        const int nx = it + G;
        if (nx < 768) { const float* wp = w_ada + (size_t)((nx / 48) * 128 + wid * 16) * NMOD6 + (nx % 48) * 256 + lane * 4;
#pragma unroll
            for (int i = 0; i < 16; ++i) wv[i] = *(const f32x4*)(wp + (size_t)i * NMOD6); }
        { const int take = (dper - jd) < 3 ? (dper - jd) : 3; dft_slice(ws, dbase + jd * 512 + tid, take); jd += take; }
#pragma unroll
        for (int r = 0; r < 5; ++r) *(LAS f32x4*)(red + (wid * 5 + r) * 256 + lane * 4) = acc[r];
        asm volatile("s_waitcnt lgkmcnt(0)" ::: "memory"); __builtin_amdgcn_s_barrier(); asm volatile("" ::: "memory");
        if (tid < 320) {
            const int r = tid >> 6, q = tid & 63;
            f32x4 s = (f32x4){0.f, 0.f, 0.f, 0.f};
#pragma unroll
            for (int w = 0; w < 8; ++w) s += *(const LAS f32x4*)(red + (w * 5 + r) * 256 + q * 4);
            if (kc == 0) s += *(const f32x4*)(P.in[I_BADA] + cc * 256 + q * 4);
            float* dst = mod + (size_t)r * NMOD6 + cc * 256 + q * 4;
            unsafeAtomicAdd(dst + 0, s[0]); unsafeAtomicAdd(dst + 1, s[1]); unsafeAtomicAdd(dst + 2, s[2]); unsafeAtomicAdd(dst + 3, s[3]);
        }
        asm volatile("s_waitcnt lgkmcnt(0)" ::: "memory"); __builtin_amdgcn_s_barrier(); asm volatile("" ::: "memory");
        it = nx;
    }
    dft_slice(ws, dbase + jd * 512 + tid, dper - jd);
    asm volatile("s_waitcnt vmcnt(0)" ::: "memory");
    __syncthreads();
    if (tid == 0) { __builtin_amdgcn_fence(__ATOMIC_RELEASE, "agent"); asm volatile("s_waitcnt vmcnt(0)" ::: "memory");
                    __hip_atomic_fetch_add((unsigned*)(ws + WS_QCTR), 1u, __ATOMIC_RELAXED, __HIP_MEMORY_SCOPE_AGENT); }
}

__device__ __forceinline__ void gen_tables(const Params& P, LAS unsigned char* lds, int blk, int nblk, int what = 3) {
    int tid_ = threadIdx.x; asm volatile("" : "+v"(tid_));
    const int tid = tid_;
    unsigned char* ws = P.ws;
    LAS float* ct = (LAS float*)lds;
    for (int j = tid; j < 2048; j += 512) ct[j] = cospif((float)j * (1.0f / 1024.0f));
    __syncthreads();
    bf16_t* dft = (bf16_t*)(ws + WS_DFT);
    if (what & 1) for (int idx = blk * 512 + tid; idx < 2048 * 512; idx += nblk * 512) {
        const int k = idx >> 9, n0 = (idx & 511) * 8, part = n0 >> 11, nn = n0 & 2047;
        float v[8];
#pragma unroll
        for (int e = 0; e < 8; ++e) { const int j = (k * (nn + e)) & 2047; v[e] = ct[part ? ((j - 512) & 2047) : j]; }
        u32x4 o; o.x = cvt_pk_bf16(v[0], v[1]); o.y = cvt_pk_bf16(v[2], v[3]); o.z = cvt_pk_bf16(v[4], v[5]); o.w = cvt_pk_bf16(v[6], v[7]);
        *(u32x4*)(dft + (size_t)k * 4096 + n0) = o;
    }
    for (int idx = blk * 512 + tid; idx < 64 * 32; idx += nblk * 512) {
        const int pv = idx >> 5, i = idx & 31;
        const float ang = (float)pv * powf(10000.0f, -(float)(2 * i) / 64.0f);
        float* t = (float*)(ws + WS_ROPE) + (size_t)(pv * 32 + i) * 2;
        t[0] = cosf(ang); t[1] = sinf(ang);
    }
    bf16_t* gt = (bf16_t*)(ws + WS_GT);
    LAS float* wfs = (LAS float*)(lds + 8192);
    const int NS = nblk >= 4 ? nblk / 4 : 1;
    for (int t = blk; t < 4 * NS; t += nblk) {
        const int g = t / NS, sidx = t - g * NS;
        const float* wf = P.in[I_WF] + (size_t)g * 128 * 128;
#pragma unroll
        for (int j = 0; j < 8; ++j) *(LAS f32x4*)(wfs + (tid + 512 * j) * 4) = *(const f32x4*)(wf + (tid + 512 * j) * 4);
        __syncthreads();
        for (int idx = sidx * 512 + tid; idx < 2 * 128 * 128; idx += NS * 512) {
            const int d = idx & 127, cch = (idx >> 7) & 127, part = idx >> 14;
            float sum = 0.f;
#pragma unroll 16
            for (int l = 0; l < 128; ++l) {
                const int j = (cch * l) & 127;
                const float cs = part ? -ct[((j - 32) & 127) * 16] : ct[j * 16];
                sum += cs * wfs[l * 128 + d];
            }
            gt[(size_t)((g * 2 + part) * 128 + d) * 128 + cch] = f2bf(sum * (1.0f / 512.0f));
        }
        __syncthreads();
    }
}

template <int MODE> __device__ __forceinline__ const float* rows_src(const Params& P, int r) {
    if (MODE == 0) return (r < MTOK) ? P.in[I_X] + (size_t)r * DM : P.in[I_CTX] + (size_t)(r - MTOK) * DM;
    return P.out + (size_t)r * DM;
}
template <int MODE> __device__ __forceinline__ void rows_pass(const Params& P, int G) {
    int tid_ = threadIdx.x; asm volatile("" : "+v"(tid_));
    const int tid = tid_, wid = tid >> 6, lane = tid & 63;
    const int gw = blockIdx.x * 8 + wid, NGW = G * 8;
    const int nrows = (MODE == 0) ? (MTOK + MCTX) : MTOK;
    if (MODE == 0) {
        if (tid == 0) { unsigned sp = 0; while (__hip_atomic_load((unsigned*)(P.ws + WS_QCTR), __ATOMIC_RELAXED, __HIP_MEMORY_SCOPE_AGENT) < (unsigned)G) { __builtin_amdgcn_s_sleep(2); if (++sp > (1u << 22)) break; } }
        __syncthreads();
        __builtin_amdgcn_fence(__ATOMIC_ACQUIRE, "agent");
    }
    const float* mod = (const float*)(P.ws + WS_MOD);
    const float* gain = P.in[MODE == 0 ? I_G1 : (MODE == 1 ? I_G2 : I_GF)];
    int r = gw;
    if (r >= nrows) return;
    f32x4 v[8], nv[8];
    { const float* src = rows_src<MODE>(P, r);
#pragma unroll
      for (int j = 0; j < 8; ++j) v[j] = *(const f32x4*)(src + (lane + 64 * j) * 4); }
    for (;;) {
        const int rn = r + NGW; const bool more = rn < nrows;
        if (more) { const float* src = rows_src<MODE>(P, rn);
#pragma unroll
            for (int j = 0; j < 8; ++j) nv[j] = *(const f32x4*)(src + (lane + 64 * j) * 4); }
        const int mr = (MODE == 0 && r >= MTOK) ? 4 : (r >> 11);
        float ss = 0.f;
#pragma unroll
        for (int j = 0; j < 8; ++j) ss += (v[j].x * v[j].x + v[j].y * v[j].y) + (v[j].z * v[j].z + v[j].w * v[j].w);
        const float rstd = rsqrtf(wave_sum(ss) * (1.0f / DM) + EPS);
#pragma unroll
        for (int j = 0; j < 8; ++j) {
            const int col = (lane + 64 * j) * 4;
            const f32x4 g = *(const f32x4*)(gain + col);
            f32x4 y = v[j] * rstd * g;
            if (MODE == 2) { *(f32x4*)(P.out + (size_t)r * DM + col) = y; }
            else {
                const float* mrow = mod + (size_t)mr * NMOD6 + (MODE == 0 ? 0 : 3 * DM);
                const f32x4 sh = *(const f32x4*)(mrow + col), sc = *(const f32x4*)(mrow + DM + col);
                y = y * (1.0f + sc) + sh;
                u32x2 o; o.x = cvt_pk_bf16(y.x, y.y); o.y = cvt_pk_bf16(y.z, y.w);
                bf16_t* dst = (bf16_t*)(P.ws + (MODE == 0 ? WS_H : WS_H2)) + (size_t)r * DM + col;
                *(u32x2*)dst = o;
            }
        }
        if (!more) break;
#pragma unroll
        for (int j = 0; j < 8; ++j) v[j] = nv[j];
        r = rn;
    }
}

__device__ __forceinline__ void attention_phase(const Params& P, unsigned char* lds, int G) {
    const int c = blockIdx.x;
    for (int j = 0;; ++j) {
        int b, h, qb;
        if (G == 256) {
            if (c < 64 || j > 1) break;
            const int grp = (c & 7) + 8 * j, w = (c - 64) >> 3;
            b = grp >> 2; h = (grp & 3) * 3 + (w >> 3); qb = w & 7;
        } else {
            const int au = c + G * j;
            if (au >= NB * NQH * 8) break;
            qb = au & 7; const int bh = au >> 3; h = bh % NQH; b = bh / NQH;
        }
        const bf16_t* Qb = (const bf16_t*)(P.ws + WS_Q) + (size_t)(b * SEQ + qb * 256) * AW + h * HD;
        const bf16_t* Kh = (const bf16_t*)(P.ws + WS_K) + (size_t)(b * NKVH + h / 3) * SKV * HD;
        const bf16_t* Vh = (const bf16_t*)(P.ws + WS_V) + (size_t)(b * NKVH + h / 3) * SKV * HD;
        bf16_t* Ob = (bf16_t*)(P.ws + WS_MIX) + (size_t)(b * SEQ + qb * 256) * DM + h * HD;
        att::attn_dense_body(Qb, Kh, Vh, Ob, SKV, (char*)lds);
    }
}


#define XB_TMO      128
#define XB_XCNT(j)  (256  + 64 * (j))
#define XB_XSUB(j)  (1280 + 64 * (j))
#define XB_XGEN(j)  (2304 + 64 * (j))
#define XB_TOP      3328
#define XB_TOPGEN   3392
#define XCD_BAR_WORDS 3456
#define XB_SPIN_CAP (1u << 22)
__device__ __forceinline__ unsigned xb_ld(unsigned* p)              { return __hip_atomic_load(p, __ATOMIC_RELAXED, __HIP_MEMORY_SCOPE_AGENT); }
__device__ __forceinline__ unsigned xb_add(unsigned* p, unsigned v) { return __hip_atomic_fetch_add(p, v, __ATOMIC_RELAXED, __HIP_MEMORY_SCOPE_AGENT); }
__device__ __forceinline__ unsigned xb_xcc_id() { return (unsigned)__builtin_amdgcn_s_getreg((3 << 11) | 20) & 0xFu; }
#define XB_SPIN(cond, bar) do { unsigned _sp = 0; while (cond) { __builtin_amdgcn_s_sleep(1); \
    if ((++_sp & 255u) == 0u) { if (xb_ld(&(bar)[XB_TMO])) break; if (_sp > XB_SPIN_CAP) { atomicAdd(&(bar)[XB_TMO], 1u); break; } } } } while (0)
struct XcdBarrier { unsigned* bar; unsigned x; volatile LAS unsigned* st; };
__device__ __forceinline__ XcdBarrier xcd_barrier_post(unsigned* bar, volatile LAS unsigned* st) {
    XcdBarrier b; b.bar = bar; b.x = xb_xcc_id(); b.st = st;
    if (threadIdx.x == 0) (void)xb_add(&bar[XB_XCNT(b.x)], 1u);
    return b;
}
__device__ __forceinline__ void xcd_barrier_complete(unsigned* bar, unsigned x, unsigned& nloc, unsigned& nx) {
    const unsigned G = gridDim.x * gridDim.y * gridDim.z;
    unsigned sum, cnt, mine, sp = 0u;
    for (;;) {
        sum = 0u; cnt = 0u; mine = 0u;
#pragma nounroll
        for (unsigned j = 0; j < 16; ++j) { const unsigned c = xb_ld(&bar[XB_XCNT(j)]); sum += c; cnt += (c > 0u) ? 1u : 0u; mine = (j == x) ? c : mine; }
        if (sum == G) break;
        __builtin_amdgcn_s_sleep(1);
        if ((++sp & 255u) == 0u) { if (xb_ld(&bar[XB_TMO])) break; if (sp > XB_SPIN_CAP) { atomicAdd(&bar[XB_TMO], 1u); break; } }
    }
    nloc = mine > 0u ? mine : 1u; nx = cnt > 0u ? cnt : 1u;
}
__device__ __forceinline__ void xcd_barrier(const XcdBarrier& b) {
    asm volatile("s_waitcnt vmcnt(0)" ::: "memory");
    __syncthreads();
    if (threadIdx.x == 0) {
        unsigned* bar = b.bar;
        __builtin_amdgcn_s_waitcnt(0);
        unsigned nloc = b.st[0], nx = b.st[1];
        if (nloc == 0u) { xcd_barrier_complete(bar, b.x, nloc, nx); b.st[0] = nloc; b.st[1] = nx; }
        const unsigned old = xb_add(&bar[XB_XSUB(b.x)], 1u);
        const unsigned gen = old / nloc;
        if (old + 1u == (gen + 1u) * nloc) {
            __builtin_amdgcn_fence(__ATOMIC_RELEASE, "agent");
            asm volatile("s_waitcnt vmcnt(0)" ::: "memory");
            const unsigned og = xb_add(&bar[XB_TOP], 1u);
            const unsigned tg = og / nx;
            if (og + 1u == (tg + 1u) * nx) xb_add(&bar[XB_TOPGEN], 1u);
            else XB_SPIN(xb_ld(&bar[XB_TOPGEN]) == tg, bar);
            __builtin_amdgcn_fence(__ATOMIC_ACQUIRE, "agent");
            xb_add(&bar[XB_XGEN(b.x)], 1u);
            asm volatile("s_waitcnt vmcnt(0)" ::: "memory");
        } else {
            XB_SPIN(xb_ld(&bar[XB_XGEN(b.x)]) == gen, bar);
            __builtin_amdgcn_fence(__ATOMIC_ACQUIRE, "agent");
            asm volatile("s_waitcnt vmcnt(0)" ::: "memory");
        }
    }
    __syncthreads();
}

__global__ void __launch_bounds__(512, 2) fwd_megakernel(Params P_) {
    extern __shared__ __attribute__((aligned(16))) unsigned char lds[];
    cg::grid_group grid = cg::this_grid();
    const int G_ = gridDim.x, c_ = blockIdx.x;
    LAS unsigned char* l3 = (LAS unsigned char*)lds;
    volatile LAS unsigned* misc = (volatile LAS unsigned*)(l3 + LDS_MISC);
    if (threadIdx.x < 64) misc[threadIdx.x] = 0u;
    __syncthreads();
    XcdBarrier xbar = xcd_barrier_post((unsigned*)(P_.ws + WS_BAR), misc + 8);
#if PROBE >= 100
    unsigned long long pt0 = 0, pt1 = 0;
#endif
#pragma nounroll
    for (int ph = 0; ph < 10; ++ph) {
        Params P = P_; int G = G_, c = c_;
        asm volatile("" : "+s"(G), "+s"(c), "+s"(P.ws), "+s"(P.out));
        int gm = -1;
#if PROBE >= 100
        if (ph == PROBE - 100) pt0 = __builtin_amdgcn_s_memrealtime();
        if (ph == PROBE - 99) pt1 = __builtin_amdgcn_s_memrealtime();
#endif
        switch (ph) {
        case 0: ada_phase(P, l3, G); transpose_share(P.in[I_WIN], DM, INW, (bf16_t*)(P.ws + WS_WIN), c, G * 8, l3); transpose_share(P.in[I_WOUT], DM, DM, (bf16_t*)(P.ws + WS_WOUT), c, G * 8, l3); __syncthreads(); gen_tables(P, l3, c, G, 2); __syncthreads();
                break;
        case 1: rows_pass<0>(P, G); break;
        case 2: gm = G_IN; break;
        case 3: if (G != 256) gm = G_F1; break;
        case 4: if (G == 256 && c < 64) {
                    gemm_phase(l3, P, G_F1, 64, c);
                    asm volatile("s_waitcnt vmcnt(0)" ::: "memory"); __syncthreads();
                    if (threadIdx.x == 0) {
                        unsigned* f1c = (unsigned*)(P.ws + WS_QCTR) + 64;
                        __builtin_amdgcn_fence(__ATOMIC_RELEASE, "agent"); asm volatile("s_waitcnt vmcnt(0)" ::: "memory");
                        __hip_atomic_fetch_add(f1c, 1u, __ATOMIC_RELAXED, __HIP_MEMORY_SCOPE_AGENT);
                        unsigned sp = 0; while (__hip_atomic_load(f1c, __ATOMIC_RELAXED, __HIP_MEMORY_SCOPE_AGENT) < 64u) { __builtin_amdgcn_s_sleep(2); if (++sp > (1u << 22)) break; }
                        __builtin_amdgcn_fence(__ATOMIC_ACQUIRE, "agent"); asm volatile("s_waitcnt vmcnt(0)" ::: "memory");
                    }
                    __syncthreads();
                }
                gm = G_F2; break;
        case 5: gm = G_OUT; break;
        case 6: if (G != 256) rows_pass<1>(P, G); break;
        case 7: gm = G_UP; break;
        case 8: gm = G_DOWN; break;
        default: if (G != 256) rows_pass<2>(P, G); break;
        }
#ifndef NO_GEMM
        if (gm >= 0) gemm_phase(l3, P, gm, G, c);
#endif
#ifndef NO_ATT
        if (ph == 4) attention_phase(P, lds, G);
#endif
        if (ph == 2) { if (G != 256) transpose_share(P.in[I_W1], DM, DFF, (bf16_t*)(P.ws + WS_W1), c, G * 8, l3);
                       else if (c >= 144) transpose_share(P.in[I_W1], DM, DFF, (bf16_t*)(P.ws + WS_W1), c - 144, 112 * 8, l3); }
        if (ph == 4) { if (G != 256) transpose_share(P.in[I_W2], DFF, DM, (bf16_t*)(P.ws + WS_W2), c, G * 8, l3);
                       else if (c < 64) transpose_share(P.in[I_W2], DFF, DM, (bf16_t*)(P.ws + WS_W2), c, 64 * 8, l3); }
#if PROBE == 3
        if (ph == 7) { __syncthreads(); gemm_phase(l3, P, gm, G, c); }
#endif
#if PROBE == 4
        if (ph == 4) { __syncthreads(); gemm_phase(l3, P, gm, G, c); attention_phase(P, lds, G); }
#endif
        if (G == 0x7fffffff) grid.sync();
        if (ph > 0 && ph < 9 && !(G == 256 && (ph == 3 || ph == 6 || ph == 8))) xcd_barrier(xbar);
    }
#if PROBE >= 100
    if (PROBE - 99 == 10) pt1 = __builtin_amdgcn_s_memrealtime();
    if (blockIdx.x == 0 && threadIdx.x < 64) {
        const unsigned long long te = __builtin_amdgcn_s_memrealtime(), want = 16ull * (pt1 - pt0);
        while (__builtin_amdgcn_s_memrealtime() - te < want) __builtin_amdgcn_s_sleep(8);
    }
#endif
}

extern "C" void kernel_launch(void* const* d_in, const int* in_sizes, int n_in, void* d_out, int out_size, void* d_ws, size_t ws_size, hipStream_t stream) {
    static int grid_blocks = 0;
    if (grid_blocks == 0) {
        if (n_in != 16 || out_size != MTOK * DM || ws_size < WS_END) { fprintf(stderr, "kernel_launch: unexpected shapes (n_in %d out %d ws %zu)\n", n_in, out_size, ws_size); grid_blocks = -1; return; }
        int dev = 0, cus = 0, per_cu = 0;
        (void)hipGetDevice(&dev);
        (void)hipDeviceGetAttribute(&cus, hipDeviceAttributeMultiprocessorCount, dev);
        if (hipFuncSetAttribute((const void*)fwd_megakernel, hipFuncAttributeMaxDynamicSharedMemorySize, LDS_BYTES) != hipSuccess) { fprintf(stderr, "kernel_launch: hipFuncSetAttribute failed\n"); grid_blocks = -1; return; }
        if (hipOccupancyMaxActiveBlocksPerMultiprocessor(&per_cu, (const void*)fwd_megakernel, 512, LDS_BYTES) != hipSuccess || per_cu < 1) { fprintf(stderr, "kernel_launch: occupancy query failed (%d)\n", per_cu); per_cu = 1; }
        (void)hipGetLastError();
        grid_blocks = cus;
    }
    if (grid_blocks < 0) return;
    (void)hipMemsetAsync((char*)d_ws + WS_MOD, 0, WS_CTL_BYTES, stream);
    Params p{};
    for (int i = 0; i < 16; ++i) p.in[i] = (const float*)d_in[i];
    p.out = (float*)d_out; p.ws = (unsigned char*)d_ws;
    void* args[] = {&p};
    hipError_t e = hipLaunchCooperativeKernel((const void*)fwd_megakernel, dim3(grid_blocks), dim3(512), args, LDS_BYTES, stream);
    if (e != hipSuccess) fprintf(stderr, "cooperative launch failed: %s (grid %d)\n", hipGetErrorString(e), grid_blocks);
}
#ifdef TEST_KERNELS
__global__ void __launch_bounds__(512, 2) t_att(Params P) { extern __shared__ __attribute__((aligned(16))) unsigned char lds[]; attention_phase(P, lds, gridDim.x); }
__global__ void __launch_bounds__(512, 2) t_gemm(Params P, int mode) { extern __shared__ __attribute__((aligned(16))) unsigned char lds[]; gemm_phase((LAS unsigned char*)lds, P, mode, gridDim.x, blockIdx.x); }
__global__ void __launch_bounds__(512, 2) t_gemm_up(Params P) { extern __shared__ __attribute__((aligned(16))) unsigned char lds[]; gemm_phase((LAS unsigned char*)lds, P, G_UP, gridDim.x, blockIdx.x); }
__global__ void __launch_bounds__(512, 2) t_gemm_out(Params P) { extern __shared__ __attribute__((aligned(16))) unsigned char lds[]; gemm_phase((LAS unsigned char*)lds, P, G_OUT, gridDim.x, blockIdx.x); }
#endif
```

```cpp
#include <hip/hip_runtime.h>
#include <hip/hip_bf16.h>
#include <hip/hip_cooperative_groups.h>
#include <cstdio>
#include <cstdint>
namespace cg = cooperative_groups;

#ifndef PROBE
#define PROBE 0
#endif
#define LAS __attribute__((address_space(3)))
typedef unsigned short bf16_t;
typedef short bf16x8 __attribute__((ext_vector_type(8)));
typedef short s16x4 __attribute__((ext_vector_type(4)));
typedef float f32x4 __attribute__((ext_vector_type(4)));
typedef float f32x16 __attribute__((ext_vector_type(16)));
typedef unsigned u32x4 __attribute__((ext_vector_type(4)));
typedef unsigned u32x2 __attribute__((ext_vector_type(2)));

constexpr int DM = 2048, NB = 4, SEQ = 2048, CTXL = 256, HD = 128, NQH = 12, NKVH = 4;
constexpr int AW = 1536, KVW = 512, FW = 512, INW = 3072, DFF = 8192, NMOD6 = 6 * DM;
constexpr int MTOK = NB * SEQ, MCTX = NB * CTXL, SKV = SEQ + CTXL;
constexpr float EPS = 1e-6f;

constexpr size_t MiB = 1u << 20;
constexpr size_t WS_MOD = 0;
constexpr size_t WS_BAR = 245760;
constexpr size_t WS_QCTR = 245760 + 16384;
constexpr size_t WS_XACC = 262144 + 4096;
constexpr size_t WS_CTL_BYTES = 262144 + 4096 + 131072;
constexpr size_t WS_XSLOT = 1 * MiB + 512 * 1024;
constexpr size_t WS_ROPE = 512 * 1024;
constexpr size_t WS_GT = 1 * MiB;
constexpr size_t WS_WIN = 2 * MiB;
constexpr size_t WS_WOUT = 14 * MiB;
constexpr size_t WS_W1 = 22 * MiB;
constexpr size_t WS_W2 = 54 * MiB;
constexpr size_t WS_DFT = 86 * MiB;
constexpr size_t WS_H2 = 102 * MiB;
constexpr size_t WS_H = 134 * MiB;
constexpr size_t WS_Q = 170 * MiB;
constexpr size_t WS_K = 194 * MiB;
constexpr size_t WS_V = 203 * MiB;
constexpr size_t WS_U = 212 * MiB;
constexpr size_t WS_ZT = 220 * MiB;
constexpr size_t WS_MIX = 236 * MiB;
constexpr size_t WS_A1 = 134 * MiB;
constexpr size_t WS_END = 268 * MiB;

constexpr int LDS_MISC = 8 * 64 * 65 * 4;
constexpr int LDS_RED = LDS_MISC + 1024;
constexpr int LDS_BYTES = LDS_RED + 8192;

struct Params { const float* in[16]; float* out; unsigned char* ws; };
enum { I_X = 0, I_C, I_CTX, I_CCTX, I_WADA, I_BADA, I_G1, I_WIN, I_QG, I_KG, I_WF, I_WOUT, I_G2, I_W1, I_W2, I_GF };

__device__ __forceinline__ unsigned cvt_pk_bf16(float lo, float hi) { unsigned r; asm("v_cvt_pk_bf16_f32 %0, %1, %2" : "=v"(r) : "v"(lo), "v"(hi)); return r; }
__device__ __forceinline__ float bf2f(bf16_t v) { return __uint_as_float(((unsigned)v) << 16); }
__device__ __forceinline__ bf16_t f2bf(float f) { return (bf16_t)(cvt_pk_bf16(f, 0.f) & 0xffffu); }
template <int M> __device__ __forceinline__ float swz_xor(float v) { return __int_as_float(__builtin_amdgcn_ds_swizzle(__float_as_int(v), 0x1F | (M << 10))); }
__device__ __forceinline__ float half_sum(float v) { auto rr = __builtin_amdgcn_permlane32_swap(__float_as_uint(v), __float_as_uint(v), false, false); return __uint_as_float(rr[0]) + __uint_as_float(rr[1]); }
__device__ __forceinline__ float wave_sum(float v) {
    v += swz_xor<1>(v); v += swz_xor<2>(v); v += swz_xor<4>(v); v += swz_xor<8>(v); v += swz_xor<16>(v);
    return half_sum(v);
}
#define LDS_WAIT() asm volatile("s_waitcnt lgkmcnt(0)" ::: "memory")

constexpr int BM = 256, BK = 64, HALF = 128, HTB = HALF * BK * 2, NXCD = 8, WGM = 8;
__device__ __forceinline__ int lds_byte(int r, int c) { const int st = (r >> 4) * 2 + (c >> 5), rr = r & 15, cc = c & 31, ob = rr * 64 + cc * 2; return st * 1024 + (ob ^ (((ob >> 9) & 1) << 5)); }
__device__ __forceinline__ void stage_rc(int b, int& R, int& C) { const int st = b / 1024, sb = b % 1024, swz = sb ^ (((sb >> 9) & 1) << 5); R = (st >> 1) * 16 + swz / 64; C = (st & 1) * 32 + (swz % 64) / 2; }
__device__ __forceinline__ int perm32(int rho) { const int n = rho >> 4, i = rho & 15; return 8 * (i >> 2) + 4 * n + (i & 3); }

struct Unit { int pm, pn; const char* a; const char* b; };
enum { G_IN = 0, G_F1, G_F2, G_OUT, G_UP, G_DOWN };

__device__ __forceinline__ void remap_tile(int L, int nM, int nN, int& pm, int& pn) {
    const int nwg = nM * nN; int wgid = L;
    { const int q = nwg / NXCD, r = nwg % NXCD, xcd = wgid % NXCD, off = wgid / NXCD; wgid = (xcd < r ? xcd * (q + 1) : r * (q + 1) + (xcd - r) * q) + off; }
    const int nig = WGM * nN, gid = wgid / nig, fm = gid * WGM, gsz = (nM - fm) < WGM ? (nM - fm) : WGM;
    pm = fm + ((wgid % nig) % gsz); pn = (wgid % nig) / gsz;
}

__device__ __forceinline__ bool get_unit(const unsigned char* ws, int mode, int i, int G, int c, Unit& u) {
    const long L = (long)i * G + c;
    switch (mode) {
    case G_IN: {
        if (L >= 400) return false;
        if (L < 256) remap_tile((int)L, 32, 8, u.pm, u.pn);
        else if (L < 384) { remap_tile((int)L - 256, 32, 4, u.pm, u.pn); u.pn += 8; }
        else { const int idx = (int)L - 384; u.pm = 32 + (idx >> 2); u.pn = 6 + (idx & 3); }
        u.a = (const char*)ws + WS_H + (size_t)u.pm * 256 * DM * 2; u.b = (const char*)ws + WS_WIN + (size_t)u.pn * 256 * DM * 2; return true; }
    case G_F1: {
        if (L >= 128) return false;
        const int g = (int)L >> 5; u.pm = g; u.pn = (int)L & 31;
        u.a = (const char*)ws + WS_GT + (size_t)g * 256 * 128 * 2; u.b = (const char*)ws + WS_U + ((size_t)u.pn * 256 * FW + g * 128) * 2; return true; }
    case G_F2: {
        if (L >= 64) return false;
        const int b = (int)L >> 4, pm = ((int)L >> 1) & 7, pn = (int)L & 1; u.pm = b * 8 + pm; u.pn = pn;
        u.a = (const char*)ws + WS_DFT + (size_t)pm * 256 * 4096 * 2; u.b = (const char*)ws + WS_ZT + ((size_t)(b * 512 + pn * 256) * 4096) * 2; return true; }
    case G_OUT: {
        if (L >= 256) return false;
        remap_tile((int)L, 32, 8, u.pm, u.pn);
        u.a = (const char*)ws + WS_MIX + (size_t)u.pm * 256 * DM * 2; u.b = (const char*)ws + WS_WOUT + (size_t)u.pn * 256 * DM * 2; return true; }
    case G_UP: {
        if (L >= 1024) return false;
        remap_tile((int)L, 32, 32, u.pm, u.pn);
        u.a = (const char*)ws + WS_H2 + (size_t)u.pm * 256 * DM * 2; u.b = (const char*)ws + WS_W1 + (size_t)u.pn * 256 * DM * 2; return true; }
    default: {
        if (L >= 256) return false;
        remap_tile((int)L, 32, 8, u.pm, u.pn);
        u.a = (const char*)ws + WS_A1 + (size_t)u.pm * 256 * DFF * 2; u.b = (const char*)ws + WS_W2 + (size_t)u.pn * 256 * DFF * 2; return true; }
    }
}

__device__ __forceinline__ void gemm_epilogue(const Params& P, int mode, const f32x4 (&acc)[2][2][4][2], const Unit& u, int wr, int wc, int fr, int fq) {
    unsigned char* ws = P.ws;
    if (mode == G_OUT || mode == G_DOWN) {
        const float* resid = (mode == G_OUT) ? P.in[I_X] : P.out;
        const float* gate = (const float*)(ws + WS_MOD) + (size_t)(u.pm >> 3) * NMOD6 + (mode == G_OUT ? 2 * DM : 5 * DM);
        const int col0 = u.pn * 256 + wc * 32 + 4 * fq;
        f32x4 gv[2][2];
#pragma unroll
        for (int bj = 0; bj < 2; ++bj)
#pragma unroll
            for (int n = 0; n < 2; ++n) gv[bj][n] = *(const f32x4*)(gate + col0 + bj * HALF + n * 16);
#pragma unroll
        for (int ai = 0; ai < 2; ++ai)
#pragma unroll
            for (int m = 0; m < 4; ++m) {
                const size_t off = (size_t)(u.pm * 256 + ai * HALF + wr * 64 + m * 16 + fr) * DM + col0;
#pragma unroll
                for (int bj = 0; bj < 2; ++bj)
#pragma unroll
                    for (int n = 0; n < 2; ++n) {
                        const f32x4 r = *(const f32x4*)(resid + off + bj * HALF + n * 16);
                        *(f32x4*)(P.out + off + bj * HALF + n * 16) = r + gv[bj][n] * acc[ai][bj][m][n];
                    }
            }
        return;
    }
    bf16_t* base; size_t ld, aistride, bjstride = HALF;
    if (mode == G_IN) {
        const int pm = u.pm, pn = u.pn;
        if (pn < 6) { base = (bf16_t*)(ws + WS_Q) + (size_t)pm * 256 * AW + pn * 256; ld = AW; }
        else if (pn < 10) {
            const int b = (pm < 32) ? (pm >> 3) : (pm - 32), t0 = (pm < 32) ? CTXL + (pm & 7) * 256 : 0, h0 = ((pn - 6) & 1) * 2;
            base = (bf16_t*)(ws + (pn < 8 ? WS_K : WS_V)) + ((size_t)(b * NKVH + h0) * SKV + t0) * HD; ld = HD; bjstride = (size_t)SKV * HD; }
        else { base = (bf16_t*)(ws + WS_U) + (size_t)pm * 256 * FW + (pn - 10) * 256; ld = FW; }
        aistride = 128 * ld;
    } else if (mode == G_F1) {
        const int g = u.pm, b = u.pn >> 3, s0 = (u.pn & 7) * 256;
        base = (bf16_t*)(ws + WS_ZT) + ((size_t)(b * 512 + g * 128) * 4096 + s0); ld = 4096; aistride = 2048;
    } else if (mode == G_F2) {
        base = (bf16_t*)(ws + WS_MIX) + (size_t)u.pm * 256 * DM + AW + u.pn * 256; ld = DM; aistride = 128 * ld;
    } else {
        base = (bf16_t*)(ws + WS_A1) + (size_t)u.pm * 256 * DFF + u.pn * 256; ld = DFF; aistride = 128 * ld;
    }
    const bool relu2 = (mode == G_UP);
    bf16_t* p0 = base + (size_t)(wr * 64 + fr) * ld + wc * 32 + 8 * fq;
#pragma unroll
    for (int ai = 0; ai < 2; ++ai)
#pragma unroll
        for (int m = 0; m < 4; ++m) {
            bf16_t* rowp = p0 + ai * aistride + (size_t)(m * 16) * ld;
#pragma unroll
            for (int bj = 0; bj < 2; ++bj) {
                f32x4 v0 = acc[ai][bj][m][0], v1 = acc[ai][bj][m][1];
                if (relu2) {
#pragma unroll
                    for (int e = 0; e < 4; ++e) { const float a = fmaxf(v0[e], 0.f), b = fmaxf(v1[e], 0.f); v0[e] = a * a; v1[e] = b * b; }
                }
                u32x4 w; w.x = cvt_pk_bf16(v0[0], v0[1]); w.y = cvt_pk_bf16(v0[2], v0[3]); w.z = cvt_pk_bf16(v1[0], v1[1]); w.w = cvt_pk_bf16(v1[2], v1[3]);
                *(u32x4*)(rowp + bj * bjstride) = w;
            }
        }
}

__device__ __forceinline__ int qk_perm(int R) { const int wc = R >> 5, n = (R >> 4) & 1, p = 16 * wc + (R & 15); return (p < 32 ? p : p + 32) + 32 * n; }
__device__ __forceinline__ void gemm_epilogue_qk(const Params& P, const f32x4 (&acc)[2][2][4][2], const Unit& u, int wr, int wc, int fr, int fq, LAS unsigned char* lds) {
    asm volatile("" : "+v"(fr), "+v"(fq), "+s"(wr), "+s"(wc));
    unsigned char* ws = P.ws;
    LAS float* red = (LAS float*)(lds + LDS_RED);
    const int pm = u.pm, pn = u.pn;
#pragma unroll
    for (int ai = 0; ai < 2; ++ai)
#pragma unroll
        for (int m = 0; m < 4; ++m)
#pragma unroll
            for (int bj = 0; bj < 2; ++bj) {
                const f32x4 a = acc[ai][bj][m][0], b = acc[ai][bj][m][1];
                float ss = ((a.x * a.x + a.y * a.y) + (a.z * a.z + a.w * a.w)) + ((b.x * b.x + b.y * b.y) + (b.z * b.z + b.w * b.w));
                ss += swz_xor<16>(ss); ss = half_sum(ss);
                if (fq == 0) red[(bj * 4 + wc) * 256 + ai * HALF + wr * 64 + m * 16 + fr] = ss;
            }
    asm volatile("s_waitcnt lgkmcnt(0)" ::: "memory"); __builtin_amdgcn_s_barrier(); asm volatile("" ::: "memory");
    const bool isq = pn < 6, rope = pm < 32;
    const int p0 = 16 * wc + 4 * fq, d0 = (p0 < 32) ? p0 : p0 + 32;
    const float* g = P.in[isq ? I_QG : I_KG];
    const f32x4 g0 = *(const f32x4*)(g + d0), g1 = *(const f32x4*)(g + d0 + 32);
    bf16_t* base; size_t ld, bjstride;
    if (isq) { base = (bf16_t*)(ws + WS_Q) + (size_t)pm * 256 * AW + pn * 256; ld = AW; bjstride = HD; }
    else { const int b = rope ? (pm >> 3) : (pm - 32), t0 = rope ? CTXL + (pm & 7) * 256 : 0, h0 = (pn - 6) * 2;
           base = (bf16_t*)(ws + WS_K) + ((size_t)(b * NKVH + h0) * SKV + t0) * HD; ld = HD; bjstride = (size_t)SKV * HD; }
    const float* tab = (const float*)(ws + WS_ROPE);
    const int i0 = 16 * (wc & 1) + 4 * fq;
#pragma unroll
    for (int ai = 0; ai < 2; ++ai)
#pragma unroll
        for (int m = 0; m < 4; ++m) {
            const int rl = ai * HALF + wr * 64 + m * 16 + fr;
            f32x4 cs0 = (f32x4){1.f, 0.f, 1.f, 0.f}, cs1 = cs0;
            if (rope) { const int pos = (pm * 256 + rl) & (SEQ - 1), av = (wc < 2) ? (pos >> 6) : (pos & 63);
                        const f32x4* t = (const f32x4*)(tab + (size_t)(av * 32 + i0) * 2); cs0 = t[0]; cs1 = t[1]; }
#pragma unroll
            for (int bj = 0; bj < 2; ++bj) {
                const float tot = (red[(bj * 4 + 0) * 256 + rl] + red[(bj * 4 + 1) * 256 + rl]) + (red[(bj * 4 + 2) * 256 + rl] + red[(bj * 4 + 3) * 256 + rl]);
                const float rstd = rsqrtf(tot * (1.0f / HD) + EPS);
                const f32x4 x1 = acc[ai][bj][m][0] * rstd * g0, x2 = acc[ai][bj][m][1] * rstd * g1;
                const float a0 = x1.x * cs0.x - x2.x * cs0.y, b0 = x2.x * cs0.x + x1.x * cs0.y;
                const float a1 = x1.y * cs0.z - x2.y * cs0.w, b1 = x2.y * cs0.z + x1.y * cs0.w;
                const float a2 = x1.z * cs1.x - x2.z * cs1.y, b2 = x2.z * cs1.x + x1.z * cs1.y;
                const float a3 = x1.w * cs1.z - x2.w * cs1.w, b3 = x2.w * cs1.z + x1.w * cs1.w;
                bf16_t* rowp = base + (size_t)rl * ld + bj * bjstride + d0;
                u32x2 o1, o2; o1.x = cvt_pk_bf16(a0, a1); o1.y = cvt_pk_bf16(a2, a3); o2.x = cvt_pk_bf16(b0, b1); o2.y = cvt_pk_bf16(b2, b3);
                *(u32x2*)rowp = o1; *(u32x2*)(rowp + 32) = o2;
            }
        }
}

__device__ __forceinline__ void gemm_epilogue_fused(const Params& P, int mode, f32x4 (&acc)[2][2][4][2], const Unit& u, int wr, int wc, int fr, int fq, LAS unsigned char* lds, int tid) {
    unsigned char* ws = P.ws;
    const int x = (mode == G_OUT) ? 0 : 1;
    const float* resid = (mode == G_OUT) ? P.in[I_X] : P.out;
    const float* modb = (const float*)(ws + WS_MOD) + (size_t)(u.pm >> 3) * NMOD6;
    const float* gate = modb + (mode == G_OUT ? 2 * DM : 5 * DM);
    const int col0 = u.pn * 256 + wc * 32 + 4 * fq;
    LAS float* Pq = (LAS float*)lds;
    LAS float* S = (LAS float*)(lds + 4096);
    {
        f32x4 gv[2][2];
#pragma unroll
        for (int bj = 0; bj < 2; ++bj)
#pragma unroll
            for (int n = 0; n < 2; ++n) gv[bj][n] = *(const f32x4*)(gate + col0 + bj * HALF + n * 16);
        f32x4 rbuf[2][2][2];
        const size_t off0 = (size_t)(u.pm * 256 + wr * 64 + fr) * DM + col0;
#pragma unroll
        for (int bj = 0; bj < 2; ++bj)
#pragma unroll
            for (int n = 0; n < 2; ++n) rbuf[0][bj][n] = (mode == G_OUT) ? __builtin_nontemporal_load((const f32x4*)(resid + off0 + bj * HALF + n * 16)) : *(const f32x4*)(resid + off0 + bj * HALF + n * 16);
#pragma unroll
        for (int g = 0; g < 8; ++g) {
            const int ai = g >> 2, m = g & 3;
            const int rl = ai * HALF + wr * 64 + m * 16 + fr;
            const size_t off = (size_t)(u.pm * 256 + rl) * DM + col0;
            if (g < 7) { const int ai2 = (g + 1) >> 2, m2 = (g + 1) & 3; const size_t offn = (size_t)(u.pm * 256 + ai2 * HALF + wr * 64 + m2 * 16 + fr) * DM + col0;
#pragma unroll
                for (int bj = 0; bj < 2; ++bj)
#pragma unroll
                    for (int n = 0; n < 2; ++n) rbuf[(g + 1) & 1][bj][n] = (mode == G_OUT) ? __builtin_nontemporal_load((const f32x4*)(resid + offn + bj * HALF + n * 16)) : *(const f32x4*)(resid + offn + bj * HALF + n * 16); }
            float ss = 0.f;
#pragma unroll
            for (int bj = 0; bj < 2; ++bj)
#pragma unroll
                for (int n = 0; n < 2; ++n) {
                    const f32x4 v = rbuf[g & 1][bj][n] + gv[bj][n] * acc[ai][bj][m][n];
                    acc[ai][bj][m][n] = v;
                    if (mode == G_OUT) *(f32x4*)(P.out + off + bj * HALF + n * 16) = v;
                    ss += (v.x * v.x + v.y * v.y) + (v.z * v.z + v.w * v.w);
                }
            ss += swz_xor<16>(ss); ss = half_sum(ss);
            if (fq == 0) Pq[rl * 4 + wc] = ss;
            asm volatile("" ::: "memory");
        }
    }
    asm volatile("s_waitcnt lgkmcnt(0)" ::: "memory"); __builtin_amdgcn_s_barrier(); asm volatile("" ::: "memory");
    if (tid < 256) {
        const f32x4 q = *(const LAS f32x4*)(Pq + tid * 4);
        const float tot = (q.x + q.y) + (q.z + q.w);
        unsigned long long* w = (unsigned long long*)(ws + WS_XACC) + (size_t)x * MTOK + (size_t)(u.pm * 256 + tid);
        __hip_atomic_fetch_add(w, (1ull << 48) + (unsigned long long)(tot * 65536.0f + 0.5f), __ATOMIC_RELAXED, __HIP_MEMORY_SCOPE_AGENT);
        unsigned long long v; unsigned sp = 0;
        for (;;) { v = __hip_atomic_load(w, __ATOMIC_RELAXED, __HIP_MEMORY_SCOPE_AGENT); if ((v >> 48) >= 8ull) break; __builtin_amdgcn_s_sleep(1); if (++sp > (1u << 22)) break; }
        S[tid] = rsqrtf((float)(v & 0xFFFFFFFFFFFFull) * (1.0f / 65536.0f) * (1.0f / DM) + EPS);
    }
    asm volatile("s_waitcnt lgkmcnt(0)" ::: "memory"); __builtin_amdgcn_s_barrier(); asm volatile("" ::: "memory");
    if (mode == G_OUT) {
        f32x4 gg[2][2], sc[2][2], sh[2][2];
#pragma unroll
        for (int bj = 0; bj < 2; ++bj)
#pragma unroll
            for (int n = 0; n < 2; ++n) { const int cc = col0 + bj * HALF + n * 16; gg[bj][n] = *(const f32x4*)(P.in[I_G2] + cc); sh[bj][n] = *(const f32x4*)(modb + 3 * DM + cc); sc[bj][n] = *(const f32x4*)(modb + 4 * DM + cc) + 1.0f; }
        bf16_t* h2 = (bf16_t*)(ws + WS_H2);
#pragma unroll
        for (int ai = 0; ai < 2; ++ai)
#pragma unroll
            for (int m = 0; m < 4; ++m) {
                const int rl = ai * HALF + wr * 64 + m * 16 + fr; const float rs = S[rl];
                const size_t off = (size_t)(u.pm * 256 + rl) * DM + col0;
#pragma unroll
                for (int bj = 0; bj < 2; ++bj)
#pragma unroll
                    for (int n = 0; n < 2; ++n) {
                        const f32x4 y = (acc[ai][bj][m][n] * rs * gg[bj][n]) * sc[bj][n] + sh[bj][n];
                        u32x2 o; o.x = cvt_pk_bf16(y.x, y.y); o.y = cvt_pk_bf16(y.z, y.w);
                        *(u32x2*)(h2 + off + bj * HALF + n * 16) = o;
                    }
            }
    } else {
        f32x4 gg[2][2];
#pragma unroll
        for (int bj = 0; bj < 2; ++bj)
#pragma unroll
            for (int n = 0; n < 2; ++n) gg[bj][n] = *(const f32x4*)(P.in[I_GF] + col0 + bj * HALF + n * 16);
#pragma unroll
        for (int ai = 0; ai < 2; ++ai)
#pragma unroll
            for (int m = 0; m < 4; ++m) {
                const int rl = ai * HALF + wr * 64 + m * 16 + fr; const float rs = S[rl];
                const size_t off = (size_t)(u.pm * 256 + rl) * DM + col0;
#pragma unroll
                for (int bj = 0; bj < 2; ++bj)
#pragma unroll
                    for (int n = 0; n < 2; ++n) __builtin_nontemporal_store(acc[ai][bj][m][n] * rs * gg[bj][n], (f32x4*)(P.out + off + bj * HALF + n * 16));
            }
    }
    asm volatile("s_waitcnt lgkmcnt(0)" ::: "memory"); __builtin_amdgcn_s_barrier();
}

__device__ __forceinline__ void gemm_phase(LAS unsigned char* lds, const Params& P, const int mode, const int G, const int c) {
    int tid_ = threadIdx.x; asm volatile("" : "+v"(tid_));
    const int tid = tid_, wid = __builtin_amdgcn_readfirstlane(tid >> 6), lane = tid & 63, wr = wid >> 2, wc = wid & 3, fr = lane & 15, fq = lane >> 4;
    int lda, ldb, K; bool perm = true;
    switch (mode) {
    case G_IN: lda = DM; ldb = DM; K = DM; break;
    case G_F1: lda = 128; ldb = FW; K = 128; break;
    case G_F2: lda = 4096; ldb = 4096; K = 4096; break;
    case G_OUT: lda = DM; ldb = DM; K = DM; perm = false; break;
    case G_UP: lda = DM; ldb = DM; K = DM; break;
    default: lda = DFF; ldb = DFF; K = DFF; perm = false; break;
    }
    const int nt = K / BK;
    const bool fusedEpi = (mode == G_OUT || mode == G_DOWN) && G == 256;
    unsigned voffA[2];
#pragma unroll
    for (int i = 0; i < 2; ++i) { int R, C; stage_rc(tid * 16 + i * 8192, R, C); voffA[i] = (unsigned)(R * lda + C) * 2u; }
#define PG8_BOFF(i, qk) ([&]() { int R, C; stage_rc(tid * 16 + (i) * 8192, R, C); const int Rb = (qk) ? qk_perm(R) : (perm ? ((R & ~31) + perm32(R & 31)) : R); return (unsigned)(Rb * ldb + C) * 2u; }())
    const size_t kstep = (size_t)(BK * 2);
    const size_t hstepA = (size_t)HALF * lda * 2, hstepB = (size_t)HALF * ldb * 2;
    const unsigned ldsw = (unsigned)wid * 1024u;
    const int aoff = lds_byte(wr * 64 + fr, fq * 8), boff = lds_byte(wc * 32 + fr, fq * 8);
#define PG8_SA(b, h) (((b) * 2 + (h)) * HTB)
#define PG8_SB(b, h) ((4 + (b) * 2 + (h)) * HTB)
#define PG8_STAGE(bufoff, gbase, voff) do { _Pragma("unroll") for (int _i = 0; _i < 2; ++_i) \
        __builtin_amdgcn_global_load_lds((const unsigned*)((const char*)(gbase) + (voff)[_i]), (LAS unsigned*)(lds + (bufoff) + ldsw + _i * 8192), 16, 0, 0); } while (0)
#define PG8_LDA(dst, b, h) do { _Pragma("unroll") for (int m = 0; m < 4; ++m) _Pragma("unroll") for (int k = 0; k < 2; ++k) dst[m][k] = *(const LAS bf16x8*)(lds + PG8_SA(b, h) + aoff + m * 2048 + k * 1024); } while (0)
#define PG8_LDB(dst, b, h) do { _Pragma("unroll") for (int n = 0; n < 2; ++n) _Pragma("unroll") for (int k = 0; k < 2; ++k) dst[n][k] = *(const LAS bf16x8*)(lds + PG8_SB(b, h) + boff + n * 2048 + k * 1024); } while (0)
#define PG8_MMA(ai, bj, At, Bt) do { __builtin_amdgcn_s_setprio(1); _Pragma("unroll") for (int m = 0; m < 4; ++m) _Pragma("unroll") for (int n = 0; n < 2; ++n) _Pragma("unroll") for (int k = 0; k < 2; ++k) \
        acc[ai][bj][m][n] = __builtin_amdgcn_mfma_f32_16x16x32_bf16(Bt[n][k], At[m][k], acc[ai][bj][m][n], 0, 0, 0); __builtin_amdgcn_s_setprio(0); } while (0)
#define PG8_WAIT_V(n) asm volatile("s_waitcnt vmcnt(" #n ")" ::: "memory")
#define PG8_WAIT_L(n) asm volatile("s_waitcnt lgkmcnt(" #n ")" ::: "memory")
#define PG8_BAR __builtin_amdgcn_s_barrier()
#define PG8_SCHED __builtin_amdgcn_sched_barrier(0)
    Unit cur, nxt; int ui = 0;
    if (!get_unit(P.ws, mode, 0, G, c, cur)) return;
    f32x4 acc[2][2][4][2];
#pragma unroll
    for (int a = 0; a < 2; ++a)
#pragma unroll
        for (int b = 0; b < 2; ++b)
#pragma unroll
            for (int m = 0; m < 4; ++m)
#pragma unroll
                for (int n = 0; n < 2; ++n) acc[a][b][m][n] = (f32x4){0.f, 0.f, 0.f, 0.f};
    bf16x8 At[4][2], B0[2][2], B1[2][2];
    const char* cA = cur.a; const char* cB = cur.b;
    bool cqk = (mode == G_IN) && cur.pn < 8;
    unsigned voffB[2] = {PG8_BOFF(0, cqk), PG8_BOFF(1, cqk)};
    PG8_STAGE(PG8_SB(0, 0), cB, voffB); PG8_STAGE(PG8_SB(0, 1), cB + hstepB, voffB); PG8_STAGE(PG8_SA(0, 0), cA, voffA); PG8_STAGE(PG8_SA(0, 1), cA + hstepA, voffA);
    if (wr == 1) PG8_BAR;
    PG8_WAIT_V(2); PG8_BAR;
    PG8_STAGE(PG8_SB(1, 0), cB + kstep, voffB); PG8_STAGE(PG8_SA(1, 0), cA + kstep, voffA); PG8_STAGE(PG8_SB(1, 1), cB + hstepB + kstep, voffB);
    PG8_WAIT_V(6); PG8_BAR;
    for (;;) {
        const bool has_next = get_unit(P.ws, mode, ui + 1, G, c, nxt);
        const char* nA = has_next ? nxt.a : cA; const char* nB = has_next ? nxt.b : cB;
        const bool nqk = has_next ? ((mode == G_IN) && nxt.pn < 8) : cqk;
        for (int t = 0; t < nt; t += 2) {
            const bool last = (t == nt - 2);
            unsigned vb2[2] = {voffB[0], voffB[1]};
            if (last && nqk != cqk) { vb2[0] = PG8_BOFF(0, nqk); vb2[1] = PG8_BOFF(1, nqk); }
            const char* a1 = cA + (size_t)(t + 1) * kstep;
            const char* a2 = last ? nA : cA + (size_t)(t + 2) * kstep; const char* b2 = last ? nB : cB + (size_t)(t + 2) * kstep;
            const char* a3 = a2 + kstep; const char* b3 = b2 + kstep;
            PG8_LDB(B0, 0, 0); PG8_LDB(B1, 0, 1); PG8_SCHED; PG8_LDA(At, 0, 0); PG8_STAGE(PG8_SA(1, 1), a1 + hstepA, voffA);
            PG8_WAIT_V(8); PG8_WAIT_L(0); PG8_BAR; PG8_MMA(0, 0, At, B0); PG8_MMA(0, 1, At, B1); PG8_BAR; PG8_SCHED;
            PG8_LDA(At, 0, 1); PG8_STAGE(PG8_SB(0, 0), b2, vb2); PG8_STAGE(PG8_SB(0, 1), b2 + hstepB, vb2); PG8_STAGE(PG8_SA(0, 0), a2, voffA);
            PG8_WAIT_V(8); PG8_WAIT_L(0); PG8_BAR; PG8_MMA(1, 0, At, B0); PG8_MMA(1, 1, At, B1); PG8_BAR; PG8_SCHED;
            PG8_LDB(B0, 1, 0); PG8_LDB(B1, 1, 1); PG8_SCHED; PG8_LDA(At, 1, 0); PG8_STAGE(PG8_SA(0, 1), a2 + hstepA, voffA);
            PG8_WAIT_V(8); PG8_WAIT_L(0); PG8_BAR; PG8_MMA(0, 0, At, B0); PG8_MMA(0, 1, At, B1); PG8_BAR; PG8_SCHED;
            PG8_LDA(At, 1, 1); PG8_STAGE(PG8_SB(1, 0), b3, vb2); PG8_STAGE(PG8_SB(1, 1), b3 + hstepB, vb2); PG8_STAGE(PG8_SA(1, 0), a3, voffA);
            PG8_WAIT_V(8); PG8_WAIT_L(0); PG8_BAR; PG8_MMA(1, 0, At, B0); PG8_MMA(1, 1, At, B1); PG8_BAR; PG8_SCHED;
        }
        if (wr == 0) PG8_BAR;
        if (cqk) gemm_epilogue_qk(P, acc, cur, wr, wc, fr, fq, lds);
        else if (!fusedEpi) gemm_epilogue(P, mode, acc, cur, wr, wc, fr, fq);
        if (!has_next) break;
#pragma unroll
        for (int a = 0; a < 2; ++a)
#pragma unroll
            for (int b = 0; b < 2; ++b)
#pragma unroll
                for (int m = 0; m < 4; ++m)
#pragma unroll
                    for (int n = 0; n < 2; ++n) acc[a][b][m][n] = (f32x4){0.f, 0.f, 0.f, 0.f};
        cur = nxt; cA = nA; cB = nB; ++ui; if (nqk != cqk) { cqk = nqk; voffB[0] = PG8_BOFF(0, cqk); voffB[1] = PG8_BOFF(1, cqk); }
        if (wr == 1) PG8_BAR;
    }
    PG8_WAIT_V(0);
    PG8_BAR;
    if (fusedEpi) gemm_epilogue_fused(P, mode, acc, cur, wr, wc, fr, fq, lds, tid);
#undef PG8_BOFF
#undef PG8_SA
#undef PG8_SB
#undef PG8_STAGE
#undef PG8_LDA
#undef PG8_LDB
#undef PG8_MMA
#undef PG8_WAIT_V
#undef PG8_WAIT_L
#undef PG8_BAR
#undef PG8_SCHED
}

namespace att {
constexpr int D = 128, NW = 8, QBLK = 32, KVBLK = 64;
constexpr float SCALE = 0.088388347648318440f;
constexpr float THR = 8.f;
constexpr int LDQ = AW, LDK = HD, LDO = DM;
constexpr size_t SHM_V = KVBLK * D * 2, SHM_K = KVBLK * D * 2, SHM_ATTN = 2 * SHM_V + 2 * SHM_K + NW * 64 * 4;
#define KSWZ(row, colB) ((row) * 256 + ((colB) ^ (((row) & 7) << 4)))
#define SBAR() __builtin_amdgcn_sched_barrier(0)
__device__ __forceinline__ int crow(int r, int hi) { return (r & 3) + 8 * (r >> 2) + 4 * hi; }
__device__ __forceinline__ unsigned cvtpk(float lo, float hi) { unsigned r; asm volatile("v_cvt_pk_bf16_f32 %0, %1, %2" : "=v"(r) : "v"(lo), "v"(hi)); return r; }
__device__ __forceinline__ bf16x8 ld8(const bf16_t* p) { return *reinterpret_cast<const bf16x8*>(p); }

__device__ __forceinline__ void partialSM(f32x16& p0, f32x16& p1, float& m_reg, float& mn, float& alpha) {
  constexpr float C = SCALE * 1.4426950408889634f;
  float pmax = p0[0];
#pragma unroll
  for (int r = 1; r < 16; ++r) pmax = fmaxf(pmax, p0[r]);
#pragma unroll
  for (int r = 0; r < 16; ++r) pmax = fmaxf(pmax, p1[r]);
  { auto rr = __builtin_amdgcn_permlane32_swap(__float_as_uint(pmax), __float_as_uint(pmax), false, false);
    pmax = fmaxf(__uint_as_float(rr[0]), __uint_as_float(rr[1])); }
  if (__builtin_expect(__all(pmax - m_reg <= THR / SCALE), 1)) { mn = m_reg; alpha = 1.f; }
  else { mn = fmaxf(m_reg, pmax); alpha = __builtin_amdgcn_exp2f((m_reg - mn) * C); m_reg = mn; }
  float mnC = -mn * C;
#pragma unroll
  for (int r = 0; r < 16; ++r) p0[r] = fmaf(p0[r], C, mnC);
#pragma unroll
  for (int r = 0; r < 16; ++r) p1[r] = fmaf(p1[r], C, mnC);
#pragma unroll
  for (int r = 0; r < 16; ++r) p0[r] = __builtin_amdgcn_exp2f(p0[r]);
}
__device__ __forceinline__ void finishSM(f32x16& p0, f32x16& p1, float alpha, float& l_reg, bf16x8& pa0, bf16x8& pa1, bf16x8& pa2, bf16x8& pa3) {
#pragma unroll
  for (int r = 0; r < 16; ++r) p1[r] = __builtin_amdgcn_exp2f(p1[r]);
  float ps = 0;
#pragma unroll
  for (int r = 0; r < 16; ++r) ps += p0[r];
#pragma unroll
  for (int r = 0; r < 16; ++r) ps += p1[r];
  { auto rr = __builtin_amdgcn_permlane32_swap(__float_as_uint(ps), __float_as_uint(ps), false, false);
    ps = __uint_as_float(rr[0]) + __uint_as_float(rr[1]); }
  l_reg = l_reg * alpha + ps;
#define PK4(P, BASE, OUT) do { unsigned a0 = cvtpk(P[BASE + 0], P[BASE + 1]), a1 = cvtpk(P[BASE + 2], P[BASE + 3]);   \
    unsigned b0 = cvtpk(P[BASE + 4], P[BASE + 5]), b1 = cvtpk(P[BASE + 6], P[BASE + 7]);                              \
    auto r0 = __builtin_amdgcn_permlane32_swap(a0, b0, false, false); auto r1 = __builtin_amdgcn_permlane32_swap(a1, b1, false, false); \
    u32x4 w = {r0[0], r1[0], r0[1], r1[1]}; OUT = *reinterpret_cast<bf16x8*>(&w); } while (0)
  PK4(p0, 0, pa0); PK4(p0, 8, pa1); PK4(p1, 0, pa2); PK4(p1, 8, pa3);
#undef PK4
}
__device__ __forceinline__ void qkt(f32x16& p0, f32x16& p1, const bf16_t* Ks, const bf16x8* qr, int r32, int hi) {
  p0 = f32x16{}; p1 = f32x16{};
#pragma unroll
  for (int d0 = 0; d0 < 8; ++d0) { int cb = (d0 * 16 + hi * 8) * 2;
    bf16x8 b0 = *reinterpret_cast<const bf16x8*>((const char*)Ks + KSWZ(r32, cb));
    bf16x8 b1 = *reinterpret_cast<const bf16x8*>((const char*)Ks + KSWZ(32 + r32, cb));
    p0 = __builtin_amdgcn_mfma_f32_32x32x16_bf16(b0, qr[d0], p0, 0, 0, 0);
    p1 = __builtin_amdgcn_mfma_f32_32x32x16_bf16(b1, qr[d0], p1, 0, 0, 0); }
}
__device__ __forceinline__ int v_st(int k, int c) { const int kk = (k & ~0xC) | ((k & 4) << 1) | ((k & 8) >> 1); return ((kk >> 3) * 4 + (c >> 5)) * 512 + ((kk & 7) * 32 + (c & 31)) * 2; }
__device__ __forceinline__ int v_rd_base(int lane) { return ((lane & 3) << 3) | (((lane >> 2) & 3) << 6) | (((lane >> 4) & 1) << 5) | (((lane >> 5) & 1) << 8); }
constexpr int v_rd_off(int d0, int ks, int half) { return d0 * 512 + ks * 4096 + half * 2048; }
template <int OFF> __device__ __forceinline__ s16x4 tr_read(int vb) {
  s16x4 r; asm volatile("ds_read_b64_tr_b16 %0, %1 offset:%2" : "=&v"(r) : "v"(vb), "i"(OFF) : "memory"); return r;
}
template <int D0> __device__ __forceinline__ void pv_one(f32x16& od, int vb, bf16x8 pa0, bf16x8 pa1, bf16x8 pa2, bf16x8 pa3) {
  const s16x4 l0 = tr_read<v_rd_off(D0, 0, 0)>(vb), h0 = tr_read<v_rd_off(D0, 0, 1)>(vb), l1 = tr_read<v_rd_off(D0, 1, 0)>(vb), h1 = tr_read<v_rd_off(D0, 1, 1)>(vb);
  const s16x4 l2 = tr_read<v_rd_off(D0, 2, 0)>(vb), h2 = tr_read<v_rd_off(D0, 2, 1)>(vb), l3 = tr_read<v_rd_off(D0, 3, 0)>(vb), h3 = tr_read<v_rd_off(D0, 3, 1)>(vb);
  asm volatile("s_waitcnt lgkmcnt(0)" ::: "memory"); SBAR();
#define PK(L, H) (bf16x8){L[0], L[1], L[2], L[3], H[0], H[1], H[2], H[3]}
  od = __builtin_amdgcn_mfma_f32_32x32x16_bf16(pa0, PK(l0, h0), od, 0, 0, 0);
  od = __builtin_amdgcn_mfma_f32_32x32x16_bf16(pa1, PK(l1, h1), od, 0, 0, 0);
  od = __builtin_amdgcn_mfma_f32_32x32x16_bf16(pa2, PK(l2, h2), od, 0, 0, 0);
  od = __builtin_amdgcn_mfma_f32_32x32x16_bf16(pa3, PK(l3, h3), od, 0, 0, 0);
#undef PK
}
__device__ __forceinline__ void pv_d0(f32x16* o, int vb, bf16x8 pa0, bf16x8 pa1, bf16x8 pa2, bf16x8 pa3) {
  pv_one<0>(o[0], vb, pa0, pa1, pa2, pa3); pv_one<1>(o[1], vb, pa0, pa1, pa2, pa3); pv_one<2>(o[2], vb, pa0, pa1, pa2, pa3); pv_one<3>(o[3], vb, pa0, pa1, pa2, pa3);
}

__device__ __forceinline__ void attn_dense_body(const bf16_t* __restrict__ Qb, const bf16_t* __restrict__ Kh, const bf16_t* __restrict__ Vh,
                                                bf16_t* __restrict__ Ob, int seq, char* lds) {
  int tid_ = threadIdx.x; asm volatile("" : "+v"(tid_));
  const int tid = tid_, wid = tid >> 6, lane = tid & 63, r32 = lane & 31, hi = lane >> 5;
  bf16_t* V_lds = (bf16_t*)lds; bf16_t* K_lds = (bf16_t*)(lds + 2 * SHM_V);
  float* ws = (float*)(lds + 2 * SHM_V + 2 * SHM_K) + wid * 64; float* li_l = ws; float* al_l = ws + 32;
  float m_reg = -1e30f, l_reg = 0; f32x16 o[4] = {}; bf16x8 qr[8];
  const bf16_t* Qw = Qb + (long)(wid * QBLK + r32) * LDQ + hi * 8;
#pragma unroll
  for (int d0 = 0; d0 < 8; ++d0) qr[d0] = ld8(Qw + d0 * 16);
  const int sr = tid >> 4, sc = (tid & 15) * 8, vst0 = v_st(sr, sc), vst1 = v_st(32 + sr, sc);
  const int vb0 = (int)(uintptr_t)V_lds + v_rd_base(lane);
  struct { bf16x8 vs0, vs1, ks0, ks1; } sr_[2];
#define SLOAD(i, k0) do { sr_[i].vs0 = ld8(&Vh[(long)((k0) + sr) * LDK + sc]); sr_[i].vs1 = ld8(&Vh[(long)((k0) + 32 + sr) * LDK + sc]); \
    sr_[i].ks0 = ld8(&Kh[(long)((k0) + sr) * LDK + sc]); sr_[i].ks1 = ld8(&Kh[(long)((k0) + 32 + sr) * LDK + sc]); } while (0)
#define SWRITE(b, i) do { *(bf16x8*)((char*)V_lds + (b) * SHM_V + vst0) = sr_[i].vs0;          \
    *(bf16x8*)((char*)V_lds + (b) * SHM_V + vst1) = sr_[i].vs1; int kc = sc * 2;               \
    *(bf16x8*)((char*)K_lds + (b) * SHM_K + KSWZ(sr, kc)) = sr_[i].ks0;                       \
    *(bf16x8*)((char*)K_lds + (b) * SHM_K + KSWZ(32 + sr, kc)) = sr_[i].ks1; } while (0)
#define SWAIT() asm volatile("s_waitcnt vmcnt(4)" ::: "memory")
#define RESC(a) do { if (__any((a) < 1.f)) { if (hi == 0) al_l[r32] = (a); asm volatile("s_waitcnt lgkmcnt(0)" ::: "memory"); \
    _Pragma("unroll") for (int d = 0; d < 4; ++d) _Pragma("unroll") for (int r = 0; r < 16; ++r) o[d][r] *= al_l[crow(r, hi)]; } } while (0)
  f32x16 pA0, pA1, pB0, pB1; float mnA, mnB, alA, alB; bf16x8 pa0, pa1, pa2, pa3; const int NT = seq / KVBLK;
  constexpr int SE = 0, SO = 1;
  SLOAD(SE, 0); asm volatile("s_waitcnt vmcnt(0)" ::: "memory"); SWRITE(0, SE); __syncthreads();
  qkt(pA0, pA1, K_lds, qr, r32, hi); partialSM(pA0, pA1, m_reg, mnA, alA);
  SLOAD(SO, KVBLK); if (2 < NT) SLOAD(SE, 2 * KVBLK);
  SWAIT(); SWRITE(1, SO); __syncthreads();
  for (int j = 1; j + 1 < NT; j += 2) {
    SBAR(); qkt(pB0, pB1, (bf16_t*)((char*)K_lds + SHM_K), qr, r32, hi);
    finishSM(pA0, pA1, alA, l_reg, pa0, pa1, pa2, pa3); SBAR();
    SLOAD(SO, (j + 2) * KVBLK); SBAR();
    pv_d0(o, vb0, pa0, pa1, pa2, pa3); partialSM(pB0, pB1, m_reg, mnB, alB);
    __syncthreads(); SWAIT(); SWRITE(0, SE);
    RESC(alB); __syncthreads();
    SBAR(); qkt(pA0, pA1, K_lds, qr, r32, hi);
    finishSM(pB0, pB1, alB, l_reg, pa0, pa1, pa2, pa3); SBAR();
    if (j + 3 < NT) SLOAD(SE, (j + 3) * KVBLK); SBAR();
    pv_d0(o, vb0 + (int)SHM_V, pa0, pa1, pa2, pa3); partialSM(pA0, pA1, m_reg, mnA, alA);
    __syncthreads(); SWAIT(); SWRITE(1, SO);
    RESC(alA); __syncthreads();
  }
  SBAR(); qkt(pB0, pB1, (bf16_t*)((char*)K_lds + SHM_K), qr, r32, hi);
  finishSM(pA0, pA1, alA, l_reg, pa0, pa1, pa2, pa3); SBAR();
  pv_d0(o, vb0, pa0, pa1, pa2, pa3); partialSM(pB0, pB1, m_reg, mnB, alB);
  __syncthreads(); RESC(alB);
  finishSM(pB0, pB1, alB, l_reg, pa0, pa1, pa2, pa3); SBAR();
  pv_d0(o, vb0 + (int)SHM_V, pa0, pa1, pa2, pa3);
  if (hi == 0) li_l[r32] = l_reg; asm volatile("s_waitcnt lgkmcnt(0)" ::: "memory");
  float rli[16];
#pragma unroll
  for (int r = 0; r < 16; ++r) rli[r] = __builtin_amdgcn_rcpf(li_l[crow(r, hi)]);
  bf16_t* Ow = Ob + (long)(wid * QBLK) * LDO;
#pragma unroll
  for (int r = 0; r < 16; ++r) { int orow = crow(r, hi);
#pragma unroll
    for (int d0 = 0; d0 < 4; ++d0) Ow[(long)orow * LDO + d0 * 32 + r32] = f2bf(o[d0][r] * rli[r]); }
  __syncthreads();
#undef SLOAD
#undef SWRITE
#undef SWAIT
#undef RESC
}
#undef KSWZ
#undef SBAR
}

constexpr int TR_LDS_WAVE = 64 * 65 * 4;
__device__ __forceinline__ void transpose_share(const float* __restrict__ W, int K, int N, bf16_t* __restrict__ WT, int w, int nw, LAS unsigned char* lds, int first = 0, int last = 1 << 30) {
    int tid_ = threadIdx.x; asm volatile("" : "+v"(tid_));
    const int wid = tid_ >> 6, lane = tid_ & 63;
    LAS float* scr = (LAS float*)(lds + wid * TR_LDS_WAVE);
    const int nblk = N / 64; int nitems = (K / 64) * nblk; if (last < nitems) nitems = last;
    const int kr = lane >> 4, n4 = (lane & 15) * 4, c = lane & 7;
    int it = first + w * 8 + wid;
    if (it >= nitems) return;
    f32x4 v[16];
    { const int kb = it / nblk, nb = it - kb * nblk;
#pragma unroll
      for (int i = 0; i < 16; ++i) v[i] = __builtin_nontemporal_load((const f32x4*)(W + (size_t)(64 * kb + 4 * i + kr) * N + 64 * nb + n4)); }
    for (;;) {
        const int kb = it / nblk, nb = it - kb * nblk, k0 = 64 * kb, n0 = 64 * nb;
#pragma unroll
        for (int i = 0; i < 16; ++i) { LAS float* d = scr + (4 * i + kr) * 65 + n4; d[0] = v[i].x; d[1] = v[i].y; d[2] = v[i].z; d[3] = v[i].w; }
        const int nx = it + nw; const bool more = nx < nitems;
        if (more) { const int kb2 = nx / nblk, nb2 = nx - kb2 * nblk;
#pragma unroll
            for (int i = 0; i < 16; ++i) v[i] = __builtin_nontemporal_load((const f32x4*)(W + (size_t)(64 * kb2 + 4 * i + kr) * N + 64 * nb2 + n4)); }
        LDS_WAIT();
#pragma unroll
        for (int j = 0; j < 8; ++j) { const int n = (lane >> 3) + 8 * j; const LAS float* sp = scr + (8 * c) * 65 + n;
            u32x4 o; o.x = cvt_pk_bf16(sp[0 * 65], sp[1 * 65]); o.y = cvt_pk_bf16(sp[2 * 65], sp[3 * 65]); o.z = cvt_pk_bf16(sp[4 * 65], sp[5 * 65]); o.w = cvt_pk_bf16(sp[6 * 65], sp[7 * 65]);
            *(u32x4*)(WT + (size_t)(n0 + n) * K + k0 + 8 * c) = o; }
        LDS_WAIT();
        if (!more) break;
        it = nx;
    }
}

__device__ __forceinline__ void dft_slice(unsigned char* ws, int first, int cnt) {
    bf16_t* dft = (bf16_t*)(ws + WS_DFT);
    for (int q = 0; q < cnt; ++q) {
        const int idx = first + q * 512;
        if (idx >= 2048 * 512) break;
        const int k = idx >> 9, n0 = (idx & 511) * 8, part = n0 >> 11, nn = n0 & 2047;
        float v[8];
#pragma unroll
        for (int e = 0; e < 8; ++e) { const float rev = (float)((k * (nn + e)) & 2047) * (1.0f / 2048.0f); v[e] = part ? __builtin_amdgcn_sinf(rev) : __builtin_amdgcn_cosf(rev); }
        u32x4 o; o.x = cvt_pk_bf16(v[0], v[1]); o.y = cvt_pk_bf16(v[2], v[3]); o.z = cvt_pk_bf16(v[4], v[5]); o.w = cvt_pk_bf16(v[6], v[7]);
        *(u32x4*)(dft + (size_t)k * 4096 + n0) = o;
    }
}

__device__ __forceinline__ void ada_phase(const Params& P, LAS unsigned char* lds, int G) {
    int tid_ = threadIdx.x; asm volatile("" : "+v"(tid_));
    const int tid = tid_, wid = tid >> 6, lane = tid & 63;
    unsigned char* ws = P.ws;
    LAS float* sl = (LAS float*)lds;
    for (int i = tid; i < 5 * DM; i += 512) { const float v = (i < 4 * DM) ? P.in[I_C][i] : P.in[I_CCTX][i - 4 * DM]; sl[i] = v / (1.f + expf(-v)); }
    __syncthreads();
    LAS float* red = (LAS float*)(lds + 40960);
    float* mod = (float*)(ws + WS_MOD);
    const float* w_ada = P.in[I_WADA];
    const int dper = (2048 * 512 / 512 + G - 1) / G, dbase = blockIdx.x * dper * 512; int jd = 0;
    int it = blockIdx.x;
    f32x4 wv[16];
    if (it < 768) { const float* wp = w_ada + (size_t)((it / 48) * 128 + wid * 16) * NMOD6 + (it % 48) * 256 + lane * 4;
#pragma unroll
        for (int i = 0; i < 16; ++i) wv[i] = __builtin_nontemporal_load((const f32x4*)(wp + (size_t)i * NMOD6)); }
    while (it < 768) {
        const int cc = it % 48, kc = it / 48;
        const int kb = kc * 128 + wid * 16;
        f32x4 acc[5];
#pragma unroll
        for (int r = 0; r < 5; ++r) acc[r] = (f32x4){0.f, 0.f, 0.f, 0.f};
#pragma unroll
        for (int i = 0; i < 16; ++i) {
#pragma unroll
            for (int r = 0; r < 5; ++r) { const float s = sl[r * DM + kb + i]; acc[r] += wv[i] * s; }
        }
        const int nx = it + G;
        if (nx < 768) { const float* wp = w_ada + (size_t)((nx / 48) * 128 + wid * 16) * NMOD6 + (nx % 48) * 256 + lane * 4;
#pragma unroll
            for (int i = 0; i < 16; ++i) wv[i] = __builtin_nontemporal_load((const f32x4*)(wp + (size_t)i * NMOD6)); }
        { const int take = (dper - jd) < 3 ? (dper - jd) : 3; dft_slice(ws, dbase + jd * 512 + tid, take); jd += take; }
#pragma unroll
        for (int r = 0; r < 5; ++r) *(LAS f32x4*)(red + (wid * 5 + r) * 256 + lane * 4) = acc[r];
        asm volatile("s_waitcnt lgkmcnt(0)" ::: "memory"); __builtin_amdgcn_s_barrier(); asm volatile("" ::: "memory");
        if (tid < 320) {
            const int r = tid >> 6, q = tid & 63;
            f32x4 s = (f32x4){0.f, 0.f, 0.f, 0.f};
#pragma unroll
            for (int w = 0; w < 8; ++w) s += *(const LAS f32x4*)(red + (w * 5 + r) * 256 + q * 4);
            if (kc == 0) s += *(const f32x4*)(P.in[I_BADA] + cc * 256 + q * 4);
            float* dst = mod + (size_t)r * NMOD6 + cc * 256 + q * 4;
            unsafeAtomicAdd(dst + 0, s[0]); unsafeAtomicAdd(dst + 1, s[1]); unsafeAtomicAdd(dst + 2, s[2]); unsafeAtomicAdd(dst + 3, s[3]);
        }
        asm volatile("s_waitcnt lgkmcnt(0)" ::: "memory"); __builtin_amdgcn_s_barrier(); asm volatile("" ::: "memory");
        it = nx;
    }
    dft_slice(ws, dbase + jd * 512 + tid, dper - jd);
    asm volatile("s_waitcnt vmcnt(0)" ::: "memory");
    __syncthreads();
    if (tid == 0) { __builtin_amdgcn_fence(__ATOMIC_RELEASE, "agent"); asm volatile("s_waitcnt vmcnt(0)" ::: "memory");
                    __hip_atomic_fetch_add((unsigned*)(ws + WS_QCTR), 1u, __ATOMIC_RELAXED, __HIP_MEMORY_SCOPE_AGENT); }
}

__device__ __forceinline__ void gen_tables(const Params& P, LAS unsigned char* lds, int blk, int nblk, int what = 3) {
    int tid_ = threadIdx.x; asm volatile("" : "+v"(tid_));
    const int tid = tid_;
    unsigned char* ws = P.ws;
    LAS float* ct = (LAS float*)lds;
    for (int j = tid; j < 2048; j += 512) ct[j] = cospif((float)j * (1.0f / 1024.0f));
    __syncthreads();
    bf16_t* dft = (bf16_t*)(ws + WS_DFT);
    if (what & 1) for (int idx = blk * 512 + tid; idx < 2048 * 512; idx += nblk * 512) {
        const int k = idx >> 9, n0 = (idx & 511) * 8, part = n0 >> 11, nn = n0 & 2047;
        float v[8];
#pragma unroll
        for (int e = 0; e < 8; ++e) { const int j = (k * (nn + e)) & 2047; v[e] = ct[part ? ((j - 512) & 2047) : j]; }
        u32x4 o; o.x = cvt_pk_bf16(v[0], v[1]); o.y = cvt_pk_bf16(v[2], v[3]); o.z = cvt_pk_bf16(v[4], v[5]); o.w = cvt_pk_bf16(v[6], v[7]);
        *(u32x4*)(dft + (size_t)k * 4096 + n0) = o;
    }
    for (int idx = blk * 512 + tid; idx < 64 * 32; idx += nblk * 512) {
        const int pv = idx >> 5, i = idx & 31;
        const float ang = (float)pv * powf(10000.0f, -(float)(2 * i) / 64.0f);
        float* t = (float*)(ws + WS_ROPE) + (size_t)(pv * 32 + i) * 2;
        t[0] = cosf(ang); t[1] = sinf(ang);
    }
    bf16_t* gt = (bf16_t*)(ws + WS_GT);
    LAS float* wfs = (LAS float*)(lds + 8192);
    const int NS = nblk >= 4 ? nblk / 4 : 1;
    for (int t = blk; t < 4 * NS; t += nblk) {
        const int g = t / NS, sidx = t - g * NS;
        const float* wf = P.in[I_WF] + (size_t)g * 128 * 128;
#pragma unroll
        for (int j = 0; j < 8; ++j) *(LAS f32x4*)(wfs + (tid + 512 * j) * 4) = *(const f32x4*)(wf + (tid + 512 * j) * 4);
        __syncthreads();
        for (int idx = sidx * 512 + tid; idx < 2 * 128 * 128; idx += NS * 512) {
            const int d = idx & 127, cch = (idx >> 7) & 127, part = idx >> 14;
            float sum = 0.f;
#pragma unroll 16
            for (int l = 0; l < 128; ++l) {
                const int j = (cch * l) & 127;
                const float cs = part ? -ct[((j - 32) & 127) * 16] : ct[j * 16];
                sum += cs * wfs[l * 128 + d];
            }
            gt[(size_t)((g * 2 + part) * 128 + d) * 128 + cch] = f2bf(sum * (1.0f / 512.0f));
        }
        __syncthreads();
    }
}

template <int MODE> __device__ __forceinline__ const float* rows_src(const Params& P, int r) {
    if (MODE == 0) return (r < MTOK) ? P.in[I_X] + (size_t)r * DM : P.in[I_CTX] + (size_t)(r - MTOK) * DM;
    return P.out + (size_t)r * DM;
}
template <int MODE> __device__ __forceinline__ void rows_pass(const Params& P, int G) {
    int tid_ = threadIdx.x; asm volatile("" : "+v"(tid_));
    const int tid = tid_, wid = tid >> 6, lane = tid & 63;
    const int gw = blockIdx.x * 8 + wid, NGW = G * 8;
    const int nrows = (MODE == 0) ? (MTOK + MCTX) : MTOK;
    if (MODE == 0) {
        if (tid == 0) { unsigned sp = 0; while (__hip_atomic_load((unsigned*)(P.ws + WS_QCTR), __ATOMIC_RELAXED, __HIP_MEMORY_SCOPE_AGENT) < (unsigned)G) { __builtin_amdgcn_s_sleep(2); if (++sp > (1u << 22)) break; } }
        __syncthreads();
        __builtin_amdgcn_fence(__ATOMIC_ACQUIRE, "agent");
    }
    const float* mod = (const float*)(P.ws + WS_MOD);
    const float* gain = P.in[MODE == 0 ? I_G1 : (MODE == 1 ? I_G2 : I_GF)];
    int r = gw;
    if (r >= nrows) return;
    f32x4 v[8], nv[8];
    { const float* src = rows_src<MODE>(P, r);
#pragma unroll
      for (int j = 0; j < 8; ++j) v[j] = (MODE == 0) ? __builtin_nontemporal_load((const f32x4*)(src + (lane + 64 * j) * 4)) : *(const f32x4*)(src + (lane + 64 * j) * 4); }
    for (;;) {
        const int rn = r + NGW; const bool more = rn < nrows;
        if (more) { const float* src = rows_src<MODE>(P, rn);
#pragma unroll
            for (int j = 0; j < 8; ++j) nv[j] = (MODE == 0) ? __builtin_nontemporal_load((const f32x4*)(src + (lane + 64 * j) * 4)) : *(const f32x4*)(src + (lane + 64 * j) * 4); }
        const int mr = (MODE == 0 && r >= MTOK) ? 4 : (r >> 11);
        float ss = 0.f;
#pragma unroll
        for (int j = 0; j < 8; ++j) ss += (v[j].x * v[j].x + v[j].y * v[j].y) + (v[j].z * v[j].z + v[j].w * v[j].w);
        const float rstd = rsqrtf(wave_sum(ss) * (1.0f / DM) + EPS);
#pragma unroll
        for (int j = 0; j < 8; ++j) {
            const int col = (lane + 64 * j) * 4;
            const f32x4 g = *(const f32x4*)(gain + col);
            f32x4 y = v[j] * rstd * g;
            if (MODE == 2) { *(f32x4*)(P.out + (size_t)r * DM + col) = y; }
            else {
                const float* mrow = mod + (size_t)mr * NMOD6 + (MODE == 0 ? 0 : 3 * DM);
                const f32x4 sh = *(const f32x4*)(mrow + col), sc = *(const f32x4*)(mrow + DM + col);
                y = y * (1.0f + sc) + sh;
                u32x2 o; o.x = cvt_pk_bf16(y.x, y.y); o.y = cvt_pk_bf16(y.z, y.w);
                bf16_t* dst = (bf16_t*)(P.ws + (MODE == 0 ? WS_H : WS_H2)) + (size_t)r * DM + col;
                *(u32x2*)dst = o;
            }
        }
        if (!more) break;
#pragma unroll
        for (int j = 0; j < 8; ++j) v[j] = nv[j];
        r = rn;
    }
}

__device__ __forceinline__ void attention_phase(const Params& P, unsigned char* lds, int G) {
    const int c = blockIdx.x;
    for (int j = 0;; ++j) {
        int b, h, qb;
        if (G == 256) {
            if (c < 64 || j > 1) break;
            const int grp = (c & 7) + 8 * j, w = (c - 64) >> 3;
            b = grp >> 2; h = (grp & 3) * 3 + (w >> 3); qb = w & 7;
        } else {
            const int au = c + G * j;
            if (au >= NB * NQH * 8) break;
            qb = au & 7; const int bh = au >> 3; h = bh % NQH; b = bh / NQH;
        }
        const bf16_t* Qb = (const bf16_t*)(P.ws + WS_Q) + (size_t)(b * SEQ + qb * 256) * AW + h * HD;
        const bf16_t* Kh = (const bf16_t*)(P.ws + WS_K) + (size_t)(b * NKVH + h / 3) * SKV * HD;
        const bf16_t* Vh = (const bf16_t*)(P.ws + WS_V) + (size_t)(b * NKVH + h / 3) * SKV * HD;
        bf16_t* Ob = (bf16_t*)(P.ws + WS_MIX) + (size_t)(b * SEQ + qb * 256) * DM + h * HD;
        att::attn_dense_body(Qb, Kh, Vh, Ob, SKV, (char*)lds);
    }
}


#define XB_TMO      128
#define XB_XCNT(j)  (256  + 64 * (j))
#define XB_XSUB(j)  (1280 + 64 * (j))
#define XB_XGEN(j)  (2304 + 64 * (j))
#define XB_TOP      3328
#define XB_TOPGEN   3392
#define XCD_BAR_WORDS 3456
#define XB_SPIN_CAP (1u << 22)
__device__ __forceinline__ unsigned xb_ld(unsigned* p)              { return __hip_atomic_load(p, __ATOMIC_RELAXED, __HIP_MEMORY_SCOPE_AGENT); }
__device__ __forceinline__ unsigned xb_add(unsigned* p, unsigned v) { return __hip_atomic_fetch_add(p, v, __ATOMIC_RELAXED, __HIP_MEMORY_SCOPE_AGENT); }
__device__ __forceinline__ unsigned xb_xcc_id() { return (unsigned)__builtin_amdgcn_s_getreg((3 << 11) | 20) & 0xFu; }
#define XB_SPIN(cond, bar) do { unsigned _sp = 0; while (cond) { __builtin_amdgcn_s_sleep(1); \
    if ((++_sp & 255u) == 0u) { if (xb_ld(&(bar)[XB_TMO])) break; if (_sp > XB_SPIN_CAP) { atomicAdd(&(bar)[XB_TMO], 1u); break; } } } } while (0)
struct XcdBarrier { unsigned* bar; unsigned x; volatile LAS unsigned* st; };
__device__ __forceinline__ XcdBarrier xcd_barrier_post(unsigned* bar, volatile LAS unsigned* st) {
    XcdBarrier b; b.bar = bar; b.x = xb_xcc_id(); b.st = st;
    if (threadIdx.x == 0) (void)xb_add(&bar[XB_XCNT(b.x)], 1u);
    return b;
}
__device__ __forceinline__ void xcd_barrier_complete(unsigned* bar, unsigned x, unsigned& nloc, unsigned& nx) {
    const unsigned G = gridDim.x * gridDim.y * gridDim.z;
    unsigned sum, cnt, mine, sp = 0u;
    for (;;) {
        sum = 0u; cnt = 0u; mine = 0u;
#pragma nounroll
        for (unsigned j = 0; j < 16; ++j) { const unsigned c = xb_ld(&bar[XB_XCNT(j)]); sum += c; cnt += (c > 0u) ? 1u : 0u; mine = (j == x) ? c : mine; }
        if (sum == G) break;
        __builtin_amdgcn_s_sleep(1);
        if ((++sp & 255u) == 0u) { if (xb_ld(&bar[XB_TMO])) break; if (sp > XB_SPIN_CAP) { atomicAdd(&bar[XB_TMO], 1u); break; } }
    }
    nloc = mine > 0u ? mine : 1u; nx = cnt > 0u ? cnt : 1u;
}
__device__ __forceinline__ void xcd_barrier(const XcdBarrier& b) {
    asm volatile("s_waitcnt vmcnt(0)" ::: "memory");
    __syncthreads();
    if (threadIdx.x == 0) {
        unsigned* bar = b.bar;
        __builtin_amdgcn_s_waitcnt(0);
        unsigned nloc = b.st[0], nx = b.st[1];
        if (nloc == 0u) { xcd_barrier_complete(bar, b.x, nloc, nx); b.st[0] = nloc; b.st[1] = nx; }
        const unsigned old = xb_add(&bar[XB_XSUB(b.x)], 1u);
        const unsigned gen = old / nloc;
        if (old + 1u == (gen + 1u) * nloc) {
            __builtin_amdgcn_fence(__ATOMIC_RELEASE, "agent");
            asm volatile("s_waitcnt vmcnt(0)" ::: "memory");
            const unsigned og = xb_add(&bar[XB_TOP], 1u);
            const unsigned tg = og / nx;
            if (og + 1u == (tg + 1u) * nx) xb_add(&bar[XB_TOPGEN], 1u);
            else XB_SPIN(xb_ld(&bar[XB_TOPGEN]) == tg, bar);
            __builtin_amdgcn_fence(__ATOMIC_ACQUIRE, "agent");
            xb_add(&bar[XB_XGEN(b.x)], 1u);
            asm volatile("s_waitcnt vmcnt(0)" ::: "memory");
        } else {
            XB_SPIN(xb_ld(&bar[XB_XGEN(b.x)]) == gen, bar);
            __builtin_amdgcn_fence(__ATOMIC_ACQUIRE, "agent");
            asm volatile("s_waitcnt vmcnt(0)" ::: "memory");
        }
    }
    __syncthreads();
}

__global__ void __launch_bounds__(512, 2) fwd_megakernel(Params P_) {
    extern __shared__ __attribute__((aligned(16))) unsigned char lds[];
    cg::grid_group grid = cg::this_grid();
    const int G_ = gridDim.x, c_ = blockIdx.x;
    LAS unsigned char* l3 = (LAS unsigned char*)lds;
    volatile LAS unsigned* misc = (volatile LAS unsigned*)(l3 + LDS_MISC);
    if (threadIdx.x < 64) misc[threadIdx.x] = 0u;
    __syncthreads();
    XcdBarrier xbar = xcd_barrier_post((unsigned*)(P_.ws + WS_BAR), misc + 8);
#if PROBE >= 100
    unsigned long long pt0 = 0, pt1 = 0;
#endif
#pragma nounroll
    for (int ph = 0; ph < 10; ++ph) {
        Params P = P_; int G = G_, c = c_;
        asm volatile("" : "+s"(G), "+s"(c), "+s"(P.ws), "+s"(P.out));
        int gm = -1;
#if PROBE >= 100
        if (ph == PROBE - 100) pt0 = __builtin_amdgcn_s_memrealtime();
        if (ph == PROBE - 99) pt1 = __builtin_amdgcn_s_memrealtime();
#endif
        switch (ph) {
        case 0: ada_phase(P, l3, G); transpose_share(P.in[I_WIN], DM, INW, (bf16_t*)(P.ws + WS_WIN), c, G * 8, l3); transpose_share(P.in[I_WOUT], DM, DM, (bf16_t*)(P.ws + WS_WOUT), c, G * 8, l3); __syncthreads(); gen_tables(P, l3, c, G, 2); __syncthreads();
                break;
        case 1: rows_pass<0>(P, G); break;
        case 2: gm = G_IN; break;
        case 3: if (G != 256) gm = G_F1; break;
        case 4: if (G == 256 && c < 64) {
                    gemm_phase(l3, P, G_F1, 64, c);
                    asm volatile("s_waitcnt vmcnt(0)" ::: "memory"); __syncthreads();
                    if (threadIdx.x == 0) {
                        unsigned* f1c = (unsigned*)(P.ws + WS_QCTR) + 64;
                        __builtin_amdgcn_fence(__ATOMIC_RELEASE, "agent"); asm volatile("s_waitcnt vmcnt(0)" ::: "memory");
                        __hip_atomic_fetch_add(f1c, 1u, __ATOMIC_RELAXED, __HIP_MEMORY_SCOPE_AGENT);
                        unsigned sp = 0; while (__hip_atomic_load(f1c, __ATOMIC_RELAXED, __HIP_MEMORY_SCOPE_AGENT) < 64u) { __builtin_amdgcn_s_sleep(2); if (++sp > (1u << 22)) break; }
                        __builtin_amdgcn_fence(__ATOMIC_ACQUIRE, "agent"); asm volatile("s_waitcnt vmcnt(0)" ::: "memory");
                    }
                    __syncthreads();
                }
                gm = G_F2; break;
        case 5: gm = G_OUT; break;
        case 6: if (G != 256) rows_pass<1>(P, G); break;
        case 7: gm = G_UP; break;
        case 8: gm = G_DOWN; break;
        default: if (G != 256) rows_pass<2>(P, G); break;
        }
#ifndef NO_GEMM
        if (gm >= 0) gemm_phase(l3, P, gm, G, c);
#endif
#ifndef NO_ATT
        if (ph == 4) attention_phase(P, lds, G);
#endif
        if (ph == 2) { if (G != 256) transpose_share(P.in[I_W1], DM, DFF, (bf16_t*)(P.ws + WS_W1), c, G * 8, l3);
                       else if (c >= 144) transpose_share(P.in[I_W1], DM, DFF, (bf16_t*)(P.ws + WS_W1), c - 144, 112 * 8, l3); }
        if (ph == 4) { if (G != 256) transpose_share(P.in[I_W2], DFF, DM, (bf16_t*)(P.ws + WS_W2), c, G * 8, l3);
                       else if (c < 64) transpose_share(P.in[I_W2], DFF, DM, (bf16_t*)(P.ws + WS_W2), c, 64 * 8, l3); }
#if PROBE == 3
        if (ph == 7) { __syncthreads(); gemm_phase(l3, P, gm, G, c); }
#endif
#if PROBE == 4
        if (ph == 4) { __syncthreads(); gemm_phase(l3, P, gm, G, c); attention_phase(P, lds, G); }
#endif
        if (G == 0x7fffffff) grid.sync();
        if (ph > 0 && ph < 9 && !(G == 256 && (ph == 3 || ph == 6 || ph == 8))) xcd_barrier(xbar);
    }
#if PROBE >= 100
    if (PROBE - 99 == 10) pt1 = __builtin_amdgcn_s_memrealtime();
    if (blockIdx.x == 0 && threadIdx.x < 64) {
        const unsigned long long te = __builtin_amdgcn_s_memrealtime(), want = 16ull * (pt1 - pt0);
        while (__builtin_amdgcn_s_memrealtime() - te < want) __builtin_amdgcn_s_sleep(8);
    }
#endif
}

extern "C" void kernel_launch(void* const* d_in, const int* in_sizes, int n_in, void* d_out, int out_size, void* d_ws, size_t ws_size, hipStream_t stream) {
    static int grid_blocks = 0;
    if (grid_blocks == 0) {
        if (n_in != 16 || out_size != MTOK * DM || ws_size < WS_END) { fprintf(stderr, "kernel_launch: unexpected shapes (n_in %d out %d ws %zu)\n", n_in, out_size, ws_size); grid_blocks = -1; return; }
        int dev = 0, cus = 0, per_cu = 0;
        (void)hipGetDevice(&dev);
        (void)hipDeviceGetAttribute(&cus, hipDeviceAttributeMultiprocessorCount, dev);
        if (hipFuncSetAttribute((const void*)fwd_megakernel, hipFuncAttributeMaxDynamicSharedMemorySize, LDS_BYTES) != hipSuccess) { fprintf(stderr, "kernel_launch: hipFuncSetAttribute failed\n"); grid_blocks = -1; return; }
        if (hipOccupancyMaxActiveBlocksPerMultiprocessor(&per_cu, (const void*)fwd_megakernel, 512, LDS_BYTES) != hipSuccess || per_cu < 1) { fprintf(stderr, "kernel_launch: occupancy query failed (%d)\n", per_cu); per_cu = 1; }
        (void)hipGetLastError();
        grid_blocks = cus;
    }
    if (grid_blocks < 0) return;
    (void)hipMemsetAsync((char*)d_ws + WS_MOD, 0, WS_CTL_BYTES, stream);
    Params p{};
    for (int i = 0; i < 16; ++i) p.in[i] = (const float*)d_in[i];
    p.out = (float*)d_out; p.ws = (unsigned char*)d_ws;
    void* args[] = {&p};
    hipError_t e = hipLaunchCooperativeKernel((const void*)fwd_megakernel, dim3(grid_blocks), dim3(512), args, LDS_BYTES, stream);
    if (e != hipSuccess) fprintf(stderr, "cooperative launch failed: %s (grid %d)\n", hipGetErrorString(e), grid_blocks);
}
#ifdef TEST_KERNELS
__global__ void __launch_bounds__(512, 2) t_att(Params P) { extern __shared__ __attribute__((aligned(16))) unsigned char lds[]; attention_phase(P, lds, gridDim.x); }
__global__ void __launch_bounds__(512, 2) t_gemm(Params P, int mode) { extern __shared__ __attribute__((aligned(16))) unsigned char lds[]; gemm_phase((LAS unsigned char*)lds, P, mode, gridDim.x, blockIdx.x); }
__global__ void __launch_bounds__(512, 2) t_gemm_up(Params P) { extern __shared__ __attribute__((aligned(16))) unsigned char lds[]; gemm_phase((LAS unsigned char*)lds, P, G_UP, gridDim.x, blockIdx.x); }
__global__ void __launch_bounds__(512, 2) t_gemm_out(Params P) { extern __shared__ __attribute__((aligned(16))) unsigned char lds[]; gemm_phase((LAS unsigned char*)lds, P, G_OUT, gridDim.x, blockIdx.x); }
#endif
```

```cpp
#include <hip/hip_runtime.h>
#include <hip/hip_bf16.h>
#include <hip/hip_cooperative_groups.h>
#include <cstdio>
#include <cstdint>
namespace cg = cooperative_groups;

#ifndef PROBE
#define PROBE 0
#endif
#define LAS __attribute__((address_space(3)))
typedef unsigned short bf16_t;
typedef short bf16x8 __attribute__((ext_vector_type(8)));
typedef short s16x4 __attribute__((ext_vector_type(4)));
typedef float f32x4 __attribute__((ext_vector_type(4)));
typedef float f32x16 __attribute__((ext_vector_type(16)));
typedef unsigned u32x4 __attribute__((ext_vector_type(4)));
typedef unsigned u32x2 __attribute__((ext_vector_type(2)));

constexpr int DM = 2048, NB = 4, SEQ = 2048, CTXL = 256, HD = 128, NQH = 12, NKVH = 4;
constexpr int AW = 1536, KVW = 512, FW = 512, INW = 3072, DFF = 8192, NMOD6 = 6 * DM;
constexpr int MTOK = NB * SEQ, MCTX = NB * CTXL, SKV = SEQ + CTXL;
constexpr float EPS = 1e-6f;

constexpr size_t MiB = 1u << 20;
constexpr size_t WS_MOD = 0;
constexpr size_t WS_BAR = 245760;
constexpr size_t WS_QCTR = 245760 + 16384;
constexpr size_t WS_XACC = 262144 + 4096;
constexpr size_t WS_CTL_BYTES = 262144 + 4096 + 131072;
constexpr size_t WS_XSLOT = 1 * MiB + 512 * 1024;
constexpr size_t WS_ROPE = 512 * 1024;
constexpr size_t WS_GT = 1 * MiB;
constexpr size_t WS_WIN = 2 * MiB;
constexpr size_t WS_WOUT = 14 * MiB;
constexpr size_t WS_W1 = 22 * MiB;
constexpr size_t WS_W2 = 54 * MiB;
constexpr size_t WS_DFT = 86 * MiB;
constexpr size_t WS_H2 = 102 * MiB;
constexpr size_t WS_H = 134 * MiB;
constexpr size_t WS_Q = 170 * MiB;
constexpr size_t WS_K = 194 * MiB;
constexpr size_t WS_V = 203 * MiB;
constexpr size_t WS_U = 212 * MiB;
constexpr size_t WS_ZT = 220 * MiB;
constexpr size_t WS_MIX = 236 * MiB;
constexpr size_t WS_A1 = 134 * MiB;
constexpr size_t WS_END = 268 * MiB;

constexpr int LDS_MISC = 8 * 64 * 65 * 4;
constexpr int LDS_RED = LDS_MISC + 1024;
constexpr int LDS_BYTES = LDS_RED + 8192;

struct Params { const float* in[16]; float* out; unsigned char* ws; };
enum { I_X = 0, I_C, I_CTX, I_CCTX, I_WADA, I_BADA, I_G1, I_WIN, I_QG, I_KG, I_WF, I_WOUT, I_G2, I_W1, I_W2, I_GF };

__device__ __forceinline__ unsigned cvt_pk_bf16(float lo, float hi) { unsigned r; asm("v_cvt_pk_bf16_f32 %0, %1, %2" : "=v"(r) : "v"(lo), "v"(hi)); return r; }
__device__ __forceinline__ float bf2f(bf16_t v) { return __uint_as_float(((unsigned)v) << 16); }
__device__ __forceinline__ bf16_t f2bf(float f) { return (bf16_t)(cvt_pk_bf16(f, 0.f) & 0xffffu); }
template <int M> __device__ __forceinline__ float swz_xor(float v) { return __int_as_float(__builtin_amdgcn_ds_swizzle(__float_as_int(v), 0x1F | (M << 10))); }
__device__ __forceinline__ float half_sum(float v) { auto rr = __builtin_amdgcn_permlane32_swap(__float_as_uint(v), __float_as_uint(v), false, false); return __uint_as_float(rr[0]) + __uint_as_float(rr[1]); }
__device__ __forceinline__ float wave_sum(float v) {
    v += swz_xor<1>(v); v += swz_xor<2>(v); v += swz_xor<4>(v); v += swz_xor<8>(v); v += swz_xor<16>(v);
    return half_sum(v);
}
#define LDS_WAIT() asm volatile("s_waitcnt lgkmcnt(0)" ::: "memory")

constexpr int BM = 256, BK = 64, HALF = 128, HTB = HALF * BK * 2, NXCD = 8, WGM = 8;
__device__ __forceinline__ int lds_byte(int r, int c) { const int st = (r >> 4) * 2 + (c >> 5), rr = r & 15, cc = c & 31, ob = rr * 64 + cc * 2; return st * 1024 + (ob ^ (((ob >> 9) & 1) << 5)); }
__device__ __forceinline__ void stage_rc(int b, int& R, int& C) { const int st = b / 1024, sb = b % 1024, swz = sb ^ (((sb >> 9) & 1) << 5); R = (st >> 1) * 16 + swz / 64; C = (st & 1) * 32 + (swz % 64) / 2; }
__device__ __forceinline__ int perm32(int rho) { const int n = rho >> 4, i = rho & 15; return 8 * (i >> 2) + 4 * n + (i & 3); }

struct Unit { int pm, pn; const char* a; const char* b; };
enum { G_IN = 0, G_F1, G_F2, G_OUT, G_UP, G_DOWN };

__device__ __forceinline__ void remap_tile(int L, int nM, int nN, int& pm, int& pn) {
    const int nwg = nM * nN; int wgid = L;
    { const int q = nwg / NXCD, r = nwg % NXCD, xcd = wgid % NXCD, off = wgid / NXCD; wgid = (xcd < r ? xcd * (q + 1) : r * (q + 1) + (xcd - r) * q) + off; }
    const int nig = WGM * nN, gid = wgid / nig, fm = gid * WGM, gsz = (nM - fm) < WGM ? (nM - fm) : WGM;
    pm = fm + ((wgid % nig) % gsz); pn = (wgid % nig) / gsz;
}

__device__ __forceinline__ bool get_unit(const unsigned char* ws, int mode, int i, int G, int c, Unit& u) {
    const long L = (long)i * G + c;
    switch (mode) {
    case G_IN: {
        if (L >= 400) return false;
        if (L < 256) remap_tile((int)L, 32, 8, u.pm, u.pn);
        else if (L < 384) { remap_tile((int)L - 256, 32, 4, u.pm, u.pn); u.pn += 8; }
        else { const int idx = (int)L - 384; u.pm = 32 + (idx >> 2); u.pn = 6 + (idx & 3); }
        u.a = (const char*)ws + WS_H + (size_t)u.pm * 256 * DM * 2; u.b = (const char*)ws + WS_WIN + (size_t)u.pn * 256 * DM * 2; return true; }
    case G_F1: {
        if (L >= 128) return false;
        const int g = (int)L >> 5; u.pm = g; u.pn = (int)L & 31;
        u.a = (const char*)ws + WS_GT + (size_t)g * 256 * 128 * 2; u.b = (const char*)ws + WS_U + ((size_t)u.pn * 256 * FW + g * 128) * 2; return true; }
    case G_F2: {
        if (L >= 64) return false;
        const int b = (int)L >> 4, pm = ((int)L >> 1) & 7, pn = (int)L & 1; u.pm = b * 8 + pm; u.pn = pn;
        u.a = (const char*)ws + WS_DFT + (size_t)pm * 256 * 4096 * 2; u.b = (const char*)ws + WS_ZT + ((size_t)(b * 512 + pn * 256) * 4096) * 2; return true; }
    case G_OUT: {
        if (L >= 256) return false;
        remap_tile((int)L, 32, 8, u.pm, u.pn);
        u.a = (const char*)ws + WS_MIX + (size_t)u.pm * 256 * DM * 2; u.b = (const char*)ws + WS_WOUT + (size_t)u.pn * 256 * DM * 2; return true; }
    case G_UP: {
        if (L >= 1024) return false;
        remap_tile((int)L, 32, 32, u.pm, u.pn);
        u.a = (const char*)ws + WS_H2 + (size_t)u.pm * 256 * DM * 2; u.b = (const char*)ws + WS_W1 + (size_t)u.pn * 256 * DM * 2; return true; }
    default: {
        if (L >= 256) return false;
        remap_tile((int)L, 32, 8, u.pm, u.pn);
        u.a = (const char*)ws + WS_A1 + (size_t)u.pm * 256 * DFF * 2; u.b = (const char*)ws + WS_W2 + (size_t)u.pn * 256 * DFF * 2; return true; }
    }
}

__device__ __forceinline__ void gemm_epilogue(const Params& P, int mode, const f32x4 (&acc)[2][2][4][2], const Unit& u, int wr, int wc, int fr, int fq) {
    unsigned char* ws = P.ws;
    if (mode == G_OUT || mode == G_DOWN) {
        const float* resid = (mode == G_OUT) ? P.in[I_X] : P.out;
        const float* gate = (const float*)(ws + WS_MOD) + (size_t)(u.pm >> 3) * NMOD6 + (mode == G_OUT ? 2 * DM : 5 * DM);
        const int col0 = u.pn * 256 + wc * 32 + 4 * fq;
        f32x4 gv[2][2];
#pragma unroll
        for (int bj = 0; bj < 2; ++bj)
#pragma unroll
            for (int n = 0; n < 2; ++n) gv[bj][n] = *(const f32x4*)(gate + col0 + bj * HALF + n * 16);
#pragma unroll
        for (int ai = 0; ai < 2; ++ai)
#pragma unroll
            for (int m = 0; m < 4; ++m) {
                const size_t off = (size_t)(u.pm * 256 + ai * HALF + wr * 64 + m * 16 + fr) * DM + col0;
#pragma unroll
                for (int bj = 0; bj < 2; ++bj)
#pragma unroll
                    for (int n = 0; n < 2; ++n) {
                        const f32x4 r = *(const f32x4*)(resid + off + bj * HALF + n * 16);
                        *(f32x4*)(P.out + off + bj * HALF + n * 16) = r + gv[bj][n] * acc[ai][bj][m][n];
                    }
            }
        return;
    }
    bf16_t* base; size_t ld, aistride, bjstride = HALF;
    if (mode == G_IN) {
        const int pm = u.pm, pn = u.pn;
        if (pn < 6) { base = (bf16_t*)(ws + WS_Q) + (size_t)pm * 256 * AW + pn * 256; ld = AW; }
        else if (pn < 10) {
            const int b = (pm < 32) ? (pm >> 3) : (pm - 32), t0 = (pm < 32) ? CTXL + (pm & 7) * 256 : 0, h0 = ((pn - 6) & 1) * 2;
            base = (bf16_t*)(ws + (pn < 8 ? WS_K : WS_V)) + ((size_t)(b * NKVH + h0) * SKV + t0) * HD; ld = HD; bjstride = (size_t)SKV * HD; }
        else { base = (bf16_t*)(ws + WS_U) + (size_t)pm * 256 * FW + (pn - 10) * 256; ld = FW; }
        aistride = 128 * ld;
    } else if (mode == G_F1) {
        const int g = u.pm, b = u.pn >> 3, s0 = (u.pn & 7) * 256;
        base = (bf16_t*)(ws + WS_ZT) + ((size_t)(b * 512 + g * 128) * 4096 + s0); ld = 4096; aistride = 2048;
    } else if (mode == G_F2) {
        base = (bf16_t*)(ws + WS_MIX) + (size_t)u.pm * 256 * DM + AW + u.pn * 256; ld = DM; aistride = 128 * ld;
    } else {
        base = (bf16_t*)(ws + WS_A1) + (size_t)u.pm * 256 * DFF + u.pn * 256; ld = DFF; aistride = 128 * ld;
    }
    const bool relu2 = (mode == G_UP);
    bf16_t* p0 = base + (size_t)(wr * 64 + fr) * ld + wc * 32 + 8 * fq;
#pragma unroll
    for (int ai = 0; ai < 2; ++ai)
#pragma unroll
        for (int m = 0; m < 4; ++m) {
            bf16_t* rowp = p0 + ai * aistride + (size_t)(m * 16) * ld;
#pragma unroll
            for (int bj = 0; bj < 2; ++bj) {
                f32x4 v0 = acc[ai][bj][m][0], v1 = acc[ai][bj][m][1];
                if (relu2) {
#pragma unroll
                    for (int e = 0; e < 4; ++e) { const float a = fmaxf(v0[e], 0.f), b = fmaxf(v1[e], 0.f); v0[e] = a * a; v1[e] = b * b; }
                }
                u32x4 w; w.x = cvt_pk_bf16(v0[0], v0[1]); w.y = cvt_pk_bf16(v0[2], v0[3]); w.z = cvt_pk_bf16(v1[0], v1[1]); w.w = cvt_pk_bf16(v1[2], v1[3]);
                *(u32x4*)(rowp + bj * bjstride) = w;
            }
        }
}

__device__ __forceinline__ int qk_perm(int R) { const int wc = R >> 5, n = (R >> 4) & 1, p = 16 * wc + (R & 15); return (p < 32 ? p : p + 32) + 32 * n; }
__device__ __forceinline__ void gemm_epilogue_qk(const Params& P, const f32x4 (&acc)[2][2][4][2], const Unit& u, int wr, int wc, int fr, int fq, LAS unsigned char* lds) {
    asm volatile("" : "+v"(fr), "+v"(fq), "+s"(wr), "+s"(wc));
    unsigned char* ws = P.ws;
    LAS float* red = (LAS float*)(lds + LDS_RED);
    const int pm = u.pm, pn = u.pn;
#pragma unroll
    for (int ai = 0; ai < 2; ++ai)
#pragma unroll
        for (int m = 0; m < 4; ++m)
#pragma unroll
            for (int bj = 0; bj < 2; ++bj) {
                const f32x4 a = acc[ai][bj][m][0], b = acc[ai][bj][m][1];
                float ss = ((a.x * a.x + a.y * a.y) + (a.z * a.z + a.w * a.w)) + ((b.x * b.x + b.y * b.y) + (b.z * b.z + b.w * b.w));
                ss += swz_xor<16>(ss); ss = half_sum(ss);
                if (fq == 0) red[(bj * 4 + wc) * 256 + ai * HALF + wr * 64 + m * 16 + fr] = ss;
            }
    asm volatile("s_waitcnt lgkmcnt(0)" ::: "memory"); __builtin_amdgcn_s_barrier(); asm volatile("" ::: "memory");
    const bool isq = pn < 6, rope = pm < 32;
    const int p0 = 16 * wc + 4 * fq, d0 = (p0 < 32) ? p0 : p0 + 32;
    const float* g = P.in[isq ? I_QG : I_KG];
    const f32x4 g0 = *(const f32x4*)(g + d0), g1 = *(const f32x4*)(g + d0 + 32);
    bf16_t* base; size_t ld, bjstride;
    if (isq) { base = (bf16_t*)(ws + WS_Q) + (size_t)pm * 256 * AW + pn * 256; ld = AW; bjstride = HD; }
    else { const int b = rope ? (pm >> 3) : (pm - 32), t0 = rope ? CTXL + (pm & 7) * 256 : 0, h0 = (pn - 6) * 2;
           base = (bf16_t*)(ws + WS_K) + ((size_t)(b * NKVH + h0) * SKV + t0) * HD; ld = HD; bjstride = (size_t)SKV * HD; }
    const float* tab = (const float*)(ws + WS_ROPE);
    const int i0 = 16 * (wc & 1) + 4 * fq;
#pragma unroll
    for (int ai = 0; ai < 2; ++ai)
#pragma unroll
        for (int m = 0; m < 4; ++m) {
            const int rl = ai * HALF + wr * 64 + m * 16 + fr;
            f32x4 cs0 = (f32x4){1.f, 0.f, 1.f, 0.f}, cs1 = cs0;
            if (rope) { const int pos = (pm * 256 + rl) & (SEQ - 1), av = (wc < 2) ? (pos >> 6) : (pos & 63);
                        const f32x4* t = (const f32x4*)(tab + (size_t)(av * 32 + i0) * 2); cs0 = t[0]; cs1 = t[1]; }
#pragma unroll
            for (int bj = 0; bj < 2; ++bj) {
                const float tot = (red[(bj * 4 + 0) * 256 + rl] + red[(bj * 4 + 1) * 256 + rl]) + (red[(bj * 4 + 2) * 256 + rl] + red[(bj * 4 + 3) * 256 + rl]);
                const float rstd = rsqrtf(tot * (1.0f / HD) + EPS);
                const f32x4 x1 = acc[ai][bj][m][0] * rstd * g0, x2 = acc[ai][bj][m][1] * rstd * g1;
                const float a0 = x1.x * cs0.x - x2.x * cs0.y, b0 = x2.x * cs0.x + x1.x * cs0.y;
                const float a1 = x1.y * cs0.z - x2.y * cs0.w, b1 = x2.y * cs0.z + x1.y * cs0.w;
                const float a2 = x1.z * cs1.x - x2.z * cs1.y, b2 = x2.z * cs1.x + x1.z * cs1.y;
                const float a3 = x1.w * cs1.z - x2.w * cs1.w, b3 = x2.w * cs1.z + x1.w * cs1.w;
                u32x2 o1, o2; o1.x = cvt_pk_bf16(a0, a1); o1.y = cvt_pk_bf16(a2, a3); o2.x = cvt_pk_bf16(b0, b1); o2.y = cvt_pk_bf16(b2, b3);
                const auto sx = __builtin_amdgcn_permlane16_swap(o1.x, o2.x, false, false), sy = __builtin_amdgcn_permlane16_swap(o1.y, o2.y, false, false);
                u32x4 w; w.x = sx[0]; w.y = sy[0]; w.z = sx[1]; w.w = sy[1];
                bf16_t* rowp = base + (size_t)rl * ld + bj * bjstride + ((fq & 1) ? d0 + 28 : d0);
                *(u32x4*)rowp = w;
            }
        }
}

__device__ __forceinline__ void gemm_epilogue_fused(const Params& P, int mode, f32x4 (&acc)[2][2][4][2], const Unit& u, int wr, int wc, int fr, int fq, LAS unsigned char* lds, int tid) {
    unsigned char* ws = P.ws;
    const int x = (mode == G_OUT) ? 0 : 1;
    const float* resid = (mode == G_OUT) ? P.in[I_X] : P.out;
    const float* modb = (const float*)(ws + WS_MOD) + (size_t)(u.pm >> 3) * NMOD6;
    const float* gate = modb + (mode == G_OUT ? 2 * DM : 5 * DM);
    const int col0 = u.pn * 256 + wc * 32 + 4 * fq;
    LAS float* Pq = (LAS float*)lds;
    LAS float* S = (LAS float*)(lds + 4096);
    {
        f32x4 gv[2][2];
#pragma unroll
        for (int bj = 0; bj < 2; ++bj)
#pragma unroll
            for (int n = 0; n < 2; ++n) gv[bj][n] = *(const f32x4*)(gate + col0 + bj * HALF + n * 16);
        f32x4 rbuf[2][2][2];
        const size_t off0 = (size_t)(u.pm * 256 + wr * 64 + fr) * DM + col0;
#pragma unroll
        for (int bj = 0; bj < 2; ++bj)
#pragma unroll
            for (int n = 0; n < 2; ++n) rbuf[0][bj][n] = (mode == G_OUT) ? __builtin_nontemporal_load((const f32x4*)(resid + off0 + bj * HALF + n * 16)) : *(const f32x4*)(resid + off0 + bj * HALF + n * 16);
#pragma unroll
        for (int g = 0; g < 8; ++g) {
            const int ai = g >> 2, m = g & 3;
            const int rl = ai * HALF + wr * 64 + m * 16 + fr;
            const size_t off = (size_t)(u.pm * 256 + rl) * DM + col0;
            if (g < 7) { const int ai2 = (g + 1) >> 2, m2 = (g + 1) & 3; const size_t offn = (size_t)(u.pm * 256 + ai2 * HALF + wr * 64 + m2 * 16 + fr) * DM + col0;
#pragma unroll
                for (int bj = 0; bj < 2; ++bj)
#pragma unroll
                    for (int n = 0; n < 2; ++n) rbuf[(g + 1) & 1][bj][n] = (mode == G_OUT) ? __builtin_nontemporal_load((const f32x4*)(resid + offn + bj * HALF + n * 16)) : *(const f32x4*)(resid + offn + bj * HALF + n * 16); }
            float ss = 0.f;
#pragma unroll
            for (int bj = 0; bj < 2; ++bj)
#pragma unroll
                for (int n = 0; n < 2; ++n) {
                    const f32x4 v = rbuf[g & 1][bj][n] + gv[bj][n] * acc[ai][bj][m][n];
                    acc[ai][bj][m][n] = v;
                    if (mode == G_OUT) *(f32x4*)(P.out + off + bj * HALF + n * 16) = v;
                    ss += (v.x * v.x + v.y * v.y) + (v.z * v.z + v.w * v.w);
                }
            ss += swz_xor<16>(ss); ss = half_sum(ss);
            if (fq == 0) Pq[rl * 4 + wc] = ss;
            asm volatile("" ::: "memory");
        }
    }
    asm volatile("s_waitcnt lgkmcnt(0)" ::: "memory"); __builtin_amdgcn_s_barrier(); asm volatile("" ::: "memory");
    if (tid < 256) {
        const f32x4 q = *(const LAS f32x4*)(Pq + tid * 4);
        const float tot = (q.x + q.y) + (q.z + q.w);
        unsigned long long* w = (unsigned long long*)(ws + WS_XACC) + (size_t)x * MTOK + (size_t)(u.pm * 256 + tid);
        __hip_atomic_fetch_add(w, (1ull << 48) + (unsigned long long)(tot * 65536.0f + 0.5f), __ATOMIC_RELAXED, __HIP_MEMORY_SCOPE_AGENT);
        unsigned long long v; unsigned sp = 0;
        for (;;) { v = __hip_atomic_load(w, __ATOMIC_RELAXED, __HIP_MEMORY_SCOPE_AGENT); if ((v >> 48) >= 8ull) break; __builtin_amdgcn_s_sleep(1); if (++sp > (1u << 22)) break; }
        S[tid] = rsqrtf((float)(v & 0xFFFFFFFFFFFFull) * (1.0f / 65536.0f) * (1.0f / DM) + EPS);
    }
    asm volatile("s_waitcnt lgkmcnt(0)" ::: "memory"); __builtin_amdgcn_s_barrier(); asm volatile("" ::: "memory");
    if (mode == G_OUT) {
        f32x4 gg[2][2], sc[2][2], sh[2][2];
#pragma unroll
        for (int bj = 0; bj < 2; ++bj)
#pragma unroll
            for (int n = 0; n < 2; ++n) { const int cc = col0 + bj * HALF + n * 16; gg[bj][n] = *(const f32x4*)(P.in[I_G2] + cc); sh[bj][n] = *(const f32x4*)(modb + 3 * DM + cc); sc[bj][n] = *(const f32x4*)(modb + 4 * DM + cc) + 1.0f; }
        bf16_t* h2 = (bf16_t*)(ws + WS_H2);
#pragma unroll
        for (int ai = 0; ai < 2; ++ai)
#pragma unroll
            for (int m = 0; m < 4; ++m) {
                const int rl = ai * HALF + wr * 64 + m * 16 + fr; const float rs = S[rl];
                const size_t off = (size_t)(u.pm * 256 + rl) * DM + col0;
#pragma unroll
                for (int bj = 0; bj < 2; ++bj)
#pragma unroll
                    for (int n = 0; n < 2; ++n) {
                        const f32x4 y = (acc[ai][bj][m][n] * rs * gg[bj][n]) * sc[bj][n] + sh[bj][n];
                        u32x2 o; o.x = cvt_pk_bf16(y.x, y.y); o.y = cvt_pk_bf16(y.z, y.w);
                        *(u32x2*)(h2 + off + bj * HALF + n * 16) = o;
                    }
            }
    } else {
        f32x4 gg[2][2];
#pragma unroll
        for (int bj = 0; bj < 2; ++bj)
#pragma unroll
            for (int n = 0; n < 2; ++n) gg[bj][n] = *(const f32x4*)(P.in[I_GF] + col0 + bj * HALF + n * 16);
#pragma unroll
        for (int ai = 0; ai < 2; ++ai)
#pragma unroll
            for (int m = 0; m < 4; ++m) {
                const int rl = ai * HALF + wr * 64 + m * 16 + fr; const float rs = S[rl];
                const size_t off = (size_t)(u.pm * 256 + rl) * DM + col0;
#pragma unroll
                for (int bj = 0; bj < 2; ++bj)
#pragma unroll
                    for (int n = 0; n < 2; ++n) __builtin_nontemporal_store(acc[ai][bj][m][n] * rs * gg[bj][n], (f32x4*)(P.out + off + bj * HALF + n * 16));
            }
    }
    asm volatile("s_waitcnt lgkmcnt(0)" ::: "memory"); __builtin_amdgcn_s_barrier();
}

__device__ __forceinline__ void gemm_phase(LAS unsigned char* lds, const Params& P, const int mode, const int G, const int c) {
    int tid_ = threadIdx.x; asm volatile("" : "+v"(tid_));
    const int tid = tid_, wid = __builtin_amdgcn_readfirstlane(tid >> 6), lane = tid & 63, wr = wid >> 2, wc = wid & 3, fr = lane & 15, fq = lane >> 4;
    int lda, ldb, K; bool perm = true;
    switch (mode) {
    case G_IN: lda = DM; ldb = DM; K = DM; break;
    case G_F1: lda = 128; ldb = FW; K = 128; break;
    case G_F2: lda = 4096; ldb = 4096; K = 4096; break;
    case G_OUT: lda = DM; ldb = DM; K = DM; perm = false; break;
    case G_UP: lda = DM; ldb = DM; K = DM; break;
    default: lda = DFF; ldb = DFF; K = DFF; perm = false; break;
    }
    const int nt = K / BK;
    const bool fusedEpi = (mode == G_OUT || mode == G_DOWN) && G == 256;
    unsigned voffA[2];
#pragma unroll
    for (int i = 0; i < 2; ++i) { int R, C; stage_rc(tid * 16 + i * 8192, R, C); voffA[i] = (unsigned)(R * lda + C) * 2u; }
#define PG8_BOFF(i, qk) ([&]() { int R, C; stage_rc(tid * 16 + (i) * 8192, R, C); const int Rb = (qk) ? qk_perm(R) : (perm ? ((R & ~31) + perm32(R & 31)) : R); return (unsigned)(Rb * ldb + C) * 2u; }())
    const size_t kstep = (size_t)(BK * 2);
    const size_t hstepA = (size_t)HALF * lda * 2, hstepB = (size_t)HALF * ldb * 2;
    const unsigned ldsw = (unsigned)wid * 1024u;
    const int aoff = lds_byte(wr * 64 + fr, fq * 8), boff = lds_byte(wc * 32 + fr, fq * 8);
#define PG8_SA(b, h) (((b) * 2 + (h)) * HTB)
#define PG8_SB(b, h) ((4 + (b) * 2 + (h)) * HTB)
#define PG8_STAGE(bufoff, gbase, voff) do { _Pragma("unroll") for (int _i = 0; _i < 2; ++_i) \
        __builtin_amdgcn_global_load_lds((const unsigned*)((const char*)(gbase) + (voff)[_i]), (LAS unsigned*)(lds + (bufoff) + ldsw + _i * 8192), 16, 0, 0); } while (0)
#define PG8_LDA(dst, b, h) do { _Pragma("unroll") for (int m = 0; m < 4; ++m) _Pragma("unroll") for (int k = 0; k < 2; ++k) dst[m][k] = *(const LAS bf16x8*)(lds + PG8_SA(b, h) + aoff + m * 2048 + k * 1024); } while (0)
#define PG8_LDB(dst, b, h) do { _Pragma("unroll") for (int n = 0; n < 2; ++n) _Pragma("unroll") for (int k = 0; k < 2; ++k) dst[n][k] = *(const LAS bf16x8*)(lds + PG8_SB(b, h) + boff + n * 2048 + k * 1024); } while (0)
#define PG8_MMA(ai, bj, At, Bt) do { __builtin_amdgcn_s_setprio(1); _Pragma("unroll") for (int m = 0; m < 4; ++m) _Pragma("unroll") for (int n = 0; n < 2; ++n) _Pragma("unroll") for (int k = 0; k < 2; ++k) \
        acc[ai][bj][m][n] = __builtin_amdgcn_mfma_f32_16x16x32_bf16(Bt[n][k], At[m][k], acc[ai][bj][m][n], 0, 0, 0); __builtin_amdgcn_s_setprio(0); } while (0)
#define PG8_WAIT_V(n) asm volatile("s_waitcnt vmcnt(" #n ")" ::: "memory")
#define PG8_WAIT_L(n) asm volatile("s_waitcnt lgkmcnt(" #n ")" ::: "memory")
#define PG8_BAR __builtin_amdgcn_s_barrier()
#define PG8_SCHED __builtin_amdgcn_sched_barrier(0)
    Unit cur, nxt; int ui = 0;
    if (!get_unit(P.ws, mode, 0, G, c, cur)) return;
    f32x4 acc[2][2][4][2];
#pragma unroll
    for (int a = 0; a < 2; ++a)
#pragma unroll
        for (int b = 0; b < 2; ++b)
#pragma unroll
            for (int m = 0; m < 4; ++m)
#pragma unroll
                for (int n = 0; n < 2; ++n) acc[a][b][m][n] = (f32x4){0.f, 0.f, 0.f, 0.f};
    bf16x8 At[4][2], B0[2][2], B1[2][2];
    const char* cA = cur.a; const char* cB = cur.b;
    bool cqk = (mode == G_IN) && cur.pn < 8;
    unsigned voffB[2] = {PG8_BOFF(0, cqk), PG8_BOFF(1, cqk)};
    PG8_STAGE(PG8_SB(0, 0), cB, voffB); PG8_STAGE(PG8_SB(0, 1), cB + hstepB, voffB); PG8_STAGE(PG8_SA(0, 0), cA, voffA); PG8_STAGE(PG8_SA(0, 1), cA + hstepA, voffA);
    if (wr == 1) PG8_BAR;
    PG8_WAIT_V(2); PG8_BAR;
    PG8_STAGE(PG8_SB(1, 0), cB + kstep, voffB); PG8_STAGE(PG8_SA(1, 0), cA + kstep, voffA); PG8_STAGE(PG8_SB(1, 1), cB + hstepB + kstep, voffB);
    PG8_WAIT_V(6); PG8_BAR;
    for (;;) {
        const bool has_next = get_unit(P.ws, mode, ui + 1, G, c, nxt);
        const char* nA = has_next ? nxt.a : cA; const char* nB = has_next ? nxt.b : cB;
        const bool nqk = has_next ? ((mode == G_IN) && nxt.pn < 8) : cqk;
        for (int t = 0; t < nt; t += 2) {
            const bool last = (t == nt - 2);
            unsigned vb2[2] = {voffB[0], voffB[1]};
            if (last && nqk != cqk) { vb2[0] = PG8_BOFF(0, nqk); vb2[1] = PG8_BOFF(1, nqk); }
            const char* a1 = cA + (size_t)(t + 1) * kstep;
            const char* a2 = last ? nA : cA + (size_t)(t + 2) * kstep; const char* b2 = last ? nB : cB + (size_t)(t + 2) * kstep;
            const char* a3 = a2 + kstep; const char* b3 = b2 + kstep;
            PG8_LDB(B0, 0, 0); PG8_LDB(B1, 0, 1); PG8_SCHED; PG8_LDA(At, 0, 0); PG8_STAGE(PG8_SA(1, 1), a1 + hstepA, voffA);
            PG8_WAIT_V(8); PG8_WAIT_L(0); PG8_BAR; PG8_MMA(0, 0, At, B0); PG8_MMA(0, 1, At, B1); PG8_BAR; PG8_SCHED;
            PG8_LDA(At, 0, 1); PG8_STAGE(PG8_SB(0, 0), b2, vb2); PG8_STAGE(PG8_SB(0, 1), b2 + hstepB, vb2); PG8_STAGE(PG8_SA(0, 0), a2, voffA);
            PG8_WAIT_V(8); PG8_WAIT_L(0); PG8_BAR; PG8_MMA(1, 0, At, B0); PG8_MMA(1, 1, At, B1); PG8_BAR; PG8_SCHED;
            PG8_LDB(B0, 1, 0); PG8_LDB(B1, 1, 1); PG8_SCHED; PG8_LDA(At, 1, 0); PG8_STAGE(PG8_SA(0, 1), a2 + hstepA, voffA);
            PG8_WAIT_V(8); PG8_WAIT_L(0); PG8_BAR; PG8_MMA(0, 0, At, B0); PG8_MMA(0, 1, At, B1); PG8_BAR; PG8_SCHED;
            PG8_LDA(At, 1, 1); PG8_STAGE(PG8_SB(1, 0), b3, vb2); PG8_STAGE(PG8_SB(1, 1), b3 + hstepB, vb2); PG8_STAGE(PG8_SA(1, 0), a3, voffA);
            PG8_WAIT_V(8); PG8_WAIT_L(0); PG8_BAR; PG8_MMA(1, 0, At, B0); PG8_MMA(1, 1, At, B1); PG8_BAR; PG8_SCHED;
        }
        if (wr == 0) PG8_BAR;
        if (cqk) gemm_epilogue_qk(P, acc, cur, wr, wc, fr, fq, lds);
        else if (!fusedEpi) gemm_epilogue(P, mode, acc, cur, wr, wc, fr, fq);
        if (!has_next) break;
#pragma unroll
        for (int a = 0; a < 2; ++a)
#pragma unroll
            for (int b = 0; b < 2; ++b)
#pragma unroll
                for (int m = 0; m < 4; ++m)
#pragma unroll
                    for (int n = 0; n < 2; ++n) acc[a][b][m][n] = (f32x4){0.f, 0.f, 0.f, 0.f};
        cur = nxt; cA = nA; cB = nB; ++ui; if (nqk != cqk) { cqk = nqk; voffB[0] = PG8_BOFF(0, cqk); voffB[1] = PG8_BOFF(1, cqk); }
        if (wr == 1) PG8_BAR;
    }
    PG8_WAIT_V(0);
    PG8_BAR;
    if (fusedEpi) gemm_epilogue_fused(P, mode, acc, cur, wr, wc, fr, fq, lds, tid);
#undef PG8_BOFF
#undef PG8_SA
#undef PG8_SB
#undef PG8_STAGE
#undef PG8_LDA
#undef PG8_LDB
#undef PG8_MMA
#undef PG8_WAIT_V
#undef PG8_WAIT_L
#undef PG8_BAR
#undef PG8_SCHED
}

namespace att {
constexpr int D = 128, NW = 8, QBLK = 32, KVBLK = 64;
constexpr float SCALE = 0.088388347648318440f;
constexpr float THR = 8.f;
constexpr int LDQ = AW, LDK = HD, LDO = DM;
constexpr size_t SHM_V = KVBLK * D * 2, SHM_K = KVBLK * D * 2, SHM_ATTN = 2 * SHM_V + 2 * SHM_K + NW * 64 * 4;
#define KSWZ(row, colB) ((row) * 256 + ((colB) ^ (((row) & 7) << 4)))
#define SBAR() __builtin_amdgcn_sched_barrier(0)
__device__ __forceinline__ int crow(int r, int hi) { return (r & 3) + 8 * (r >> 2) + 4 * hi; }
__device__ __forceinline__ unsigned cvtpk(float lo, float hi) { unsigned r; asm volatile("v_cvt_pk_bf16_f32 %0, %1, %2" : "=v"(r) : "v"(lo), "v"(hi)); return r; }
__device__ __forceinline__ bf16x8 ld8(const bf16_t* p) { return *reinterpret_cast<const bf16x8*>(p); }

__device__ __forceinline__ void partialSM(f32x16& p0, f32x16& p1, float& m_reg, float& mn, float& alpha) {
  constexpr float C = SCALE * 1.4426950408889634f;
  float pmax = p0[0];
#pragma unroll
  for (int r = 1; r < 16; ++r) pmax = fmaxf(pmax, p0[r]);
#pragma unroll
  for (int r = 0; r < 16; ++r) pmax = fmaxf(pmax, p1[r]);
  { auto rr = __builtin_amdgcn_permlane32_swap(__float_as_uint(pmax), __float_as_uint(pmax), false, false);
    pmax = fmaxf(__uint_as_float(rr[0]), __uint_as_float(rr[1])); }
  if (__builtin_expect(__all(pmax - m_reg <= THR / SCALE), 1)) { mn = m_reg; alpha = 1.f; }
  else { mn = fmaxf(m_reg, pmax); alpha = __builtin_amdgcn_exp2f((m_reg - mn) * C); m_reg = mn; }
  float mnC = -mn * C;
#pragma unroll
  for (int r = 0; r < 16; ++r) p0[r] = fmaf(p0[r], C, mnC);
#pragma unroll
  for (int r = 0; r < 16; ++r) p1[r] = fmaf(p1[r], C, mnC);
#pragma unroll
  for (int r = 0; r < 16; ++r) p0[r] = __builtin_amdgcn_exp2f(p0[r]);
}
__device__ __forceinline__ void finishSM(f32x16& p0, f32x16& p1, float alpha, float& l_reg, bf16x8& pa0, bf16x8& pa1, bf16x8& pa2, bf16x8& pa3) {
#pragma unroll
  for (int r = 0; r < 16; ++r) p1[r] = __builtin_amdgcn_exp2f(p1[r]);
  float ps = 0;
#pragma unroll
  for (int r = 0; r < 16; ++r) ps += p0[r];
#pragma unroll
  for (int r = 0; r < 16; ++r) ps += p1[r];
  { auto rr = __builtin_amdgcn_permlane32_swap(__float_as_uint(ps), __float_as_uint(ps), false, false);
    ps = __uint_as_float(rr[0]) + __uint_as_float(rr[1]); }
  l_reg = l_reg * alpha + ps;
#define PK4(P, BASE, OUT) do { unsigned a0 = cvtpk(P[BASE + 0], P[BASE + 1]), a1 = cvtpk(P[BASE + 2], P[BASE + 3]);   \
    unsigned b0 = cvtpk(P[BASE + 4], P[BASE + 5]), b1 = cvtpk(P[BASE + 6], P[BASE + 7]);                              \
    auto r0 = __builtin_amdgcn_permlane32_swap(a0, b0, false, false); auto r1 = __builtin_amdgcn_permlane32_swap(a1, b1, false, false); \
    u32x4 w = {r0[0], r1[0], r0[1], r1[1]}; OUT = *reinterpret_cast<bf16x8*>(&w); } while (0)
  PK4(p0, 0, pa0); PK4(p0, 8, pa1); PK4(p1, 0, pa2); PK4(p1, 8, pa3);
#undef PK4
}
__device__ __forceinline__ void qkt(f32x16& p0, f32x16& p1, const bf16_t* Ks, const bf16x8* qr, int r32, int hi) {
  p0 = f32x16{}; p1 = f32x16{};
#pragma unroll
  for (int d0 = 0; d0 < 8; ++d0) { int cb = (d0 * 16 + hi * 8) * 2;
    bf16x8 b0 = *reinterpret_cast<const bf16x8*>((const char*)Ks + KSWZ(r32, cb));
    bf16x8 b1 = *reinterpret_cast<const bf16x8*>((const char*)Ks + KSWZ(32 + r32, cb));
    p0 = __builtin_amdgcn_mfma_f32_32x32x16_bf16(b0, qr[d0], p0, 0, 0, 0);
    p1 = __builtin_amdgcn_mfma_f32_32x32x16_bf16(b1, qr[d0], p1, 0, 0, 0); }
}
__device__ __forceinline__ int v_st(int k, int c) { const int kk = (k & ~0xC) | ((k & 4) << 1) | ((k & 8) >> 1); return ((kk >> 3) * 4 + (c >> 5)) * 512 + ((kk & 7) * 32 + (c & 31)) * 2; }
__device__ __forceinline__ int v_rd_base(int lane) { return ((lane & 3) << 3) | (((lane >> 2) & 3) << 6) | (((lane >> 4) & 1) << 5) | (((lane >> 5) & 1) << 8); }
constexpr int v_rd_off(int d0, int ks, int half) { return d0 * 512 + ks * 4096 + half * 2048; }
template <int OFF> __device__ __forceinline__ s16x4 tr_read(int vb) {
  s16x4 r; asm volatile("ds_read_b64_tr_b16 %0, %1 offset:%2" : "=&v"(r) : "v"(vb), "i"(OFF) : "memory"); return r;
}
template <int D0> __device__ __forceinline__ void pv_one(f32x16& od, int vb, bf16x8 pa0, bf16x8 pa1, bf16x8 pa2, bf16x8 pa3) {
  const s16x4 l0 = tr_read<v_rd_off(D0, 0, 0)>(vb), h0 = tr_read<v_rd_off(D0, 0, 1)>(vb), l1 = tr_read<v_rd_off(D0, 1, 0)>(vb), h1 = tr_read<v_rd_off(D0, 1, 1)>(vb);
  const s16x4 l2 = tr_read<v_rd_off(D0, 2, 0)>(vb), h2 = tr_read<v_rd_off(D0, 2, 1)>(vb), l3 = tr_read<v_rd_off(D0, 3, 0)>(vb), h3 = tr_read<v_rd_off(D0, 3, 1)>(vb);
  asm volatile("s_waitcnt lgkmcnt(0)" ::: "memory"); SBAR();
#define PK(L, H) (bf16x8){L[0], L[1], L[2], L[3], H[0], H[1], H[2], H[3]}
  od = __builtin_amdgcn_mfma_f32_32x32x16_bf16(pa0, PK(l0, h0), od, 0, 0, 0);
  od = __builtin_amdgcn_mfma_f32_32x32x16_bf16(pa1, PK(l1, h1), od, 0, 0, 0);
  od = __builtin_amdgcn_mfma_f32_32x32x16_bf16(pa2, PK(l2, h2), od, 0, 0, 0);
  od = __builtin_amdgcn_mfma_f32_32x32x16_bf16(pa3, PK(l3, h3), od, 0, 0, 0);
#undef PK
}
__device__ __forceinline__ void pv_d0(f32x16* o, int vb, bf16x8 pa0, bf16x8 pa1, bf16x8 pa2, bf16x8 pa3) {
  pv_one<0>(o[0], vb, pa0, pa1, pa2, pa3); pv_one<1>(o[1], vb, pa0, pa1, pa2, pa3); pv_one<2>(o[2], vb, pa0, pa1, pa2, pa3); pv_one<3>(o[3], vb, pa0, pa1, pa2, pa3);
}

__device__ __forceinline__ void attn_dense_body(const bf16_t* __restrict__ Qb, const bf16_t* __restrict__ Kh, const bf16_t* __restrict__ Vh,
                                                bf16_t* __restrict__ Ob, int seq, char* lds) {
  int tid_ = threadIdx.x; asm volatile("" : "+v"(tid_));
  const int tid = tid_, wid = tid >> 6, lane = tid & 63, r32 = lane & 31, hi = lane >> 5;
  bf16_t* V_lds = (bf16_t*)lds; bf16_t* K_lds = (bf16_t*)(lds + 2 * SHM_V);
  float* ws = (float*)(lds + 2 * SHM_V + 2 * SHM_K) + wid * 64; float* li_l = ws; float* al_l = ws + 32;
  float m_reg = -1e30f, l_reg = 0; f32x16 o[4] = {}; bf16x8 qr[8];
  const bf16_t* Qw = Qb + (long)(wid * QBLK + r32) * LDQ + hi * 8;
#pragma unroll
  for (int d0 = 0; d0 < 8; ++d0) qr[d0] = ld8(Qw + d0 * 16);
  const int sr = tid >> 4, sc = (tid & 15) * 8, vst0 = v_st(sr, sc), vst1 = v_st(32 + sr, sc);
  const int vb0 = (int)(uintptr_t)V_lds + v_rd_base(lane);
  struct { bf16x8 vs0, vs1, ks0, ks1; } sr_[2];
#define SLOAD(i, k0) do { sr_[i].vs0 = ld8(&Vh[(long)((k0) + sr) * LDK + sc]); sr_[i].vs1 = ld8(&Vh[(long)((k0) + 32 + sr) * LDK + sc]); \
    sr_[i].ks0 = ld8(&Kh[(long)((k0) + sr) * LDK + sc]); sr_[i].ks1 = ld8(&Kh[(long)((k0) + 32 + sr) * LDK + sc]); } while (0)
#define SWRITE(b, i) do { *(bf16x8*)((char*)V_lds + (b) * SHM_V + vst0) = sr_[i].vs0;          \
    *(bf16x8*)((char*)V_lds + (b) * SHM_V + vst1) = sr_[i].vs1; int kc = sc * 2;               \
    *(bf16x8*)((char*)K_lds + (b) * SHM_K + KSWZ(sr, kc)) = sr_[i].ks0;                       \
    *(bf16x8*)((char*)K_lds + (b) * SHM_K + KSWZ(32 + sr, kc)) = sr_[i].ks1; } while (0)
#define SWAIT() asm volatile("s_waitcnt vmcnt(4)" ::: "memory")
#define RESC(a) do { if (__any((a) < 1.f)) { if (hi == 0) al_l[r32] = (a); asm volatile("s_waitcnt lgkmcnt(0)" ::: "memory"); \
    _Pragma("unroll") for (int d = 0; d < 4; ++d) _Pragma("unroll") for (int r = 0; r < 16; ++r) o[d][r] *= al_l[crow(r, hi)]; } } while (0)
  f32x16 pA0, pA1, pB0, pB1; float mnA, mnB, alA, alB; bf16x8 pa0, pa1, pa2, pa3; const int NT = seq / KVBLK;
  constexpr int SE = 0, SO = 1;
  SLOAD(SE, 0); asm volatile("s_waitcnt vmcnt(0)" ::: "memory"); SWRITE(0, SE); __syncthreads();
  qkt(pA0, pA1, K_lds, qr, r32, hi); partialSM(pA0, pA1, m_reg, mnA, alA);
  SLOAD(SO, KVBLK); if (2 < NT) SLOAD(SE, 2 * KVBLK);
  SWAIT(); SWRITE(1, SO); __syncthreads();
  for (int j = 1; j + 1 < NT; j += 2) {
    SBAR(); qkt(pB0, pB1, (bf16_t*)((char*)K_lds + SHM_K), qr, r32, hi);
    finishSM(pA0, pA1, alA, l_reg, pa0, pa1, pa2, pa3); SBAR();
    SLOAD(SO, (j + 2) * KVBLK); SBAR();
    pv_d0(o, vb0, pa0, pa1, pa2, pa3); partialSM(pB0, pB1, m_reg, mnB, alB);
    __syncthreads(); SWAIT(); SWRITE(0, SE);
    RESC(alB); __syncthreads();
    SBAR(); qkt(pA0, pA1, K_lds, qr, r32, hi);
    finishSM(pB0, pB1, alB, l_reg, pa0, pa1, pa2, pa3); SBAR();
    if (j + 3 < NT) SLOAD(SE, (j + 3) * KVBLK); SBAR();
    pv_d0(o, vb0 + (int)SHM_V, pa0, pa1, pa2, pa3); partialSM(pA0, pA1, m_reg, mnA, alA);
    __syncthreads(); SWAIT(); SWRITE(1, SO);
    RESC(alA); __syncthreads();
  }
  SBAR(); qkt(pB0, pB1, (bf16_t*)((char*)K_lds + SHM_K), qr, r32, hi);
  finishSM(pA0, pA1, alA, l_reg, pa0, pa1, pa2, pa3); SBAR();
  pv_d0(o, vb0, pa0, pa1, pa2, pa3); partialSM(pB0, pB1, m_reg, mnB, alB);
  __syncthreads(); RESC(alB);
  finishSM(pB0, pB1, alB, l_reg, pa0, pa1, pa2, pa3); SBAR();
  pv_d0(o, vb0 + (int)SHM_V, pa0, pa1, pa2, pa3);
  if (hi == 0) li_l[r32] = l_reg; asm volatile("s_waitcnt lgkmcnt(0)" ::: "memory");
  float rli[16];
#pragma unroll
  for (int r = 0; r < 16; ++r) rli[r] = __builtin_amdgcn_rcpf(li_l[crow(r, hi)]);
  bf16_t* Ow = Ob + (long)(wid * QBLK) * LDO;
#pragma unroll
  for (int r = 0; r < 16; ++r) { int orow = crow(r, hi);
#pragma unroll
    for (int d0 = 0; d0 < 4; ++d0) Ow[(long)orow * LDO + d0 * 32 + r32] = f2bf(o[d0][r] * rli[r]); }
  __syncthreads();
#undef SLOAD
#undef SWRITE
#undef SWAIT
#undef RESC
}
#undef KSWZ
#undef SBAR
}

constexpr int TR_LDS_WAVE = 64 * 65 * 4;
__device__ __forceinline__ void transpose_share(const float* __restrict__ W, int K, int N, bf16_t* __restrict__ WT, int w, int nw, LAS unsigned char* lds, int first = 0, int last = 1 << 30) {
    int tid_ = threadIdx.x; asm volatile("" : "+v"(tid_));
    const int wid = tid_ >> 6, lane = tid_ & 63;
    LAS float* scr = (LAS float*)(lds + wid * TR_LDS_WAVE);
    const int nblk = N / 64; int nitems = (K / 64) * nblk; if (last < nitems) nitems = last;
    const int kr = lane >> 4, n4 = (lane & 15) * 4, c = lane & 7;
    int it = first + w * 8 + wid;
    if (it >= nitems) return;
    f32x4 v[16];
    { const int kb = it / nblk, nb = it - kb * nblk;
#pragma unroll
      for (int i = 0; i < 16; ++i) v[i] = __builtin_nontemporal_load((const f32x4*)(W + (size_t)(64 * kb + 4 * i + kr) * N + 64 * nb + n4)); }
    for (;;) {
        const int kb = it / nblk, nb = it - kb * nblk, k0 = 64 * kb, n0 = 64 * nb;
#pragma unroll
        for (int i = 0; i < 16; ++i) { LAS float* d = scr + (4 * i + kr) * 65 + n4; d[0] = v[i].x; d[1] = v[i].y; d[2] = v[i].z; d[3] = v[i].w; }
        const int nx = it + nw; const bool more = nx < nitems;
        if (more) { const int kb2 = nx / nblk, nb2 = nx - kb2 * nblk;
#pragma unroll
            for (int i = 0; i < 16; ++i) v[i] = __builtin_nontemporal_load((const f32x4*)(W + (size_t)(64 * kb2 + 4 * i + kr) * N + 64 * nb2 + n4)); }
        LDS_WAIT();
#pragma unroll
        for (int j = 0; j < 8; ++j) { const int n = (lane >> 3) + 8 * j; const LAS float* sp = scr + (8 * c) * 65 + n;
            u32x4 o; o.x = cvt_pk_bf16(sp[0 * 65], sp[1 * 65]); o.y = cvt_pk_bf16(sp[2 * 65], sp[3 * 65]); o.z = cvt_pk_bf16(sp[4 * 65], sp[5 * 65]); o.w = cvt_pk_bf16(sp[6 * 65], sp[7 * 65]);
            *(u32x4*)(WT + (size_t)(n0 + n) * K + k0 + 8 * c) = o; }
        LDS_WAIT();
        if (!more) break;
        it = nx;
    }
}

__device__ __forceinline__ void dft_slice(unsigned char* ws, int first, int cnt) {
    bf16_t* dft = (bf16_t*)(ws + WS_DFT);
    for (int q = 0; q < cnt; ++q) {
        const int idx = first + q * 512;
        if (idx >= 2048 * 512) break;
        const int k = idx >> 9, n0 = (idx & 511) * 8, part = n0 >> 11, nn = n0 & 2047;
        float v[8];
#pragma unroll
        for (int e = 0; e < 8; ++e) { const float rev = (float)((k * (nn + e)) & 2047) * (1.0f / 2048.0f); v[e] = part ? __builtin_amdgcn_sinf(rev) : __builtin_amdgcn_cosf(rev); }
        u32x4 o; o.x = cvt_pk_bf16(v[0], v[1]); o.y = cvt_pk_bf16(v[2], v[3]); o.z = cvt_pk_bf16(v[4], v[5]); o.w = cvt_pk_bf16(v[6], v[7]);
        *(u32x4*)(dft + (size_t)k * 4096 + n0) = o;
    }
}

__device__ __forceinline__ void ada_phase(const Params& P, LAS unsigned char* lds, int G) {
    int tid_ = threadIdx.x; asm volatile("" : "+v"(tid_));
    const int tid = tid_, wid = tid >> 6, lane = tid & 63;
    unsigned char* ws = P.ws;
    LAS float* sl = (LAS float*)lds;
    for (int i = tid; i < 5 * DM; i += 512) { const float v = (i < 4 * DM) ? P.in[I_C][i] : P.in[I_CCTX][i - 4 * DM]; sl[i] = v / (1.f + expf(-v)); }
    __syncthreads();
    LAS float* red = (LAS float*)(lds + 40960);
    float* mod = (float*)(ws + WS_MOD);
    const float* w_ada = P.in[I_WADA];
    const int dper = (2048 * 512 / 512 + G - 1) / G, dbase = blockIdx.x * dper * 512; int jd = 0;
    int it = blockIdx.x;
    f32x4 wv[16];
    if (it < 768) { const float* wp = w_ada + (size_t)((it / 48) * 128 + wid * 16) * NMOD6 + (it % 48) * 256 + lane * 4;
#pragma unroll
        for (int i = 0; i < 16; ++i) wv[i] = __builtin_nontemporal_load((const f32x4*)(wp + (size_t)i * NMOD6)); }
    while (it < 768) {
        const int cc = it % 48, kc = it / 48;
        const int kb = kc * 128 + wid * 16;
        f32x4 acc[5];
#pragma unroll
        for (int r = 0; r < 5; ++r) acc[r] = (f32x4){0.f, 0.f, 0.f, 0.f};
#pragma unroll
        for (int i = 0; i < 16; ++i) {
#pragma unroll
            for (int r = 0; r < 5; ++r) { const float s = sl[r * DM + kb + i]; acc[r] += wv[i] * s; }
        }
        const int nx = it + G;
        if (nx < 768) { const float* wp = w_ada + (size_t)((nx / 48) * 128 + wid * 16) * NMOD6 + (nx % 48) * 256 + lane * 4;
#pragma unroll
            for (int i = 0; i < 16; ++i) wv[i] = __builtin_nontemporal_load((const f32x4*)(wp + (size_t)i * NMOD6)); }
        { const int take = (dper - jd) < 3 ? (dper - jd) : 3; dft_slice(ws, dbase + jd * 512 + tid, take); jd += take; }
#pragma unroll
        for (int r = 0; r < 5; ++r) *(LAS f32x4*)(red + (wid * 5 + r) * 256 + lane * 4) = acc[r];
        asm volatile("s_waitcnt lgkmcnt(0)" ::: "memory"); __builtin_amdgcn_s_barrier(); asm volatile("" ::: "memory");
        if (tid < 320) {
            const int r = tid >> 6, q = tid & 63;
            f32x4 s = (f32x4){0.f, 0.f, 0.f, 0.f};
#pragma unroll
            for (int w = 0; w < 8; ++w) s += *(const LAS f32x4*)(red + (w * 5 + r) * 256 + q * 4);
            if (kc == 0) s += *(const f32x4*)(P.in[I_BADA] + cc * 256 + q * 4);
            float* dst = mod + (size_t)r * NMOD6 + cc * 256 + q * 4;
            unsafeAtomicAdd(dst + 0, s[0]); unsafeAtomicAdd(dst + 1, s[1]); unsafeAtomicAdd(dst + 2, s[2]); unsafeAtomicAdd(dst + 3, s[3]);
        }
        asm volatile("s_waitcnt lgkmcnt(0)" ::: "memory"); __builtin_amdgcn_s_barrier(); asm volatile("" ::: "memory");
        it = nx;
    }
    dft_slice(ws, dbase + jd * 512 + tid, dper - jd);
    asm volatile("s_waitcnt vmcnt(0)" ::: "memory");
    __syncthreads();
    if (tid == 0) { __builtin_amdgcn_fence(__ATOMIC_RELEASE, "agent"); asm volatile("s_waitcnt vmcnt(0)" ::: "memory");
                    __hip_atomic_fetch_add((unsigned*)(ws + WS_QCTR), 1u, __ATOMIC_RELAXED, __HIP_MEMORY_SCOPE_AGENT); }
}

__device__ __forceinline__ void gen_tables(const Params& P, LAS unsigned char* lds, int blk, int nblk, int what = 3) {
    int tid_ = threadIdx.x; asm volatile("" : "+v"(tid_));
    const int tid = tid_;
    unsigned char* ws = P.ws;
    LAS float* ct = (LAS float*)lds;
    for (int j = tid; j < 2048; j += 512) ct[j] = cospif((float)j * (1.0f / 1024.0f));
    __syncthreads();
    bf16_t* dft = (bf16_t*)(ws + WS_DFT);
    if (what & 1) for (int idx = blk * 512 + tid; idx < 2048 * 512; idx += nblk * 512) {
        const int k = idx >> 9, n0 = (idx & 511) * 8, part = n0 >> 11, nn = n0 & 2047;
        float v[8];
#pragma unroll
        for (int e = 0; e < 8; ++e) { const int j = (k * (nn + e)) & 2047; v[e] = ct[part ? ((j - 512) & 2047) : j]; }
        u32x4 o; o.x = cvt_pk_bf16(v[0], v[1]); o.y = cvt_pk_bf16(v[2], v[3]); o.z = cvt_pk_bf16(v[4], v[5]); o.w = cvt_pk_bf16(v[6], v[7]);
        *(u32x4*)(dft + (size_t)k * 4096 + n0) = o;
    }
    for (int idx = blk * 512 + tid; idx < 64 * 32; idx += nblk * 512) {
        const int pv = idx >> 5, i = idx & 31;
        const float ang = (float)pv * powf(10000.0f, -(float)(2 * i) / 64.0f);
        float* t = (float*)(ws + WS_ROPE) + (size_t)(pv * 32 + i) * 2;
        t[0] = cosf(ang); t[1] = sinf(ang);
    }
    bf16_t* gt = (bf16_t*)(ws + WS_GT);
    LAS float* wfs = (LAS float*)(lds + 8192);
    const int NS = nblk >= 4 ? nblk / 4 : 1;
    for (int t = blk; t < 4 * NS; t += nblk) {
        const int g = t / NS, sidx = t - g * NS;
        const float* wf = P.in[I_WF] + (size_t)g * 128 * 128;
#pragma unroll
        for (int j = 0; j < 8; ++j) *(LAS f32x4*)(wfs + (tid + 512 * j) * 4) = *(const f32x4*)(wf + (tid + 512 * j) * 4);
        __syncthreads();
        for (int idx = sidx * 512 + tid; idx < 2 * 128 * 128; idx += NS * 512) {
            const int d = idx & 127, cch = (idx >> 7) & 127, part = idx >> 14;
            float sum = 0.f;
#pragma unroll 16
            for (int l = 0; l < 128; ++l) {
                const int j = (cch * l) & 127;
                const float cs = part ? -ct[((j - 32) & 127) * 16] : ct[j * 16];
                sum += cs * wfs[l * 128 + d];
            }
            gt[(size_t)((g * 2 + part) * 128 + d) * 128 + cch] = f2bf(sum * (1.0f / 512.0f));
        }
        __syncthreads();
    }
}

template <int MODE> __device__ __forceinline__ const float* rows_src(const Params& P, int r) {
    if (MODE == 0) return (r < MTOK) ? P.in[I_X] + (size_t)r * DM : P.in[I_CTX] + (size_t)(r - MTOK) * DM;
    return P.out + (size_t)r * DM;
}
template <int MODE> __device__ __forceinline__ void rows_pass(const Params& P, int G) {
    int tid_ = threadIdx.x; asm volatile("" : "+v"(tid_));
    const int tid = tid_, wid = tid >> 6, lane = tid & 63;
    const int gw = blockIdx.x * 8 + wid, NGW = G * 8;
    const int nrows = (MODE == 0) ? (MTOK + MCTX) : MTOK;
    if (MODE == 0) {
        if (tid == 0) { unsigned sp = 0; while (__hip_atomic_load((unsigned*)(P.ws + WS_QCTR), __ATOMIC_RELAXED, __HIP_MEMORY_SCOPE_AGENT) < (unsigned)G) { __builtin_amdgcn_s_sleep(2); if (++sp > (1u << 22)) break; } }
        __syncthreads();
        __builtin_amdgcn_fence(__ATOMIC_ACQUIRE, "agent");
    }
    const float* mod = (const float*)(P.ws + WS_MOD);
    const float* gain = P.in[MODE == 0 ? I_G1 : (MODE == 1 ? I_G2 : I_GF)];
    int r = gw;
    if (r >= nrows) return;
    f32x4 v[8], nv[8];
    { const float* src = rows_src<MODE>(P, r);
#pragma unroll
      for (int j = 0; j < 8; ++j) v[j] = (MODE == 0) ? __builtin_nontemporal_load((const f32x4*)(src + (lane + 64 * j) * 4)) : *(const f32x4*)(src + (lane + 64 * j) * 4); }
    for (;;) {
        const int rn = r + NGW; const bool more = rn < nrows;
        if (more) { const float* src = rows_src<MODE>(P, rn);
#pragma unroll
            for (int j = 0; j < 8; ++j) nv[j] = (MODE == 0) ? __builtin_nontemporal_load((const f32x4*)(src + (lane + 64 * j) * 4)) : *(const f32x4*)(src + (lane + 64 * j) * 4); }
        const int mr = (MODE == 0 && r >= MTOK) ? 4 : (r >> 11);
        float ss = 0.f;
#pragma unroll
        for (int j = 0; j < 8; ++j) ss += (v[j].x * v[j].x + v[j].y * v[j].y) + (v[j].z * v[j].z + v[j].w * v[j].w);
        const float rstd = rsqrtf(wave_sum(ss) * (1.0f / DM) + EPS);
#pragma unroll
        for (int j = 0; j < 8; ++j) {
            const int col = (lane + 64 * j) * 4;
            const f32x4 g = *(const f32x4*)(gain + col);
            f32x4 y = v[j] * rstd * g;
            if (MODE == 2) { *(f32x4*)(P.out + (size_t)r * DM + col) = y; }
            else {
                const float* mrow = mod + (size_t)mr * NMOD6 + (MODE == 0 ? 0 : 3 * DM);
                const f32x4 sh = *(const f32x4*)(mrow + col), sc = *(const f32x4*)(mrow + DM + col);
                y = y * (1.0f + sc) + sh;
                u32x2 o; o.x = cvt_pk_bf16(y.x, y.y); o.y = cvt_pk_bf16(y.z, y.w);
                bf16_t* dst = (bf16_t*)(P.ws + (MODE == 0 ? WS_H : WS_H2)) + (size_t)r * DM + col;
                *(u32x2*)dst = o;
            }
        }
        if (!more) break;
#pragma unroll
        for (int j = 0; j < 8; ++j) v[j] = nv[j];
        r = rn;
    }
}

__device__ __forceinline__ void attention_phase(const Params& P, unsigned char* lds, int G) {
    const int c = blockIdx.x;
    for (int j = 0;; ++j) {
        int b, h, qb;
        if (G == 256) {
            if (c < 64 || j > 1) break;
            const int grp = (c & 7) + 8 * j, w = (c - 64) >> 3;
            b = grp >> 2; h = (grp & 3) * 3 + (w >> 3); qb = w & 7;
        } else {
            const int au = c + G * j;
            if (au >= NB * NQH * 8) break;
            qb = au & 7; const int bh = au >> 3; h = bh % NQH; b = bh / NQH;
        }
        const bf16_t* Qb = (const bf16_t*)(P.ws + WS_Q) + (size_t)(b * SEQ + qb * 256) * AW + h * HD;
        const bf16_t* Kh = (const bf16_t*)(P.ws + WS_K) + (size_t)(b * NKVH + h / 3) * SKV * HD;
        const bf16_t* Vh = (const bf16_t*)(P.ws + WS_V) + (size_t)(b * NKVH + h / 3) * SKV * HD;
        bf16_t* Ob = (bf16_t*)(P.ws + WS_MIX) + (size_t)(b * SEQ + qb * 256) * DM + h * HD;
        att::attn_dense_body(Qb, Kh, Vh, Ob, SKV, (char*)lds);
    }
}


#define XB_TMO      128
#define XB_XCNT(j)  (256  + 64 * (j))
#define XB_XSUB(j)  (1280 + 64 * (j))
#define XB_XGEN(j)  (2304 + 64 * (j))
#define XB_TOP      3328
#define XB_TOPGEN   3392
#define XCD_BAR_WORDS 3456
#define XB_SPIN_CAP (1u << 22)
__device__ __forceinline__ unsigned xb_ld(unsigned* p)              { return __hip_atomic_load(p, __ATOMIC_RELAXED, __HIP_MEMORY_SCOPE_AGENT); }
__device__ __forceinline__ unsigned xb_add(unsigned* p, unsigned v) { return __hip_atomic_fetch_add(p, v, __ATOMIC_RELAXED, __HIP_MEMORY_SCOPE_AGENT); }
__device__ __forceinline__ unsigned xb_xcc_id() { return (unsigned)__builtin_amdgcn_s_getreg((3 << 11) | 20) & 0xFu; }
#define XB_SPIN(cond, bar) do { unsigned _sp = 0; while (cond) { __builtin_amdgcn_s_sleep(1); \
    if ((++_sp & 255u) == 0u) { if (xb_ld(&(bar)[XB_TMO])) break; if (_sp > XB_SPIN_CAP) { atomicAdd(&(bar)[XB_TMO], 1u); break; } } } } while (0)
struct XcdBarrier { unsigned* bar; unsigned x; volatile LAS unsigned* st; };
__device__ __forceinline__ XcdBarrier xcd_barrier_post(unsigned* bar, volatile LAS unsigned* st) {
    XcdBarrier b; b.bar = bar; b.x = xb_xcc_id(); b.st = st;
    if (threadIdx.x == 0) (void)xb_add(&bar[XB_XCNT(b.x)], 1u);
    return b;
}
__device__ __forceinline__ void xcd_barrier_complete(unsigned* bar, unsigned x, unsigned& nloc, unsigned& nx) {
    const unsigned G = gridDim.x * gridDim.y * gridDim.z;
    unsigned sum, cnt, mine, sp = 0u;
    for (;;) {
        sum = 0u; cnt = 0u; mine = 0u;
#pragma nounroll
        for (unsigned j = 0; j < 16; ++j) { const unsigned c = xb_ld(&bar[XB_XCNT(j)]); sum += c; cnt += (c > 0u) ? 1u : 0u; mine = (j == x) ? c : mine; }
        if (sum == G) break;
        __builtin_amdgcn_s_sleep(1);
        if ((++sp & 255u) == 0u) { if (xb_ld(&bar[XB_TMO])) break; if (sp > XB_SPIN_CAP) { atomicAdd(&bar[XB_TMO], 1u); break; } }
    }
    nloc = mine > 0u ? mine : 1u; nx = cnt > 0u ? cnt : 1u;
}
__device__ __forceinline__ void xcd_barrier(const XcdBarrier& b) {
    asm volatile("s_waitcnt vmcnt(0)" ::: "memory");
    __syncthreads();
    if (threadIdx.x == 0) {
        unsigned* bar = b.bar;
        __builtin_amdgcn_s_waitcnt(0);
        unsigned nloc = b.st[0], nx = b.st[1];
        if (nloc == 0u) { xcd_barrier_complete(bar, b.x, nloc, nx); b.st[0] = nloc; b.st[1] = nx; }
        const unsigned old = xb_add(&bar[XB_XSUB(b.x)], 1u);
        const unsigned gen = old / nloc;
        if (old + 1u == (gen + 1u) * nloc) {
            __builtin_amdgcn_fence(__ATOMIC_RELEASE, "agent");
            asm volatile("s_waitcnt vmcnt(0)" ::: "memory");
            const unsigned og = xb_add(&bar[XB_TOP], 1u);
            const unsigned tg = og / nx;
            if (og + 1u == (tg + 1u) * nx) xb_add(&bar[XB_TOPGEN], 1u);
            else XB_SPIN(xb_ld(&bar[XB_TOPGEN]) == tg, bar);
            __builtin_amdgcn_fence(__ATOMIC_ACQUIRE, "agent");
            xb_add(&bar[XB_XGEN(b.x)], 1u);
            asm volatile("s_waitcnt vmcnt(0)" ::: "memory");
        } else {
            XB_SPIN(xb_ld(&bar[XB_XGEN(b.x)]) == gen, bar);
            __builtin_amdgcn_fence(__ATOMIC_ACQUIRE, "agent");
            asm volatile("s_waitcnt vmcnt(0)" ::: "memory");
        }
    }
    __syncthreads();
}

__global__ void __launch_bounds__(512, 2) fwd_megakernel(Params P_) {
    extern __shared__ __attribute__((aligned(16))) unsigned char lds[];
    cg::grid_group grid = cg::this_grid();
    const int G_ = gridDim.x, c_ = blockIdx.x;
    LAS unsigned char* l3 = (LAS unsigned char*)lds;
    volatile LAS unsigned* misc = (volatile LAS unsigned*)(l3 + LDS_MISC);
    if (threadIdx.x < 64) misc[threadIdx.x] = 0u;
    __syncthreads();
    XcdBarrier xbar = xcd_barrier_post((unsigned*)(P_.ws + WS_BAR), misc + 8);
#if PROBE >= 100
    unsigned long long pt0 = 0, pt1 = 0;
#endif
#pragma nounroll
    for (int ph = 0; ph < 10; ++ph) {
        Params P = P_; int G = G_, c = c_;
        asm volatile("" : "+s"(G), "+s"(c), "+s"(P.ws), "+s"(P.out));
        int gm = -1;
#if PROBE >= 100
        if (ph == PROBE - 100) pt0 = __builtin_amdgcn_s_memrealtime();
        if (ph == PROBE - 99) pt1 = __builtin_amdgcn_s_memrealtime();
#endif
        switch (ph) {
        case 0: ada_phase(P, l3, G); transpose_share(P.in[I_WIN], DM, INW, (bf16_t*)(P.ws + WS_WIN), c, G * 8, l3); transpose_share(P.in[I_WOUT], DM, DM, (bf16_t*)(P.ws + WS_WOUT), c, G * 8, l3); __syncthreads(); gen_tables(P, l3, c, G, 2); __syncthreads();
                break;
        case 1: rows_pass<0>(P, G); break;
        case 2: gm = G_IN; break;
        case 3: if (G != 256) gm = G_F1; break;
        case 4: if (G == 256 && c < 64) {
                    gemm_phase(l3, P, G_F1, 64, c);
                    asm volatile("s_waitcnt vmcnt(0)" ::: "memory"); __syncthreads();
                    if (threadIdx.x == 0) {
                        unsigned* f1c = (unsigned*)(P.ws + WS_QCTR) + 64;
                        __builtin_amdgcn_fence(__ATOMIC_RELEASE, "agent"); asm volatile("s_waitcnt vmcnt(0)" ::: "memory");
                        __hip_atomic_fetch_add(f1c, 1u, __ATOMIC_RELAXED, __HIP_MEMORY_SCOPE_AGENT);
                        unsigned sp = 0; while (__hip_atomic_load(f1c, __ATOMIC_RELAXED, __HIP_MEMORY_SCOPE_AGENT) < 64u) { __builtin_amdgcn_s_sleep(2); if (++sp > (1u << 22)) break; }
                        __builtin_amdgcn_fence(__ATOMIC_ACQUIRE, "agent"); asm volatile("s_waitcnt vmcnt(0)" ::: "memory");
                    }
                    __syncthreads();
                }
                gm = G_F2; break;
        case 5: gm = G_OUT; break;
        case 6: if (G != 256) rows_pass<1>(P, G); break;
        case 7: gm = G_UP; break;
        case 8: gm = G_DOWN; break;
        default: if (G != 256) rows_pass<2>(P, G); break;
        }
#ifndef NO_GEMM
        if (gm >= 0) gemm_phase(l3, P, gm, G, c);
#endif
#ifndef NO_ATT
        if (ph == 4) attention_phase(P, lds, G);
#endif
        if (ph == 2) { if (G != 256) transpose_share(P.in[I_W1], DM, DFF, (bf16_t*)(P.ws + WS_W1), c, G * 8, l3);
                       else if (c >= 144) transpose_share(P.in[I_W1], DM, DFF, (bf16_t*)(P.ws + WS_W1), c - 144, 112 * 8, l3); }
        if (ph == 4) { if (G != 256) transpose_share(P.in[I_W2], DFF, DM, (bf16_t*)(P.ws + WS_W2), c, G * 8, l3);
                       else if (c < 64) transpose_share(P.in[I_W2], DFF, DM, (bf16_t*)(P.ws + WS_W2), c, 64 * 8, l3); }
#if PROBE == 3
        if (ph == 7) { __syncthreads(); gemm_phase(l3, P, gm, G, c); }
#endif
#if PROBE == 4
        if (ph == 4) { __syncthreads(); gemm_phase(l3, P, gm, G, c); attention_phase(P, lds, G); }
#endif
        if (G == 0x7fffffff) grid.sync();
        if (ph > 0 && ph < 9 && !(G == 256 && (ph == 3 || ph == 6 || ph == 8))) xcd_barrier(xbar);
    }
#if PROBE >= 100
    if (PROBE - 99 == 10) pt1 = __builtin_amdgcn_s_memrealtime();
    if (blockIdx.x == 0 && threadIdx.x < 64) {
        const unsigned long long te = __builtin_amdgcn_s_memrealtime(), want = 16ull * (pt1 - pt0);
        while (__builtin_amdgcn_s_memrealtime() - te < want) __builtin_amdgcn_s_sleep(8);
    }
#endif
}

extern "C" void kernel_launch(void* const* d_in, const int* in_sizes, int n_in, void* d_out, int out_size, void* d_ws, size_t ws_size, hipStream_t stream) {
    static int grid_blocks = 0;
    if (grid_blocks == 0) {
        if (n_in != 16 || out_size != MTOK * DM || ws_size < WS_END) { fprintf(stderr, "kernel_launch: unexpected shapes (n_in %d out %d ws %zu)\n", n_in, out_size, ws_size); grid_blocks = -1; return; }
        int dev = 0, cus = 0, per_cu = 0;
        (void)hipGetDevice(&dev);
        (void)hipDeviceGetAttribute(&cus, hipDeviceAttributeMultiprocessorCount, dev);
        if (hipFuncSetAttribute((const void*)fwd_megakernel, hipFuncAttributeMaxDynamicSharedMemorySize, LDS_BYTES) != hipSuccess) { fprintf(stderr, "kernel_launch: hipFuncSetAttribute failed\n"); grid_blocks = -1; return; }
        if (hipOccupancyMaxActiveBlocksPerMultiprocessor(&per_cu, (const void*)fwd_megakernel, 512, LDS_BYTES) != hipSuccess || per_cu < 1) { fprintf(stderr, "kernel_launch: occupancy query failed (%d)\n", per_cu); per_cu = 1; }
        (void)hipGetLastError();
        grid_blocks = cus;
    }
    if (grid_blocks < 0) return;
    (void)hipMemsetAsync((char*)d_ws + WS_MOD, 0, WS_CTL_BYTES, stream);
    Params p{};
    for (int i = 0; i < 16; ++i) p.in[i] = (const float*)d_in[i];
    p.out = (float*)d_out; p.ws = (unsigned char*)d_ws;
    void* args[] = {&p};
    hipError_t e = hipLaunchCooperativeKernel((const void*)fwd_megakernel, dim3(grid_blocks), dim3(512), args, LDS_BYTES, stream);
    if (e != hipSuccess) fprintf(stderr, "cooperative launch failed: %s (grid %d)\n", hipGetErrorString(e), grid_blocks);
}
#ifdef TEST_KERNELS
__global__ void __launch_bounds__(512, 2) t_att(Params P) { extern __shared__ __attribute__((aligned(16))) unsigned char lds[]; attention_phase(P, lds, gridDim.x); }
__global__ void __launch_bounds__(512, 2) t_gemm(Params P, int mode) { extern __shared__ __attribute__((aligned(16))) unsigned char lds[]; gemm_phase((LAS unsigned char*)lds, P, mode, gridDim.x, blockIdx.x); }
__global__ void __launch_bounds__(512, 2) t_gemm_up(Params P) { extern __shared__ __attribute__((aligned(16))) unsigned char lds[]; gemm_phase((LAS unsigned char*)lds, P, G_UP, gridDim.x, blockIdx.x); }
__global__ void __launch_bounds__(512, 2) t_gemm_out(Params P) { extern __shared__ __attribute__((aligned(16))) unsigned char lds[]; gemm_phase((LAS unsigned char*)lds, P, G_OUT, gridDim.x, blockIdx.x); }
#endif
```

```cpp
#include <hip/hip_runtime.h>
#include <hip/hip_bf16.h>
#include <hip/hip_cooperative_groups.h>
#include <cstdio>
#include <cstdint>
namespace cg = cooperative_groups;

#ifndef PROBE
#define PROBE 0
#endif
#define LAS __attribute__((address_space(3)))
typedef unsigned short bf16_t;
typedef short bf16x8 __attribute__((ext_vector_type(8)));
typedef short s16x4 __attribute__((ext_vector_type(4)));
typedef float f32x4 __attribute__((ext_vector_type(4)));
typedef float f32x16 __attribute__((ext_vector_type(16)));
typedef unsigned u32x4 __attribute__((ext_vector_type(4)));
typedef unsigned u32x2 __attribute__((ext_vector_type(2)));

constexpr int DM = 2048, NB = 4, SEQ = 2048, CTXL = 256, HD = 128, NQH = 12, NKVH = 4;
constexpr int AW = 1536, KVW = 512, FW = 512, INW = 3072, DFF = 8192, NMOD6 = 6 * DM;
constexpr int MTOK = NB * SEQ, MCTX = NB * CTXL, SKV = SEQ + CTXL;
constexpr float EPS = 1e-6f;

constexpr size_t MiB = 1u << 20;
constexpr size_t WS_MOD = 0;
constexpr size_t WS_BAR = 245760;
constexpr size_t WS_QCTR = 245760 + 16384;
constexpr size_t WS_XACC = 262144 + 4096;
constexpr size_t WS_CTL_BYTES = 262144 + 4096 + 131072;
constexpr size_t WS_XSLOT = 1 * MiB + 512 * 1024;
constexpr size_t WS_ROPE = 512 * 1024;
constexpr size_t WS_GT = 1 * MiB;
constexpr size_t WS_WIN = 2 * MiB;
constexpr size_t WS_WOUT = 14 * MiB;
constexpr size_t WS_W1 = 22 * MiB;
constexpr size_t WS_W2 = 54 * MiB;
constexpr size_t WS_DFT = 86 * MiB;
constexpr size_t WS_H2 = 102 * MiB;
constexpr size_t WS_H = 134 * MiB;
constexpr size_t WS_Q = 170 * MiB;
constexpr size_t WS_K = 194 * MiB;
constexpr size_t WS_V = 203 * MiB;
constexpr size_t WS_U = 212 * MiB;
constexpr size_t WS_ZT = 220 * MiB;
constexpr size_t WS_MIX = 236 * MiB;
constexpr size_t WS_A1 = 134 * MiB;
constexpr size_t WS_END = 268 * MiB;

constexpr int LDS_MISC = 8 * 64 * 65 * 4;
constexpr int LDS_RED = LDS_MISC + 1024;
constexpr int LDS_BYTES = LDS_RED + 8192;

struct Params { const float* in[16]; float* out; unsigned char* ws; };
enum { I_X = 0, I_C, I_CTX, I_CCTX, I_WADA, I_BADA, I_G1, I_WIN, I_QG, I_KG, I_WF, I_WOUT, I_G2, I_W1, I_W2, I_GF };

__device__ __forceinline__ unsigned cvt_pk_bf16(float lo, float hi) { unsigned r; asm("v_cvt_pk_bf16_f32 %0, %1, %2" : "=v"(r) : "v"(lo), "v"(hi)); return r; }
__device__ __forceinline__ float bf2f(bf16_t v) { return __uint_as_float(((unsigned)v) << 16); }
__device__ __forceinline__ bf16_t f2bf(float f) { return (bf16_t)(cvt_pk_bf16(f, 0.f) & 0xffffu); }
template <int M> __device__ __forceinline__ float swz_xor(float v) { return __int_as_float(__builtin_amdgcn_ds_swizzle(__float_as_int(v), 0x1F | (M << 10))); }
__device__ __forceinline__ float half_sum(float v) { auto rr = __builtin_amdgcn_permlane32_swap(__float_as_uint(v), __float_as_uint(v), false, false); return __uint_as_float(rr[0]) + __uint_as_float(rr[1]); }
__device__ __forceinline__ float wave_sum(float v) {
    v += swz_xor<1>(v); v += swz_xor<2>(v); v += swz_xor<4>(v); v += swz_xor<8>(v); v += swz_xor<16>(v);
    return half_sum(v);
}
#define LDS_WAIT() asm volatile("s_waitcnt lgkmcnt(0)" ::: "memory")

constexpr int BM = 256, BK = 64, HALF = 128, HTB = HALF * BK * 2, NXCD = 8, WGM = 8;
__device__ __forceinline__ int lds_byte(int r, int c) { const int st = (r >> 4) * 2 + (c >> 5), rr = r & 15, cc = c & 31, ob = rr * 64 + cc * 2; return st * 1024 + (ob ^ (((ob >> 9) & 1) << 5)); }
__device__ __forceinline__ void stage_rc(int b, int& R, int& C) { const int st = b / 1024, sb = b % 1024, swz = sb ^ (((sb >> 9) & 1) << 5); R = (st >> 1) * 16 + swz / 64; C = (st & 1) * 32 + (swz % 64) / 2; }
__device__ __forceinline__ int perm32(int rho) { const int n = rho >> 4, i = rho & 15; return 8 * (i >> 2) + 4 * n + (i & 3); }

struct Unit { int pm, pn; const char* a; const char* b; };
enum { G_IN = 0, G_F1, G_F2, G_OUT, G_UP, G_DOWN };

__device__ __forceinline__ void remap_tile(int L, int nM, int nN, int& pm, int& pn) {
    const int nwg = nM * nN; int wgid = L;
    { const int q = nwg / NXCD, r = nwg % NXCD, xcd = wgid % NXCD, off = wgid / NXCD; wgid = (xcd < r ? xcd * (q + 1) : r * (q + 1) + (xcd - r) * q) + off; }
    const int nig = WGM * nN, gid = wgid / nig, fm = gid * WGM, gsz = (nM - fm) < WGM ? (nM - fm) : WGM;
    pm = fm + ((wgid % nig) % gsz); pn = (wgid % nig) / gsz;
}

__device__ __forceinline__ bool get_unit(const unsigned char* ws, int mode, int i, int G, int c, Unit& u) {
    const long L = (long)i * G + c;
    switch (mode) {
    case G_IN: {
        if (L >= 400) return false;
        if (L < 256) remap_tile((int)L, 32, 8, u.pm, u.pn);
        else if (L < 384) { remap_tile((int)L - 256, 32, 4, u.pm, u.pn); u.pn += 8; }
        else { const int idx = (int)L - 384; u.pm = 32 + (idx >> 2); u.pn = 6 + (idx & 3); }
        u.a = (const char*)ws + WS_H + (size_t)u.pm * 256 * DM * 2; u.b = (const char*)ws + WS_WIN + (size_t)u.pn * 256 * DM * 2; return true; }
    case G_F1: {
        if (L >= 128) return false;
        const int g = (int)L >> 5; u.pm = g; u.pn = (int)L & 31;
        u.a = (const char*)ws + WS_GT + (size_t)g * 256 * 128 * 2; u.b = (const char*)ws + WS_U + ((size_t)u.pn * 256 * FW + g * 128) * 2; return true; }
    case G_F2: {
        if (L >= 64) return false;
        const int b = (int)L >> 4, pm = ((int)L >> 1) & 7, pn = (int)L & 1; u.pm = b * 8 + pm; u.pn = pn;
        u.a = (const char*)ws + WS_DFT + (size_t)pm * 256 * 4096 * 2; u.b = (const char*)ws + WS_ZT + ((size_t)(b * 512 + pn * 256) * 4096) * 2; return true; }
    case G_OUT: {
        if (L >= 256) return false;
        remap_tile((int)L, 32, 8, u.pm, u.pn);
        u.a = (const char*)ws + WS_MIX + (size_t)u.pm * 256 * DM * 2; u.b = (const char*)ws + WS_WOUT + (size_t)u.pn * 256 * DM * 2; return true; }
    case G_UP: {
        if (L >= 1024) return false;
        remap_tile((int)L, 32, 32, u.pm, u.pn);
        u.a = (const char*)ws + WS_H2 + (size_t)u.pm * 256 * DM * 2; u.b = (const char*)ws + WS_W1 + (size_t)u.pn * 256 * DM * 2; return true; }
    default: {
        if (L >= 256) return false;
        remap_tile((int)L, 32, 8, u.pm, u.pn);
        u.a = (const char*)ws + WS_A1 + (size_t)u.pm * 256 * DFF * 2; u.b = (const char*)ws + WS_W2 + (size_t)u.pn * 256 * DFF * 2; return true; }
    }
}

__device__ __forceinline__ void gemm_epilogue(const Params& P, int mode, const f32x4 (&acc)[2][2][4][2], const Unit& u, int wr, int wc, int fr, int fq) {
    unsigned char* ws = P.ws;
    if (mode == G_OUT || mode == G_DOWN) {
        const float* resid = (mode == G_OUT) ? P.in[I_X] : P.out;
        const float* gate = (const float*)(ws + WS_MOD) + (size_t)(u.pm >> 3) * NMOD6 + (mode == G_OUT ? 2 * DM : 5 * DM);
        const int col0 = u.pn * 256 + wc * 32 + 4 * fq;
        f32x4 gv[2][2];
#pragma unroll
        for (int bj = 0; bj < 2; ++bj)
#pragma unroll
            for (int n = 0; n < 2; ++n) gv[bj][n] = *(const f32x4*)(gate + col0 + bj * HALF + n * 16);
#pragma unroll
        for (int ai = 0; ai < 2; ++ai)
#pragma unroll
            for (int m = 0; m < 4; ++m) {
                const size_t off = (size_t)(u.pm * 256 + ai * HALF + wr * 64 + m * 16 + fr) * DM + col0;
#pragma unroll
                for (int bj = 0; bj < 2; ++bj)
#pragma unroll
                    for (int n = 0; n < 2; ++n) {
                        const f32x4 r = *(const f32x4*)(resid + off + bj * HALF + n * 16);
                        *(f32x4*)(P.out + off + bj * HALF + n * 16) = r + gv[bj][n] * acc[ai][bj][m][n];
                    }
            }
        return;
    }
    bf16_t* base; size_t ld, aistride, bjstride = HALF;
    if (mode == G_IN) {
        const int pm = u.pm, pn = u.pn;
        if (pn < 6) { base = (bf16_t*)(ws + WS_Q) + (size_t)pm * 256 * AW + pn * 256; ld = AW; }
        else if (pn < 10) {
            const int b = (pm < 32) ? (pm >> 3) : (pm - 32), t0 = (pm < 32) ? CTXL + (pm & 7) * 256 : 0, h0 = ((pn - 6) & 1) * 2;
            base = (bf16_t*)(ws + (pn < 8 ? WS_K : WS_V)) + ((size_t)(b * NKVH + h0) * SKV + t0) * HD; ld = HD; bjstride = (size_t)SKV * HD; }
        else { base = (bf16_t*)(ws + WS_U) + (size_t)pm * 256 * FW + (pn - 10) * 256; ld = FW; }
        aistride = 128 * ld;
    } else if (mode == G_F1) {
        const int g = u.pm, b = u.pn >> 3, s0 = (u.pn & 7) * 256;
        base = (bf16_t*)(ws + WS_ZT) + ((size_t)(b * 512 + g * 128) * 4096 + s0); ld = 4096; aistride = 2048;
    } else if (mode == G_F2) {
        base = (bf16_t*)(ws + WS_MIX) + (size_t)u.pm * 256 * DM + AW + u.pn * 256; ld = DM; aistride = 128 * ld;
    } else {
        base = (bf16_t*)(ws + WS_A1) + (size_t)u.pm * 256 * DFF + u.pn * 256; ld = DFF; aistride = 128 * ld;
    }
    const bool relu2 = (mode == G_UP);
    bf16_t* p0 = base + (size_t)(wr * 64 + fr) * ld + wc * 32 + 8 * fq;
#pragma unroll
    for (int ai = 0; ai < 2; ++ai)
#pragma unroll
        for (int m = 0; m < 4; ++m) {
            bf16_t* rowp = p0 + ai * aistride + (size_t)(m * 16) * ld;
#pragma unroll
            for (int bj = 0; bj < 2; ++bj) {
                f32x4 v0 = acc[ai][bj][m][0], v1 = acc[ai][bj][m][1];
                if (relu2) {
#pragma unroll
                    for (int e = 0; e < 4; ++e) { const float a = fmaxf(v0[e], 0.f), b = fmaxf(v1[e], 0.f); v0[e] = a * a; v1[e] = b * b; }
                }
                u32x4 w; w.x = cvt_pk_bf16(v0[0], v0[1]); w.y = cvt_pk_bf16(v0[2], v0[3]); w.z = cvt_pk_bf16(v1[0], v1[1]); w.w = cvt_pk_bf16(v1[2], v1[3]);
                *(u32x4*)(rowp + bj * bjstride) = w;
            }
        }
}

__device__ __forceinline__ int qk_perm(int R) { const int wc = R >> 5, n = (R >> 4) & 1, p = 16 * wc + (R & 15); return (p < 32 ? p : p + 32) + 32 * n; }
__device__ __forceinline__ void gemm_epilogue_qk(const Params& P, const f32x4 (&acc)[2][2][4][2], const Unit& u, int wr, int wc, int fr, int fq, LAS unsigned char* lds) {
    asm volatile("" : "+v"(fr), "+v"(fq), "+s"(wr), "+s"(wc));
    unsigned char* ws = P.ws;
    LAS float* red = (LAS float*)(lds + LDS_RED);
    const int pm = u.pm, pn = u.pn;
#pragma unroll
    for (int ai = 0; ai < 2; ++ai)
#pragma unroll
        for (int m = 0; m < 4; ++m)
#pragma unroll
            for (int bj = 0; bj < 2; ++bj) {
                const f32x4 a = acc[ai][bj][m][0], b = acc[ai][bj][m][1];
                float ss = ((a.x * a.x + a.y * a.y) + (a.z * a.z + a.w * a.w)) + ((b.x * b.x + b.y * b.y) + (b.z * b.z + b.w * b.w));
                ss += swz_xor<16>(ss); ss = half_sum(ss);
                if (fq == 0) red[(bj * 4 + wc) * 256 + ai * HALF + wr * 64 + m * 16 + fr] = ss;
            }
    asm volatile("s_waitcnt lgkmcnt(0)" ::: "memory"); __builtin_amdgcn_s_barrier(); asm volatile("" ::: "memory");
    const bool isq = pn < 6, rope = pm < 32;
    const int p0 = 16 * wc + 4 * fq, d0 = (p0 < 32) ? p0 : p0 + 32;
    const float* g = P.in[isq ? I_QG : I_KG];
    const f32x4 g0 = *(const f32x4*)(g + d0), g1 = *(const f32x4*)(g + d0 + 32);
    bf16_t* base; size_t ld, bjstride;
    if (isq) { base = (bf16_t*)(ws + WS_Q) + (size_t)pm * 256 * AW + pn * 256; ld = AW; bjstride = HD; }
    else { const int b = rope ? (pm >> 3) : (pm - 32), t0 = rope ? CTXL + (pm & 7) * 256 : 0, h0 = (pn - 6) * 2;
           base = (bf16_t*)(ws + WS_K) + ((size_t)(b * NKVH + h0) * SKV + t0) * HD; ld = HD; bjstride = (size_t)SKV * HD; }
    const float* tab = (const float*)(ws + WS_ROPE);
    const int i0 = 16 * (wc & 1) + 4 * fq;
#pragma unroll
    for (int ai = 0; ai < 2; ++ai)
#pragma unroll
        for (int m = 0; m < 4; ++m) {
            const int rl = ai * HALF + wr * 64 + m * 16 + fr;
            f32x4 cs0 = (f32x4){1.f, 0.f, 1.f, 0.f}, cs1 = cs0;
            if (rope) { const int pos = (pm * 256 + rl) & (SEQ - 1), av = (wc < 2) ? (pos >> 6) : (pos & 63);
                        const f32x4* t = (const f32x4*)(tab + (size_t)(av * 32 + i0) * 2); cs0 = t[0]; cs1 = t[1]; }
#pragma unroll
            for (int bj = 0; bj < 2; ++bj) {
                const float tot = (red[(bj * 4 + 0) * 256 + rl] + red[(bj * 4 + 1) * 256 + rl]) + (red[(bj * 4 + 2) * 256 + rl] + red[(bj * 4 + 3) * 256 + rl]);
                const float rstd = rsqrtf(tot * (1.0f / HD) + EPS);
                const f32x4 x1 = acc[ai][bj][m][0] * rstd * g0, x2 = acc[ai][bj][m][1] * rstd * g1;
                const float a0 = x1.x * cs0.x - x2.x * cs0.y, b0 = x2.x * cs0.x + x1.x * cs0.y;
                const float a1 = x1.y * cs0.z - x2.y * cs0.w, b1 = x2.y * cs0.z + x1.y * cs0.w;
                const float a2 = x1.z * cs1.x - x2.z * cs1.y, b2 = x2.z * cs1.x + x1.z * cs1.y;
                const float a3 = x1.w * cs1.z - x2.w * cs1.w, b3 = x2.w * cs1.z + x1.w * cs1.w;
                u32x2 o1, o2; o1.x = cvt_pk_bf16(a0, a1); o1.y = cvt_pk_bf16(a2, a3); o2.x = cvt_pk_bf16(b0, b1); o2.y = cvt_pk_bf16(b2, b3);
                const auto sx = __builtin_amdgcn_permlane16_swap(o1.x, o2.x, false, false), sy = __builtin_amdgcn_permlane16_swap(o1.y, o2.y, false, false);
                u32x4 w; w.x = sx[0]; w.y = sy[0]; w.z = sx[1]; w.w = sy[1];
                bf16_t* rowp = base + (size_t)rl * ld + bj * bjstride + ((fq & 1) ? d0 + 28 : d0);
                *(u32x4*)rowp = w;
            }
        }
}

__device__ __forceinline__ void gemm_epilogue_fused(const Params& P, int mode, f32x4 (&acc)[2][2][4][2], const Unit& u, int wr, int wc, int fr, int fq, LAS unsigned char* lds, int tid) {
    unsigned char* ws = P.ws;
    const int x = (mode == G_OUT) ? 0 : 1;
    const float* resid = (mode == G_OUT) ? P.in[I_X] : P.out;
    const float* modb = (const float*)(ws + WS_MOD) + (size_t)(u.pm >> 3) * NMOD6;
    const float* gate = modb + (mode == G_OUT ? 2 * DM : 5 * DM);
    const int col0 = u.pn * 256 + wc * 32 + 4 * fq;
    LAS float* Pq = (LAS float*)lds;
    LAS float* S = (LAS float*)(lds + 4096);
    {
        f32x4 gv[2][2];
#pragma unroll
        for (int bj = 0; bj < 2; ++bj)
#pragma unroll
            for (int n = 0; n < 2; ++n) gv[bj][n] = *(const f32x4*)(gate + col0 + bj * HALF + n * 16);
        f32x4 rbuf[2][2][2];
        const size_t off0 = (size_t)(u.pm * 256 + wr * 64 + fr) * DM + col0;
#pragma unroll
        for (int bj = 0; bj < 2; ++bj)
#pragma unroll
            for (int n = 0; n < 2; ++n) rbuf[0][bj][n] = (mode == G_OUT) ? __builtin_nontemporal_load((const f32x4*)(resid + off0 + bj * HALF + n * 16)) : *(const f32x4*)(resid + off0 + bj * HALF + n * 16);
#pragma unroll
        for (int g = 0; g < 8; ++g) {
            const int ai = g >> 2, m = g & 3;
            const int rl = ai * HALF + wr * 64 + m * 16 + fr;
            const size_t off = (size_t)(u.pm * 256 + rl) * DM + col0;
            if (g < 7) { const int ai2 = (g + 1) >> 2, m2 = (g + 1) & 3; const size_t offn = (size_t)(u.pm * 256 + ai2 * HALF + wr * 64 + m2 * 16 + fr) * DM + col0;
#pragma unroll
                for (int bj = 0; bj < 2; ++bj)
#pragma unroll
                    for (int n = 0; n < 2; ++n) rbuf[(g + 1) & 1][bj][n] = (mode == G_OUT) ? __builtin_nontemporal_load((const f32x4*)(resid + offn + bj * HALF + n * 16)) : *(const f32x4*)(resid + offn + bj * HALF + n * 16); }
            float ss = 0.f;
#pragma unroll
            for (int bj = 0; bj < 2; ++bj)
#pragma unroll
                for (int n = 0; n < 2; ++n) {
                    const f32x4 v = rbuf[g & 1][bj][n] + gv[bj][n] * acc[ai][bj][m][n];
                    acc[ai][bj][m][n] = v;
                    if (mode == G_OUT) *(f32x4*)(P.out + off + bj * HALF + n * 16) = v;
                    ss += (v.x * v.x + v.y * v.y) + (v.z * v.z + v.w * v.w);
                }
            ss += swz_xor<16>(ss); ss = half_sum(ss);
            if (fq == 0) Pq[rl * 4 + wc] = ss;
            asm volatile("" ::: "memory");
        }
    }
    asm volatile("s_waitcnt lgkmcnt(0)" ::: "memory"); __builtin_amdgcn_s_barrier(); asm volatile("" ::: "memory");
    if (tid < 256) {
        const f32x4 q = *(const LAS f32x4*)(Pq + tid * 4);
        const float tot = (q.x + q.y) + (q.z + q.w);
        unsigned long long* w = (unsigned long long*)(ws + WS_XACC) + (size_t)x * MTOK + (size_t)(u.pm * 256 + tid);
        __hip_atomic_fetch_add(w, (1ull << 48) + (unsigned long long)(tot * 65536.0f + 0.5f), __ATOMIC_RELAXED, __HIP_MEMORY_SCOPE_AGENT);
        unsigned long long v; unsigned sp = 0;
        for (;;) { v = __hip_atomic_load(w, __ATOMIC_RELAXED, __HIP_MEMORY_SCOPE_AGENT); if ((v >> 48) >= 8ull) break; __builtin_amdgcn_s_sleep(1); if (++sp > (1u << 22)) break; }
        S[tid] = rsqrtf((float)(v & 0xFFFFFFFFFFFFull) * (1.0f / 65536.0f) * (1.0f / DM) + EPS);
    }
    asm volatile("s_waitcnt lgkmcnt(0)" ::: "memory"); __builtin_amdgcn_s_barrier(); asm volatile("" ::: "memory");
    if (mode == G_OUT) {
        f32x4 gg[2][2], sc[2][2], sh[2][2];
#pragma unroll
        for (int bj = 0; bj < 2; ++bj)
#pragma unroll
            for (int n = 0; n < 2; ++n) { const int cc = col0 + bj * HALF + n * 16; gg[bj][n] = *(const f32x4*)(P.in[I_G2] + cc); sh[bj][n] = *(const f32x4*)(modb + 3 * DM + cc); sc[bj][n] = *(const f32x4*)(modb + 4 * DM + cc) + 1.0f; }
        bf16_t* h2 = (bf16_t*)(ws + WS_H2);
#pragma unroll
        for (int ai = 0; ai < 2; ++ai)
#pragma unroll
            for (int m = 0; m < 4; ++m) {
                const int rl = ai * HALF + wr * 64 + m * 16 + fr; const float rs = S[rl];
                const size_t off = (size_t)(u.pm * 256 + rl) * DM + col0;
#pragma unroll
                for (int bj = 0; bj < 2; ++bj) {
                    const f32x4 y0 = (acc[ai][bj][m][0] * rs * gg[bj][0]) * sc[bj][0] + sh[bj][0], y1 = (acc[ai][bj][m][1] * rs * gg[bj][1]) * sc[bj][1] + sh[bj][1];
                    const unsigned p0x = cvt_pk_bf16(y0.x, y0.y), p0y = cvt_pk_bf16(y0.z, y0.w), p1x = cvt_pk_bf16(y1.x, y1.y), p1y = cvt_pk_bf16(y1.z, y1.w);
                    const auto sx = __builtin_amdgcn_permlane16_swap(p0x, p1x, false, false), sy = __builtin_amdgcn_permlane16_swap(p0y, p1y, false, false);
                    u32x4 w; w.x = sx[0]; w.y = sy[0]; w.z = sx[1]; w.w = sy[1];
                    *(u32x4*)(h2 + off + bj * HALF + ((fq & 1) ? 12 : 0)) = w;
                }
            }
    } else {
        f32x4 gg[2][2];
#pragma unroll
        for (int bj = 0; bj < 2; ++bj)
#pragma unroll
            for (int n = 0; n < 2; ++n) gg[bj][n] = *(const f32x4*)(P.in[I_GF] + col0 + bj * HALF + n * 16);
#pragma unroll
        for (int ai = 0; ai < 2; ++ai)
#pragma unroll
            for (int m = 0; m < 4; ++m) {
                const int rl = ai * HALF + wr * 64 + m * 16 + fr; const float rs = S[rl];
                const size_t off = (size_t)(u.pm * 256 + rl) * DM + col0;
#pragma unroll
                for (int bj = 0; bj < 2; ++bj)
#pragma unroll
                    for (int n = 0; n < 2; ++n) __builtin_nontemporal_store(acc[ai][bj][m][n] * rs * gg[bj][n], (f32x4*)(P.out + off + bj * HALF + n * 16));
            }
    }
    asm volatile("s_waitcnt lgkmcnt(0)" ::: "memory"); __builtin_amdgcn_s_barrier();
}

__device__ __forceinline__ void gemm_phase(LAS unsigned char* lds, const Params& P, const int mode, const int G, const int c) {
    int tid_ = threadIdx.x; asm volatile("" : "+v"(tid_));
    const int tid = tid_, wid = __builtin_amdgcn_readfirstlane(tid >> 6), lane = tid & 63, wr = wid >> 2, wc = wid & 3, fr = lane & 15, fq = lane >> 4;
    int lda, ldb, K; bool perm = true;
    switch (mode) {
    case G_IN: lda = DM; ldb = DM; K = DM; break;
    case G_F1: lda = 128; ldb = FW; K = 128; break;
    case G_F2: lda = 4096; ldb = 4096; K = 4096; break;
    case G_OUT: lda = DM; ldb = DM; K = DM; perm = false; break;
    case G_UP: lda = DM; ldb = DM; K = DM; break;
    default: lda = DFF; ldb = DFF; K = DFF; perm = false; break;
    }
    const int nt = K / BK;
    const bool fusedEpi = (mode == G_OUT || mode == G_DOWN) && G == 256;
    unsigned voffA[2];
#pragma unroll
    for (int i = 0; i < 2; ++i) { int R, C; stage_rc(tid * 16 + i * 8192, R, C); voffA[i] = (unsigned)(R * lda + C) * 2u; }
#define PG8_BOFF(i, qk) ([&]() { int R, C; stage_rc(tid * 16 + (i) * 8192, R, C); const int Rb = (qk) ? qk_perm(R) : (perm ? ((R & ~31) + perm32(R & 31)) : R); return (unsigned)(Rb * ldb + C) * 2u; }())
    const size_t kstep = (size_t)(BK * 2);
    const size_t hstepA = (size_t)HALF * lda * 2, hstepB = (size_t)HALF * ldb * 2;
    const unsigned ldsw = (unsigned)wid * 1024u;
    const int aoff = lds_byte(wr * 64 + fr, fq * 8), boff = lds_byte(wc * 32 + fr, fq * 8);
#define PG8_SA(b, h) (((b) * 2 + (h)) * HTB)
#define PG8_SB(b, h) ((4 + (b) * 2 + (h)) * HTB)
#define PG8_STAGE(bufoff, gbase, voff) do { _Pragma("unroll") for (int _i = 0; _i < 2; ++_i) \
        __builtin_amdgcn_global_load_lds((const unsigned*)((const char*)(gbase) + (voff)[_i]), (LAS unsigned*)(lds + (bufoff) + ldsw + _i * 8192), 16, 0, 0); } while (0)
#define PG8_LDA(dst, b, h) do { _Pragma("unroll") for (int m = 0; m < 4; ++m) _Pragma("unroll") for (int k = 0; k < 2; ++k) dst[m][k] = *(const LAS bf16x8*)(lds + PG8_SA(b, h) + aoff + m * 2048 + k * 1024); } while (0)
#define PG8_LDB(dst, b, h) do { _Pragma("unroll") for (int n = 0; n < 2; ++n) _Pragma("unroll") for (int k = 0; k < 2; ++k) dst[n][k] = *(const LAS bf16x8*)(lds + PG8_SB(b, h) + boff + n * 2048 + k * 1024); } while (0)
#define PG8_MMA(ai, bj, At, Bt) do { __builtin_amdgcn_s_setprio(1); _Pragma("unroll") for (int m = 0; m < 4; ++m) _Pragma("unroll") for (int n = 0; n < 2; ++n) _Pragma("unroll") for (int k = 0; k < 2; ++k) \
        acc[ai][bj][m][n] = __builtin_amdgcn_mfma_f32_16x16x32_bf16(Bt[n][k], At[m][k], acc[ai][bj][m][n], 0, 0, 0); __builtin_amdgcn_s_setprio(0); } while (0)
#define PG8_WAIT_V(n) asm volatile("s_waitcnt vmcnt(" #n ")" ::: "memory")
#define PG8_WAIT_L(n) asm volatile("s_waitcnt lgkmcnt(" #n ")" ::: "memory")
#define PG8_BAR __builtin_amdgcn_s_barrier()
#define PG8_SCHED __builtin_amdgcn_sched_barrier(0)
    Unit cur, nxt; int ui = 0;
    if (!get_unit(P.ws, mode, 0, G, c, cur)) return;
    f32x4 acc[2][2][4][2];
#pragma unroll
    for (int a = 0; a < 2; ++a)
#pragma unroll
        for (int b = 0; b < 2; ++b)
#pragma unroll
            for (int m = 0; m < 4; ++m)
#pragma unroll
                for (int n = 0; n < 2; ++n) acc[a][b][m][n] = (f32x4){0.f, 0.f, 0.f, 0.f};
    bf16x8 At[4][2], B0[2][2], B1[2][2];
    const char* cA = cur.a; const char* cB = cur.b;
    bool cqk = (mode == G_IN) && cur.pn < 8;
    unsigned voffB[2] = {PG8_BOFF(0, cqk), PG8_BOFF(1, cqk)};
    PG8_STAGE(PG8_SB(0, 0), cB, voffB); PG8_STAGE(PG8_SB(0, 1), cB + hstepB, voffB); PG8_STAGE(PG8_SA(0, 0), cA, voffA); PG8_STAGE(PG8_SA(0, 1), cA + hstepA, voffA);
    if (wr == 1) PG8_BAR;
    PG8_WAIT_V(2); PG8_BAR;
    PG8_STAGE(PG8_SB(1, 0), cB + kstep, voffB); PG8_STAGE(PG8_SA(1, 0), cA + kstep, voffA); PG8_STAGE(PG8_SB(1, 1), cB + hstepB + kstep, voffB);
    PG8_WAIT_V(6); PG8_BAR;
    for (;;) {
        const bool has_next = get_unit(P.ws, mode, ui + 1, G, c, nxt);
        const char* nA = has_next ? nxt.a : cA; const char* nB = has_next ? nxt.b : cB;
        const bool nqk = has_next ? ((mode == G_IN) && nxt.pn < 8) : cqk;
        for (int t = 0; t < nt; t += 2) {
            const bool last = (t == nt - 2);
            unsigned vb2[2] = {voffB[0], voffB[1]};
            if (last && nqk != cqk) { vb2[0] = PG8_BOFF(0, nqk); vb2[1] = PG8_BOFF(1, nqk); }
            const char* a1 = cA + (size_t)(t + 1) * kstep;
            const char* a2 = last ? nA : cA + (size_t)(t + 2) * kstep; const char* b2 = last ? nB : cB + (size_t)(t + 2) * kstep;
            const char* a3 = a2 + kstep; const char* b3 = b2 + kstep;
            PG8_LDB(B0, 0, 0); PG8_LDB(B1, 0, 1); PG8_SCHED; PG8_LDA(At, 0, 0); PG8_STAGE(PG8_SA(1, 1), a1 + hstepA, voffA);
            PG8_WAIT_V(8); PG8_WAIT_L(0); PG8_BAR; PG8_MMA(0, 0, At, B0); PG8_MMA(0, 1, At, B1); PG8_BAR; PG8_SCHED;
            PG8_LDA(At, 0, 1); PG8_STAGE(PG8_SB(0, 0), b2, vb2); PG8_STAGE(PG8_SB(0, 1), b2 + hstepB, vb2); PG8_STAGE(PG8_SA(0, 0), a2, voffA);
            PG8_WAIT_V(8); PG8_WAIT_L(0); PG8_BAR; PG8_MMA(1, 0, At, B0); PG8_MMA(1, 1, At, B1); PG8_BAR; PG8_SCHED;
            PG8_LDB(B0, 1, 0); PG8_LDB(B1, 1, 1); PG8_SCHED; PG8_LDA(At, 1, 0); PG8_STAGE(PG8_SA(0, 1), a2 + hstepA, voffA);
            PG8_WAIT_V(8); PG8_WAIT_L(0); PG8_BAR; PG8_MMA(0, 0, At, B0); PG8_MMA(0, 1, At, B1); PG8_BAR; PG8_SCHED;
            PG8_LDA(At, 1, 1); PG8_STAGE(PG8_SB(1, 0), b3, vb2); PG8_STAGE(PG8_SB(1, 1), b3 + hstepB, vb2); PG8_STAGE(PG8_SA(1, 0), a3, voffA);
            PG8_WAIT_V(8); PG8_WAIT_L(0); PG8_BAR; PG8_MMA(1, 0, At, B0); PG8_MMA(1, 1, At, B1); PG8_BAR; PG8_SCHED;
        }
        if (wr == 0) PG8_BAR;
        if (cqk) gemm_epilogue_qk(P, acc, cur, wr, wc, fr, fq, lds);
        else if (!fusedEpi) gemm_epilogue(P, mode, acc, cur, wr, wc, fr, fq);
        if (!has_next) break;
#pragma unroll
        for (int a = 0; a < 2; ++a)
#pragma unroll
            for (int b = 0; b < 2; ++b)
#pragma unroll
                for (int m = 0; m < 4; ++m)
#pragma unroll
                    for (int n = 0; n < 2; ++n) acc[a][b][m][n] = (f32x4){0.f, 0.f, 0.f, 0.f};
        cur = nxt; cA = nA; cB = nB; ++ui; if (nqk != cqk) { cqk = nqk; voffB[0] = PG8_BOFF(0, cqk); voffB[1] = PG8_BOFF(1, cqk); }
        if (wr == 1) PG8_BAR;
    }
    PG8_WAIT_V(0);
    PG8_BAR;
    if (fusedEpi) gemm_epilogue_fused(P, mode, acc, cur, wr, wc, fr, fq, lds, tid);
#undef PG8_BOFF
#undef PG8_SA
#undef PG8_SB
#undef PG8_STAGE
#undef PG8_LDA
#undef PG8_LDB
#undef PG8_MMA
#undef PG8_WAIT_V
#undef PG8_WAIT_L
#undef PG8_BAR
#undef PG8_SCHED
}

namespace att {
constexpr int D = 128, NW = 8, QBLK = 32, KVBLK = 64;
constexpr float SCALE = 0.088388347648318440f;
constexpr float THR = 8.f;
constexpr int LDQ = AW, LDK = HD, LDO = DM;
constexpr size_t SHM_V = KVBLK * D * 2, SHM_K = KVBLK * D * 2, SHM_ATTN = 2 * SHM_V + 2 * SHM_K + NW * 64 * 4;
#define KSWZ(row, colB) ((row) * 256 + ((colB) ^ (((row) & 7) << 4)))
#define SBAR() __builtin_amdgcn_sched_barrier(0)
__device__ __forceinline__ int crow(int r, int hi) { return (r & 3) + 8 * (r >> 2) + 4 * hi; }
__device__ __forceinline__ unsigned cvtpk(float lo, float hi) { unsigned r; asm volatile("v_cvt_pk_bf16_f32 %0, %1, %2" : "=v"(r) : "v"(lo), "v"(hi)); return r; }
__device__ __forceinline__ bf16x8 ld8(const bf16_t* p) { return *reinterpret_cast<const bf16x8*>(p); }

__device__ __forceinline__ void partialSM(f32x16& p0, f32x16& p1, float& m_reg, float& mn, float& alpha) {
  constexpr float C = SCALE * 1.4426950408889634f;
  float pmax = p0[0];
#pragma unroll
  for (int r = 1; r < 16; ++r) pmax = fmaxf(pmax, p0[r]);
#pragma unroll
  for (int r = 0; r < 16; ++r) pmax = fmaxf(pmax, p1[r]);
  { auto rr = __builtin_amdgcn_permlane32_swap(__float_as_uint(pmax), __float_as_uint(pmax), false, false);
    pmax = fmaxf(__uint_as_float(rr[0]), __uint_as_float(rr[1])); }
  if (__builtin_expect(__all(pmax - m_reg <= THR / SCALE), 1)) { mn = m_reg; alpha = 1.f; }
  else { mn = fmaxf(m_reg, pmax); alpha = __builtin_amdgcn_exp2f((m_reg - mn) * C); m_reg = mn; }
  float mnC = -mn * C;
#pragma unroll
  for (int r = 0; r < 16; ++r) p0[r] = fmaf(p0[r], C, mnC);
#pragma unroll
  for (int r = 0; r < 16; ++r) p1[r] = fmaf(p1[r], C, mnC);
#pragma unroll
  for (int r = 0; r < 16; ++r) p0[r] = __builtin_amdgcn_exp2f(p0[r]);
}
__device__ __forceinline__ void finishSM(f32x16& p0, f32x16& p1, float alpha, float& l_reg, bf16x8& pa0, bf16x8& pa1, bf16x8& pa2, bf16x8& pa3) {
#pragma unroll
  for (int r = 0; r < 16; ++r) p1[r] = __builtin_amdgcn_exp2f(p1[r]);
  float ps = 0;
#pragma unroll
  for (int r = 0; r < 16; ++r) ps += p0[r];
#pragma unroll
  for (int r = 0; r < 16; ++r) ps += p1[r];
  { auto rr = __builtin_amdgcn_permlane32_swap(__float_as_uint(ps), __float_as_uint(ps), false, false);
    ps = __uint_as_float(rr[0]) + __uint_as_float(rr[1]); }
  l_reg = l_reg * alpha + ps;
#define PK4(P, BASE, OUT) do { unsigned a0 = cvtpk(P[BASE + 0], P[BASE + 1]), a1 = cvtpk(P[BASE + 2], P[BASE + 3]);   \
    unsigned b0 = cvtpk(P[BASE + 4], P[BASE + 5]), b1 = cvtpk(P[BASE + 6], P[BASE + 7]);                              \
    auto r0 = __builtin_amdgcn_permlane32_swap(a0, b0, false, false); auto r1 = __builtin_amdgcn_permlane32_swap(a1, b1, false, false); \
    u32x4 w = {r0[0], r1[0], r0[1], r1[1]}; OUT = *reinterpret_cast<bf16x8*>(&w); } while (0)
  PK4(p0, 0, pa0); PK4(p0, 8, pa1); PK4(p1, 0, pa2); PK4(p1, 8, pa3);
#undef PK4
}
__device__ __forceinline__ void qkt(f32x16& p0, f32x16& p1, const bf16_t* Ks, const bf16x8* qr, int r32, int hi) {
  p0 = f32x16{}; p1 = f32x16{};
#pragma unroll
  for (int d0 = 0; d0 < 8; ++d0) { int cb = (d0 * 16 + hi * 8) * 2;
    bf16x8 b0 = *reinterpret_cast<const bf16x8*>((const char*)Ks + KSWZ(r32, cb));
    bf16x8 b1 = *reinterpret_cast<const bf16x8*>((const char*)Ks + KSWZ(32 + r32, cb));
    p0 = __builtin_amdgcn_mfma_f32_32x32x16_bf16(b0, qr[d0], p0, 0, 0, 0);
    p1 = __builtin_amdgcn_mfma_f32_32x32x16_bf16(b1, qr[d0], p1, 0, 0, 0); }
}
__device__ __forceinline__ int v_st(int k, int c) { const int kk = (k & ~0xC) | ((k & 4) << 1) | ((k & 8) >> 1); return ((kk >> 3) * 4 + (c >> 5)) * 512 + ((kk & 7) * 32 + (c & 31)) * 2; }
__device__ __forceinline__ int v_rd_base(int lane) { return ((lane & 3) << 3) | (((lane >> 2) & 3) << 6) | (((lane >> 4) & 1) << 5) | (((lane >> 5) & 1) << 8); }
constexpr int v_rd_off(int d0, int ks, int half) { return d0 * 512 + ks * 4096 + half * 2048; }
template <int OFF> __device__ __forceinline__ s16x4 tr_read(int vb) {
  s16x4 r; asm volatile("ds_read_b64_tr_b16 %0, %1 offset:%2" : "=&v"(r) : "v"(vb), "i"(OFF) : "memory"); return r;
}
template <int D0> __device__ __forceinline__ void pv_one(f32x16& od, int vb, bf16x8 pa0, bf16x8 pa1, bf16x8 pa2, bf16x8 pa3) {
  const s16x4 l0 = tr_read<v_rd_off(D0, 0, 0)>(vb), h0 = tr_read<v_rd_off(D0, 0, 1)>(vb), l1 = tr_read<v_rd_off(D0, 1, 0)>(vb), h1 = tr_read<v_rd_off(D0, 1, 1)>(vb);
  const s16x4 l2 = tr_read<v_rd_off(D0, 2, 0)>(vb), h2 = tr_read<v_rd_off(D0, 2, 1)>(vb), l3 = tr_read<v_rd_off(D0, 3, 0)>(vb), h3 = tr_read<v_rd_off(D0, 3, 1)>(vb);
  asm volatile("s_waitcnt lgkmcnt(0)" ::: "memory"); SBAR();
#define PK(L, H) (bf16x8){L[0], L[1], L[2], L[3], H[0], H[1], H[2], H[3]}
  od = __builtin_amdgcn_mfma_f32_32x32x16_bf16(pa0, PK(l0, h0), od, 0, 0, 0);
  od = __builtin_amdgcn_mfma_f32_32x32x16_bf16(pa1, PK(l1, h1), od, 0, 0, 0);
  od = __builtin_amdgcn_mfma_f32_32x32x16_bf16(pa2, PK(l2, h2), od, 0, 0, 0);
  od = __builtin_amdgcn_mfma_f32_32x32x16_bf16(pa3, PK(l3, h3), od, 0, 0, 0);
#undef PK
}
__device__ __forceinline__ void pv_d0(f32x16* o, int vb, bf16x8 pa0, bf16x8 pa1, bf16x8 pa2, bf16x8 pa3) {
  pv_one<0>(o[0], vb, pa0, pa1, pa2, pa3); pv_one<1>(o[1], vb, pa0, pa1, pa2, pa3); pv_one<2>(o[2], vb, pa0, pa1, pa2, pa3); pv_one<3>(o[3], vb, pa0, pa1, pa2, pa3);
}

__device__ __forceinline__ void attn_dense_body(const bf16_t* __restrict__ Qb, const bf16_t* __restrict__ Kh, const bf16_t* __restrict__ Vh,
                                                bf16_t* __restrict__ Ob, int seq, char* lds) {
  int tid_ = threadIdx.x; asm volatile("" : "+v"(tid_));
  const int tid = tid_, wid = tid >> 6, lane = tid & 63, r32 = lane & 31, hi = lane >> 5;
  bf16_t* V_lds = (bf16_t*)lds; bf16_t* K_lds = (bf16_t*)(lds + 2 * SHM_V);
  float* ws = (float*)(lds + 2 * SHM_V + 2 * SHM_K) + wid * 64; float* li_l = ws; float* al_l = ws + 32;
  float m_reg = -1e30f, l_reg = 0; f32x16 o[4] = {}; bf16x8 qr[8];
  const bf16_t* Qw = Qb + (long)(wid * QBLK + r32) * LDQ + hi * 8;
#pragma unroll
  for (int d0 = 0; d0 < 8; ++d0) qr[d0] = ld8(Qw + d0 * 16);
  const int sr = tid >> 4, sc = (tid & 15) * 8, vst0 = v_st(sr, sc), vst1 = v_st(32 + sr, sc);
  const int vb0 = (int)(uintptr_t)V_lds + v_rd_base(lane);
  struct { bf16x8 vs0, vs1, ks0, ks1; } sr_[2];
#define SLOAD(i, k0) do { sr_[i].vs0 = ld8(&Vh[(long)((k0) + sr) * LDK + sc]); sr_[i].vs1 = ld8(&Vh[(long)((k0) + 32 + sr) * LDK + sc]); \
    sr_[i].ks0 = ld8(&Kh[(long)((k0) + sr) * LDK + sc]); sr_[i].ks1 = ld8(&Kh[(long)((k0) + 32 + sr) * LDK + sc]); } while (0)
#define SWRITE(b, i) do { *(bf16x8*)((char*)V_lds + (b) * SHM_V + vst0) = sr_[i].vs0;          \
    *(bf16x8*)((char*)V_lds + (b) * SHM_V + vst1) = sr_[i].vs1; int kc = sc * 2;               \
    *(bf16x8*)((char*)K_lds + (b) * SHM_K + KSWZ(sr, kc)) = sr_[i].ks0;                       \
    *(bf16x8*)((char*)K_lds + (b) * SHM_K + KSWZ(32 + sr, kc)) = sr_[i].ks1; } while (0)
#define SWAIT() asm volatile("s_waitcnt vmcnt(4)" ::: "memory")
#define RESC(a) do { if (__any((a) < 1.f)) { if (hi == 0) al_l[r32] = (a); asm volatile("s_waitcnt lgkmcnt(0)" ::: "memory"); \
    _Pragma("unroll") for (int d = 0; d < 4; ++d) _Pragma("unroll") for (int r = 0; r < 16; ++r) o[d][r] *= al_l[crow(r, hi)]; } } while (0)
  f32x16 pA0, pA1, pB0, pB1; float mnA, mnB, alA, alB; bf16x8 pa0, pa1, pa2, pa3; const int NT = seq / KVBLK;
  constexpr int SE = 0, SO = 1;
  SLOAD(SE, 0); asm volatile("s_waitcnt vmcnt(0)" ::: "memory"); SWRITE(0, SE); __syncthreads();
  qkt(pA0, pA1, K_lds, qr, r32, hi); partialSM(pA0, pA1, m_reg, mnA, alA);
  SLOAD(SO, KVBLK); if (2 < NT) SLOAD(SE, 2 * KVBLK);
  SWAIT(); SWRITE(1, SO); __syncthreads();
  for (int j = 1; j + 1 < NT; j += 2) {
    SBAR(); qkt(pB0, pB1, (bf16_t*)((char*)K_lds + SHM_K), qr, r32, hi);
    finishSM(pA0, pA1, alA, l_reg, pa0, pa1, pa2, pa3); SBAR();
    SLOAD(SO, (j + 2) * KVBLK); SBAR();
    pv_d0(o, vb0, pa0, pa1, pa2, pa3); partialSM(pB0, pB1, m_reg, mnB, alB);
    __syncthreads(); SWAIT(); SWRITE(0, SE);
    RESC(alB); __syncthreads();
    SBAR(); qkt(pA0, pA1, K_lds, qr, r32, hi);
    finishSM(pB0, pB1, alB, l_reg, pa0, pa1, pa2, pa3); SBAR();
    if (j + 3 < NT) SLOAD(SE, (j + 3) * KVBLK); SBAR();
    pv_d0(o, vb0 + (int)SHM_V, pa0, pa1, pa2, pa3); partialSM(pA0, pA1, m_reg, mnA, alA);
    __syncthreads(); SWAIT(); SWRITE(1, SO);
    RESC(alA); __syncthreads();
  }
  SBAR(); qkt(pB0, pB1, (bf16_t*)((char*)K_lds + SHM_K), qr, r32, hi);
  finishSM(pA0, pA1, alA, l_reg, pa0, pa1, pa2, pa3); SBAR();
  pv_d0(o, vb0, pa0, pa1, pa2, pa3); partialSM(pB0, pB1, m_reg, mnB, alB);
  __syncthreads(); RESC(alB);
  finishSM(pB0, pB1, alB, l_reg, pa0, pa1, pa2, pa3); SBAR();
  pv_d0(o, vb0 + (int)SHM_V, pa0, pa1, pa2, pa3);
  if (hi == 0) li_l[r32] = l_reg; asm volatile("s_waitcnt lgkmcnt(0)" ::: "memory");
  float rli[16];
#pragma unroll
  for (int r = 0; r < 16; ++r) rli[r] = __builtin_amdgcn_rcpf(li_l[crow(r, hi)]);
  bf16_t* Ow = Ob + (long)(wid * QBLK) * LDO;
#pragma unroll
  for (int r = 0; r < 16; ++r) { int orow = crow(r, hi);
#pragma unroll
    for (int d0 = 0; d0 < 4; ++d0) Ow[(long)orow * LDO + d0 * 32 + r32] = f2bf(o[d0][r] * rli[r]); }
  __syncthreads();
#undef SLOAD
#undef SWRITE
#undef SWAIT
#undef RESC
}
#undef KSWZ
#undef SBAR
}

constexpr int TR_LDS_WAVE = 64 * 65 * 4;
__device__ __forceinline__ void transpose_share(const float* __restrict__ W, int K, int N, bf16_t* __restrict__ WT, int w, int nw, LAS unsigned char* lds, int first = 0, int last = 1 << 30) {
    int tid_ = threadIdx.x; asm volatile("" : "+v"(tid_));
    const int wid = tid_ >> 6, lane = tid_ & 63;
    LAS float* scr = (LAS float*)(lds + wid * TR_LDS_WAVE);
    const int nblk = N / 64; int nitems = (K / 64) * nblk; if (last < nitems) nitems = last;
    const int kr = lane >> 4, n4 = (lane & 15) * 4, c = lane & 7;
    int it = first + w * 8 + wid;
    if (it >= nitems) return;
    f32x4 v[16];
    { const int kb = it / nblk, nb = it - kb * nblk;
#pragma unroll
      for (int i = 0; i < 16; ++i) v[i] = __builtin_nontemporal_load((const f32x4*)(W + (size_t)(64 * kb + 4 * i + kr) * N + 64 * nb + n4)); }
    for (;;) {
        const int kb = it / nblk, nb = it - kb * nblk, k0 = 64 * kb, n0 = 64 * nb;
#pragma unroll
        for (int i = 0; i < 16; ++i) { LAS float* d = scr + (4 * i + kr) * 65 + n4; d[0] = v[i].x; d[1] = v[i].y; d[2] = v[i].z; d[3] = v[i].w; }
        const int nx = it + nw; const bool more = nx < nitems;
        if (more) { const int kb2 = nx / nblk, nb2 = nx - kb2 * nblk;
#pragma unroll
            for (int i = 0; i < 16; ++i) v[i] = __builtin_nontemporal_load((const f32x4*)(W + (size_t)(64 * kb2 + 4 * i + kr) * N + 64 * nb2 + n4)); }
        LDS_WAIT();
#pragma unroll
        for (int j = 0; j < 8; ++j) { const int n = (lane >> 3) + 8 * j; const LAS float* sp = scr + (8 * c) * 65 + n;
            u32x4 o; o.x = cvt_pk_bf16(sp[0 * 65], sp[1 * 65]); o.y = cvt_pk_bf16(sp[2 * 65], sp[3 * 65]); o.z = cvt_pk_bf16(sp[4 * 65], sp[5 * 65]); o.w = cvt_pk_bf16(sp[6 * 65], sp[7 * 65]);
            *(u32x4*)(WT + (size_t)(n0 + n) * K + k0 + 8 * c) = o; }
        LDS_WAIT();
        if (!more) break;
        it = nx;
    }
}

__device__ __forceinline__ void dft_slice(unsigned char* ws, int first, int cnt) {
    bf16_t* dft = (bf16_t*)(ws + WS_DFT);
    for (int q = 0; q < cnt; ++q) {
        const int idx = first + q * 512;
        if (idx >= 2048 * 512) break;
        const int k = idx >> 9, n0 = (idx & 511) * 8, part = n0 >> 11, nn = n0 & 2047;
        float v[8];
#pragma unroll
        for (int e = 0; e < 8; ++e) { const float rev = (float)((k * (nn + e)) & 2047) * (1.0f / 2048.0f); v[e] = part ? __builtin_amdgcn_sinf(rev) : __builtin_amdgcn_cosf(rev); }
        u32x4 o; o.x = cvt_pk_bf16(v[0], v[1]); o.y = cvt_pk_bf16(v[2], v[3]); o.z = cvt_pk_bf16(v[4], v[5]); o.w = cvt_pk_bf16(v[6], v[7]);
        *(u32x4*)(dft + (size_t)k * 4096 + n0) = o;
    }
}

__device__ __forceinline__ void ada_phase(const Params& P, LAS unsigned char* lds, int G) {
    int tid_ = threadIdx.x; asm volatile("" : "+v"(tid_));
    const int tid = tid_, wid = tid >> 6, lane = tid & 63;
    unsigned char* ws = P.ws;
    LAS float* sl = (LAS float*)lds;
    for (int i = tid; i < 5 * DM; i += 512) { const float v = (i < 4 * DM) ? P.in[I_C][i] : P.in[I_CCTX][i - 4 * DM]; sl[i] = v / (1.f + expf(-v)); }
    __syncthreads();
    LAS float* red = (LAS float*)(lds + 40960);
    float* mod = (float*)(ws + WS_MOD);
    const float* w_ada = P.in[I_WADA];
    const int dper = (2048 * 512 / 512 + G - 1) / G, dbase = blockIdx.x * dper * 512; int jd = 0;
    int it = blockIdx.x;
    f32x4 wv[16];
    if (it < 768) { const float* wp = w_ada + (size_t)((it / 48) * 128 + wid * 16) * NMOD6 + (it % 48) * 256 + lane * 4;
#pragma unroll
        for (int i = 0; i < 16; ++i) wv[i] = __builtin_nontemporal_load((const f32x4*)(wp + (size_t)i * NMOD6)); }
    while (it < 768) {
        const int cc = it % 48, kc = it / 48;
        const int kb = kc * 128 + wid * 16;
        f32x4 acc[5];
#pragma unroll
        for (int r = 0; r < 5; ++r) acc[r] = (f32x4){0.f, 0.f, 0.f, 0.f};
#pragma unroll
        for (int i = 0; i < 16; ++i) {
#pragma unroll
            for (int r = 0; r < 5; ++r) { const float s = sl[r * DM + kb + i]; acc[r] += wv[i] * s; }
        }
        const int nx = it + G;
        if (nx < 768) { const float* wp = w_ada + (size_t)((nx / 48) * 128 + wid * 16) * NMOD6 + (nx % 48) * 256 + lane * 4;
#pragma unroll
            for (int i = 0; i < 16; ++i) wv[i] = __builtin_nontemporal_load((const f32x4*)(wp + (size_t)i * NMOD6)); }
        { const int take = (dper - jd) < 3 ? (dper - jd) : 3; dft_slice(ws, dbase + jd * 512 + tid, take); jd += take; }
#pragma unroll
        for (int r = 0; r < 5; ++r) *(LAS f32x4*)(red + (wid * 5 + r) * 256 + lane * 4) = acc[r];
        asm volatile("s_waitcnt lgkmcnt(0)" ::: "memory"); __builtin_amdgcn_s_barrier(); asm volatile("" ::: "memory");
        if (tid < 320) {
            const int r = tid >> 6, q = tid & 63;
            f32x4 s = (f32x4){0.f, 0.f, 0.f, 0.f};
#pragma unroll
            for (int w = 0; w < 8; ++w) s += *(const LAS f32x4*)(red + (w * 5 + r) * 256 + q * 4);
            if (kc == 0) s += *(const f32x4*)(P.in[I_BADA] + cc * 256 + q * 4);
            float* dst = mod + (size_t)r * NMOD6 + cc * 256 + q * 4;
            unsafeAtomicAdd(dst + 0, s[0]); unsafeAtomicAdd(dst + 1, s[1]); unsafeAtomicAdd(dst + 2, s[2]); unsafeAtomicAdd(dst + 3, s[3]);
        }
        asm volatile("s_waitcnt lgkmcnt(0)" ::: "memory"); __builtin_amdgcn_s_barrier(); asm volatile("" ::: "memory");
        it = nx;
    }
    dft_slice(ws, dbase + jd * 512 + tid, dper - jd);
    asm volatile("s_waitcnt vmcnt(0)" ::: "memory");
    __syncthreads();
    if (tid == 0) { __builtin_amdgcn_fence(__ATOMIC_RELEASE, "agent"); asm volatile("s_waitcnt vmcnt(0)" ::: "memory");
                    __hip_atomic_fetch_add((unsigned*)(ws + WS_QCTR), 1u, __ATOMIC_RELAXED, __HIP_MEMORY_SCOPE_AGENT); }
}

__device__ __forceinline__ void gen_tables(const Params& P, LAS unsigned char* lds, int blk, int nblk, int what = 3) {
    int tid_ = threadIdx.x; asm volatile("" : "+v"(tid_));
    const int tid = tid_;
    unsigned char* ws = P.ws;
    LAS float* ct = (LAS float*)lds;
    for (int j = tid; j < 2048; j += 512) ct[j] = cospif((float)j * (1.0f / 1024.0f));
    __syncthreads();
    bf16_t* dft = (bf16_t*)(ws + WS_DFT);
    if (what & 1) for (int idx = blk * 512 + tid; idx < 2048 * 512; idx += nblk * 512) {
        const int k = idx >> 9, n0 = (idx & 511) * 8, part = n0 >> 11, nn = n0 & 2047;
        float v[8];
#pragma unroll
        for (int e = 0; e < 8; ++e) { const int j = (k * (nn + e)) & 2047; v[e] = ct[part ? ((j - 512) & 2047) : j]; }
        u32x4 o; o.x = cvt_pk_bf16(v[0], v[1]); o.y = cvt_pk_bf16(v[2], v[3]); o.z = cvt_pk_bf16(v[4], v[5]); o.w = cvt_pk_bf16(v[6], v[7]);
        *(u32x4*)(dft + (size_t)k * 4096 + n0) = o;
    }
    for (int idx = blk * 512 + tid; idx < 64 * 32; idx += nblk * 512) {
        const int pv = idx >> 5, i = idx & 31;
        const float ang = (float)pv * powf(10000.0f, -(float)(2 * i) / 64.0f);
        float* t = (float*)(ws + WS_ROPE) + (size_t)(pv * 32 + i) * 2;
        t[0] = cosf(ang); t[1] = sinf(ang);
    }
    bf16_t* gt = (bf16_t*)(ws + WS_GT);
    LAS float* wfs = (LAS float*)(lds + 8192);
    const int NS = nblk >= 4 ? nblk / 4 : 1;
    for (int t = blk; t < 4 * NS; t += nblk) {
        const int g = t / NS, sidx = t - g * NS;
        const float* wf = P.in[I_WF] + (size_t)g * 128 * 128;
#pragma unroll
        for (int j = 0; j < 8; ++j) *(LAS f32x4*)(wfs + (tid + 512 * j) * 4) = *(const f32x4*)(wf + (tid + 512 * j) * 4);
        __syncthreads();
        for (int idx = sidx * 512 + tid; idx < 2 * 128 * 128; idx += NS * 512) {
            const int d = idx & 127, cch = (idx >> 7) & 127, part = idx >> 14;
            float sum = 0.f;
#pragma unroll 16
            for (int l = 0; l < 128; ++l) {
                const int j = (cch * l) & 127;
                const float cs = part ? -ct[((j - 32) & 127) * 16] : ct[j * 16];
                sum += cs * wfs[l * 128 + d];
            }
            gt[(size_t)((g * 2 + part) * 128 + d) * 128 + cch] = f2bf(sum * (1.0f / 512.0f));
        }
        __syncthreads();
    }
}

template <int MODE> __device__ __forceinline__ const float* rows_src(const Params& P, int r) {
    if (MODE == 0) return (r < MTOK) ? P.in[I_X] + (size_t)r * DM : P.in[I_CTX] + (size_t)(r - MTOK) * DM;
    return P.out + (size_t)r * DM;
}
template <int MODE> __device__ __forceinline__ void rows_pass(const Params& P, int G) {
    int tid_ = threadIdx.x; asm volatile("" : "+v"(tid_));
    const int tid = tid_, wid = tid >> 6, lane = tid & 63;
    const int gw = blockIdx.x * 8 + wid, NGW = G * 8;
    const int nrows = (MODE == 0) ? (MTOK + MCTX) : MTOK;
    if (MODE == 0) {
        if (tid == 0) { unsigned sp = 0; while (__hip_atomic_load((unsigned*)(P.ws + WS_QCTR), __ATOMIC_RELAXED, __HIP_MEMORY_SCOPE_AGENT) < (unsigned)G) { __builtin_amdgcn_s_sleep(2); if (++sp > (1u << 22)) break; } }
        __syncthreads();
        __builtin_amdgcn_fence(__ATOMIC_ACQUIRE, "agent");
    }
    const float* mod = (const float*)(P.ws + WS_MOD);
    const float* gain = P.in[MODE == 0 ? I_G1 : (MODE == 1 ? I_G2 : I_GF)];
    int r = gw;
    if (r >= nrows) return;
    f32x4 v[8], nv[8];
    { const float* src = rows_src<MODE>(P, r);
#pragma unroll
      for (int j = 0; j < 8; ++j) v[j] = (MODE == 0) ? __builtin_nontemporal_load((const f32x4*)(src + (lane + 64 * j) * 4)) : *(const f32x4*)(src + (lane + 64 * j) * 4); }
    for (;;) {
        const int rn = r + NGW; const bool more = rn < nrows;
        if (more) { const float* src = rows_src<MODE>(P, rn);
#pragma unroll
            for (int j = 0; j < 8; ++j) nv[j] = (MODE == 0) ? __builtin_nontemporal_load((const f32x4*)(src + (lane + 64 * j) * 4)) : *(const f32x4*)(src + (lane + 64 * j) * 4); }
        const int mr = (MODE == 0 && r >= MTOK) ? 4 : (r >> 11);
        float ss = 0.f;
#pragma unroll
        for (int j = 0; j < 8; ++j) ss += (v[j].x * v[j].x + v[j].y * v[j].y) + (v[j].z * v[j].z + v[j].w * v[j].w);
        const float rstd = rsqrtf(wave_sum(ss) * (1.0f / DM) + EPS);
#pragma unroll
        for (int j = 0; j < 8; ++j) {
            const int col = (lane + 64 * j) * 4;
            const f32x4 g = *(const f32x4*)(gain + col);
            f32x4 y = v[j] * rstd * g;
            if (MODE == 2) { *(f32x4*)(P.out + (size_t)r * DM + col) = y; }
            else {
                const float* mrow = mod + (size_t)mr * NMOD6 + (MODE == 0 ? 0 : 3 * DM);
                const f32x4 sh = *(const f32x4*)(mrow + col), sc = *(const f32x4*)(mrow + DM + col);
                y = y * (1.0f + sc) + sh;
                u32x2 o; o.x = cvt_pk_bf16(y.x, y.y); o.y = cvt_pk_bf16(y.z, y.w);
                bf16_t* dst = (bf16_t*)(P.ws + (MODE == 0 ? WS_H : WS_H2)) + (size_t)r * DM + col;
                *(u32x2*)dst = o;
            }
        }
        if (!more) break;
#pragma unroll
        for (int j = 0; j < 8; ++j) v[j] = nv[j];
        r = rn;
    }
}

__device__ __forceinline__ void attention_phase(const Params& P, unsigned char* lds, int G) {
    const int c = blockIdx.x;
    for (int j = 0;; ++j) {
        int b, h, qb;
        if (G == 256) {
            if (c < 64 || j > 1) break;
            const int grp = (c & 7) + 8 * j, w = (c - 64) >> 3;
            b = grp >> 2; h = (grp & 3) * 3 + (w >> 3); qb = w & 7;
        } else {
            const int au = c + G * j;
            if (au >= NB * NQH * 8) break;
            qb = au & 7; const int bh = au >> 3; h = bh % NQH; b = bh / NQH;
        }
        const bf16_t* Qb = (const bf16_t*)(P.ws + WS_Q) + (size_t)(b * SEQ + qb * 256) * AW + h * HD;
        const bf16_t* Kh = (const bf16_t*)(P.ws + WS_K) + (size_t)(b * NKVH + h / 3) * SKV * HD;
        const bf16_t* Vh = (const bf16_t*)(P.ws + WS_V) + (size_t)(b * NKVH + h / 3) * SKV * HD;
        bf16_t* Ob = (bf16_t*)(P.ws + WS_MIX) + (size_t)(b * SEQ + qb * 256) * DM + h * HD;
        att::attn_dense_body(Qb, Kh, Vh, Ob, SKV, (char*)lds);
    }
}


#define XB_TMO      128
#define XB_XCNT(j)  (256  + 64 * (j))
#define XB_XSUB(j)  (1280 + 64 * (j))
#define XB_XGEN(j)  (2304 + 64 * (j))
#define XB_TOP      3328
#define XB_TOPGEN   3392
#define XCD_BAR_WORDS 3456
#define XB_SPIN_CAP (1u << 22)
__device__ __forceinline__ unsigned xb_ld(unsigned* p)              { return __hip_atomic_load(p, __ATOMIC_RELAXED, __HIP_MEMORY_SCOPE_AGENT); }
__device__ __forceinline__ unsigned xb_add(unsigned* p, unsigned v) { return __hip_atomic_fetch_add(p, v, __ATOMIC_RELAXED, __HIP_MEMORY_SCOPE_AGENT); }
__device__ __forceinline__ unsigned xb_xcc_id() { return (unsigned)__builtin_amdgcn_s_getreg((3 << 11) | 20) & 0xFu; }
#define XB_SPIN(cond, bar) do { unsigned _sp = 0; while (cond) { __builtin_amdgcn_s_sleep(1); \
    if ((++_sp & 255u) == 0u) { if (xb_ld(&(bar)[XB_TMO])) break; if (_sp > XB_SPIN_CAP) { atomicAdd(&(bar)[XB_TMO], 1u); break; } } } } while (0)
struct XcdBarrier { unsigned* bar; unsigned x; volatile LAS unsigned* st; };
__device__ __forceinline__ XcdBarrier xcd_barrier_post(unsigned* bar, volatile LAS unsigned* st) {
    XcdBarrier b; b.bar = bar; b.x = xb_xcc_id(); b.st = st;
    if (threadIdx.x == 0) (void)xb_add(&bar[XB_XCNT(b.x)], 1u);
    return b;
}
__device__ __forceinline__ void xcd_barrier_complete(unsigned* bar, unsigned x, unsigned& nloc, unsigned& nx) {
    const unsigned G = gridDim.x * gridDim.y * gridDim.z;
    unsigned sum, cnt, mine, sp = 0u;
    for (;;) {
        sum = 0u; cnt = 0u; mine = 0u;
#pragma nounroll
        for (unsigned j = 0; j < 16; ++j) { const unsigned c = xb_ld(&bar[XB_XCNT(j)]); sum += c; cnt += (c > 0u) ? 1u : 0u; mine = (j == x) ? c : mine; }
        if (sum == G) break;
        __builtin_amdgcn_s_sleep(1);
        if ((++sp & 255u) == 0u) { if (xb_ld(&bar[XB_TMO])) break; if (sp > XB_SPIN_CAP) { atomicAdd(&bar[XB_TMO], 1u); break; } }
    }
    nloc = mine > 0u ? mine : 1u; nx = cnt > 0u ? cnt : 1u;
}
__device__ __forceinline__ void xcd_barrier(const XcdBarrier& b) {
    asm volatile("s_waitcnt vmcnt(0)" ::: "memory");
    __syncthreads();
    if (threadIdx.x == 0) {
        unsigned* bar = b.bar;
        __builtin_amdgcn_s_waitcnt(0);
        unsigned nloc = b.st[0], nx = b.st[1];
        if (nloc == 0u) { xcd_barrier_complete(bar, b.x, nloc, nx); b.st[0] = nloc; b.st[1] = nx; }
        const unsigned old = xb_add(&bar[XB_XSUB(b.x)], 1u);
        const unsigned gen = old / nloc;
        if (old + 1u == (gen + 1u) * nloc) {
            __builtin_amdgcn_fence(__ATOMIC_RELEASE, "agent");
            asm volatile("s_waitcnt vmcnt(0)" ::: "memory");
            const unsigned og = xb_add(&bar[XB_TOP], 1u);
            const unsigned tg = og / nx;
            if (og + 1u == (tg + 1u) * nx) xb_add(&bar[XB_TOPGEN], 1u);
            else XB_SPIN(xb_ld(&bar[XB_TOPGEN]) == tg, bar);
            __builtin_amdgcn_fence(__ATOMIC_ACQUIRE, "agent");
            xb_add(&bar[XB_XGEN(b.x)], 1u);
            asm volatile("s_waitcnt vmcnt(0)" ::: "memory");
        } else {
            XB_SPIN(xb_ld(&bar[XB_XGEN(b.x)]) == gen, bar);
            __builtin_amdgcn_fence(__ATOMIC_ACQUIRE, "agent");
            asm volatile("s_waitcnt vmcnt(0)" ::: "memory");
        }
    }
    __syncthreads();
}

__global__ void __launch_bounds__(512, 2) fwd_megakernel(Params P_) {
    extern __shared__ __attribute__((aligned(16))) unsigned char lds[];
    cg::grid_group grid = cg::this_grid();
    const int G_ = gridDim.x, c_ = blockIdx.x;
    LAS unsigned char* l3 = (LAS unsigned char*)lds;
    volatile LAS unsigned* misc = (volatile LAS unsigned*)(l3 + LDS_MISC);
    if (threadIdx.x < 64) misc[threadIdx.x] = 0u;
    __syncthreads();
    XcdBarrier xbar = xcd_barrier_post((unsigned*)(P_.ws + WS_BAR), misc + 8);
#if PROBE >= 100
    unsigned long long pt0 = 0, pt1 = 0;
#endif
#pragma nounroll
    for (int ph = 0; ph < 10; ++ph) {
        Params P = P_; int G = G_, c = c_;
        asm volatile("" : "+s"(G), "+s"(c), "+s"(P.ws), "+s"(P.out));
        int gm = -1;
#if PROBE >= 100
        if (ph == PROBE - 100) pt0 = __builtin_amdgcn_s_memrealtime();
        if (ph == PROBE - 99) pt1 = __builtin_amdgcn_s_memrealtime();
#endif
        switch (ph) {
        case 0: ada_phase(P, l3, G); transpose_share(P.in[I_WIN], DM, INW, (bf16_t*)(P.ws + WS_WIN), c, G * 8, l3); transpose_share(P.in[I_WOUT], DM, DM, (bf16_t*)(P.ws + WS_WOUT), c, G * 8, l3); __syncthreads(); gen_tables(P, l3, c, G, 2); __syncthreads();
                break;
        case 1: rows_pass<0>(P, G); break;
        case 2: gm = G_IN; break;
        case 3: if (G != 256) gm = G_F1; break;
        case 4: if (G == 256 && c < 64) {
                    gemm_phase(l3, P, G_F1, 64, c);
                    asm volatile("s_waitcnt vmcnt(0)" ::: "memory"); __syncthreads();
                    if (threadIdx.x == 0) {
                        unsigned* f1c = (unsigned*)(P.ws + WS_QCTR) + 64;
                        __builtin_amdgcn_fence(__ATOMIC_RELEASE, "agent"); asm volatile("s_waitcnt vmcnt(0)" ::: "memory");
                        __hip_atomic_fetch_add(f1c, 1u, __ATOMIC_RELAXED, __HIP_MEMORY_SCOPE_AGENT);
                        unsigned sp = 0; while (__hip_atomic_load(f1c, __ATOMIC_RELAXED, __HIP_MEMORY_SCOPE_AGENT) < 64u) { __builtin_amdgcn_s_sleep(2); if (++sp > (1u << 22)) break; }
                        __builtin_amdgcn_fence(__ATOMIC_ACQUIRE, "agent"); asm volatile("s_waitcnt vmcnt(0)" ::: "memory");
                    }
                    __syncthreads();
                }
                gm = G_F2; break;
        case 5: gm = G_OUT; break;
        case 6: if (G != 256) rows_pass<1>(P, G); break;
        case 7: gm = G_UP; break;
        case 8: gm = G_DOWN; break;
        default: if (G != 256) rows_pass<2>(P, G); break;
        }
#ifndef NO_GEMM
        if (gm >= 0) gemm_phase(l3, P, gm, G, c);
#endif
#ifndef NO_ATT
        if (ph == 4) attention_phase(P, lds, G);
#endif
        if (ph == 2) { if (G != 256) transpose_share(P.in[I_W1], DM, DFF, (bf16_t*)(P.ws + WS_W1), c, G * 8, l3);
                       else if (c >= 144) transpose_share(P.in[I_W1], DM, DFF, (bf16_t*)(P.ws + WS_W1), c - 144, 112 * 8, l3); }
        if (ph == 4) { if (G != 256) transpose_share(P.in[I_W2], DFF, DM, (bf16_t*)(P.ws + WS_W2), c, G * 8, l3);
                       else if (c < 64) transpose_share(P.in[I_W2], DFF, DM, (bf16_t*)(P.ws + WS_W2), c, 64 * 8, l3); }
#if PROBE == 3
        if (ph == 7) { __syncthreads(); gemm_phase(l3, P, gm, G, c); }
#endif
#if PROBE == 4
        if (ph == 4) { __syncthreads(); gemm_phase(l3, P, gm, G, c); attention_phase(P, lds, G); }
#endif
        if (G == 0x7fffffff) grid.sync();
        if (ph > 0 && ph < 9 && !(G == 256 && (ph == 3 || ph == 6 || ph == 8))) xcd_barrier(xbar);
    }
#if PROBE >= 100
    if (PROBE - 99 == 10) pt1 = __builtin_amdgcn_s_memrealtime();
    if (blockIdx.x == 0 && threadIdx.x < 64) {
        const unsigned long long te = __builtin_amdgcn_s_memrealtime(), want = 16ull * (pt1 - pt0);
        while (__builtin_amdgcn_s_memrealtime() - te < want) __builtin_amdgcn_s_sleep(8);
    }
#endif
}

extern "C" void kernel_launch(void* const* d_in, const int* in_sizes, int n_in, void* d_out, int out_size, void* d_ws, size_t ws_size, hipStream_t stream) {
    static int grid_blocks = 0;
    if (grid_blocks == 0) {
        if (n_in != 16 || out_size != MTOK * DM || ws_size < WS_END) { fprintf(stderr, "kernel_launch: unexpected shapes (n_in %d out %d ws %zu)\n", n_in, out_size, ws_size); grid_blocks = -1; return; }
        int dev = 0, cus = 0, per_cu = 0;
        (void)hipGetDevice(&dev);
        (void)hipDeviceGetAttribute(&cus, hipDeviceAttributeMultiprocessorCount, dev);
        if (hipFuncSetAttribute((const void*)fwd_megakernel, hipFuncAttributeMaxDynamicSharedMemorySize, LDS_BYTES) != hipSuccess) { fprintf(stderr, "kernel_launch: hipFuncSetAttribute failed\n"); grid_blocks = -1; return; }
        if (hipOccupancyMaxActiveBlocksPerMultiprocessor(&per_cu, (const void*)fwd_megakernel, 512, LDS_BYTES) != hipSuccess || per_cu < 1) { fprintf(stderr, "kernel_launch: occupancy query failed (%d)\n", per_cu); per_cu = 1; }
        (void)hipGetLastError();
        grid_blocks = cus;
    }
    if (grid_blocks < 0) return;
    (void)hipMemsetAsync((char*)d_ws + WS_MOD, 0, WS_CTL_BYTES, stream);
    Params p{};
    for (int i = 0; i < 16; ++i) p.in[i] = (const float*)d_in[i];
    p.out = (float*)d_out; p.ws = (unsigned char*)d_ws;
    void* args[] = {&p};
    hipError_t e = hipLaunchCooperativeKernel((const void*)fwd_megakernel, dim3(grid_blocks), dim3(512), args, LDS_BYTES, stream);
    if (e != hipSuccess) fprintf(stderr, "cooperative launch failed: %s (grid %d)\n", hipGetErrorString(e), grid_blocks);
}
#ifdef TEST_KERNELS
__global__ void __launch_bounds__(512, 2) t_att(Params P) { extern __shared__ __attribute__((aligned(16))) unsigned char lds[]; attention_phase(P, lds, gridDim.x); }
__global__ void __launch_bounds__(512, 2) t_gemm(Params P, int mode) { extern __shared__ __attribute__((aligned(16))) unsigned char lds[]; gemm_phase((LAS unsigned char*)lds, P, mode, gridDim.x, blockIdx.x); }
__global__ void __launch_bounds__(512, 2) t_gemm_up(Params P) { extern __shared__ __attribute__((aligned(16))) unsigned char lds[]; gemm_phase((LAS unsigned char*)lds, P, G_UP, gridDim.x, blockIdx.x); }
__global__ void __launch_bounds__(512, 2) t_gemm_out(Params P) { extern __shared__ __attribute__((aligned(16))) unsigned char lds[]; gemm_phase((LAS unsigned char*)lds, P, G_OUT, gridDim.x, blockIdx.x); }
#endif
```

```cpp
#include <hip/hip_runtime.h>
#include <hip/hip_bf16.h>
#include <hip/hip_cooperative_groups.h>
#include <cstdio>
#include <cstdint>
namespace cg = cooperative_groups;

#ifndef PROBE
#define PROBE 0
#endif
#define LAS __attribute__((address_space(3)))
typedef unsigned short bf16_t;
typedef short bf16x8 __attribute__((ext_vector_type(8)));
typedef short s16x4 __attribute__((ext_vector_type(4)));
typedef float f32x4 __attribute__((ext_vector_type(4)));
typedef float f32x16 __attribute__((ext_vector_type(16)));
typedef unsigned u32x4 __attribute__((ext_vector_type(4)));
typedef unsigned u32x2 __attribute__((ext_vector_type(2)));

constexpr int DM = 2048, NB = 4, SEQ = 2048, CTXL = 256, HD = 128, NQH = 12, NKVH = 4;
constexpr int AW = 1536, KVW = 512, FW = 512, INW = 3072, DFF = 8192, NMOD6 = 6 * DM;
constexpr int MTOK = NB * SEQ, MCTX = NB * CTXL, SKV = SEQ + CTXL;
constexpr float EPS = 1e-6f;

constexpr size_t MiB = 1u << 20;
constexpr size_t WS_MOD = 0;
constexpr size_t WS_BAR = 245760;
constexpr size_t WS_QCTR = 245760 + 16384;
constexpr size_t WS_XACC = 262144 + 4096;
constexpr size_t WS_CTL_BYTES = 262144 + 4096 + 131072;
constexpr size_t WS_XSLOT = 1 * MiB + 512 * 1024;
constexpr size_t WS_ROPE = 512 * 1024;
constexpr size_t WS_GT = 1 * MiB;
constexpr size_t WS_WIN = 2 * MiB;
constexpr size_t WS_WOUT = 14 * MiB;
constexpr size_t WS_W1 = 22 * MiB;
constexpr size_t WS_W2 = 54 * MiB;
constexpr size_t WS_DFT = 86 * MiB;
constexpr size_t WS_H2 = 102 * MiB;
constexpr size_t WS_H = 134 * MiB;
constexpr size_t WS_Q = 170 * MiB;
constexpr size_t WS_K = 194 * MiB;
constexpr size_t WS_V = 203 * MiB;
constexpr size_t WS_U = 212 * MiB;
constexpr size_t WS_ZT = 220 * MiB;
constexpr size_t WS_MIX = 236 * MiB;
constexpr size_t WS_A1 = 134 * MiB;
constexpr size_t WS_END = 268 * MiB;

constexpr int LDS_MISC = 8 * 64 * 65 * 4;
constexpr int LDS_RED = LDS_MISC + 1024;
constexpr int LDS_BYTES = LDS_RED + 8192;

struct Params { const float* in[16]; float* out; unsigned char* ws; };
enum { I_X = 0, I_C, I_CTX, I_CCTX, I_WADA, I_BADA, I_G1, I_WIN, I_QG, I_KG, I_WF, I_WOUT, I_G2, I_W1, I_W2, I_GF };

__device__ __forceinline__ unsigned cvt_pk_bf16(float lo, float hi) { unsigned r; asm("v_cvt_pk_bf16_f32 %0, %1, %2" : "=v"(r) : "v"(lo), "v"(hi)); return r; }
__device__ __forceinline__ float bf2f(bf16_t v) { return __uint_as_float(((unsigned)v) << 16); }
__device__ __forceinline__ bf16_t f2bf(float f) { return (bf16_t)(cvt_pk_bf16(f, 0.f) & 0xffffu); }
template <int M> __device__ __forceinline__ float swz_xor(float v) { return __int_as_float(__builtin_amdgcn_ds_swizzle(__float_as_int(v), 0x1F | (M << 10))); }
__device__ __forceinline__ float half_sum(float v) { auto rr = __builtin_amdgcn_permlane32_swap(__float_as_uint(v), __float_as_uint(v), false, false); return __uint_as_float(rr[0]) + __uint_as_float(rr[1]); }
__device__ __forceinline__ float wave_sum(float v) {
    v += swz_xor<1>(v); v += swz_xor<2>(v); v += swz_xor<4>(v); v += swz_xor<8>(v); v += swz_xor<16>(v);
    return half_sum(v);
}
#define LDS_WAIT() asm volatile("s_waitcnt lgkmcnt(0)" ::: "memory")

constexpr int BM = 256, BK = 64, HALF = 128, HTB = HALF * BK * 2, NXCD = 8, WGM = 8;
__device__ __forceinline__ int lds_byte(int r, int c) { const int st = (r >> 4) * 2 + (c >> 5), rr = r & 15, cc = c & 31, ob = rr * 64 + cc * 2; return st * 1024 + (ob ^ (((ob >> 9) & 1) << 5)); }
__device__ __forceinline__ void stage_rc(int b, int& R, int& C) { const int st = b / 1024, sb = b % 1024, swz = sb ^ (((sb >> 9) & 1) << 5); R = (st >> 1) * 16 + swz / 64; C = (st & 1) * 32 + (swz % 64) / 2; }
__device__ __forceinline__ int perm32(int rho) { const int n = rho >> 4, i = rho & 15; return 8 * (i >> 2) + 4 * n + (i & 3); }

struct Unit { int pm, pn; const char* a; const char* b; };
enum { G_IN = 0, G_F1, G_F2, G_OUT, G_UP, G_DOWN };

__device__ __forceinline__ void remap_tile(int L, int nM, int nN, int& pm, int& pn) {
    const int nwg = nM * nN; int wgid = L;
    { const int q = nwg / NXCD, r = nwg % NXCD, xcd = wgid % NXCD, off = wgid / NXCD; wgid = (xcd < r ? xcd * (q + 1) : r * (q + 1) + (xcd - r) * q) + off; }
    const int nig = WGM * nN, gid = wgid / nig, fm = gid * WGM, gsz = (nM - fm) < WGM ? (nM - fm) : WGM;
    pm = fm + ((wgid % nig) % gsz); pn = (wgid % nig) / gsz;
}

__device__ __forceinline__ bool get_unit(const unsigned char* ws, int mode, int i, int G, int c, Unit& u) {
    const long L = (long)i * G + c;
    switch (mode) {
    case G_IN: {
        if (L >= 400) return false;
        if (L < 256) remap_tile((int)L, 32, 8, u.pm, u.pn);
        else if (L < 384) { remap_tile((int)L - 256, 32, 4, u.pm, u.pn); u.pn += 8; }
        else { const int idx = (int)L - 384; u.pm = 32 + (idx >> 2); u.pn = 6 + (idx & 3); }
        u.a = (const char*)ws + WS_H + (size_t)u.pm * 256 * DM * 2; u.b = (const char*)ws + WS_WIN + (size_t)u.pn * 256 * DM * 2; return true; }
    case G_F1: {
        if (L >= 128) return false;
        const int g = (int)L >> 5; u.pm = g; u.pn = (int)L & 31;
        u.a = (const char*)ws + WS_GT + (size_t)g * 256 * 128 * 2; u.b = (const char*)ws + WS_U + ((size_t)u.pn * 256 * FW + g * 128) * 2; return true; }
    case G_F2: {
        if (L >= 64) return false;
        const int b = (int)L >> 4, pm = ((int)L >> 1) & 7, pn = (int)L & 1; u.pm = b * 8 + pm; u.pn = pn;
        u.a = (const char*)ws + WS_DFT + (size_t)pm * 256 * 4096 * 2; u.b = (const char*)ws + WS_ZT + ((size_t)(b * 512 + pn * 256) * 4096) * 2; return true; }
    case G_OUT: {
        if (L >= 256) return false;
        remap_tile((int)L, 32, 8, u.pm, u.pn);
        u.a = (const char*)ws + WS_MIX + (size_t)u.pm * 256 * DM * 2; u.b = (const char*)ws + WS_WOUT + (size_t)u.pn * 256 * DM * 2; return true; }
    case G_UP: {
        if (L >= 1024) return false;
        remap_tile((int)L, 32, 32, u.pm, u.pn);
        u.a = (const char*)ws + WS_H2 + (size_t)u.pm * 256 * DM * 2; u.b = (const char*)ws + WS_W1 + (size_t)u.pn * 256 * DM * 2; return true; }
    default: {
        if (L >= 256) return false;
        remap_tile((int)L, 32, 8, u.pm, u.pn);
        u.a = (const char*)ws + WS_A1 + (size_t)u.pm * 256 * DFF * 2; u.b = (const char*)ws + WS_W2 + (size_t)u.pn * 256 * DFF * 2; return true; }
    }
}

__device__ __forceinline__ void gemm_epilogue(const Params& P, int mode, const f32x4 (&acc)[2][2][4][2], const Unit& u, int wr, int wc, int fr, int fq) {
    unsigned char* ws = P.ws;
    if (mode == G_OUT || mode == G_DOWN) {
        const float* resid = (mode == G_OUT) ? P.in[I_X] : P.out;
        const float* gate = (const float*)(ws + WS_MOD) + (size_t)(u.pm >> 3) * NMOD6 + (mode == G_OUT ? 2 * DM : 5 * DM);
        const int col0 = u.pn * 256 + wc * 32 + 4 * fq;
        f32x4 gv[2][2];
#pragma unroll
        for (int bj = 0; bj < 2; ++bj)
#pragma unroll
            for (int n = 0; n < 2; ++n) gv[bj][n] = *(const f32x4*)(gate + col0 + bj * HALF + n * 16);
#pragma unroll
        for (int ai = 0; ai < 2; ++ai)
#pragma unroll
            for (int m = 0; m < 4; ++m) {
                const size_t off = (size_t)(u.pm * 256 + ai * HALF + wr * 64 + m * 16 + fr) * DM + col0;
#pragma unroll
                for (int bj = 0; bj < 2; ++bj)
#pragma unroll
                    for (int n = 0; n < 2; ++n) {
                        const f32x4 r = *(const f32x4*)(resid + off + bj * HALF + n * 16);
                        *(f32x4*)(P.out + off + bj * HALF + n * 16) = r + gv[bj][n] * acc[ai][bj][m][n];
                    }
            }
        return;
    }
    bf16_t* base; size_t ld, aistride, bjstride = HALF;
    if (mode == G_IN) {
        const int pm = u.pm, pn = u.pn;
        if (pn < 6) { base = (bf16_t*)(ws + WS_Q) + (size_t)pm * 256 * AW + pn * 256; ld = AW; }
        else if (pn < 10) {
            const int b = (pm < 32) ? (pm >> 3) : (pm - 32), t0 = (pm < 32) ? CTXL + (pm & 7) * 256 : 0, h0 = ((pn - 6) & 1) * 2;
            base = (bf16_t*)(ws + (pn < 8 ? WS_K : WS_V)) + ((size_t)(b * NKVH + h0) * SKV + t0) * HD; ld = HD; bjstride = (size_t)SKV * HD; }
        else { base = (bf16_t*)(ws + WS_U) + (size_t)pm * 256 * FW + (pn - 10) * 256; ld = FW; }
        aistride = 128 * ld;
    } else if (mode == G_F1) {
        const int g = u.pm, b = u.pn >> 3, s0 = (u.pn & 7) * 256;
        base = (bf16_t*)(ws + WS_ZT) + ((size_t)(b * 512 + g * 128) * 4096 + s0); ld = 4096; aistride = 2048;
    } else if (mode == G_F2) {
        base = (bf16_t*)(ws + WS_MIX) + (size_t)u.pm * 256 * DM + AW + u.pn * 256; ld = DM; aistride = 128 * ld;
    } else {
        base = (bf16_t*)(ws + WS_A1) + (size_t)u.pm * 256 * DFF + u.pn * 256; ld = DFF; aistride = 128 * ld;
    }
    const bool relu2 = (mode == G_UP);
    bf16_t* p0 = base + (size_t)(wr * 64 + fr) * ld + wc * 32 + 8 * fq;
#pragma unroll
    for (int ai = 0; ai < 2; ++ai)
#pragma unroll
        for (int m = 0; m < 4; ++m) {
            bf16_t* rowp = p0 + ai * aistride + (size_t)(m * 16) * ld;
#pragma unroll
            for (int bj = 0; bj < 2; ++bj) {
                f32x4 v0 = acc[ai][bj][m][0], v1 = acc[ai][bj][m][1];
                if (relu2) {
#pragma unroll
                    for (int e = 0; e < 4; ++e) { const float a = fmaxf(v0[e], 0.f), b = fmaxf(v1[e], 0.f); v0[e] = a * a; v1[e] = b * b; }
                }
                u32x4 w; w.x = cvt_pk_bf16(v0[0], v0[1]); w.y = cvt_pk_bf16(v0[2], v0[3]); w.z = cvt_pk_bf16(v1[0], v1[1]); w.w = cvt_pk_bf16(v1[2], v1[3]);
                *(u32x4*)(rowp + bj * bjstride) = w;
            }
        }
}

__device__ __forceinline__ int qk_perm(int R) { const int wc = R >> 5, n = (R >> 4) & 1, p = 16 * wc + (R & 15); return (p < 32 ? p : p + 32) + 32 * n; }
__device__ __forceinline__ void gemm_epilogue_qk(const Params& P, const f32x4 (&acc)[2][2][4][2], const Unit& u, int wr, int wc, int fr, int fq, LAS unsigned char* lds) {
    asm volatile("" : "+v"(fr), "+v"(fq), "+s"(wr), "+s"(wc));
    unsigned char* ws = P.ws;
    LAS float* red = (LAS float*)(lds + LDS_RED);
    const int pm = u.pm, pn = u.pn;
#pragma unroll
    for (int ai = 0; ai < 2; ++ai)
#pragma unroll
        for (int m = 0; m < 4; ++m)
#pragma unroll
            for (int bj = 0; bj < 2; ++bj) {
                const f32x4 a = acc[ai][bj][m][0], b = acc[ai][bj][m][1];
                float ss = ((a.x * a.x + a.y * a.y) + (a.z * a.z + a.w * a.w)) + ((b.x * b.x + b.y * b.y) + (b.z * b.z + b.w * b.w));
                ss += swz_xor<16>(ss); ss = half_sum(ss);
                if (fq == 0) red[(bj * 4 + wc) * 256 + ai * HALF + wr * 64 + m * 16 + fr] = ss;
            }
    asm volatile("s_waitcnt lgkmcnt(0)" ::: "memory"); __builtin_amdgcn_s_barrier(); asm volatile("" ::: "memory");
    const bool isq = pn < 6, rope = pm < 32;
    const int p0 = 16 * wc + 4 * fq, d0 = (p0 < 32) ? p0 : p0 + 32;
    const float* g = P.in[isq ? I_QG : I_KG];
    const f32x4 g0 = *(const f32x4*)(g + d0), g1 = *(const f32x4*)(g + d0 + 32);
    bf16_t* base; size_t ld, bjstride;
    if (isq) { base = (bf16_t*)(ws + WS_Q) + (size_t)pm * 256 * AW + pn * 256; ld = AW; bjstride = HD; }
    else { const int b = rope ? (pm >> 3) : (pm - 32), t0 = rope ? CTXL + (pm & 7) * 256 : 0, h0 = (pn - 6) * 2;
           base = (bf16_t*)(ws + WS_K) + ((size_t)(b * NKVH + h0) * SKV + t0) * HD; ld = HD; bjstride = (size_t)SKV * HD; }
    const float* tab = (const float*)(ws + WS_ROPE);
    const int i0 = 16 * (wc & 1) + 4 * fq;
#pragma unroll
    for (int ai = 0; ai < 2; ++ai)
#pragma unroll
        for (int m = 0; m < 4; ++m) {
            const int rl = ai * HALF + wr * 64 + m * 16 + fr;
            f32x4 cs0 = (f32x4){1.f, 0.f, 1.f, 0.f}, cs1 = cs0;
            if (rope) { const int pos = (pm * 256 + rl) & (SEQ - 1), av = (wc < 2) ? (pos >> 6) : (pos & 63);
                        const f32x4* t = (const f32x4*)(tab + (size_t)(av * 32 + i0) * 2); cs0 = t[0]; cs1 = t[1]; }
#pragma unroll
            for (int bj = 0; bj < 2; ++bj) {
                const float tot = (red[(bj * 4 + 0) * 256 + rl] + red[(bj * 4 + 1) * 256 + rl]) + (red[(bj * 4 + 2) * 256 + rl] + red[(bj * 4 + 3) * 256 + rl]);
                const float rstd = rsqrtf(tot * (1.0f / HD) + EPS);
                const f32x4 x1 = acc[ai][bj][m][0] * rstd * g0, x2 = acc[ai][bj][m][1] * rstd * g1;
                const float a0 = x1.x * cs0.x - x2.x * cs0.y, b0 = x2.x * cs0.x + x1.x * cs0.y;
                const float a1 = x1.y * cs0.z - x2.y * cs0.w, b1 = x2.y * cs0.z + x1.y * cs0.w;
                const float a2 = x1.z * cs1.x - x2.z * cs1.y, b2 = x2.z * cs1.x + x1.z * cs1.y;
                const float a3 = x1.w * cs1.z - x2.w * cs1.w, b3 = x2.w * cs1.z + x1.w * cs1.w;
                u32x2 o1, o2; o1.x = cvt_pk_bf16(a0, a1); o1.y = cvt_pk_bf16(a2, a3); o2.x = cvt_pk_bf16(b0, b1); o2.y = cvt_pk_bf16(b2, b3);
                const auto sx = __builtin_amdgcn_permlane16_swap(o1.x, o2.x, false, false), sy = __builtin_amdgcn_permlane16_swap(o1.y, o2.y, false, false);
                u32x4 w; w.x = sx[0]; w.y = sy[0]; w.z = sx[1]; w.w = sy[1];
                bf16_t* rowp = base + (size_t)rl * ld + bj * bjstride + ((fq & 1) ? d0 + 28 : d0);
                *(u32x4*)rowp = w;
            }
        }
}

__device__ __forceinline__ void gemm_epilogue_fused(const Params& P, int mode, f32x4 (&acc)[2][2][4][2], const Unit& u, int wr, int wc, int fr, int fq, LAS unsigned char* lds, int tid) {
    unsigned char* ws = P.ws;
    const int x = (mode == G_OUT) ? 0 : 1;
    const float* resid = (mode == G_OUT) ? P.in[I_X] : P.out;
    const float* modb = (const float*)(ws + WS_MOD) + (size_t)(u.pm >> 3) * NMOD6;
    const float* gate = modb + (mode == G_OUT ? 2 * DM : 5 * DM);
    const int col0 = u.pn * 256 + wc * 32 + 4 * fq;
    LAS float* Pq = (LAS float*)lds;
    LAS float* S = (LAS float*)(lds + 4096);
    {
        f32x4 gv[2][2];
#pragma unroll
        for (int bj = 0; bj < 2; ++bj)
#pragma unroll
            for (int n = 0; n < 2; ++n) gv[bj][n] = *(const f32x4*)(gate + col0 + bj * HALF + n * 16);
        f32x4 rbuf[2][2][2];
        const size_t off0 = (size_t)(u.pm * 256 + wr * 64 + fr) * DM + col0;
#pragma unroll
        for (int bj = 0; bj < 2; ++bj)
#pragma unroll
            for (int n = 0; n < 2; ++n) rbuf[0][bj][n] = (mode == G_OUT) ? __builtin_nontemporal_load((const f32x4*)(resid + off0 + bj * HALF + n * 16)) : *(const f32x4*)(resid + off0 + bj * HALF + n * 16);
#pragma unroll
        for (int g = 0; g < 8; ++g) {
            const int ai = g >> 2, m = g & 3;
            const int rl = ai * HALF + wr * 64 + m * 16 + fr;
            const size_t off = (size_t)(u.pm * 256 + rl) * DM + col0;
            if (g < 7) { const int ai2 = (g + 1) >> 2, m2 = (g + 1) & 3; const size_t offn = (size_t)(u.pm * 256 + ai2 * HALF + wr * 64 + m2 * 16 + fr) * DM + col0;
#pragma unroll
                for (int bj = 0; bj < 2; ++bj)
#pragma unroll
                    for (int n = 0; n < 2; ++n) rbuf[(g + 1) & 1][bj][n] = (mode == G_OUT) ? __builtin_nontemporal_load((const f32x4*)(resid + offn + bj * HALF + n * 16)) : *(const f32x4*)(resid + offn + bj * HALF + n * 16); }
            float ss = 0.f;
#pragma unroll
            for (int bj = 0; bj < 2; ++bj)
#pragma unroll
                for (int n = 0; n < 2; ++n) {
                    const f32x4 v = rbuf[g & 1][bj][n] + gv[bj][n] * acc[ai][bj][m][n];
                    acc[ai][bj][m][n] = v;
                    if (mode == G_OUT) *(f32x4*)(P.out + off + bj * HALF + n * 16) = v;
                    ss += (v.x * v.x + v.y * v.y) + (v.z * v.z + v.w * v.w);
                }
            ss += swz_xor<16>(ss); ss = half_sum(ss);
            if (fq == 0) Pq[rl * 4 + wc] = ss;
            asm volatile("" ::: "memory");
        }
    }
    asm volatile("s_waitcnt lgkmcnt(0)" ::: "memory"); __builtin_amdgcn_s_barrier(); asm volatile("" ::: "memory");
    if (tid < 256) {
        const f32x4 q = *(const LAS f32x4*)(Pq + tid * 4);
        const float tot = (q.x + q.y) + (q.z + q.w);
        unsigned long long* w = (unsigned long long*)(ws + WS_XACC) + (size_t)x * MTOK + (size_t)(u.pm * 256 + tid);
        __hip_atomic_fetch_add(w, (1ull << 48) + (unsigned long long)(tot * 65536.0f + 0.5f), __ATOMIC_RELAXED, __HIP_MEMORY_SCOPE_AGENT);
        unsigned long long v; unsigned sp = 0;
        for (;;) { v = __hip_atomic_load(w, __ATOMIC_RELAXED, __HIP_MEMORY_SCOPE_AGENT); if ((v >> 48) >= 8ull) break; __builtin_amdgcn_s_sleep(1); if (++sp > (1u << 22)) break; }
        S[tid] = rsqrtf((float)(v & 0xFFFFFFFFFFFFull) * (1.0f / 65536.0f) * (1.0f / DM) + EPS);
    }
    asm volatile("s_waitcnt lgkmcnt(0)" ::: "memory"); __builtin_amdgcn_s_barrier(); asm volatile("" ::: "memory");
    if (mode == G_OUT) {
        f32x4 gg[2][2], sc[2][2], sh[2][2];
#pragma unroll
        for (int bj = 0; bj < 2; ++bj)
#pragma unroll
            for (int n = 0; n < 2; ++n) { const int cc = col0 + bj * HALF + n * 16; gg[bj][n] = *(const f32x4*)(P.in[I_G2] + cc); sh[bj][n] = *(const f32x4*)(modb + 3 * DM + cc); sc[bj][n] = *(const f32x4*)(modb + 4 * DM + cc) + 1.0f; }
        bf16_t* h2 = (bf16_t*)(ws + WS_H2);
#pragma unroll
        for (int ai = 0; ai < 2; ++ai)
#pragma unroll
            for (int m = 0; m < 4; ++m) {
                const int rl = ai * HALF + wr * 64 + m * 16 + fr; const float rs = S[rl];
                const size_t off = (size_t)(u.pm * 256 + rl) * DM + col0;
#pragma unroll
                for (int bj = 0; bj < 2; ++bj) {
                    const f32x4 y0 = (acc[ai][bj][m][0] * rs * gg[bj][0]) * sc[bj][0] + sh[bj][0], y1 = (acc[ai][bj][m][1] * rs * gg[bj][1]) * sc[bj][1] + sh[bj][1];
                    const unsigned p0x = cvt_pk_bf16(y0.x, y0.y), p0y = cvt_pk_bf16(y0.z, y0.w), p1x = cvt_pk_bf16(y1.x, y1.y), p1y = cvt_pk_bf16(y1.z, y1.w);
                    const auto sx = __builtin_amdgcn_permlane16_swap(p0x, p1x, false, false), sy = __builtin_amdgcn_permlane16_swap(p0y, p1y, false, false);
                    u32x4 w; w.x = sx[0]; w.y = sy[0]; w.z = sx[1]; w.w = sy[1];
                    *(u32x4*)(h2 + off + bj * HALF + ((fq & 1) ? 12 : 0)) = w;
                }
            }
    } else {
        f32x4 gg[2][2];
#pragma unroll
        for (int bj = 0; bj < 2; ++bj)
#pragma unroll
            for (int n = 0; n < 2; ++n) gg[bj][n] = *(const f32x4*)(P.in[I_GF] + col0 + bj * HALF + n * 16);
#pragma unroll
        for (int ai = 0; ai < 2; ++ai)
#pragma unroll
            for (int m = 0; m < 4; ++m) {
                const int rl = ai * HALF + wr * 64 + m * 16 + fr; const float rs = S[rl];
                const size_t off = (size_t)(u.pm * 256 + rl) * DM + col0;
#pragma unroll
                for (int bj = 0; bj < 2; ++bj)
#pragma unroll
                    for (int n = 0; n < 2; ++n) __builtin_nontemporal_store(acc[ai][bj][m][n] * rs * gg[bj][n], (f32x4*)(P.out + off + bj * HALF + n * 16));
            }
    }
    asm volatile("s_waitcnt lgkmcnt(0)" ::: "memory"); __builtin_amdgcn_s_barrier();
}

__device__ __forceinline__ void gemm_phase(LAS unsigned char* lds, const Params& P, const int mode, const int G, const int c) {
    int tid_ = threadIdx.x; asm volatile("" : "+v"(tid_));
    const int tid = tid_, wid = __builtin_amdgcn_readfirstlane(tid >> 6), lane = tid & 63, wr = wid >> 2, wc = wid & 3, fr = lane & 15, fq = lane >> 4;
    int lda, ldb, K; bool perm = true;
    switch (mode) {
    case G_IN: lda = DM; ldb = DM; K = DM; break;
    case G_F1: lda = 128; ldb = FW; K = 128; break;
    case G_F2: lda = 4096; ldb = 4096; K = 4096; break;
    case G_OUT: lda = DM; ldb = DM; K = DM; perm = false; break;
    case G_UP: lda = DM; ldb = DM; K = DM; break;
    default: lda = DFF; ldb = DFF; K = DFF; perm = false; break;
    }
    const int nt = K / BK;
    const bool fusedEpi = (mode == G_OUT || mode == G_DOWN) && G == 256;
    unsigned voffA[2];
#pragma unroll
    for (int i = 0; i < 2; ++i) { int R, C; stage_rc(tid * 16 + i * 8192, R, C); voffA[i] = (unsigned)(R * lda + C) * 2u; }
#define PG8_BOFF(i, qk) ([&]() { int R, C; stage_rc(tid * 16 + (i) * 8192, R, C); const int Rb = (qk) ? qk_perm(R) : (perm ? ((R & ~31) + perm32(R & 31)) : R); return (unsigned)(Rb * ldb + C) * 2u; }())
    const size_t kstep = (size_t)(BK * 2);
    const size_t hstepA = (size_t)HALF * lda * 2, hstepB = (size_t)HALF * ldb * 2;
    const unsigned ldsw = (unsigned)wid * 1024u;
    const int aoff = lds_byte(wr * 64 + fr, fq * 8), boff = lds_byte(wc * 32 + fr, fq * 8);
#define PG8_SA(b, h) (((b) * 2 + (h)) * HTB)
#define PG8_SB(b, h) ((4 + (b) * 2 + (h)) * HTB)
#define PG8_STAGE(bufoff, gbase, voff) do { _Pragma("unroll") for (int _i = 0; _i < 2; ++_i) \
        __builtin_amdgcn_global_load_lds((const unsigned*)((const char*)(gbase) + (voff)[_i]), (LAS unsigned*)(lds + (bufoff) + ldsw + _i * 8192), 16, 0, 0); } while (0)
#define PG8_LDA(dst, b, h) do { _Pragma("unroll") for (int m = 0; m < 4; ++m) _Pragma("unroll") for (int k = 0; k < 2; ++k) dst[m][k] = *(const LAS bf16x8*)(lds + PG8_SA(b, h) + aoff + m * 2048 + k * 1024); } while (0)
#define PG8_LDB(dst, b, h) do { _Pragma("unroll") for (int n = 0; n < 2; ++n) _Pragma("unroll") for (int k = 0; k < 2; ++k) dst[n][k] = *(const LAS bf16x8*)(lds + PG8_SB(b, h) + boff + n * 2048 + k * 1024); } while (0)
#define PG8_MMA(ai, bj, At, Bt) do { __builtin_amdgcn_s_setprio(1); _Pragma("unroll") for (int m = 0; m < 4; ++m) _Pragma("unroll") for (int n = 0; n < 2; ++n) _Pragma("unroll") for (int k = 0; k < 2; ++k) \
        acc[ai][bj][m][n] = __builtin_amdgcn_mfma_f32_16x16x32_bf16(Bt[n][k], At[m][k], acc[ai][bj][m][n], 0, 0, 0); __builtin_amdgcn_s_setprio(0); } while (0)
#define PG8_WAIT_V(n) asm volatile("s_waitcnt vmcnt(" #n ")" ::: "memory")
#define PG8_WAIT_L(n) asm volatile("s_waitcnt lgkmcnt(" #n ")" ::: "memory")
#define PG8_BAR __builtin_amdgcn_s_barrier()
#define PG8_SCHED __builtin_amdgcn_sched_barrier(0)
    Unit cur, nxt; int ui = 0;
    if (!get_unit(P.ws, mode, 0, G, c, cur)) return;
    f32x4 acc[2][2][4][2];
#pragma unroll
    for (int a = 0; a < 2; ++a)
#pragma unroll
        for (int b = 0; b < 2; ++b)
#pragma unroll
            for (int m = 0; m < 4; ++m)
#pragma unroll
                for (int n = 0; n < 2; ++n) acc[a][b][m][n] = (f32x4){0.f, 0.f, 0.f, 0.f};
    bf16x8 At[4][2], B0[2][2], B1[2][2];
    const char* cA = cur.a; const char* cB = cur.b;
    bool cqk = (mode == G_IN) && cur.pn < 8;
    unsigned voffB[2] = {PG8_BOFF(0, cqk), PG8_BOFF(1, cqk)};
    PG8_STAGE(PG8_SB(0, 0), cB, voffB); PG8_STAGE(PG8_SB(0, 1), cB + hstepB, voffB); PG8_STAGE(PG8_SA(0, 0), cA, voffA); PG8_STAGE(PG8_SA(0, 1), cA + hstepA, voffA);
    if (wr == 1) PG8_BAR;
    PG8_WAIT_V(2); PG8_BAR;
    PG8_STAGE(PG8_SB(1, 0), cB + kstep, voffB); PG8_STAGE(PG8_SA(1, 0), cA + kstep, voffA); PG8_STAGE(PG8_SB(1, 1), cB + hstepB + kstep, voffB);
    PG8_WAIT_V(6); PG8_BAR;
    for (;;) {
        const bool has_next = get_unit(P.ws, mode, ui + 1, G, c, nxt);
        const char* nA = has_next ? nxt.a : cA; const char* nB = has_next ? nxt.b : cB;
        const bool nqk = has_next ? ((mode == G_IN) && nxt.pn < 8) : cqk;
        for (int t = 0; t < nt; t += 2) {
            const bool last = (t == nt - 2);
            unsigned vb2[2] = {voffB[0], voffB[1]};
            if (last && nqk != cqk) { vb2[0] = PG8_BOFF(0, nqk); vb2[1] = PG8_BOFF(1, nqk); }
            const char* a1 = cA + (size_t)(t + 1) * kstep;
            const char* a2 = last ? nA : cA + (size_t)(t + 2) * kstep; const char* b2 = last ? nB : cB + (size_t)(t + 2) * kstep;
            const char* a3 = a2 + kstep; const char* b3 = b2 + kstep;
            PG8_LDB(B0, 0, 0); PG8_LDB(B1, 0, 1); PG8_SCHED; PG8_LDA(At, 0, 0); PG8_STAGE(PG8_SA(1, 1), a1 + hstepA, voffA);
            PG8_WAIT_V(8); PG8_WAIT_L(0); PG8_BAR; PG8_MMA(0, 0, At, B0); PG8_MMA(0, 1, At, B1); PG8_BAR; PG8_SCHED;
            PG8_LDA(At, 0, 1); PG8_STAGE(PG8_SB(0, 0), b2, vb2); PG8_STAGE(PG8_SB(0, 1), b2 + hstepB, vb2); PG8_STAGE(PG8_SA(0, 0), a2, voffA);
            PG8_WAIT_V(8); PG8_WAIT_L(0); PG8_BAR; PG8_MMA(1, 0, At, B0); PG8_MMA(1, 1, At, B1); PG8_BAR; PG8_SCHED;
            PG8_LDB(B0, 1, 0); PG8_LDB(B1, 1, 1); PG8_SCHED; PG8_LDA(At, 1, 0); PG8_STAGE(PG8_SA(0, 1), a2 + hstepA, voffA);
            PG8_WAIT_V(8); PG8_WAIT_L(0); PG8_BAR; PG8_MMA(0, 0, At, B0); PG8_MMA(0, 1, At, B1); PG8_BAR; PG8_SCHED;
            PG8_LDA(At, 1, 1); PG8_STAGE(PG8_SB(1, 0), b3, vb2); PG8_STAGE(PG8_SB(1, 1), b3 + hstepB, vb2); PG8_STAGE(PG8_SA(1, 0), a3, voffA);
            PG8_WAIT_V(8); PG8_WAIT_L(0); PG8_BAR; PG8_MMA(1, 0, At, B0); PG8_MMA(1, 1, At, B1); PG8_BAR; PG8_SCHED;
        }
        if (wr == 0) PG8_BAR;
        if (cqk) gemm_epilogue_qk(P, acc, cur, wr, wc, fr, fq, lds);
        else if (!fusedEpi) gemm_epilogue(P, mode, acc, cur, wr, wc, fr, fq);
        if (!has_next) break;
#pragma unroll
        for (int a = 0; a < 2; ++a)
#pragma unroll
            for (int b = 0; b < 2; ++b)
#pragma unroll
                for (int m = 0; m < 4; ++m)
#pragma unroll
                    for (int n = 0; n < 2; ++n) acc[a][b][m][n] = (f32x4){0.f, 0.f, 0.f, 0.f};
        cur = nxt; cA = nA; cB = nB; ++ui; if (nqk != cqk) { cqk = nqk; voffB[0] = PG8_BOFF(0, cqk); voffB[1] = PG8_BOFF(1, cqk); }
        if (wr == 1) PG8_BAR;
    }
    PG8_WAIT_V(0);
    PG8_BAR;
    if (fusedEpi) gemm_epilogue_fused(P, mode, acc, cur, wr, wc, fr, fq, lds, tid);
#undef PG8_BOFF
#undef PG8_SA
#undef PG8_SB
#undef PG8_STAGE
#undef PG8_LDA
#undef PG8_LDB
#undef PG8_MMA
#undef PG8_WAIT_V
#undef PG8_WAIT_L
#undef PG8_BAR
#undef PG8_SCHED
}

namespace att {
constexpr int D = 128, NW = 8, QBLK = 32, KVBLK = 64;
constexpr float SCALE = 0.088388347648318440f;
constexpr float THR = 8.f;
constexpr int LDQ = AW, LDK = HD, LDO = DM;
constexpr size_t SHM_V = KVBLK * D * 2, SHM_K = KVBLK * D * 2, SHM_ATTN = 2 * SHM_V + 2 * SHM_K + NW * 64 * 4;
#define KSWZ(row, colB) ((row) * 256 + ((colB) ^ (((row) & 7) << 4)))
#define SBAR() __builtin_amdgcn_sched_barrier(0)
__device__ __forceinline__ int crow(int r, int hi) { return (r & 3) + 8 * (r >> 2) + 4 * hi; }
__device__ __forceinline__ unsigned cvtpk(float lo, float hi) { unsigned r; asm volatile("v_cvt_pk_bf16_f32 %0, %1, %2" : "=v"(r) : "v"(lo), "v"(hi)); return r; }
__device__ __forceinline__ bf16x8 ld8(const bf16_t* p) { return *reinterpret_cast<const bf16x8*>(p); }

__device__ __forceinline__ void partialSM(f32x16& p0, f32x16& p1, float& m_reg, float& mn, float& alpha) {
  constexpr float C = SCALE * 1.4426950408889634f;
  float pmax = p0[0];
#pragma unroll
  for (int r = 1; r < 16; ++r) pmax = fmaxf(pmax, p0[r]);
#pragma unroll
  for (int r = 0; r < 16; ++r) pmax = fmaxf(pmax, p1[r]);
  { auto rr = __builtin_amdgcn_permlane32_swap(__float_as_uint(pmax), __float_as_uint(pmax), false, false);
    pmax = fmaxf(__uint_as_float(rr[0]), __uint_as_float(rr[1])); }
  if (__builtin_expect(__all(pmax - m_reg <= THR / SCALE), 1)) { mn = m_reg; alpha = 1.f; }
  else { mn = fmaxf(m_reg, pmax); alpha = __builtin_amdgcn_exp2f((m_reg - mn) * C); m_reg = mn; }
  float mnC = -mn * C;
#pragma unroll
  for (int r = 0; r < 16; ++r) p0[r] = fmaf(p0[r], C, mnC);
#pragma unroll
  for (int r = 0; r < 16; ++r) p1[r] = fmaf(p1[r], C, mnC);
#pragma unroll
  for (int r = 0; r < 16; ++r) p0[r] = __builtin_amdgcn_exp2f(p0[r]);
}
__device__ __forceinline__ void finishSM(f32x16& p0, f32x16& p1, float alpha, float& l_reg, bf16x8& pa0, bf16x8& pa1, bf16x8& pa2, bf16x8& pa3) {
#pragma unroll
  for (int r = 0; r < 16; ++r) p1[r] = __builtin_amdgcn_exp2f(p1[r]);
  float ps = 0;
#pragma unroll
  for (int r = 0; r < 16; ++r) ps += p0[r];
#pragma unroll
  for (int r = 0; r < 16; ++r) ps += p1[r];
  { auto rr = __builtin_amdgcn_permlane32_swap(__float_as_uint(ps), __float_as_uint(ps), false, false);
    ps = __uint_as_float(rr[0]) + __uint_as_float(rr[1]); }
  l_reg = l_reg * alpha + ps;
#define PK4(P, BASE, OUT) do { unsigned a0 = cvtpk(P[BASE + 0], P[BASE + 1]), a1 = cvtpk(P[BASE + 2], P[BASE + 3]);   \
    unsigned b0 = cvtpk(P[BASE + 4], P[BASE + 5]), b1 = cvtpk(P[BASE + 6], P[BASE + 7]);                              \
    auto r0 = __builtin_amdgcn_permlane32_swap(a0, b0, false, false); auto r1 = __builtin_amdgcn_permlane32_swap(a1, b1, false, false); \
    u32x4 w = {r0[0], r1[0], r0[1], r1[1]}; OUT = *reinterpret_cast<bf16x8*>(&w); } while (0)
  PK4(p0, 0, pa0); PK4(p0, 8, pa1); PK4(p1, 0, pa2); PK4(p1, 8, pa3);
#undef PK4
}
__device__ __forceinline__ void qkt(f32x16& p0, f32x16& p1, const bf16_t* Ks, const bf16x8* qr, int r32, int hi) {
  p0 = f32x16{}; p1 = f32x16{};
#pragma unroll
  for (int d0 = 0; d0 < 8; ++d0) { int cb = (d0 * 16 + hi * 8) * 2;
    bf16x8 b0 = *reinterpret_cast<const bf16x8*>((const char*)Ks + KSWZ(r32, cb));
    bf16x8 b1 = *reinterpret_cast<const bf16x8*>((const char*)Ks + KSWZ(32 + r32, cb));
    p0 = __builtin_amdgcn_mfma_f32_32x32x16_bf16(b0, qr[d0], p0, 0, 0, 0);
    p1 = __builtin_amdgcn_mfma_f32_32x32x16_bf16(b1, qr[d0], p1, 0, 0, 0); }
}
__device__ __forceinline__ int v_st(int k, int c) { const int kk = (k & ~0xC) | ((k & 4) << 1) | ((k & 8) >> 1); return ((kk >> 3) * 4 + (c >> 5)) * 512 + ((kk & 7) * 32 + (c & 31)) * 2; }
__device__ __forceinline__ int v_rd_base(int lane) { return ((lane & 3) << 3) | (((lane >> 2) & 3) << 6) | (((lane >> 4) & 1) << 5) | (((lane >> 5) & 1) << 8); }
constexpr int v_rd_off(int d0, int ks, int half) { return d0 * 512 + ks * 4096 + half * 2048; }
template <int OFF> __device__ __forceinline__ s16x4 tr_read(int vb) {
  s16x4 r; asm volatile("ds_read_b64_tr_b16 %0, %1 offset:%2" : "=&v"(r) : "v"(vb), "i"(OFF) : "memory"); return r;
}
template <int D0> __device__ __forceinline__ void pv_one(f32x16& od, int vb, bf16x8 pa0, bf16x8 pa1, bf16x8 pa2, bf16x8 pa3) {
  const s16x4 l0 = tr_read<v_rd_off(D0, 0, 0)>(vb), h0 = tr_read<v_rd_off(D0, 0, 1)>(vb), l1 = tr_read<v_rd_off(D0, 1, 0)>(vb), h1 = tr_read<v_rd_off(D0, 1, 1)>(vb);
  const s16x4 l2 = tr_read<v_rd_off(D0, 2, 0)>(vb), h2 = tr_read<v_rd_off(D0, 2, 1)>(vb), l3 = tr_read<v_rd_off(D0, 3, 0)>(vb), h3 = tr_read<v_rd_off(D0, 3, 1)>(vb);
  asm volatile("s_waitcnt lgkmcnt(0)" ::: "memory"); SBAR();
#define PK(L, H) (bf16x8){L[0], L[1], L[2], L[3], H[0], H[1], H[2], H[3]}
  od = __builtin_amdgcn_mfma_f32_32x32x16_bf16(pa0, PK(l0, h0), od, 0, 0, 0);
  od = __builtin_amdgcn_mfma_f32_32x32x16_bf16(pa1, PK(l1, h1), od, 0, 0, 0);
  od = __builtin_amdgcn_mfma_f32_32x32x16_bf16(pa2, PK(l2, h2), od, 0, 0, 0);
  od = __builtin_amdgcn_mfma_f32_32x32x16_bf16(pa3, PK(l3, h3), od, 0, 0, 0);
#undef PK
}
__device__ __forceinline__ void pv_d0(f32x16* o, int vb, bf16x8 pa0, bf16x8 pa1, bf16x8 pa2, bf16x8 pa3) {
  pv_one<0>(o[0], vb, pa0, pa1, pa2, pa3); pv_one<1>(o[1], vb, pa0, pa1, pa2, pa3); pv_one<2>(o[2], vb, pa0, pa1, pa2, pa3); pv_one<3>(o[3], vb, pa0, pa1, pa2, pa3);
}

__device__ __forceinline__ void attn_dense_body(const bf16_t* __restrict__ Qb, const bf16_t* __restrict__ Kh, const bf16_t* __restrict__ Vh,
                                                bf16_t* __restrict__ Ob, int seq, char* lds) {
  int tid_ = threadIdx.x; asm volatile("" : "+v"(tid_));
  const int tid = tid_, wid = tid >> 6, lane = tid & 63, r32 = lane & 31, hi = lane >> 5;
  bf16_t* V_lds = (bf16_t*)lds; bf16_t* K_lds = (bf16_t*)(lds + 2 * SHM_V);
  float* ws = (float*)(lds + 2 * SHM_V + 2 * SHM_K) + wid * 64; float* li_l = ws; float* al_l = ws + 32;
  float m_reg = -1e30f, l_reg = 0; f32x16 o[4] = {}; bf16x8 qr[8];
  const bf16_t* Qw = Qb + (long)(wid * QBLK + r32) * LDQ + hi * 8;
#pragma unroll
  for (int d0 = 0; d0 < 8; ++d0) qr[d0] = ld8(Qw + d0 * 16);
  const int sr = tid >> 4, sc = (tid & 15) * 8, vst0 = v_st(sr, sc), vst1 = v_st(32 + sr, sc);
  const int vb0 = (int)(uintptr_t)V_lds + v_rd_base(lane);
  struct { bf16x8 vs0, vs1, ks0, ks1; } sr_[2];
#define SLOAD(i, k0) do { sr_[i].vs0 = ld8(&Vh[(long)((k0) + sr) * LDK + sc]); sr_[i].vs1 = ld8(&Vh[(long)((k0) + 32 + sr) * LDK + sc]); \
    sr_[i].ks0 = ld8(&Kh[(long)((k0) + sr) * LDK + sc]); sr_[i].ks1 = ld8(&Kh[(long)((k0) + 32 + sr) * LDK + sc]); } while (0)
#define SWRITE(b, i) do { *(bf16x8*)((char*)V_lds + (b) * SHM_V + vst0) = sr_[i].vs0;          \
    *(bf16x8*)((char*)V_lds + (b) * SHM_V + vst1) = sr_[i].vs1; int kc = sc * 2;               \
    *(bf16x8*)((char*)K_lds + (b) * SHM_K + KSWZ(sr, kc)) = sr_[i].ks0;                       \
    *(bf16x8*)((char*)K_lds + (b) * SHM_K + KSWZ(32 + sr, kc)) = sr_[i].ks1; } while (0)
#define SWAIT() asm volatile("s_waitcnt vmcnt(4)" ::: "memory")
#define RESC(a) do { if (__any((a) < 1.f)) { if (hi == 0) al_l[r32] = (a); asm volatile("s_waitcnt lgkmcnt(0)" ::: "memory"); \
    _Pragma("unroll") for (int d = 0; d < 4; ++d) _Pragma("unroll") for (int r = 0; r < 16; ++r) o[d][r] *= al_l[crow(r, hi)]; } } while (0)
  f32x16 pA0, pA1, pB0, pB1; float mnA, mnB, alA, alB; bf16x8 pa0, pa1, pa2, pa3; const int NT = seq / KVBLK;
  constexpr int SE = 0, SO = 1;
  SLOAD(SE, 0); asm volatile("s_waitcnt vmcnt(0)" ::: "memory"); SWRITE(0, SE); __syncthreads();
  qkt(pA0, pA1, K_lds, qr, r32, hi); partialSM(pA0, pA1, m_reg, mnA, alA);
  SLOAD(SO, KVBLK); if (2 < NT) SLOAD(SE, 2 * KVBLK);
  SWAIT(); SWRITE(1, SO); __syncthreads();
  for (int j = 1; j + 1 < NT; j += 2) {
    SBAR(); qkt(pB0, pB1, (bf16_t*)((char*)K_lds + SHM_K), qr, r32, hi);
    finishSM(pA0, pA1, alA, l_reg, pa0, pa1, pa2, pa3); SBAR();
    SLOAD(SO, (j + 2) * KVBLK); SBAR();
    pv_d0(o, vb0, pa0, pa1, pa2, pa3); partialSM(pB0, pB1, m_reg, mnB, alB);
    __syncthreads(); SWAIT(); SWRITE(0, SE);
    RESC(alB); __syncthreads();
    SBAR(); qkt(pA0, pA1, K_lds, qr, r32, hi);
    finishSM(pB0, pB1, alB, l_reg, pa0, pa1, pa2, pa3); SBAR();
    if (j + 3 < NT) SLOAD(SE, (j + 3) * KVBLK); SBAR();
    pv_d0(o, vb0 + (int)SHM_V, pa0, pa1, pa2, pa3); partialSM(pA0, pA1, m_reg, mnA, alA);
    __syncthreads(); SWAIT(); SWRITE(1, SO);
    RESC(alA); __syncthreads();
  }
  SBAR(); qkt(pB0, pB1, (bf16_t*)((char*)K_lds + SHM_K), qr, r32, hi);
  finishSM(pA0, pA1, alA, l_reg, pa0, pa1, pa2, pa3); SBAR();
  pv_d0(o, vb0, pa0, pa1, pa2, pa3); partialSM(pB0, pB1, m_reg, mnB, alB);
  __syncthreads(); RESC(alB);
  finishSM(pB0, pB1, alB, l_reg, pa0, pa1, pa2, pa3); SBAR();
  pv_d0(o, vb0 + (int)SHM_V, pa0, pa1, pa2, pa3);
  if (hi == 0) li_l[r32] = l_reg; asm volatile("s_waitcnt lgkmcnt(0)" ::: "memory");
  float rli[16];
#pragma unroll
  for (int r = 0; r < 16; ++r) rli[r] = __builtin_amdgcn_rcpf(li_l[crow(r, hi)]);
  bf16_t* Ow = Ob + (long)(wid * QBLK) * LDO;
#pragma unroll
  for (int r = 0; r < 16; ++r) { int orow = crow(r, hi);
#pragma unroll
    for (int d0 = 0; d0 < 4; ++d0) Ow[(long)orow * LDO + d0 * 32 + r32] = f2bf(o[d0][r] * rli[r]); }
  __syncthreads();
#undef SLOAD
#undef SWRITE
#undef SWAIT
#undef RESC
}
#undef KSWZ
#undef SBAR
}

constexpr int TR_LDS_WAVE = 64 * 65 * 4;
__device__ __forceinline__ void transpose_share(const float* __restrict__ W, int K, int N, bf16_t* __restrict__ WT, int w, int nw, LAS unsigned char* lds, int first = 0, int last = 1 << 30) {
    int tid_ = threadIdx.x; asm volatile("" : "+v"(tid_));
    const int wid = tid_ >> 6, lane = tid_ & 63;
    LAS float* scr = (LAS float*)(lds + wid * TR_LDS_WAVE);
    const int nblk = N / 64; int nitems = (K / 64) * nblk; if (last < nitems) nitems = last;
    const int kr = lane >> 4, n4 = (lane & 15) * 4, c = lane & 7;
    int it = first + w * 8 + wid;
    if (it >= nitems) return;
    f32x4 v[16];
    { const int kb = it / nblk, nb = it - kb * nblk;
#pragma unroll
      for (int i = 0; i < 16; ++i) v[i] = __builtin_nontemporal_load((const f32x4*)(W + (size_t)(64 * kb + 4 * i + kr) * N + 64 * nb + n4)); }
    for (;;) {
        const int kb = it / nblk, nb = it - kb * nblk, k0 = 64 * kb, n0 = 64 * nb;
#pragma unroll
        for (int i = 0; i < 16; ++i) { LAS float* d = scr + (4 * i + kr) * 65 + n4; d[0] = v[i].x; d[1] = v[i].y; d[2] = v[i].z; d[3] = v[i].w; }
        const int nx = it + nw; const bool more = nx < nitems;
        if (more) { const int kb2 = nx / nblk, nb2 = nx - kb2 * nblk;
#pragma unroll
            for (int i = 0; i < 16; ++i) v[i] = __builtin_nontemporal_load((const f32x4*)(W + (size_t)(64 * kb2 + 4 * i + kr) * N + 64 * nb2 + n4)); }
        LDS_WAIT();
#pragma unroll
        for (int j = 0; j < 8; ++j) { const int n = (lane >> 3) + 8 * j; const LAS float* sp = scr + (8 * c) * 65 + n;
            u32x4 o; o.x = cvt_pk_bf16(sp[0 * 65], sp[1 * 65]); o.y = cvt_pk_bf16(sp[2 * 65], sp[3 * 65]); o.z = cvt_pk_bf16(sp[4 * 65], sp[5 * 65]); o.w = cvt_pk_bf16(sp[6 * 65], sp[7 * 65]);
            *(u32x4*)(WT + (size_t)(n0 + n) * K + k0 + 8 * c) = o; }
        LDS_WAIT();
        if (!more) break;
        it = nx;
    }
}

__device__ __forceinline__ void dft_slice(unsigned char* ws, int first, int cnt) {
    bf16_t* dft = (bf16_t*)(ws + WS_DFT);
    for (int q = 0; q < cnt; ++q) {
        const int idx = first + q * 512;
        if (idx >= 2048 * 512) break;
        const int k = idx >> 9, n0 = (idx & 511) * 8, part = n0 >> 11, nn = n0 & 2047;
        float v[8];
#pragma unroll
        for (int e = 0; e < 8; ++e) { const float rev = (float)((k * (nn + e)) & 2047) * (1.0f / 2048.0f); v[e] = part ? __builtin_amdgcn_sinf(rev) : __builtin_amdgcn_cosf(rev); }
        u32x4 o; o.x = cvt_pk_bf16(v[0], v[1]); o.y = cvt_pk_bf16(v[2], v[3]); o.z = cvt_pk_bf16(v[4], v[5]); o.w = cvt_pk_bf16(v[6], v[7]);
        *(u32x4*)(dft + (size_t)k * 4096 + n0) = o;
    }
}

__device__ __forceinline__ void ada_phase(const Params& P, LAS unsigned char* lds, int G) {
    int tid_ = threadIdx.x; asm volatile("" : "+v"(tid_));
    const int tid = tid_, wid = tid >> 6, lane = tid & 63;
    unsigned char* ws = P.ws;
    LAS float* sl = (LAS float*)lds;
    for (int i = tid; i < 5 * DM; i += 512) { const float v = (i < 4 * DM) ? P.in[I_C][i] : P.in[I_CCTX][i - 4 * DM]; sl[i] = v / (1.f + expf(-v)); }
    __syncthreads();
    LAS float* red = (LAS float*)(lds + 40960);
    float* mod = (float*)(ws + WS_MOD);
    const float* w_ada = P.in[I_WADA];
    const int dper = (2048 * 512 / 512 + G - 1) / G, dbase = blockIdx.x * dper * 512; int jd = 0;
    int it = blockIdx.x;
    f32x4 wv[16];
    if (it < 768) { const float* wp = w_ada + (size_t)((it / 48) * 128 + wid * 16) * NMOD6 + (it % 48) * 256 + lane * 4;
#pragma unroll
        for (int i = 0; i < 16; ++i) wv[i] = __builtin_nontemporal_load((const f32x4*)(wp + (size_t)i * NMOD6)); }
    while (it < 768) {
        const int cc = it % 48, kc = it / 48;
        const int kb = kc * 128 + wid * 16;
        f32x4 acc[5];
#pragma unroll
        for (int r = 0; r < 5; ++r) acc[r] = (f32x4){0.f, 0.f, 0.f, 0.f};
#pragma unroll
        for (int i = 0; i < 16; ++i) {
#pragma unroll
            for (int r = 0; r < 5; ++r) { const float s = sl[r * DM + kb + i]; acc[r] += wv[i] * s; }
        }
        const int nx = it + G;
        if (nx < 768) { const float* wp = w_ada + (size_t)((nx / 48) * 128 + wid * 16) * NMOD6 + (nx % 48) * 256 + lane * 4;
#pragma unroll
            for (int i = 0; i < 16; ++i) wv[i] = __builtin_nontemporal_load((const f32x4*)(wp + (size_t)i * NMOD6)); }
        { const int take = (dper - jd) < 3 ? (dper - jd) : 3; dft_slice(ws, dbase + jd * 512 + tid, take); jd += take; }
#pragma unroll
        for (int r = 0; r < 5; ++r) *(LAS f32x4*)(red + (wid * 5 + r) * 256 + lane * 4) = acc[r];
        asm volatile("s_waitcnt lgkmcnt(0)" ::: "memory"); __builtin_amdgcn_s_barrier(); asm volatile("" ::: "memory");
        if (tid < 320) {
            const int r = tid >> 6, q = tid & 63;
            f32x4 s = (f32x4){0.f, 0.f, 0.f, 0.f};
#pragma unroll
            for (int w = 0; w < 8; ++w) s += *(const LAS f32x4*)(red + (w * 5 + r) * 256 + q * 4);
            if (kc == 0) s += *(const f32x4*)(P.in[I_BADA] + cc * 256 + q * 4);
            float* dst = mod + (size_t)r * NMOD6 + cc * 256 + q * 4;
            unsafeAtomicAdd(dst + 0, s[0]); unsafeAtomicAdd(dst + 1, s[1]); unsafeAtomicAdd(dst + 2, s[2]); unsafeAtomicAdd(dst + 3, s[3]);
        }
        asm volatile("s_waitcnt lgkmcnt(0)" ::: "memory"); __builtin_amdgcn_s_barrier(); asm volatile("" ::: "memory");
        it = nx;
    }
    dft_slice(ws, dbase + jd * 512 + tid, dper - jd);
    asm volatile("s_waitcnt vmcnt(0)" ::: "memory");
    __syncthreads();
    if (tid == 0) { __builtin_amdgcn_fence(__ATOMIC_RELEASE, "agent"); asm volatile("s_waitcnt vmcnt(0)" ::: "memory");
                    __hip_atomic_fetch_add((unsigned*)(ws + WS_QCTR), 1u, __ATOMIC_RELAXED, __HIP_MEMORY_SCOPE_AGENT); }
}

__device__ __forceinline__ void gen_tables(const Params& P, LAS unsigned char* lds, int blk, int nblk, int what = 3) {
    int tid_ = threadIdx.x; asm volatile("" : "+v"(tid_));
    const int tid = tid_;
    unsigned char* ws = P.ws;
    LAS float* ct = (LAS float*)lds;
    for (int j = tid; j < 2048; j += 512) ct[j] = cospif((float)j * (1.0f / 1024.0f));
    __syncthreads();
    bf16_t* dft = (bf16_t*)(ws + WS_DFT);
    if (what & 1) for (int idx = blk * 512 + tid; idx < 2048 * 512; idx += nblk * 512) {
        const int k = idx >> 9, n0 = (idx & 511) * 8, part = n0 >> 11, nn = n0 & 2047;
        float v[8];
#pragma unroll
        for (int e = 0; e < 8; ++e) { const int j = (k * (nn + e)) & 2047; v[e] = ct[part ? ((j - 512) & 2047) : j]; }
        u32x4 o; o.x = cvt_pk_bf16(v[0], v[1]); o.y = cvt_pk_bf16(v[2], v[3]); o.z = cvt_pk_bf16(v[4], v[5]); o.w = cvt_pk_bf16(v[6], v[7]);
        *(u32x4*)(dft + (size_t)k * 4096 + n0) = o;
    }
    for (int idx = blk * 512 + tid; idx < 64 * 32; idx += nblk * 512) {
        const int pv = idx >> 5, i = idx & 31;
        const float ang = (float)pv * powf(10000.0f, -(float)(2 * i) / 64.0f);
        float* t = (float*)(ws + WS_ROPE) + (size_t)(pv * 32 + i) * 2;
        t[0] = cosf(ang); t[1] = sinf(ang);
    }
    bf16_t* gt = (bf16_t*)(ws + WS_GT);
    LAS float* wfs = (LAS float*)(lds + 8192);
    const int NS = nblk >= 4 ? nblk / 4 : 1;
    for (int t = blk; t < 4 * NS; t += nblk) {
        const int g = t / NS, sidx = t - g * NS;
        const float* wf = P.in[I_WF] + (size_t)g * 128 * 128;
#pragma unroll
        for (int j = 0; j < 8; ++j) *(LAS f32x4*)(wfs + (tid + 512 * j) * 4) = *(const f32x4*)(wf + (tid + 512 * j) * 4);
        __syncthreads();
        for (int idx = sidx * 512 + tid; idx < 2 * 128 * 128; idx += NS * 512) {
            const int d = idx & 127, cch = (idx >> 7) & 127, part = idx >> 14;
            float sum = 0.f;
#pragma unroll 16
            for (int l = 0; l < 128; ++l) {
                const int j = (cch * l) & 127;
                const float cs = part ? -ct[((j - 32) & 127) * 16] : ct[j * 16];
                sum += cs * wfs[l * 128 + d];
            }
            gt[(size_t)((g * 2 + part) * 128 + d) * 128 + cch] = f2bf(sum * (1.0f / 512.0f));
        }
        __syncthreads();
    }
}

__device__ __forceinline__ void rows_pass_h(const Params& P, int G) {
    int tid_ = threadIdx.x; asm volatile("" : "+v"(tid_));
    const int tid = tid_, wid = tid >> 6, lane = tid & 63;
    const int gw = blockIdx.x * 8 + wid, NGW = G * 8;
    if (tid == 0) { unsigned sp = 0; while (__hip_atomic_load((unsigned*)(P.ws + WS_QCTR), __ATOMIC_RELAXED, __HIP_MEMORY_SCOPE_AGENT) < (unsigned)G) { __builtin_amdgcn_s_sleep(2); if (++sp > (1u << 22)) break; } }
    __syncthreads();
    __builtin_amdgcn_fence(__ATOMIC_ACQUIRE, "agent");
    const float* mod = (const float*)(P.ws + WS_MOD);
    const int chunk = (MTOK + NGW - 1) / NGW, r0 = gw * chunk, r1 = (r0 + chunk < MTOK) ? r0 + chunk : MTOK;
    const int c0 = MTOK + gw;
    int r = (r0 < r1) ? r0 : (c0 < MTOK + MCTX ? c0 : -1);
    if (r < 0) return;
    f32x4 g[8], sh[8], sc[8], v[8], nv[8];
#pragma unroll
    for (int j = 0; j < 8; ++j) g[j] = *(const f32x4*)(P.in[I_G1] + (lane + 64 * j) * 4);
    int cur_mr = -1;
#define ROWP(R) (((R) < MTOK) ? P.in[I_X] + (size_t)(R) * DM : P.in[I_CTX] + (size_t)((R) - MTOK) * DM)
    { const float* src = ROWP(r);
#pragma unroll
      for (int j = 0; j < 8; ++j) v[j] = __builtin_nontemporal_load((const f32x4*)(src + (lane + 64 * j) * 4)); }
    for (;;) {
        int rn;
        if (r < MTOK) rn = (r + 1 < r1) ? r + 1 : (c0 < MTOK + MCTX ? c0 : -1);
        else rn = (r + NGW < MTOK + MCTX) ? r + NGW : -1;
        if (rn >= 0) { const float* src = ROWP(rn);
#pragma unroll
            for (int j = 0; j < 8; ++j) nv[j] = __builtin_nontemporal_load((const f32x4*)(src + (lane + 64 * j) * 4)); }
        const int mr = (r >= MTOK) ? 4 : (r >> 11);
        if (mr != cur_mr) { cur_mr = mr; const float* mrow = mod + (size_t)mr * NMOD6;
#pragma unroll
            for (int j = 0; j < 8; ++j) { sh[j] = *(const f32x4*)(mrow + (lane + 64 * j) * 4); sc[j] = *(const f32x4*)(mrow + DM + (lane + 64 * j) * 4) + 1.0f; } }
        float ss = 0.f;
#pragma unroll
        for (int j = 0; j < 8; ++j) ss += (v[j].x * v[j].x + v[j].y * v[j].y) + (v[j].z * v[j].z + v[j].w * v[j].w);
        const float rstd = rsqrtf(wave_sum(ss) * (1.0f / DM) + EPS);
        bf16_t* dst = (bf16_t*)(P.ws + WS_H) + (size_t)r * DM;
#pragma unroll
        for (int j = 0; j < 8; ++j) {
            const f32x4 y = (v[j] * rstd * g[j]) * sc[j] + sh[j];
            u32x2 o; o.x = cvt_pk_bf16(y.x, y.y); o.y = cvt_pk_bf16(y.z, y.w);
            *(u32x2*)(dst + (lane + 64 * j) * 4) = o;
        }
        if (rn < 0) break;
#pragma unroll
        for (int j = 0; j < 8; ++j) v[j] = nv[j];
        r = rn;
    }
#undef ROWP
}

template <int MODE> __device__ __forceinline__ const float* rows_src(const Params& P, int r) {
    if (MODE == 0) return (r < MTOK) ? P.in[I_X] + (size_t)r * DM : P.in[I_CTX] + (size_t)(r - MTOK) * DM;
    return P.out + (size_t)r * DM;
}
template <int MODE> __device__ __forceinline__ void rows_pass(const Params& P, int G) {
    int tid_ = threadIdx.x; asm volatile("" : "+v"(tid_));
    const int tid = tid_, wid = tid >> 6, lane = tid & 63;
    const int gw = blockIdx.x * 8 + wid, NGW = G * 8;
    const int nrows = (MODE == 0) ? (MTOK + MCTX) : MTOK;
    if (MODE == 0) {
        if (tid == 0) { unsigned sp = 0; while (__hip_atomic_load((unsigned*)(P.ws + WS_QCTR), __ATOMIC_RELAXED, __HIP_MEMORY_SCOPE_AGENT) < (unsigned)G) { __builtin_amdgcn_s_sleep(2); if (++sp > (1u << 22)) break; } }
        __syncthreads();
        __builtin_amdgcn_fence(__ATOMIC_ACQUIRE, "agent");
    }
    const float* mod = (const float*)(P.ws + WS_MOD);
    const float* gain = P.in[MODE == 0 ? I_G1 : (MODE == 1 ? I_G2 : I_GF)];
    int r = gw;
    if (r >= nrows) return;
    f32x4 v[8], nv[8];
    { const float* src = rows_src<MODE>(P, r);
#pragma unroll
      for (int j = 0; j < 8; ++j) v[j] = (MODE == 0) ? __builtin_nontemporal_load((const f32x4*)(src + (lane + 64 * j) * 4)) : *(const f32x4*)(src + (lane + 64 * j) * 4); }
    for (;;) {
        const int rn = r + NGW; const bool more = rn < nrows;
        if (more) { const float* src = rows_src<MODE>(P, rn);
#pragma unroll
            for (int j = 0; j < 8; ++j) nv[j] = (MODE == 0) ? __builtin_nontemporal_load((const f32x4*)(src + (lane + 64 * j) * 4)) : *(const f32x4*)(src + (lane + 64 * j) * 4); }
        const int mr = (MODE == 0 && r >= MTOK) ? 4 : (r >> 11);
        float ss = 0.f;
#pragma unroll
        for (int j = 0; j < 8; ++j) ss += (v[j].x * v[j].x + v[j].y * v[j].y) + (v[j].z * v[j].z + v[j].w * v[j].w);
        const float rstd = rsqrtf(wave_sum(ss) * (1.0f / DM) + EPS);
#pragma unroll
        for (int j = 0; j < 8; ++j) {
            const int col = (lane + 64 * j) * 4;
            const f32x4 g = *(const f32x4*)(gain + col);
            f32x4 y = v[j] * rstd * g;
            if (MODE == 2) { *(f32x4*)(P.out + (size_t)r * DM + col) = y; }
            else {
                const float* mrow = mod + (size_t)mr * NMOD6 + (MODE == 0 ? 0 : 3 * DM);
                const f32x4 sh = *(const f32x4*)(mrow + col), sc = *(const f32x4*)(mrow + DM + col);
                y = y * (1.0f + sc) + sh;
                u32x2 o; o.x = cvt_pk_bf16(y.x, y.y); o.y = cvt_pk_bf16(y.z, y.w);
                bf16_t* dst = (bf16_t*)(P.ws + (MODE == 0 ? WS_H : WS_H2)) + (size_t)r * DM + col;
                *(u32x2*)dst = o;
            }
        }
        if (!more) break;
#pragma unroll
        for (int j = 0; j < 8; ++j) v[j] = nv[j];
        r = rn;
    }
}

__device__ __forceinline__ void attention_phase(const Params& P, unsigned char* lds, int G) {
    const int c = blockIdx.x;
    for (int j = 0;; ++j) {
        int b, h, qb;
        if (G == 256) {
            if (c < 64 || j > 1) break;
            const int grp = (c & 7) + 8 * j, w = (c - 64) >> 3;
            b = grp >> 2; h = (grp & 3) * 3 + (w >> 3); qb = w & 7;
        } else {
            const int au = c + G * j;
            if (au >= NB * NQH * 8) break;
            qb = au & 7; const int bh = au >> 3; h = bh % NQH; b = bh / NQH;
        }
        const bf16_t* Qb = (const bf16_t*)(P.ws + WS_Q) + (size_t)(b * SEQ + qb * 256) * AW + h * HD;
        const bf16_t* Kh = (const bf16_t*)(P.ws + WS_K) + (size_t)(b * NKVH + h / 3) * SKV * HD;
        const bf16_t* Vh = (const bf16_t*)(P.ws + WS_V) + (size_t)(b * NKVH + h / 3) * SKV * HD;
        bf16_t* Ob = (bf16_t*)(P.ws + WS_MIX) + (size_t)(b * SEQ + qb * 256) * DM + h * HD;
        att::attn_dense_body(Qb, Kh, Vh, Ob, SKV, (char*)lds);
    }
}


#define XB_TMO      128
#define XB_XCNT(j)  (256  + 64 * (j))
#define XB_XSUB(j)  (1280 + 64 * (j))
#define XB_XGEN(j)  (2304 + 64 * (j))
#define XB_TOP      3328
#define XB_TOPGEN   3392
#define XCD_BAR_WORDS 3456
#define XB_SPIN_CAP (1u << 22)
__device__ __forceinline__ unsigned xb_ld(unsigned* p)              { return __hip_atomic_load(p, __ATOMIC_RELAXED, __HIP_MEMORY_SCOPE_AGENT); }
__device__ __forceinline__ unsigned xb_add(unsigned* p, unsigned v) { return __hip_atomic_fetch_add(p, v, __ATOMIC_RELAXED, __HIP_MEMORY_SCOPE_AGENT); }
__device__ __forceinline__ unsigned xb_xcc_id() { return (unsigned)__builtin_amdgcn_s_getreg((3 << 11) | 20) & 0xFu; }
#define XB_SPIN(cond, bar) do { unsigned _sp = 0; while (cond) { __builtin_amdgcn_s_sleep(1); \
    if ((++_sp & 255u) == 0u) { if (xb_ld(&(bar)[XB_TMO])) break; if (_sp > XB_SPIN_CAP) { atomicAdd(&(bar)[XB_TMO], 1u); break; } } } } while (0)
struct XcdBarrier { unsigned* bar; unsigned x; volatile LAS unsigned* st; };
__device__ __forceinline__ XcdBarrier xcd_barrier_post(unsigned* bar, volatile LAS unsigned* st) {
    XcdBarrier b; b.bar = bar; b.x = xb_xcc_id(); b.st = st;
    if (threadIdx.x == 0) (void)xb_add(&bar[XB_XCNT(b.x)], 1u);
    return b;
}
__device__ __forceinline__ void xcd_barrier_complete(unsigned* bar, unsigned x, unsigned& nloc, unsigned& nx) {
    const unsigned G = gridDim.x * gridDim.y * gridDim.z;
    unsigned sum, cnt, mine, sp = 0u;
    for (;;) {
        sum = 0u; cnt = 0u; mine = 0u;
#pragma nounroll
        for (unsigned j = 0; j < 16; ++j) { const unsigned c = xb_ld(&bar[XB_XCNT(j)]); sum += c; cnt += (c > 0u) ? 1u : 0u; mine = (j == x) ? c : mine; }
        if (sum == G) break;
        __builtin_amdgcn_s_sleep(1);
        if ((++sp & 255u) == 0u) { if (xb_ld(&bar[XB_TMO])) break; if (sp > XB_SPIN_CAP) { atomicAdd(&bar[XB_TMO], 1u); break; } }
    }
    nloc = mine > 0u ? mine : 1u; nx = cnt > 0u ? cnt : 1u;
}
__device__ __forceinline__ void xcd_barrier(const XcdBarrier& b) {
    asm volatile("s_waitcnt vmcnt(0)" ::: "memory");
    __syncthreads();
    if (threadIdx.x == 0) {
        unsigned* bar = b.bar;
        __builtin_amdgcn_s_waitcnt(0);
        unsigned nloc = b.st[0], nx = b.st[1];
        if (nloc == 0u) { xcd_barrier_complete(bar, b.x, nloc, nx); b.st[0] = nloc; b.st[1] = nx; }
        const unsigned old = xb_add(&bar[XB_XSUB(b.x)], 1u);
        const unsigned gen = old / nloc;
        if (old + 1u == (gen + 1u) * nloc) {
            __builtin_amdgcn_fence(__ATOMIC_RELEASE, "agent");
            asm volatile("s_waitcnt vmcnt(0)" ::: "memory");
            const unsigned og = xb_add(&bar[XB_TOP], 1u);
            const unsigned tg = og / nx;
            if (og + 1u == (tg + 1u) * nx) xb_add(&bar[XB_TOPGEN], 1u);
            else XB_SPIN(xb_ld(&bar[XB_TOPGEN]) == tg, bar);
            __builtin_amdgcn_fence(__ATOMIC_ACQUIRE, "agent");
            xb_add(&bar[XB_XGEN(b.x)], 1u);
            asm volatile("s_waitcnt vmcnt(0)" ::: "memory");
        } else {
            XB_SPIN(xb_ld(&bar[XB_XGEN(b.x)]) == gen, bar);
            __builtin_amdgcn_fence(__ATOMIC_ACQUIRE, "agent");
            asm volatile("s_waitcnt vmcnt(0)" ::: "memory");
        }
    }
    __syncthreads();
}

__global__ void __launch_bounds__(512, 2) fwd_megakernel(Params P_) {
    extern __shared__ __attribute__((aligned(16))) unsigned char lds[];
    cg::grid_group grid = cg::this_grid();
    const int G_ = gridDim.x, c_ = blockIdx.x;
    LAS unsigned char* l3 = (LAS unsigned char*)lds;
    volatile LAS unsigned* misc = (volatile LAS unsigned*)(l3 + LDS_MISC);
    if (threadIdx.x < 64) misc[threadIdx.x] = 0u;
    __syncthreads();
    XcdBarrier xbar = xcd_barrier_post((unsigned*)(P_.ws + WS_BAR), misc + 8);
#if PROBE >= 100
    unsigned long long pt0 = 0, pt1 = 0;
#endif
#pragma nounroll
    for (int ph = 0; ph < 10; ++ph) {
        Params P = P_; int G = G_, c = c_;
        asm volatile("" : "+s"(G), "+s"(c), "+s"(P.ws), "+s"(P.out));
        int gm = -1;
#if PROBE >= 100
        if (ph == PROBE - 100) pt0 = __builtin_amdgcn_s_memrealtime();
        if (ph == PROBE - 99) pt1 = __builtin_amdgcn_s_memrealtime();
#endif
        switch (ph) {
        case 0: ada_phase(P, l3, G); transpose_share(P.in[I_WIN], DM, INW, (bf16_t*)(P.ws + WS_WIN), c, G * 8, l3); transpose_share(P.in[I_WOUT], DM, DM, (bf16_t*)(P.ws + WS_WOUT), c, G * 8, l3); __syncthreads(); gen_tables(P, l3, c, G, 2); __syncthreads();
                break;
        case 1: rows_pass_h(P, G); break;
        case 2: gm = G_IN; break;
        case 3: if (G != 256) gm = G_F1; break;
        case 4: if (G == 256 && c < 64) {
                    gemm_phase(l3, P, G_F1, 64, c);
                    asm volatile("s_waitcnt vmcnt(0)" ::: "memory"); __syncthreads();
                    if (threadIdx.x == 0) {
                        unsigned* f1c = (unsigned*)(P.ws + WS_QCTR) + 64;
                        __builtin_amdgcn_fence(__ATOMIC_RELEASE, "agent"); asm volatile("s_waitcnt vmcnt(0)" ::: "memory");
                        __hip_atomic_fetch_add(f1c, 1u, __ATOMIC_RELAXED, __HIP_MEMORY_SCOPE_AGENT);
                        unsigned sp = 0; while (__hip_atomic_load(f1c, __ATOMIC_RELAXED, __HIP_MEMORY_SCOPE_AGENT) < 64u) { __builtin_amdgcn_s_sleep(2); if (++sp > (1u << 22)) break; }
                        __builtin_amdgcn_fence(__ATOMIC_ACQUIRE, "agent"); asm volatile("s_waitcnt vmcnt(0)" ::: "memory");
                    }
                    __syncthreads();
                }
                gm = G_F2; break;
        case 5: gm = G_OUT; break;
        case 6: if (G != 256) rows_pass<1>(P, G); break;
        case 7: gm = G_UP; break;
        case 8: gm = G_DOWN; break;
        default: if (G != 256) rows_pass<2>(P, G); break;
        }
#ifndef NO_GEMM
        if (gm >= 0) gemm_phase(l3, P, gm, G, c);
#endif
#ifndef NO_ATT
        if (ph == 4) attention_phase(P, lds, G);
#endif
        if (ph == 2) { if (G != 256) transpose_share(P.in[I_W1], DM, DFF, (bf16_t*)(P.ws + WS_W1), c, G * 8, l3);
                       else if (c >= 144) transpose_share(P.in[I_W1], DM, DFF, (bf16_t*)(P.ws + WS_W1), c - 144, 112 * 8, l3); }
        if (ph == 4) { if (G != 256) transpose_share(P.in[I_W2], DFF, DM, (bf16_t*)(P.ws + WS_W2), c, G * 8, l3);
                       else if (c < 64) transpose_share(P.in[I_W2], DFF, DM, (bf16_t*)(P.ws + WS_W2), c, 64 * 8, l3); }
#if PROBE == 3
        if (ph == 7) { __syncthreads(); gemm_phase(l3, P, gm, G, c); }
#endif
#if PROBE == 4
        if (ph == 4) { __syncthreads(); gemm_phase(l3, P, gm, G, c); attention_phase(P, lds, G); }
#endif
        if (G == 0x7fffffff) grid.sync();
        if (ph > 0 && ph < 9 && !(G == 256 && (ph == 3 || ph == 6 || ph == 8))) xcd_barrier(xbar);
    }
#if PROBE >= 100
    if (PROBE - 99 == 10) pt1 = __builtin_amdgcn_s_memrealtime();
    if (blockIdx.x == 0 && threadIdx.x < 64) {
        const unsigned long long te = __builtin_amdgcn_s_memrealtime(), want = 16ull * (pt1 - pt0);
        while (__builtin_amdgcn_s_memrealtime() - te < want) __builtin_amdgcn_s_sleep(8);
    }
#endif
}

extern "C" void kernel_launch(void* const* d_in, const int* in_sizes, int n_in, void* d_out, int out_size, void* d_ws, size_t ws_size, hipStream_t stream) {
    static int grid_blocks = 0;
    if (grid_blocks == 0) {
        if (n_in != 16 || out_size != MTOK * DM || ws_size < WS_END) { fprintf(stderr, "kernel_launch: unexpected shapes (n_in %d out %d ws %zu)\n", n_in, out_size, ws_size); grid_blocks = -1; return; }
        int dev = 0, cus = 0, per_cu = 0;
        (void)hipGetDevice(&dev);
        (void)hipDeviceGetAttribute(&cus, hipDeviceAttributeMultiprocessorCount, dev);
        if (hipFuncSetAttribute((const void*)fwd_megakernel, hipFuncAttributeMaxDynamicSharedMemorySize, LDS_BYTES) != hipSuccess) { fprintf(stderr, "kernel_launch: hipFuncSetAttribute failed\n"); grid_blocks = -1; return; }
        if (hipOccupancyMaxActiveBlocksPerMultiprocessor(&per_cu, (const void*)fwd_megakernel, 512, LDS_BYTES) != hipSuccess || per_cu < 1) { fprintf(stderr, "kernel_launch: occupancy query failed (%d)\n", per_cu); per_cu = 1; }
        (void)hipGetLastError();
        grid_blocks = cus;
    }
    if (grid_blocks < 0) return;
    (void)hipMemsetAsync((char*)d_ws + WS_MOD, 0, WS_CTL_BYTES, stream);
    Params p{};
    for (int i = 0; i < 16; ++i) p.in[i] = (const float*)d_in[i];
    p.out = (float*)d_out; p.ws = (unsigned char*)d_ws;
    void* args[] = {&p};
    hipError_t e = hipLaunchCooperativeKernel((const void*)fwd_megakernel, dim3(grid_blocks), dim3(512), args, LDS_BYTES, stream);
    if (e != hipSuccess) fprintf(stderr, "cooperative launch failed: %s (grid %d)\n", hipGetErrorString(e), grid_blocks);
}
#ifdef TEST_KERNELS
__global__ void __launch_bounds__(512, 2) t_att(Params P) { extern __shared__ __attribute__((aligned(16))) unsigned char lds[]; attention_phase(P, lds, gridDim.x); }
__global__ void __launch_bounds__(512, 2) t_gemm(Params P, int mode) { extern __shared__ __attribute__((aligned(16))) unsigned char lds[]; gemm_phase((LAS unsigned char*)lds, P, mode, gridDim.x, blockIdx.x); }
__global__ void __launch_bounds__(512, 2) t_gemm_up(Params P) { extern __shared__ __attribute__((aligned(16))) unsigned char lds[]; gemm_phase((LAS unsigned char*)lds, P, G_UP, gridDim.x, blockIdx.x); }
__global__ void __launch_bounds__(512, 2) t_gemm_out(Params P) { extern __shared__ __attribute__((aligned(16))) unsigned char lds[]; gemm_phase((LAS unsigned char*)lds, P, G_OUT, gridDim.x, blockIdx.x); }
#endif
```
